# Optimizing an MI355X kernel written in HIP

```python
import jax, jax.numpy as jnp
from jax import lax
import numpy as np

D_MODEL = 1024
BATCH = 8
SEQ = 8192
DEPTH = 4

CHUNK = 64
N_A_LAYERS = DEPTH // 2
N_B_LAYERS = DEPTH - N_A_LAYERS
A_HEADS = 8
A_KEY_DIM = 128
A_VAL_DIM = D_MODEL // A_HEADS
A_FORGET_DIM = A_HEADS * A_KEY_DIM
A_IN_DIM = 2 * A_FORGET_DIM + 2 * D_MODEL
B_HEADS = 16
B_HEAD_DIM = D_MODEL // B_HEADS
B_DIM = B_HEADS * B_HEAD_DIM
B_PAST_CHUNKS = 8
B_BAND = (B_PAST_CHUNKS + 1) * CHUNK
REL_CLIP = 256
N_REL = REL_CLIP + CHUNK
FFN_DIM = -(-8 * D_MODEL // (3 * 256)) * 256
NORM_EPS = 1e-6
N_MOD = 6
MASK_VALUE = -1e30
MIN_FORGET = 1e-30

kernel_name = "yoco_hgrn2_chunk_band_attention_trunk"


def rms_norm(x, gain):
    xf = x.astype(jnp.float32)
    y = xf * lax.rsqrt(jnp.mean(xf * xf, axis=-1, keepdims=True) + NORM_EPS)
    return (y * gain.astype(jnp.float32)).astype(x.dtype)


def modulate(x, shift, scale):
    return x * (1 + scale[:, None, :]) + shift[:, None, :]


def swiglu(u, w_in, w_out):
    gate, up = jnp.split(u @ w_in, 2, axis=-1)
    return (jax.nn.silu(gate) * up) @ w_out


def hgrn2_mixer(u, w_in, w_out, lb, o_gain):
    bsz, seq, _ = u.shape
    n_chunks = seq // CHUNK
    q, z_f, v, g = jnp.split(u @ w_in, [A_FORGET_DIM, 2 * A_FORGET_DIM, 2 * A_FORGET_DIM + D_MODEL], axis=-1)
    q = jax.nn.silu(q)
    zf = z_f.astype(jnp.float32)
    lbf = lb.astype(jnp.float32)
    sig = jax.nn.sigmoid(zf)
    f = lbf + (1 - lbf) * sig
    log_f = jnp.log(jnp.maximum(f, MIN_FORGET))
    k = (1 - lbf) * (1 - sig)

    def to_chunks(t, d):
        return t.astype(jnp.float32).reshape(bsz, n_chunks, CHUNK, A_HEADS, d).transpose(1, 0, 2, 3, 4)

    xs = (to_chunks(q, A_KEY_DIM), to_chunks(k, A_KEY_DIM), to_chunks(v, A_VAL_DIM), to_chunks(log_f, A_KEY_DIM))
    causal = jnp.tril(jnp.ones((CHUNK, CHUNK), dtype=bool))

    def step(state, chunk):
        qc, kc, vc, lfc = chunk
        b = jnp.cumsum(lfc, axis=1)
        diff = b[:, :, None] - b[:, None, :]
        decay = jnp.exp(jnp.where(causal[None, :, :, None, None], diff, MASK_VALUE))
        attn = jnp.einsum('bthd,btshd,bshd->bhts', qc, decay, kc)
        o = (jnp.einsum('bhts,bshv->bthv', attn, vc)
             + jnp.einsum('bthd,bhdv->bthv', qc * jnp.exp(b), state))
        b_last = b[:, -1]
        state = (jnp.exp(b_last)[..., None] * state
                 + jnp.einsum('bshd,bshv->bhdv', kc * jnp.exp(b_last[:, None] - b), vc))
        return state, o

    state0 = jnp.zeros((bsz, A_HEADS, A_KEY_DIM, A_VAL_DIM), jnp.float32)
    _, o = lax.scan(step, state0, xs)
    o = o.transpose(1, 0, 2, 3, 4).reshape(bsz, seq, A_HEADS, A_VAL_DIM)
    o = o * lax.rsqrt(jnp.mean(o * o, axis=-1, keepdims=True) + NORM_EPS) * o_gain.astype(jnp.float32)
    o = o * jax.nn.silu(g.astype(jnp.float32)).reshape(bsz, seq, A_HEADS, A_VAL_DIM)
    return o.reshape(bsz, seq, D_MODEL).astype(u.dtype) @ w_out


def shared_kv(h, c_act, gain, mod_w, mod_b, w_kv):
    bsz, seq, _ = h.shape
    shift, scale = jnp.split(c_act @ mod_w + mod_b, 2, axis=-1)
    u = modulate(rms_norm(h, gain), shift, scale)
    k, v = jnp.split(u @ w_kv, 2, axis=-1)
    pad = ((0, 0), (B_PAST_CHUNKS * CHUNK, 0), (0, 0), (0, 0))
    k = jnp.pad(k.reshape(bsz, seq, B_HEADS, B_HEAD_DIM), pad)
    v = jnp.pad(v.reshape(bsz, seq, B_HEADS, B_HEAD_DIM), pad)
    return k, v


def chunk_band_attention(u, k_pad, v_pad, w_q, w_o, rel_bias):
    bsz, seq, _ = u.shape
    n_chunks = seq // CHUNK
    q = (u @ w_q).reshape(bsz, n_chunks, CHUNK, B_HEADS, B_HEAD_DIM).transpose(1, 0, 2, 3, 4)
    q_pos = jnp.arange(CHUNK)[:, None] + B_PAST_CHUNKS * CHUNK
    k_pos = jnp.arange(B_BAND)
    rel = jnp.clip(k_pos[None, :] - q_pos, -REL_CLIP, CHUNK - 1) + REL_CLIP
    bias = rel_bias.astype(jnp.float32)[rel].transpose(2, 0, 1)
    scale = B_HEAD_DIM ** -0.5

    def one_chunk(args):
        qc, idx = args
        kb = lax.dynamic_slice_in_dim(k_pad, idx * CHUNK, B_BAND, axis=1)
        vb = lax.dynamic_slice_in_dim(v_pad, idx * CHUNK, B_BAND, axis=1)
        s = jnp.einsum('bqhd,bkhd->bhqk', qc, kb).astype(jnp.float32) * scale + bias
        valid = k_pos >= (B_PAST_CHUNKS - idx) * CHUNK
        s = jnp.where(valid, s, MASK_VALUE)
        p = jax.nn.softmax(s, axis=-1).astype(vb.dtype)
        return jnp.einsum('bhqk,bkhd->bqhd', p, vb)

    o = lax.map(one_chunk, (q, jnp.arange(n_chunks)))
    o = o.transpose(1, 0, 2, 3, 4).reshape(bsz, seq, B_DIM)
    return o @ w_o


def setup_inputs(seed: int = 0) -> dict:
    key = jax.random.key(seed)
    ks = jax.random.split(key, 24)
    f32 = jnp.float32
    nrm = lambda k, shape, s: jax.random.normal(k, shape, f32) * s
    D = D_MODEL
    return {
        "x": nrm(ks[0], (BATCH, SEQ, D), 1.0),
        "c": nrm(ks[1], (BATCH, D), 1.0),
        "mod_w": nrm(ks[2], (DEPTH, D, N_MOD * D), 0.5 * D ** -0.5),
        "mod_b": nrm(ks[3], (DEPTH, N_MOD * D), 0.02),
        "norm_mix": 1.0 + nrm(ks[4], (DEPTH, D), 0.02),
        "norm_ffn": 1.0 + nrm(ks[5], (DEPTH, D), 0.02),
        "ffn_w_in": nrm(ks[6], (DEPTH, D, 2 * FFN_DIM), D ** -0.5),
        "ffn_w_out": nrm(ks[7], (DEPTH, FFN_DIM, D), FFN_DIM ** -0.5),
        "a_w_in": nrm(ks[8], (N_A_LAYERS, D, A_IN_DIM), D ** -0.5),
        "a_w_out": nrm(ks[9], (N_A_LAYERS, D, D), D ** -0.5),
        "a_lb": nrm(ks[10], (N_A_LAYERS, A_FORGET_DIM), 1.0),
        "a_out_norm": 1.0 + nrm(ks[11], (N_A_LAYERS, A_VAL_DIM), 0.02),
        "kv_norm": 1.0 + nrm(ks[12], (D,), 0.02),
        "kv_mod_w": nrm(ks[13], (D, 2 * D), 0.5 * D ** -0.5),
        "kv_mod_b": nrm(ks[14], (2 * D,), 0.02),
        "kv_w": nrm(ks[15], (D, 2 * B_DIM), D ** -0.5),
        "b_w_q": nrm(ks[16], (N_B_LAYERS, D, B_DIM), D ** -0.5),
        "b_w_o": nrm(ks[17], (N_B_LAYERS, B_DIM, D), B_DIM ** -0.5),
        "b_rel_bias": nrm(ks[18], (N_B_LAYERS, N_REL, B_HEADS), 0.5),
        "final_norm": 1.0 + nrm(ks[19], (D,), 0.02),
    }


def reference(x, c, mod_w, mod_b, norm_mix, norm_ffn, ffn_w_in, ffn_w_out,
              a_w_in, a_w_out, a_lb, a_out_norm,
              kv_norm, kv_mod_w, kv_mod_b, kv_w,
              b_w_q, b_w_o, b_rel_bias, final_norm):
    c_act = jax.nn.silu(c)
    sm = jax.nn.softmax(a_lb.astype(jnp.float32), axis=0)
    lower_bounds = jnp.cumsum(sm, axis=0) - sm[0]
    h = x
    k_pad = None
    v_pad = None
    for layer in range(DEPTH):
        mod = c_act @ mod_w[layer] + mod_b[layer]
        sh1, sc1, g1, sh2, sc2, g2 = jnp.split(mod, N_MOD, axis=-1)
        u = modulate(rms_norm(h, norm_mix[layer]), sh1, sc1)
        if layer < N_A_LAYERS:
            mix = hgrn2_mixer(u, a_w_in[layer], a_w_out[layer], lower_bounds[layer], a_out_norm[layer])
        else:
            j = layer - N_A_LAYERS
            mix = chunk_band_attention(u, k_pad, v_pad, b_w_q[j], b_w_o[j], b_rel_bias[j])
        h = h + g1[:, None, :] * mix
        u = modulate(rms_norm(h, norm_ffn[layer]), sh2, sc2)
        h = h + g2[:, None, :] * swiglu(u, ffn_w_in[layer], ffn_w_out[layer])
        if layer == N_A_LAYERS - 1:
            k_pad, v_pad = shared_kv(h, c_act, kv_norm, kv_mod_w, kv_mod_b, kv_w)
    return rms_norm(h, final_norm)
```

```cpp
#include <hip/hip_runtime.h>
#include <hip/hip_cooperative_groups.h>
#include <cstdio>
namespace cg = cooperative_groups;

#define LAS __attribute__((address_space(3)))
typedef unsigned short bf16_t;
typedef short bf16x8 __attribute__((ext_vector_type(8)));
typedef float f32x4 __attribute__((ext_vector_type(4)));
typedef unsigned u32x4 __attribute__((ext_vector_type(4)));
typedef unsigned u32x2 __attribute__((ext_vector_type(2)));

constexpr int D = 1024, BATCH = 8, SEQ = 8192, MTOK = BATCH * SEQ, FFN = 2816, AIN = 4096;
constexpr int LDS_BYTES = 144 * 1024;

__device__ __forceinline__ unsigned cvt_pk_bf16(float lo, float hi) { unsigned r; asm volatile("v_cvt_pk_bf16_f32 %0, %1, %2" : "=v"(r) : "v"(lo), "v"(hi)); return r; }
__device__ __forceinline__ float bf2f(unsigned short h) { return __uint_as_float((unsigned)h << 16); }
__device__ __forceinline__ float bflo(unsigned w) { return __uint_as_float(w << 16); }
__device__ __forceinline__ float bfhi(unsigned w) { return __uint_as_float(w & 0xffff0000u); }
__device__ __forceinline__ float silu_f(float x) { return x * __builtin_amdgcn_rcpf(1.0f + __expf(-x)); }

__device__ __forceinline__ int opaque_tid() { int t = threadIdx.x; asm volatile("" : "+v"(t)); return t; }
struct WGroup { const float* src; bf16_t* dst; int K, N, L, mode; };

struct Params {
    const float *x, *c, *mod_w, *mod_b, *norm_mix, *norm_ffn, *ffn_w_in, *ffn_w_out, *a_w_in, *a_w_out, *a_lb, *a_out_norm,
                *kv_norm, *kv_mod_w, *kv_mod_b, *kv_w, *b_w_q, *b_w_o, *b_rel_bias, *final_norm;
    float* h;
    bf16_t *wb_a_in, *wb_a_out, *wb_ffn_in, *wb_ffn_out, *wb_kv, *wb_q, *wb_o;
    float *modv, *kvmod, *lbv;
    bf16_t *U, *U2, *Qh, *Vh, *Gh;
    float* LF;
    bf16_t *ACT, *Kb, *Vb, *Qb;
    WGroup wg[7];
};

namespace pg8 {
constexpr int BM = 256, BK = 64, HALF = 128, HTB = HALF * BK * 2, STAGE_BYTES = 8 * HTB, NXCD = 8, WGM = 8;
__device__ __forceinline__ int lds_byte(int r, int c) { const int st = (r >> 4) * 2 + (c >> 5), rr = r & 15, cc = c & 31, ob = rr * 64 + cc * 2; return st * 1024 + (ob ^ (((ob >> 9) & 1) << 5)); }
__device__ __forceinline__ void stage_rc(int b, int& R, int& C) { const int st = b / 1024, sb = b % 1024, swz = sb ^ (((sb >> 9) & 1) << 5); R = (st >> 1) * 16 + swz / 64; C = (st & 1) * 32 + (swz % 64) / 2; }
__device__ __forceinline__ int perm32(int rho) { const int n = rho >> 4, i = rho & 15; return 8 * (i >> 2) + 4 * n + (i & 3); }
struct Unit { int pm, pn; };
struct Gemm { const bf16_t* A; const bf16_t* Bt; int M, N, K; };
struct StaticOrder {
    int nM, nN, nwg, G, c;
    __device__ void init(int M, int N, int G_, int c_) { nM = M / BM; nN = N / BM; nwg = nM * nN; G = G_; c = c_; }
    __device__ bool next(int i, Unit& u) const {
        const long L = (long)i * G + c; if (L >= nwg) return false;
        int wgid = (int)L; { const int q = nwg / NXCD, r = nwg % NXCD, xcd = wgid % NXCD, off = wgid / NXCD; wgid = (xcd < r ? xcd * (q + 1) : r * (q + 1) + (xcd - r) * q) + off; }
        const int nig = WGM * nN, gid = wgid / nig, fm = gid * WGM, gsz = (nM - fm) < WGM ? (nM - fm) : WGM;
        u.pm = fm + ((wgid % nig) % gsz); u.pn = (wgid % nig) / gsz; return true;
    }
};

template <class Epi>
__device__ __forceinline__ void gemm_phase(LAS unsigned char* lds, const Gemm g, const StaticOrder& S, const Epi& E) {
    const int tid = opaque_tid(), wid = __builtin_amdgcn_readfirstlane(tid >> 6), lane = tid & 63, wr = wid >> 2, wc = wid & 3, fr = lane & 15, fq = lane >> 4;
    const int K = g.K, nt = K / BK;
    unsigned voffA[2], voffB[2];
#pragma unroll
    for (int i = 0; i < 2; ++i) { int R, C; stage_rc(tid * 16 + i * 8192, R, C); const int Rb = Epi::PERM ? ((R & ~31) + perm32(R & 31)) : R;
        voffA[i] = (unsigned)(R * K + C) * 2u; voffB[i] = (unsigned)(Rb * K + C) * 2u; }
    const size_t kstep = (size_t)(BK * 2);
    const size_t hstep = (size_t)HALF * K * 2;
    const size_t tstep = 2 * hstep;
    const unsigned ldsw = (unsigned)wid * 1024u;
    const int aoff = lds_byte(wr * 64 + fr, fq * 8), boff = lds_byte(wc * 32 + fr, fq * 8);
#define PG8_SA(b, h) (((b) * 2 + (h)) * HTB)
#define PG8_SB(b, h) ((4 + (b) * 2 + (h)) * HTB)
#define PG8_STAGE(bufoff, gbase, voff) do { _Pragma("unroll") for (int _i = 0; _i < 2; ++_i) \
        __builtin_amdgcn_global_load_lds((const unsigned*)((const char*)(gbase) + (voff)[_i]), (LAS unsigned*)(lds + (bufoff) + ldsw + _i * 8192), 16, 0, 0); } while (0)
#define PG8_LDA(dst, b, h) do { _Pragma("unroll") for (int m = 0; m < 4; ++m) _Pragma("unroll") for (int k = 0; k < 2; ++k) dst[m][k] = *(const LAS bf16x8*)(lds + PG8_SA(b, h) + aoff + m * 2048 + k * 1024); } while (0)
#define PG8_LDB(dst, b, h) do { _Pragma("unroll") for (int n = 0; n < 2; ++n) _Pragma("unroll") for (int k = 0; k < 2; ++k) dst[n][k] = *(const LAS bf16x8*)(lds + PG8_SB(b, h) + boff + n * 2048 + k * 1024); } while (0)
#define PG8_MMA(ai, bj, At, Bt) do { __builtin_amdgcn_s_setprio(1); _Pragma("unroll") for (int m = 0; m < 4; ++m) _Pragma("unroll") for (int n = 0; n < 2; ++n) _Pragma("unroll") for (int k = 0; k < 2; ++k) \
        acc[ai][bj][m][n] = __builtin_amdgcn_mfma_f32_16x16x32_bf16(Bt[n][k], At[m][k], acc[ai][bj][m][n], 0, 0, 0); __builtin_amdgcn_s_setprio(0); } while (0)
#define PG8_WAIT_V(n) asm volatile("s_waitcnt vmcnt(" #n ")" ::: "memory")
#define PG8_WAIT_L(n) asm volatile("s_waitcnt lgkmcnt(" #n ")" ::: "memory")
#define PG8_BAR __builtin_amdgcn_s_barrier()
#define PG8_SCHED __builtin_amdgcn_sched_barrier(0)
    Unit cur, nxt; int ui = 0;
    if (!S.next(0, cur)) return;
    f32x4 acc[2][2][4][2];
#pragma unroll
    for (int a = 0; a < 2; ++a)
#pragma unroll
        for (int b = 0; b < 2; ++b)
#pragma unroll
            for (int m = 0; m < 4; ++m)
#pragma unroll
                for (int n = 0; n < 2; ++n) acc[a][b][m][n] = (f32x4){0.f, 0.f, 0.f, 0.f};
    bf16x8 At[4][2], B0[2][2], B1[2][2];
    const char* cA = (const char*)g.A + (size_t)cur.pm * tstep; const char* cB = (const char*)g.Bt + (size_t)cur.pn * tstep;
    PG8_STAGE(PG8_SB(0, 0), cB, voffB); PG8_STAGE(PG8_SA(0, 0), cA, voffA); PG8_STAGE(PG8_SB(0, 1), cB + hstep, voffB); PG8_STAGE(PG8_SA(0, 1), cA + hstep, voffA);
    if (wr == 1) PG8_BAR;
    PG8_WAIT_V(4); PG8_BAR;
    PG8_STAGE(PG8_SB(1, 0), cB + kstep, voffB); PG8_STAGE(PG8_SA(1, 0), cA + kstep, voffA); PG8_STAGE(PG8_SB(1, 1), cB + hstep + kstep, voffB);
    PG8_WAIT_V(6); PG8_BAR;
    for (;;) {
        const bool has_next = S.next(ui + 1, nxt);
        const char* nA = has_next ? (const char*)g.A + (size_t)nxt.pm * tstep : cA; const char* nB = has_next ? (const char*)g.Bt + (size_t)nxt.pn * tstep : cB;
        for (int t = 0; t < nt; t += 2) {
            const bool last = (t == nt - 2);
            const char* a1 = cA + (size_t)(t + 1) * kstep;
            const char* a2 = last ? nA : cA + (size_t)(t + 2) * kstep; const char* b2 = last ? nB : cB + (size_t)(t + 2) * kstep;
            const char* a3 = a2 + kstep; const char* b3 = b2 + kstep;
            PG8_LDB(B0, 0, 0); PG8_SCHED; PG8_LDA(At, 0, 0); PG8_STAGE(PG8_SA(1, 1), a1 + hstep, voffA);
            PG8_WAIT_L(8); PG8_BAR; PG8_WAIT_L(0); PG8_MMA(0, 0, At, B0); PG8_BAR; PG8_SCHED;
            PG8_LDB(B1, 0, 1); PG8_STAGE(PG8_SB(0, 0), b2, voffB);
            PG8_BAR; PG8_WAIT_L(0); PG8_MMA(0, 1, At, B1); PG8_BAR;
            PG8_LDA(At, 0, 1); PG8_STAGE(PG8_SA(0, 0), a2, voffA);
            PG8_BAR; PG8_WAIT_L(0); PG8_MMA(1, 0, At, B0); PG8_BAR; PG8_SCHED;
            PG8_STAGE(PG8_SB(0, 1), b2 + hstep, voffB);
            PG8_WAIT_V(6); PG8_BAR; PG8_MMA(1, 1, At, B1); PG8_BAR;
            PG8_LDB(B0, 1, 0); PG8_SCHED; PG8_LDA(At, 1, 0); PG8_STAGE(PG8_SA(0, 1), a2 + hstep, voffA);
            PG8_WAIT_L(8); PG8_BAR; PG8_WAIT_L(0); PG8_MMA(0, 0, At, B0); PG8_BAR; PG8_SCHED;
            PG8_LDB(B1, 1, 1); PG8_STAGE(PG8_SB(1, 0), b3, voffB);
            PG8_BAR; PG8_WAIT_L(0); PG8_MMA(0, 1, At, B1); PG8_BAR;
            PG8_LDA(At, 1, 1); PG8_STAGE(PG8_SA(1, 0), a3, voffA);
            PG8_BAR; PG8_WAIT_L(0); PG8_MMA(1, 0, At, B0); PG8_BAR; PG8_SCHED;
            PG8_STAGE(PG8_SB(1, 1), b3 + hstep, voffB);
            PG8_WAIT_V(6); PG8_BAR; PG8_MMA(1, 1, At, B1); PG8_BAR;
        }
        E(acc, cur, wr, wc, fr, fq);
        if (!has_next) break;
#pragma unroll
        for (int a = 0; a < 2; ++a)
#pragma unroll
            for (int b = 0; b < 2; ++b)
#pragma unroll
                for (int m = 0; m < 4; ++m)
#pragma unroll
                    for (int n = 0; n < 2; ++n) acc[a][b][m][n] = (f32x4){0.f, 0.f, 0.f, 0.f};
        cur = nxt; cA = nA; cB = nB; ++ui;
    }
    PG8_WAIT_V(0);
    if (wr == 0) PG8_BAR;
    PG8_BAR;
#undef PG8_SA
#undef PG8_SB
#undef PG8_STAGE
#undef PG8_LDA
#undef PG8_LDB
#undef PG8_MMA
#undef PG8_WAIT_V
#undef PG8_WAIT_L
#undef PG8_BAR
#undef PG8_SCHED
}

struct EpiHgrnIn {
    static constexpr bool PERM = true;
    bf16_t* QVG; float* LF; const float* lb;
    __device__ __forceinline__ void operator()(const f32x4 (&acc)[2][2][4][2], const Unit& u, int wr, int wc, int fr, int fq) const {
        const int seg = u.pn >> 2, colt = (u.pn & 3) * 256;
        const int row0 = u.pm * BM + wr * 64 + fr, col0 = colt + wc * 32 + 8 * fq;
        if (seg == 1) {
#pragma unroll
            for (int bj = 0; bj < 2; ++bj) {
                const f32x4 l0 = *(const f32x4*)(lb + col0 + bj * HALF), l1 = *(const f32x4*)(lb + col0 + bj * HALF + 4);
#pragma unroll
                for (int ai = 0; ai < 2; ++ai)
#pragma unroll
                    for (int m = 0; m < 4; ++m) {
                        float* rowp = LF + (size_t)(row0 + ai * HALF + m * 16) * D + col0 + bj * HALF;
                        f32x4 o0, o1;
#pragma unroll
                        for (int j = 0; j < 4; ++j) {
                            float z = acc[ai][bj][m][0][j]; float sg = __builtin_amdgcn_rcpf(1.0f + __expf(-z)); float f = l0[j] + (1.0f - l0[j]) * sg; o0[j] = logf(fmaxf(f, 1e-30f));
                            z = acc[ai][bj][m][1][j]; sg = __builtin_amdgcn_rcpf(1.0f + __expf(-z)); f = l1[j] + (1.0f - l1[j]) * sg; o1[j] = logf(fmaxf(f, 1e-30f));
                        }
                        *(f32x4*)rowp = o0; *(f32x4*)(rowp + 4) = o1;
                    }
            }
        } else {
            bf16_t* base = QVG + (size_t)(seg == 0 ? 0 : (seg == 2 ? 1 : 2)) * ((size_t)MTOK * D);
            const bool act = (seg != 2);
#pragma unroll
            for (int ai = 0; ai < 2; ++ai)
#pragma unroll
                for (int m = 0; m < 4; ++m)
#pragma unroll
                    for (int bj = 0; bj < 2; ++bj) {
                        f32x4 v0 = acc[ai][bj][m][0], v1 = acc[ai][bj][m][1];
                        if (act) {
#pragma unroll
                            for (int j = 0; j < 4; ++j) { v0[j] = silu_f(v0[j]); v1[j] = silu_f(v1[j]); }
                        }
                        u32x4 w; w.x = cvt_pk_bf16(v0[0], v0[1]); w.y = cvt_pk_bf16(v0[2], v0[3]); w.z = cvt_pk_bf16(v1[0], v1[1]); w.w = cvt_pk_bf16(v1[2], v1[3]);
                        *(u32x4*)(base + (size_t)(row0 + ai * HALF + m * 16) * D + col0 + bj * HALF) = w;
                    }
        }
    }
};
struct EpiResid {
    static constexpr bool PERM = true;
    const float* src; float* dst; const float* gate;
    __device__ __forceinline__ void operator()(const f32x4 (&acc)[2][2][4][2], const Unit& u, int wr, int wc, int fr, int fq) const {
        const int b = u.pm >> 5;
        const float* gp = gate + (size_t)b * 6144;
        const int row0 = u.pm * BM + wr * 64 + fr, col0 = u.pn * BM + wc * 32 + 8 * fq;
        f32x4 gv[2][2];
#pragma unroll
        for (int bj = 0; bj < 2; ++bj)
#pragma unroll
            for (int n = 0; n < 2; ++n) gv[bj][n] = *(const f32x4*)(gp + col0 + bj * HALF + 4 * n);
#pragma unroll
        for (int ai = 0; ai < 2; ++ai)
#pragma unroll
            for (int m = 0; m < 4; ++m) {
                const size_t ro = (size_t)(row0 + ai * HALF + m * 16) * D + col0;
#pragma unroll
                for (int bj = 0; bj < 2; ++bj)
#pragma unroll
                    for (int n = 0; n < 2; ++n) {
                        const f32x4 s = *(const f32x4*)(src + ro + bj * HALF + 4 * n);
                        *(f32x4*)(dst + ro + bj * HALF + 4 * n) = s + gv[bj][n] * acc[ai][bj][m][n];
                    }
            }
    }
};
struct EpiSwiglu {
    static constexpr bool PERM = true;
    bf16_t* act;
    __device__ __forceinline__ void operator()(const f32x4 (&acc)[2][2][4][2], const Unit& u, int wr, int wc, int fr, int fq) const {
        const int row0 = u.pm * BM + wr * 64 + fr, col0 = u.pn * HALF + wc * 32 + 8 * fq;
#pragma unroll
        for (int ai = 0; ai < 2; ++ai)
#pragma unroll
            for (int m = 0; m < 4; ++m) {
                f32x4 r0, r1;
#pragma unroll
                for (int j = 0; j < 4; ++j) { r0[j] = silu_f(acc[ai][0][m][0][j]) * acc[ai][1][m][0][j]; r1[j] = silu_f(acc[ai][0][m][1][j]) * acc[ai][1][m][1][j]; }
                u32x4 w; w.x = cvt_pk_bf16(r0[0], r0[1]); w.y = cvt_pk_bf16(r0[2], r0[3]); w.z = cvt_pk_bf16(r1[0], r1[1]); w.w = cvt_pk_bf16(r1[2], r1[3]);
                *(u32x4*)(act + (size_t)(row0 + ai * HALF + m * 16) * FFN + col0) = w;
            }
    }
};
struct EpiBf16Split {
    static constexpr bool PERM = true;
    bf16_t* d0; float scale;
    __device__ __forceinline__ void operator()(const f32x4 (&acc)[2][2][4][2], const Unit& u, int wr, int wc, int fr, int fq) const {
        bf16_t* base = d0 + (size_t)(u.pn >> 2) * ((size_t)MTOK * D);
        const int row0 = u.pm * BM + wr * 64 + fr, col0 = (u.pn & 3) * 256 + wc * 32 + 8 * fq;
#pragma unroll
        for (int ai = 0; ai < 2; ++ai)
#pragma unroll
            for (int m = 0; m < 4; ++m)
#pragma unroll
                for (int bj = 0; bj < 2; ++bj) {
                    const f32x4 v0 = acc[ai][bj][m][0] * scale, v1 = acc[ai][bj][m][1] * scale;
                    u32x4 w; w.x = cvt_pk_bf16(v0[0], v0[1]); w.y = cvt_pk_bf16(v0[2], v0[3]); w.z = cvt_pk_bf16(v1[0], v1[1]); w.w = cvt_pk_bf16(v1[2], v1[3]);
                    *(u32x4*)(base + (size_t)(row0 + ai * HALF + m * 16) * D + col0 + bj * HALF) = w;
                }
    }
};
}

template <class Epi>
__device__ __forceinline__ void run_gemm(unsigned char* shm, const bf16_t* A, const bf16_t* Bt, int N, int K, const Epi& E) {
    pg8::Gemm g; g.A = A; g.Bt = Bt; g.M = MTOK; g.N = N; g.K = K;
    pg8::StaticOrder S; S.init(MTOK, N, (int)gridDim.x, (int)blockIdx.x);
    pg8::gemm_phase<Epi>((LAS unsigned char*)shm, g, S, E);
    __syncthreads();
}

__device__ __forceinline__ int ffnmap(int nn) { return nn < FFN ? ((nn >> 7) * 256 + (nn & 127)) : (((nn - FFN) >> 7) * 256 + 128 + ((nn - FFN) & 127)); }

__device__ void prep_phase(const Params& p, unsigned char* shm) {
    const int tid = opaque_tid();
    {
        float* cact = (float*)shm;
        float* red = cact + 8192;
        bool loaded = false;
        const int wv = tid >> 6, lane = tid & 63;
        for (int task = blockIdx.x; task < 416; task += gridDim.x) {
            if (!loaded) {
                for (int i = tid; i < 8192; i += 512) { const int k = i >> 3, b = i & 7; cact[i] = silu_f(p.c[b * D + k]); }
                loaded = true;
            }
            __syncthreads();
            const int c0 = task * 64;
            const float* src; const float* bias; float* dst; int stride, dstride;
            if (c0 < 24576) { const int l = c0 / 6144, j = c0 % 6144; src = p.mod_w + (size_t)l * D * 6144 + j; stride = 6144; bias = p.mod_b + l * 6144 + j; dst = p.modv + (size_t)l * 8 * 6144 + j; dstride = 6144; }
            else { const int j = c0 - 24576; src = p.kv_mod_w + j; stride = 2048; bias = p.kv_mod_b + j; dst = p.kvmod + j; dstride = 2048; }
            float a[8];
#pragma unroll
            for (int b = 0; b < 8; ++b) a[b] = 0.f;
            const float* sp = src + (size_t)(wv * 128) * stride + lane;
#pragma unroll 8
            for (int k = 0; k < 128; ++k) {
                const float w = sp[(size_t)k * stride];
                const f32x4 c0v = *(const f32x4*)(cact + (wv * 128 + k) * 8), c1v = *(const f32x4*)(cact + (wv * 128 + k) * 8 + 4);
                a[0] += w * c0v[0]; a[1] += w * c0v[1]; a[2] += w * c0v[2]; a[3] += w * c0v[3];
                a[4] += w * c1v[0]; a[5] += w * c1v[1]; a[6] += w * c1v[2]; a[7] += w * c1v[3];
            }
#pragma unroll
            for (int b = 0; b < 8; ++b) red[(wv * 8 + b) * 64 + lane] = a[b];
            __syncthreads();
            {
                const int b = tid >> 6, col = tid & 63;
                float s = bias[col];
#pragma unroll
                for (int w = 0; w < 8; ++w) s += red[(w * 8 + b) * 64 + col];
                dst[(size_t)b * dstride + col] = s;
            }
        }
        __syncthreads();
    }
    for (int i = blockIdx.x * 512 + tid; i < 1024; i += gridDim.x * 512) {
        const float a0 = p.a_lb[i], a1 = p.a_lb[1024 + i];
        const float mx = fmaxf(a0, a1), e0 = __expf(a0 - mx), e1 = __expf(a1 - mx);
        p.lbv[i] = 0.f; p.lbv[1024 + i] = e1 / (e0 + e1);
    }
    {
        float* st = (float*)shm;
        int total = 0;
        for (int g = 0; g < 7; ++g) total += p.wg[g].L * (p.wg[g].K / 64) * (p.wg[g].N / 64);
        for (int tile = blockIdx.x; tile < total; tile += gridDim.x) {
            int g = 0, rem = tile;
            for (;;) { const int cnt = p.wg[g].L * (p.wg[g].K / 64) * (p.wg[g].N / 64); if (rem < cnt) break; rem -= cnt; ++g; }
            const int K = p.wg[g].K, N = p.wg[g].N, mode = p.wg[g].mode;
            const int per = (K / 64) * (N / 64), l = rem / per, tt = rem % per, ntn = N / 64, k0 = (tt / ntn) * 64, n0 = (tt % ntn) * 64;
            const float* src = p.wg[g].src + (size_t)l * K * N; bf16_t* dst = p.wg[g].dst + (size_t)l * K * N;
            __syncthreads();
            for (int i = tid; i < 4096; i += 512) { const int k = i >> 6, n = i & 63; st[k * 65 + n] = src[(size_t)(k0 + k) * N + n0 + n]; }
            __syncthreads();
            for (int i = tid; i < 2048; i += 512) { const int n = i >> 5, kp = i & 31; const int nn = n0 + n; const int drow = mode ? ffnmap(nn) : nn;
                *(unsigned*)(dst + (size_t)drow * K + k0 + 2 * kp) = cvt_pk_bf16(st[(2 * kp) * 65 + n], st[(2 * kp + 1) * 65 + n]); }
        }
        __syncthreads();
    }
}

__device__ void norm_phase(const float* src, bf16_t* U1, const float* gain1, const float* sh1, const float* sc1, int bs1,
                           bf16_t* U2, const float* gain2, const float* sh2, const float* sc2, int bs2) {
    const int tid_ = opaque_tid(); const int lane = tid_ & 63, gw = blockIdx.x * 8 + (tid_ >> 6), nw = gridDim.x * 8;
    for (int row = gw; row < MTOK; row += nw) {
        const int b = row >> 13;
        const float* xp = src + (size_t)row * D;
        f32x4 xv[4]; float ss = 0.f;
#pragma unroll
        for (int i = 0; i < 4; ++i) { xv[i] = *(const f32x4*)(xp + i * 256 + lane * 4); ss += xv[i][0] * xv[i][0] + xv[i][1] * xv[i][1] + xv[i][2] * xv[i][2] + xv[i][3] * xv[i][3]; }
#pragma unroll
        for (int o = 1; o < 64; o <<= 1) ss += __shfl_xor(ss, o);
        const float rstd = rsqrtf(ss * (1.0f / D) + 1e-6f);
#pragma unroll
        for (int i = 0; i < 4; ++i) {
            const int k = i * 256 + lane * 4;
            const f32x4 g = *(const f32x4*)(gain1 + k), s = *(const f32x4*)(sc1 + (size_t)b * bs1 + k), t = *(const f32x4*)(sh1 + (size_t)b * bs1 + k);
            f32x4 u;
#pragma unroll
            for (int j = 0; j < 4; ++j) u[j] = (xv[i][j] * rstd * g[j]) * (1.0f + s[j]) + t[j];
            u32x2 w; w.x = cvt_pk_bf16(u[0], u[1]); w.y = cvt_pk_bf16(u[2], u[3]);
            *(u32x2*)(U1 + (size_t)row * D + k) = w;
        }
        if (U2) {
#pragma unroll
            for (int i = 0; i < 4; ++i) {
                const int k = i * 256 + lane * 4;
                const f32x4 g = *(const f32x4*)(gain2 + k), s = *(const f32x4*)(sc2 + (size_t)b * bs2 + k), t = *(const f32x4*)(sh2 + (size_t)b * bs2 + k);
                f32x4 u;
#pragma unroll
                for (int j = 0; j < 4; ++j) u[j] = (xv[i][j] * rstd * g[j]) * (1.0f + s[j]) + t[j];
                u32x2 w; w.x = cvt_pk_bf16(u[0], u[1]); w.y = cvt_pk_bf16(u[2], u[3]);
                *(u32x2*)(U2 + (size_t)row * D + k) = w;
            }
        }
    }
}
__device__ void final_norm_phase(float* h, const float* gain) {
    const int tid_ = opaque_tid(); const int lane = tid_ & 63, gw = blockIdx.x * 8 + (tid_ >> 6), nw = gridDim.x * 8;
    for (int row = gw; row < MTOK; row += nw) {
        float* xp = h + (size_t)row * D;
        f32x4 xv[4]; float ss = 0.f;
#pragma unroll
        for (int i = 0; i < 4; ++i) { xv[i] = *(const f32x4*)(xp + i * 256 + lane * 4); ss += xv[i][0] * xv[i][0] + xv[i][1] * xv[i][1] + xv[i][2] * xv[i][2] + xv[i][3] * xv[i][3]; }
#pragma unroll
        for (int o = 1; o < 64; o <<= 1) ss += __shfl_xor(ss, o);
        const float rstd = rsqrtf(ss * (1.0f / D) + 1e-6f);
#pragma unroll
        for (int i = 0; i < 4; ++i) {
            const int k = i * 256 + lane * 4;
            const f32x4 g = *(const f32x4*)(gain + k);
            f32x4 u;
#pragma unroll
            for (int j = 0; j < 4; ++j) u[j] = xv[i][j] * rstd * g[j];
            *(f32x4*)(xp + k) = u;
        }
    }
}

__device__ void rec_simple_phase(const Params& p, unsigned char* shm) {
    float* sf = (float*)shm; float* sk = sf + 4096; float* sq = sk + 4096; float* sv = sq + 4096;
    const int tid = opaque_tid(), ds = tid & 7, vc = tid >> 3;
    for (int task = blockIdx.x; task < 128; task += gridDim.x) {
        const int b = task >> 4, h = (task >> 1) & 7, vh = task & 1;
        float S[16];
#pragma unroll
        for (int e = 0; e < 16; ++e) S[e] = 0.f;
        const size_t rowbase = (size_t)b * SEQ;
        for (int t0 = 0; t0 < SEQ; t0 += 32) {
            __syncthreads();
            for (int i = tid; i < 4096; i += 512) { const int t = i >> 7, d = i & 127; const size_t g = (rowbase + t0 + t) * D + h * 128 + d;
                const float f = __expf(p.LF[g]); sf[i] = f; sk[i] = 1.0f - f; sq[i] = bf2f(p.Qh[g]); }
            for (int i = tid; i < 2048; i += 512) { const int t = i >> 6, v = i & 63; sv[i] = bf2f(p.Vh[(rowbase + t0 + t) * D + h * 128 + vh * 64 + v]); }
            __syncthreads();
            for (int t = 0; t < 32; ++t) {
                const float vv = sv[t * 64 + vc]; float a = 0.f;
#pragma unroll
                for (int e4 = 0; e4 < 4; ++e4) {
                    const f32x4 f4 = *(const f32x4*)(sf + t * 128 + ds * 16 + e4 * 4), k4 = *(const f32x4*)(sk + t * 128 + ds * 16 + e4 * 4), q4 = *(const f32x4*)(sq + t * 128 + ds * 16 + e4 * 4);
#pragma unroll
                    for (int j = 0; j < 4; ++j) { S[e4 * 4 + j] = f4[j] * S[e4 * 4 + j] + k4[j] * vv; a += q4[j] * S[e4 * 4 + j]; }
                }
                a += __shfl_xor(a, 1); a += __shfl_xor(a, 2); a += __shfl_xor(a, 4);
                if (ds == 0) p.U[(rowbase + t0 + t) * D + h * 128 + vh * 64 + vc] = (bf16_t)(cvt_pk_bf16(a, 0.f) & 0xffffu);
            }
        }
    }
    __syncthreads();
}
__device__ void rec_norm_phase(const Params& p, const float* ogain) {
    const int tid_ = opaque_tid(); const int lane = tid_ & 63, gw = blockIdx.x * 8 + (tid_ >> 6), nw = gridDim.x * 8;
    for (int row = gw; row < MTOK; row += nw) {
        bf16_t* op = p.U + (size_t)row * D + lane * 16;
        const bf16_t* gp = p.Gh + (size_t)row * D + lane * 16;
        const u32x4 o0 = *(const u32x4*)op, o1 = *(const u32x4*)(op + 8), g0 = *(const u32x4*)gp, g1 = *(const u32x4*)(gp + 8);
        float ov[16], gv[16];
#pragma unroll
        for (int j = 0; j < 4; ++j) { ov[2 * j] = bflo(o0[j]); ov[2 * j + 1] = bfhi(o0[j]); ov[8 + 2 * j] = bflo(o1[j]); ov[8 + 2 * j + 1] = bfhi(o1[j]);
            gv[2 * j] = bflo(g0[j]); gv[2 * j + 1] = bfhi(g0[j]); gv[8 + 2 * j] = bflo(g1[j]); gv[8 + 2 * j + 1] = bfhi(g1[j]); }
        float ss = 0.f;
#pragma unroll
        for (int j = 0; j < 16; ++j) ss += ov[j] * ov[j];
        ss += __shfl_xor(ss, 1); ss += __shfl_xor(ss, 2); ss += __shfl_xor(ss, 4);
        const float rstd = rsqrtf(ss * (1.0f / 128.0f) + 1e-6f);
        const float* gn = ogain + (lane & 7) * 16;
        float r[16];
#pragma unroll
        for (int j = 0; j < 16; ++j) r[j] = ov[j] * rstd * gn[j] * gv[j];
        u32x4 w0, w1;
#pragma unroll
        for (int j = 0; j < 4; ++j) { w0[j] = cvt_pk_bf16(r[2 * j], r[2 * j + 1]); w1[j] = cvt_pk_bf16(r[8 + 2 * j], r[8 + 2 * j + 1]); }
        *(u32x4*)op = w0; *(u32x4*)(op + 8) = w1;
    }
}

__device__ void attn_simple_phase(const Params& p, int jl, unsigned char* shm) {
    bf16_t* sK = (bf16_t*)shm; bf16_t* sV = sK + 64 * 512; float* sB = (float*)(sV + 64 * 512);
    const int tid = opaque_tid(), t = tid & 63, hh = tid >> 6;
    for (int task = blockIdx.x; task < 2048; task += gridDim.x) {
        const int hg = task & 1, c = (task >> 1) & 127, b = task >> 8, h = hg * 8 + hh;
        __syncthreads();
        for (int i = tid; i < 320 * 8; i += 512) { const int r = i >> 3, e = i & 7; sB[i] = p.b_rel_bias[((size_t)jl * 320 + r) * 16 + hg * 8 + e]; }
        float q[64], o[64];
        {
            const bf16_t* qp = p.Qb + ((size_t)b * SEQ + c * 64 + t) * D + h * 64;
#pragma unroll
            for (int d8 = 0; d8 < 8; ++d8) { const u32x4 w = *(const u32x4*)(qp + d8 * 8);
#pragma unroll
                for (int j = 0; j < 4; ++j) { q[d8 * 8 + 2 * j] = bflo(w[j]); q[d8 * 8 + 2 * j + 1] = bfhi(w[j]); } }
        }
#pragma unroll
        for (int d = 0; d < 64; ++d) o[d] = 0.f;
        float m = -1e30f, l = 0.f;
        for (int kc = (c - 8 > 0 ? c - 8 : 0); kc <= c; ++kc) {
            __syncthreads();
            for (int i = tid; i < 4096; i += 512) { const int key = i >> 6, piece = i & 63; const size_t so = ((size_t)b * SEQ + kc * 64 + key) * D + hg * 512 + piece * 8;
                *(u32x4*)(sK + key * 512 + piece * 8) = *(const u32x4*)(p.Kb + so); *(u32x4*)(sV + key * 512 + piece * 8) = *(const u32x4*)(p.Vb + so); }
            __syncthreads();
            for (int key = 0; key < 64; ++key) {
                float s = 0.f;
#pragma unroll
                for (int d8 = 0; d8 < 8; ++d8) { const u32x4 w = *(const u32x4*)(sK + key * 512 + hh * 64 + d8 * 8);
#pragma unroll
                    for (int j = 0; j < 4; ++j) { s += q[d8 * 8 + 2 * j] * bflo(w[j]); s += q[d8 * 8 + 2 * j + 1] * bfhi(w[j]); } }
                int rel = (kc - c) * 64 + key - t; rel = rel < -256 ? -256 : (rel > 63 ? 63 : rel);
                s += sB[(rel + 256) * 8 + hh];
                const float mn = fmaxf(m, s), corr = __expf(m - mn), pp = __expf(s - mn);
                l = l * corr + pp; m = mn;
#pragma unroll
                for (int d8 = 0; d8 < 8; ++d8) { const u32x4 w = *(const u32x4*)(sV + key * 512 + hh * 64 + d8 * 8);
#pragma unroll
                    for (int j = 0; j < 4; ++j) { o[d8 * 8 + 2 * j] = o[d8 * 8 + 2 * j] * corr + pp * bflo(w[j]); o[d8 * 8 + 2 * j + 1] = o[d8 * 8 + 2 * j + 1] * corr + pp * bfhi(w[j]); } }
            }
        }
        const float inv = 1.0f / l;
        bf16_t* op = p.U + ((size_t)b * SEQ + c * 64 + t) * D + h * 64;
#pragma unroll
        for (int d8 = 0; d8 < 8; ++d8) { u32x4 w;
#pragma unroll
            for (int j = 0; j < 4; ++j) w[j] = cvt_pk_bf16(o[d8 * 8 + 2 * j] * inv, o[d8 * 8 + 2 * j + 1] * inv);
            *(u32x4*)(op + d8 * 8) = w; }
    }
    __syncthreads();
}

__global__ void __launch_bounds__(512, 2) yoco_fwd(Params p) {
    extern __shared__ __attribute__((aligned(16))) unsigned char shm[];
    cg::grid_group grid = cg::this_grid();
    prep_phase(p, shm);
    grid.sync();
    for (int l = 0; l < 4; ++l) {
        const float* hsrc = (l == 0) ? p.x : p.h;
        const float* mv = p.modv + (size_t)l * 8 * 6144;
        if (l == 2) norm_phase(hsrc, p.U, p.norm_mix + l * D, mv, mv + D, 6144, p.U2, p.kv_norm, p.kvmod, p.kvmod + D, 2048);
        else norm_phase(hsrc, p.U, p.norm_mix + l * D, mv, mv + D, 6144, nullptr, nullptr, nullptr, nullptr, 0);
        grid.sync();
        if (l < 2) {
            pg8::EpiHgrnIn e; e.QVG = p.Qh; e.LF = p.LF; e.lb = p.lbv + l * D;
            run_gemm(shm, p.U, p.wb_a_in + (size_t)l * AIN * D, AIN, D, e);
            grid.sync();
            rec_simple_phase(p, shm);
            grid.sync();
            rec_norm_phase(p, p.a_out_norm + l * 128);
        } else {
            if (l == 2) { pg8::EpiBf16Split e; e.d0 = p.Kb; e.scale = 1.0f; run_gemm(shm, p.U2, p.wb_kv, 2048, D, e); }
            { pg8::EpiBf16Split e; e.d0 = p.Qb; e.scale = 0.125f; run_gemm(shm, p.U, p.wb_q + (size_t)(l - 2) * D * D, D, D, e); }
            grid.sync();
            attn_simple_phase(p, l - 2, shm);
        }
        grid.sync();
        {
            pg8::EpiResid e; e.src = hsrc; e.dst = p.h; e.gate = mv + 2 * D;
            run_gemm(shm, p.U, (l < 2) ? p.wb_a_out + (size_t)l * D * D : p.wb_o + (size_t)(l - 2) * D * D, D, D, e);
        }
        grid.sync();
        norm_phase(p.h, p.U, p.norm_ffn + l * D, mv + 3 * D, mv + 4 * D, 6144, nullptr, nullptr, nullptr, nullptr, 0);
        grid.sync();
        { pg8::EpiSwiglu e; e.act = p.ACT; run_gemm(shm, p.U, p.wb_ffn_in + (size_t)l * 2 * FFN * D, 2 * FFN, D, e); }
        grid.sync();
        { pg8::EpiResid e; e.src = p.h; e.dst = p.h; e.gate = mv + 5 * D; run_gemm(shm, p.ACT, p.wb_ffn_out + (size_t)l * D * FFN, D, FFN, e); }
        grid.sync();
    }
    final_norm_phase(p.h, p.final_norm);
}

extern "C" void kernel_launch(void* const* d_in, const int* in_sizes, int n_in, void* d_out, int out_size, void* d_ws, size_t ws_size, hipStream_t stream) {
    static int grid_blocks = 0;
    if (!grid_blocks) {
        int dev = 0, cus = 0, per_cu = 0;
        hipGetDevice(&dev);
        hipDeviceGetAttribute(&cus, hipDeviceAttributeMultiprocessorCount, dev);
        hipFuncSetAttribute((const void*)yoco_fwd, hipFuncAttributeMaxDynamicSharedMemorySize, LDS_BYTES);
        hipOccupancyMaxActiveBlocksPerMultiprocessor(&per_cu, (const void*)yoco_fwd, 512, LDS_BYTES);
        if (per_cu < 1) per_cu = 1;
        grid_blocks = cus * per_cu;
        (void)hipGetLastError();
    }
    Params p{};
    const float* const* in = (const float* const*)d_in;
    p.x = in[0]; p.c = in[1]; p.mod_w = in[2]; p.mod_b = in[3]; p.norm_mix = in[4]; p.norm_ffn = in[5]; p.ffn_w_in = in[6]; p.ffn_w_out = in[7];
    p.a_w_in = in[8]; p.a_w_out = in[9]; p.a_lb = in[10]; p.a_out_norm = in[11]; p.kv_norm = in[12]; p.kv_mod_w = in[13]; p.kv_mod_b = in[14]; p.kv_w = in[15];
    p.b_w_q = in[16]; p.b_w_o = in[17]; p.b_rel_bias = in[18]; p.final_norm = in[19];
    p.h = (float*)d_out;
    unsigned char* ws = (unsigned char*)d_ws; size_t off = 0;
    auto take = [&](size_t bytes) { unsigned char* r = ws + off; off += (bytes + 255) & ~(size_t)255; return r; };
    p.wb_a_in = (bf16_t*)take((size_t)2 * AIN * D * 2);
    p.wb_a_out = (bf16_t*)take((size_t)2 * D * D * 2);
    p.wb_ffn_in = (bf16_t*)take((size_t)4 * 2 * FFN * D * 2);
    p.wb_ffn_out = (bf16_t*)take((size_t)4 * D * FFN * 2);
    p.wb_kv = (bf16_t*)take((size_t)2 * D * D * 2);
    p.wb_q = (bf16_t*)take((size_t)2 * D * D * 2);
    p.wb_o = (bf16_t*)take((size_t)2 * D * D * 2);
    p.modv = (float*)take((size_t)4 * 8 * 6144 * 4);
    p.kvmod = (float*)take((size_t)8 * 2048 * 4);
    p.lbv = (float*)take((size_t)2 * D * 4);
    const size_t act = (size_t)MTOK * D * 2;
    p.U = (bf16_t*)take(act);
    unsigned char* R = ws + off;
    p.Qh = (bf16_t*)R; p.Vh = (bf16_t*)(R + act); p.Gh = (bf16_t*)(R + 2 * act); p.LF = (float*)(R + 3 * act);
    p.ACT = (bf16_t*)R;
    p.U2 = (bf16_t*)R;
    p.Kb = (bf16_t*)(R + (size_t)MTOK * FFN * 2); p.Vb = p.Kb + (size_t)MTOK * D; p.Qb = p.Vb + (size_t)MTOK * D;
    p.wg[0] = WGroup{p.a_w_in, p.wb_a_in, D, AIN, 2, 0};
    p.wg[1] = WGroup{p.a_w_out, p.wb_a_out, D, D, 2, 0};
    p.wg[2] = WGroup{p.ffn_w_in, p.wb_ffn_in, D, 2 * FFN, 4, 1};
    p.wg[3] = WGroup{p.ffn_w_out, p.wb_ffn_out, FFN, D, 4, 0};
    p.wg[4] = WGroup{p.kv_w, p.wb_kv, D, 2 * D, 1, 0};
    p.wg[5] = WGroup{p.b_w_q, p.wb_q, D, D, 2, 0};
    p.wg[6] = WGroup{p.b_w_o, p.wb_o, D, D, 2, 0};
    void* args[] = {&p};
    hipError_t e = hipLaunchCooperativeKernel((const void*)yoco_fwd, dim3(grid_blocks), dim3(512), args, LDS_BYTES, stream);
    if (e != hipSuccess) fprintf(stderr, "cooperative launch failed: %s (grid %d)\n", hipGetErrorString(e), grid_blocks);
}
```

```cpp
#include <hip/hip_runtime.h>
#include <hip/hip_cooperative_groups.h>
#include <cstdio>
namespace cg = cooperative_groups;

#define LAS __attribute__((address_space(3)))
typedef unsigned short bf16_t;
typedef short bf16x8 __attribute__((ext_vector_type(8)));
typedef float f32x4 __attribute__((ext_vector_type(4)));
typedef unsigned u32x4 __attribute__((ext_vector_type(4)));
typedef unsigned u32x2 __attribute__((ext_vector_type(2)));

constexpr int D = 1024, BATCH = 8, SEQ = 8192, MTOK = BATCH * SEQ, FFN = 2816, AIN = 4096;
constexpr int LDS_BYTES = 144 * 1024;

__device__ __forceinline__ unsigned cvt_pk_bf16(float lo, float hi) { unsigned r; asm volatile("v_cvt_pk_bf16_f32 %0, %1, %2" : "=v"(r) : "v"(lo), "v"(hi)); return r; }
__device__ __forceinline__ float bf2f(unsigned short h) { return __uint_as_float((unsigned)h << 16); }
__device__ __forceinline__ float bflo(unsigned w) { return __uint_as_float(w << 16); }
__device__ __forceinline__ float bfhi(unsigned w) { return __uint_as_float(w & 0xffff0000u); }
__device__ __forceinline__ float silu_f(float x) { return x * __builtin_amdgcn_rcpf(1.0f + __expf(-x)); }

__device__ __forceinline__ int opaque_tid() { int t = threadIdx.x; asm volatile("" : "+v"(t)); return t; }
struct WGroup { const float* src; bf16_t* dst; int K, N, L, mode; };

struct Params {
    const float *x, *c, *mod_w, *mod_b, *norm_mix, *norm_ffn, *ffn_w_in, *ffn_w_out, *a_w_in, *a_w_out, *a_lb, *a_out_norm,
                *kv_norm, *kv_mod_w, *kv_mod_b, *kv_w, *b_w_q, *b_w_o, *b_rel_bias, *final_norm;
    float* h;
    bf16_t *wb_a_in, *wb_a_out, *wb_ffn_in, *wb_ffn_out, *wb_kv, *wb_q, *wb_o;
    float *modv, *kvmod, *lbv;
    bf16_t *U, *U2, *Qh, *Vh, *Gh;
    float* LF;
    bf16_t *ACT, *Kb, *Vb, *Qb;
    WGroup wg[7];
};

namespace pg8 {
constexpr int BM = 256, BK = 64, HALF = 128, HTB = HALF * BK * 2, STAGE_BYTES = 8 * HTB, NXCD = 8, WGM = 8;
__device__ __forceinline__ int lds_byte(int r, int c) { const int st = (r >> 4) * 2 + (c >> 5), rr = r & 15, cc = c & 31, ob = rr * 64 + cc * 2; return st * 1024 + (ob ^ (((ob >> 9) & 1) << 5)); }
__device__ __forceinline__ void stage_rc(int b, int& R, int& C) { const int st = b / 1024, sb = b % 1024, swz = sb ^ (((sb >> 9) & 1) << 5); R = (st >> 1) * 16 + swz / 64; C = (st & 1) * 32 + (swz % 64) / 2; }
__device__ __forceinline__ int perm32(int rho) { const int n = rho >> 4, i = rho & 15; return 8 * (i >> 2) + 4 * n + (i & 3); }
struct Unit { int pm, pn; };
struct Gemm { const bf16_t* A; const bf16_t* Bt; int M, N, K; };
struct StaticOrder {
    int nM, nN, nwg, G, c;
    __device__ void init(int M, int N, int G_, int c_) { nM = M / BM; nN = N / BM; nwg = nM * nN; G = G_; c = c_; }
    __device__ bool next(int i, Unit& u) const {
        const long L = (long)i * G + c; if (L >= nwg) return false;
        int wgid = (int)L; { const int q = nwg / NXCD, r = nwg % NXCD, xcd = wgid % NXCD, off = wgid / NXCD; wgid = (xcd < r ? xcd * (q + 1) : r * (q + 1) + (xcd - r) * q) + off; }
        const int nig = WGM * nN, gid = wgid / nig, fm = gid * WGM, gsz = (nM - fm) < WGM ? (nM - fm) : WGM;
        u.pm = fm + ((wgid % nig) % gsz); u.pn = (wgid % nig) / gsz; return true;
    }
};

template <class Epi>
__device__ __forceinline__ void gemm_phase(LAS unsigned char* lds, const Gemm g, const StaticOrder& S, const Epi& E) {
    const int tid = opaque_tid(), wid = __builtin_amdgcn_readfirstlane(tid >> 6), lane = tid & 63, wr = wid >> 2, wc = wid & 3, fr = lane & 15, fq = lane >> 4;
    const int K = g.K, nt = K / BK;
    unsigned voffA[2], voffB[2];
#pragma unroll
    for (int i = 0; i < 2; ++i) { int R, C; stage_rc(tid * 16 + i * 8192, R, C); const int Rb = Epi::PERM ? ((R & ~31) + perm32(R & 31)) : R;
        voffA[i] = (unsigned)(R * K + C) * 2u; voffB[i] = (unsigned)(Rb * K + C) * 2u; }
    const size_t kstep = (size_t)(BK * 2);
    const size_t hstep = (size_t)HALF * K * 2;
    const size_t tstep = 2 * hstep;
    const unsigned ldsw = (unsigned)wid * 1024u;
    const int aoff = lds_byte(wr * 64 + fr, fq * 8), boff = lds_byte(wc * 32 + fr, fq * 8);
#define PG8_SA(b, h) (((b) * 2 + (h)) * HTB)
#define PG8_SB(b, h) ((4 + (b) * 2 + (h)) * HTB)
#define PG8_STAGE(bufoff, gbase, voff) do { _Pragma("unroll") for (int _i = 0; _i < 2; ++_i) \
        __builtin_amdgcn_global_load_lds((const unsigned*)((const char*)(gbase) + (voff)[_i]), (LAS unsigned*)(lds + (bufoff) + ldsw + _i * 8192), 16, 0, 0); } while (0)
#define PG8_LDA(dst, b, h) do { _Pragma("unroll") for (int m = 0; m < 4; ++m) _Pragma("unroll") for (int k = 0; k < 2; ++k) dst[m][k] = *(const LAS bf16x8*)(lds + PG8_SA(b, h) + aoff + m * 2048 + k * 1024); } while (0)
#define PG8_LDB(dst, b, h) do { _Pragma("unroll") for (int n = 0; n < 2; ++n) _Pragma("unroll") for (int k = 0; k < 2; ++k) dst[n][k] = *(const LAS bf16x8*)(lds + PG8_SB(b, h) + boff + n * 2048 + k * 1024); } while (0)
#define PG8_MMA(ai, bj, At, Bt) do { __builtin_amdgcn_s_setprio(1); _Pragma("unroll") for (int m = 0; m < 4; ++m) _Pragma("unroll") for (int n = 0; n < 2; ++n) _Pragma("unroll") for (int k = 0; k < 2; ++k) \
        acc[ai][bj][m][n] = __builtin_amdgcn_mfma_f32_16x16x32_bf16(Bt[n][k], At[m][k], acc[ai][bj][m][n], 0, 0, 0); __builtin_amdgcn_s_setprio(0); } while (0)
#define PG8_WAIT_V(n) asm volatile("s_waitcnt vmcnt(" #n ")" ::: "memory")
#define PG8_WAIT_L(n) asm volatile("s_waitcnt lgkmcnt(" #n ")" ::: "memory")
#define PG8_BAR __builtin_amdgcn_s_barrier()
#define PG8_SCHED __builtin_amdgcn_sched_barrier(0)
    Unit cur, nxt; int ui = 0;
    if (!S.next(0, cur)) return;
    f32x4 acc[2][2][4][2];
#pragma unroll
    for (int a = 0; a < 2; ++a)
#pragma unroll
        for (int b = 0; b < 2; ++b)
#pragma unroll
            for (int m = 0; m < 4; ++m)
#pragma unroll
                for (int n = 0; n < 2; ++n) acc[a][b][m][n] = (f32x4){0.f, 0.f, 0.f, 0.f};
    bf16x8 At[4][2], B0[2][2], B1[2][2];
    const char* cA = (const char*)g.A + (size_t)cur.pm * tstep; const char* cB = (const char*)g.Bt + (size_t)cur.pn * tstep;
    PG8_STAGE(PG8_SB(0, 0), cB, voffB); PG8_STAGE(PG8_SA(0, 0), cA, voffA); PG8_STAGE(PG8_SB(0, 1), cB + hstep, voffB); PG8_STAGE(PG8_SA(0, 1), cA + hstep, voffA);
    if (wr == 1) PG8_BAR;
    PG8_WAIT_V(4); PG8_BAR;
    PG8_STAGE(PG8_SB(1, 0), cB + kstep, voffB); PG8_STAGE(PG8_SA(1, 0), cA + kstep, voffA); PG8_STAGE(PG8_SB(1, 1), cB + hstep + kstep, voffB);
    PG8_WAIT_V(6); PG8_BAR;
    for (;;) {
        const bool has_next = S.next(ui + 1, nxt);
        const char* nA = has_next ? (const char*)g.A + (size_t)nxt.pm * tstep : cA; const char* nB = has_next ? (const char*)g.Bt + (size_t)nxt.pn * tstep : cB;
        for (int t = 0; t < nt; t += 2) {
            const bool last = (t == nt - 2);
            const char* a1 = cA + (size_t)(t + 1) * kstep;
            const char* a2 = last ? nA : cA + (size_t)(t + 2) * kstep; const char* b2 = last ? nB : cB + (size_t)(t + 2) * kstep;
            const char* a3 = a2 + kstep; const char* b3 = b2 + kstep;
            PG8_LDB(B0, 0, 0); PG8_SCHED; PG8_LDA(At, 0, 0); PG8_STAGE(PG8_SA(1, 1), a1 + hstep, voffA);
            PG8_WAIT_L(8); PG8_BAR; PG8_WAIT_L(0); PG8_MMA(0, 0, At, B0); PG8_BAR; PG8_SCHED;
            PG8_LDB(B1, 0, 1); PG8_STAGE(PG8_SB(0, 0), b2, voffB);
            PG8_BAR; PG8_WAIT_L(0); PG8_MMA(0, 1, At, B1); PG8_BAR;
            PG8_LDA(At, 0, 1); PG8_STAGE(PG8_SA(0, 0), a2, voffA);
            PG8_BAR; PG8_WAIT_L(0); PG8_MMA(1, 0, At, B0); PG8_BAR; PG8_SCHED;
            PG8_STAGE(PG8_SB(0, 1), b2 + hstep, voffB);
            PG8_WAIT_V(6); PG8_BAR; PG8_MMA(1, 1, At, B1); PG8_BAR;
            PG8_LDB(B0, 1, 0); PG8_SCHED; PG8_LDA(At, 1, 0); PG8_STAGE(PG8_SA(0, 1), a2 + hstep, voffA);
            PG8_WAIT_L(8); PG8_BAR; PG8_WAIT_L(0); PG8_MMA(0, 0, At, B0); PG8_BAR; PG8_SCHED;
            PG8_LDB(B1, 1, 1); PG8_STAGE(PG8_SB(1, 0), b3, voffB);
            PG8_BAR; PG8_WAIT_L(0); PG8_MMA(0, 1, At, B1); PG8_BAR;
            PG8_LDA(At, 1, 1); PG8_STAGE(PG8_SA(1, 0), a3, voffA);
            PG8_BAR; PG8_WAIT_L(0); PG8_MMA(1, 0, At, B0); PG8_BAR; PG8_SCHED;
            PG8_STAGE(PG8_SB(1, 1), b3 + hstep, voffB);
            PG8_WAIT_V(6); PG8_BAR; PG8_MMA(1, 1, At, B1); PG8_BAR;
        }
        E(acc, cur, wr, wc, fr, fq);
        if (!has_next) break;
#pragma unroll
        for (int a = 0; a < 2; ++a)
#pragma unroll
            for (int b = 0; b < 2; ++b)
#pragma unroll
                for (int m = 0; m < 4; ++m)
#pragma unroll
                    for (int n = 0; n < 2; ++n) acc[a][b][m][n] = (f32x4){0.f, 0.f, 0.f, 0.f};
        cur = nxt; cA = nA; cB = nB; ++ui;
    }
    PG8_WAIT_V(0);
    if (wr == 0) PG8_BAR;
    PG8_BAR;
#undef PG8_SA
#undef PG8_SB
#undef PG8_STAGE
#undef PG8_LDA
#undef PG8_LDB
#undef PG8_MMA
#undef PG8_WAIT_V
#undef PG8_WAIT_L
#undef PG8_BAR
#undef PG8_SCHED
}

struct EpiHgrnIn {
    static constexpr bool PERM = true;
    bf16_t* QVG; float* LF; const float* lb;
    __device__ __forceinline__ void operator()(const f32x4 (&acc)[2][2][4][2], const Unit& u, int wr, int wc, int fr, int fq) const {
        const int seg = u.pn >> 2, colt = (u.pn & 3) * 256;
        const int row0 = u.pm * BM + wr * 64 + fr, col0 = colt + wc * 32 + 8 * fq;
        if (seg == 1) {
#pragma unroll
            for (int bj = 0; bj < 2; ++bj) {
                const f32x4 l0 = *(const f32x4*)(lb + col0 + bj * HALF), l1 = *(const f32x4*)(lb + col0 + bj * HALF + 4);
#pragma unroll
                for (int ai = 0; ai < 2; ++ai)
#pragma unroll
                    for (int m = 0; m < 4; ++m) {
                        float* rowp = LF + (size_t)(row0 + ai * HALF + m * 16) * D + col0 + bj * HALF;
                        f32x4 o0, o1;
#pragma unroll
                        for (int j = 0; j < 4; ++j) {
                            float z = acc[ai][bj][m][0][j]; float sg = __builtin_amdgcn_rcpf(1.0f + __expf(-z)); float f = l0[j] + (1.0f - l0[j]) * sg; o0[j] = logf(fmaxf(f, 1e-30f));
                            z = acc[ai][bj][m][1][j]; sg = __builtin_amdgcn_rcpf(1.0f + __expf(-z)); f = l1[j] + (1.0f - l1[j]) * sg; o1[j] = logf(fmaxf(f, 1e-30f));
                        }
                        *(f32x4*)rowp = o0; *(f32x4*)(rowp + 4) = o1;
                    }
            }
        } else {
            bf16_t* base = QVG + (size_t)(seg == 0 ? 0 : (seg == 2 ? 1 : 2)) * ((size_t)MTOK * D);
            const bool act = (seg != 2);
#pragma unroll
            for (int ai = 0; ai < 2; ++ai)
#pragma unroll
                for (int m = 0; m < 4; ++m)
#pragma unroll
                    for (int bj = 0; bj < 2; ++bj) {
                        f32x4 v0 = acc[ai][bj][m][0], v1 = acc[ai][bj][m][1];
                        if (act) {
#pragma unroll
                            for (int j = 0; j < 4; ++j) { v0[j] = silu_f(v0[j]); v1[j] = silu_f(v1[j]); }
                        }
                        u32x4 w; w.x = cvt_pk_bf16(v0[0], v0[1]); w.y = cvt_pk_bf16(v0[2], v0[3]); w.z = cvt_pk_bf16(v1[0], v1[1]); w.w = cvt_pk_bf16(v1[2], v1[3]);
                        *(u32x4*)(base + (size_t)(row0 + ai * HALF + m * 16) * D + col0 + bj * HALF) = w;
                    }
        }
    }
};
struct EpiResid {
    static constexpr bool PERM = true;
    const float* src; float* dst; const float* gate;
    __device__ __forceinline__ void operator()(const f32x4 (&acc)[2][2][4][2], const Unit& u, int wr, int wc, int fr, int fq) const {
        const int b = u.pm >> 5;
        const float* gp = gate + (size_t)b * 6144;
        const int row0 = u.pm * BM + wr * 64 + fr, col0 = u.pn * BM + wc * 32 + 8 * fq;
        f32x4 gv[2][2];
#pragma unroll
        for (int bj = 0; bj < 2; ++bj)
#pragma unroll
            for (int n = 0; n < 2; ++n) gv[bj][n] = *(const f32x4*)(gp + col0 + bj * HALF + 4 * n);
#pragma unroll
        for (int ai = 0; ai < 2; ++ai)
#pragma unroll
            for (int m = 0; m < 4; ++m) {
                const size_t ro = (size_t)(row0 + ai * HALF + m * 16) * D + col0;
#pragma unroll
                for (int bj = 0; bj < 2; ++bj)
#pragma unroll
                    for (int n = 0; n < 2; ++n) {
                        const f32x4 s = *(const f32x4*)(src + ro + bj * HALF + 4 * n);
                        *(f32x4*)(dst + ro + bj * HALF + 4 * n) = s + gv[bj][n] * acc[ai][bj][m][n];
                    }
            }
    }
};
struct EpiSwiglu {
    static constexpr bool PERM = true;
    bf16_t* act;
    __device__ __forceinline__ void operator()(const f32x4 (&acc)[2][2][4][2], const Unit& u, int wr, int wc, int fr, int fq) const {
        const int row0 = u.pm * BM + wr * 64 + fr, col0 = u.pn * HALF + wc * 32 + 8 * fq;
#pragma unroll
        for (int ai = 0; ai < 2; ++ai)
#pragma unroll
            for (int m = 0; m < 4; ++m) {
                f32x4 r0, r1;
#pragma unroll
                for (int j = 0; j < 4; ++j) { r0[j] = silu_f(acc[ai][0][m][0][j]) * acc[ai][1][m][0][j]; r1[j] = silu_f(acc[ai][0][m][1][j]) * acc[ai][1][m][1][j]; }
                u32x4 w; w.x = cvt_pk_bf16(r0[0], r0[1]); w.y = cvt_pk_bf16(r0[2], r0[3]); w.z = cvt_pk_bf16(r1[0], r1[1]); w.w = cvt_pk_bf16(r1[2], r1[3]);
                *(u32x4*)(act + (size_t)(row0 + ai * HALF + m * 16) * FFN + col0) = w;
            }
    }
};
struct EpiBf16Split {
    static constexpr bool PERM = true;
    bf16_t* d0; float scale;
    __device__ __forceinline__ void operator()(const f32x4 (&acc)[2][2][4][2], const Unit& u, int wr, int wc, int fr, int fq) const {
        bf16_t* base = d0 + (size_t)(u.pn >> 2) * ((size_t)MTOK * D);
        const int row0 = u.pm * BM + wr * 64 + fr, col0 = (u.pn & 3) * 256 + wc * 32 + 8 * fq;
#pragma unroll
        for (int ai = 0; ai < 2; ++ai)
#pragma unroll
            for (int m = 0; m < 4; ++m)
#pragma unroll
                for (int bj = 0; bj < 2; ++bj) {
                    const f32x4 v0 = acc[ai][bj][m][0] * scale, v1 = acc[ai][bj][m][1] * scale;
                    u32x4 w; w.x = cvt_pk_bf16(v0[0], v0[1]); w.y = cvt_pk_bf16(v0[2], v0[3]); w.z = cvt_pk_bf16(v1[0], v1[1]); w.w = cvt_pk_bf16(v1[2], v1[3]);
                    *(u32x4*)(base + (size_t)(row0 + ai * HALF + m * 16) * D + col0 + bj * HALF) = w;
                }
    }
};
}

template <class Epi>
__device__ __forceinline__ void run_gemm(unsigned char* shm, const bf16_t* A, const bf16_t* Bt, int N, int K, const Epi& E) {
    pg8::Gemm g; g.A = A; g.Bt = Bt; g.M = MTOK; g.N = N; g.K = K;
    pg8::StaticOrder S; S.init(MTOK, N, (int)gridDim.x, (int)blockIdx.x);
    pg8::gemm_phase<Epi>((LAS unsigned char*)shm, g, S, E);
    __syncthreads();
}

__device__ __forceinline__ int ffnmap(int nn) { return nn < FFN ? ((nn >> 7) * 256 + (nn & 127)) : (((nn - FFN) >> 7) * 256 + 128 + ((nn - FFN) & 127)); }

__device__ void prep_phase(const Params& p, unsigned char* shm) {
    const int tid = opaque_tid();
    {
        float* cact = (float*)shm;
        float* red = cact + 8192;
        bool loaded = false;
        const int wv = tid >> 6, lane = tid & 63;
        for (int task = blockIdx.x; task < 416; task += gridDim.x) {
            if (!loaded) {
                for (int i = tid; i < 8192; i += 512) { const int k = i >> 3, b = i & 7; cact[i] = silu_f(p.c[b * D + k]); }
                loaded = true;
            }
            __syncthreads();
            const int c0 = task * 64;
            const float* src; const float* bias; float* dst; int stride, dstride;
            if (c0 < 24576) { const int l = c0 / 6144, j = c0 % 6144; src = p.mod_w + (size_t)l * D * 6144 + j; stride = 6144; bias = p.mod_b + l * 6144 + j; dst = p.modv + (size_t)l * 8 * 6144 + j; dstride = 6144; }
            else { const int j = c0 - 24576; src = p.kv_mod_w + j; stride = 2048; bias = p.kv_mod_b + j; dst = p.kvmod + j; dstride = 2048; }
            float a[8];
#pragma unroll
            for (int b = 0; b < 8; ++b) a[b] = 0.f;
            const float* sp = src + (size_t)(wv * 128) * stride + lane;
#pragma unroll 8
            for (int k = 0; k < 128; ++k) {
                const float w = sp[(size_t)k * stride];
                const f32x4 c0v = *(const f32x4*)(cact + (wv * 128 + k) * 8), c1v = *(const f32x4*)(cact + (wv * 128 + k) * 8 + 4);
                a[0] += w * c0v[0]; a[1] += w * c0v[1]; a[2] += w * c0v[2]; a[3] += w * c0v[3];
                a[4] += w * c1v[0]; a[5] += w * c1v[1]; a[6] += w * c1v[2]; a[7] += w * c1v[3];
            }
#pragma unroll
            for (int b = 0; b < 8; ++b) red[(wv * 8 + b) * 64 + lane] = a[b];
            __syncthreads();
            {
                const int b = tid >> 6, col = tid & 63;
                float s = bias[col];
#pragma unroll
                for (int w = 0; w < 8; ++w) s += red[(w * 8 + b) * 64 + col];
                dst[(size_t)b * dstride + col] = s;
            }
        }
        __syncthreads();
    }
    for (int i = blockIdx.x * 512 + tid; i < 1024; i += gridDim.x * 512) {
        const float a0 = p.a_lb[i], a1 = p.a_lb[1024 + i];
        const float mx = fmaxf(a0, a1), e0 = __expf(a0 - mx), e1 = __expf(a1 - mx);
        p.lbv[i] = 0.f; p.lbv[1024 + i] = e1 / (e0 + e1);
    }
    {
        float* st = (float*)shm;
        int total = 0;
        for (int g = 0; g < 7; ++g) total += p.wg[g].L * (p.wg[g].K / 64) * (p.wg[g].N / 64);
        for (int tile = blockIdx.x; tile < total; tile += gridDim.x) {
            int g = 0, rem = tile;
            for (;;) { const int cnt = p.wg[g].L * (p.wg[g].K / 64) * (p.wg[g].N / 64); if (rem < cnt) break; rem -= cnt; ++g; }
            const int K = p.wg[g].K, N = p.wg[g].N, mode = p.wg[g].mode;
            const int per = (K / 64) * (N / 64), l = rem / per, tt = rem % per, ntn = N / 64, k0 = (tt / ntn) * 64, n0 = (tt % ntn) * 64;
            const float* src = p.wg[g].src + (size_t)l * K * N; bf16_t* dst = p.wg[g].dst + (size_t)l * K * N;
            __syncthreads();
            for (int i = tid; i < 4096; i += 512) { const int k = i >> 6, n = i & 63; st[k * 65 + n] = src[(size_t)(k0 + k) * N + n0 + n]; }
            __syncthreads();
            for (int i = tid; i < 2048; i += 512) { const int n = i >> 5, kp = i & 31; const int nn = n0 + n; const int drow = mode ? ffnmap(nn) : nn;
                *(unsigned*)(dst + (size_t)drow * K + k0 + 2 * kp) = cvt_pk_bf16(st[(2 * kp) * 65 + n], st[(2 * kp + 1) * 65 + n]); }
        }
        __syncthreads();
    }
}

__device__ void norm_phase(const float* src, bf16_t* U1, const float* gain1, const float* sh1, const float* sc1, int bs1,
                           bf16_t* U2, const float* gain2, const float* sh2, const float* sc2, int bs2) {
    const int tid_ = opaque_tid(); const int lane = tid_ & 63, gw = blockIdx.x * 8 + (tid_ >> 6), nw = gridDim.x * 8;
    for (int row = gw; row < MTOK; row += nw) {
        const int b = row >> 13;
        const float* xp = src + (size_t)row * D;
        f32x4 xv[4]; float ss = 0.f;
#pragma unroll
        for (int i = 0; i < 4; ++i) { xv[i] = *(const f32x4*)(xp + i * 256 + lane * 4); ss += xv[i][0] * xv[i][0] + xv[i][1] * xv[i][1] + xv[i][2] * xv[i][2] + xv[i][3] * xv[i][3]; }
#pragma unroll
        for (int o = 1; o < 64; o <<= 1) ss += __shfl_xor(ss, o);
        const float rstd = rsqrtf(ss * (1.0f / D) + 1e-6f);
#pragma unroll
        for (int i = 0; i < 4; ++i) {
            const int k = i * 256 + lane * 4;
            const f32x4 g = *(const f32x4*)(gain1 + k), s = *(const f32x4*)(sc1 + (size_t)b * bs1 + k), t = *(const f32x4*)(sh1 + (size_t)b * bs1 + k);
            f32x4 u;
#pragma unroll
            for (int j = 0; j < 4; ++j) u[j] = (xv[i][j] * rstd * g[j]) * (1.0f + s[j]) + t[j];
            u32x2 w; w.x = cvt_pk_bf16(u[0], u[1]); w.y = cvt_pk_bf16(u[2], u[3]);
            *(u32x2*)(U1 + (size_t)row * D + k) = w;
        }
        if (U2) {
#pragma unroll
            for (int i = 0; i < 4; ++i) {
                const int k = i * 256 + lane * 4;
                const f32x4 g = *(const f32x4*)(gain2 + k), s = *(const f32x4*)(sc2 + (size_t)b * bs2 + k), t = *(const f32x4*)(sh2 + (size_t)b * bs2 + k);
                f32x4 u;
#pragma unroll
                for (int j = 0; j < 4; ++j) u[j] = (xv[i][j] * rstd * g[j]) * (1.0f + s[j]) + t[j];
                u32x2 w; w.x = cvt_pk_bf16(u[0], u[1]); w.y = cvt_pk_bf16(u[2], u[3]);
                *(u32x2*)(U2 + (size_t)row * D + k) = w;
            }
        }
    }
}
__device__ void final_norm_phase(float* h, const float* gain) {
    const int tid_ = opaque_tid(); const int lane = tid_ & 63, gw = blockIdx.x * 8 + (tid_ >> 6), nw = gridDim.x * 8;
    for (int row = gw; row < MTOK; row += nw) {
        float* xp = h + (size_t)row * D;
        f32x4 xv[4]; float ss = 0.f;
#pragma unroll
        for (int i = 0; i < 4; ++i) { xv[i] = *(const f32x4*)(xp + i * 256 + lane * 4); ss += xv[i][0] * xv[i][0] + xv[i][1] * xv[i][1] + xv[i][2] * xv[i][2] + xv[i][3] * xv[i][3]; }
#pragma unroll
        for (int o = 1; o < 64; o <<= 1) ss += __shfl_xor(ss, o);
        const float rstd = rsqrtf(ss * (1.0f / D) + 1e-6f);
#pragma unroll
        for (int i = 0; i < 4; ++i) {
            const int k = i * 256 + lane * 4;
            const f32x4 g = *(const f32x4*)(gain + k);
            f32x4 u;
#pragma unroll
            for (int j = 0; j < 4; ++j) u[j] = xv[i][j] * rstd * g[j];
            *(f32x4*)(xp + k) = u;
        }
    }
}

__device__ void rec_simple_phase(const Params& p, unsigned char* shm) {
    float* sf = (float*)shm; float* sk = sf + 4096; float* sq = sk + 4096; float* sv = sq + 4096;
    const int tid = opaque_tid(), ds = tid & 7, vc = tid >> 3;
    for (int task = blockIdx.x; task < 128; task += gridDim.x) {
        const int b = task >> 4, h = (task >> 1) & 7, vh = task & 1;
        float S[16];
#pragma unroll
        for (int e = 0; e < 16; ++e) S[e] = 0.f;
        const size_t rowbase = (size_t)b * SEQ;
        for (int t0 = 0; t0 < SEQ; t0 += 32) {
            __syncthreads();
            for (int i = tid; i < 4096; i += 512) { const int t = i >> 7, d = i & 127; const size_t g = (rowbase + t0 + t) * D + h * 128 + d;
                const float f = __expf(p.LF[g]); sf[i] = f; sk[i] = 1.0f - f; sq[i] = bf2f(p.Qh[g]); }
            for (int i = tid; i < 2048; i += 512) { const int t = i >> 6, v = i & 63; sv[i] = bf2f(p.Vh[(rowbase + t0 + t) * D + h * 128 + vh * 64 + v]); }
            __syncthreads();
            for (int t = 0; t < 32; ++t) {
                const float vv = sv[t * 64 + vc]; float a = 0.f;
#pragma unroll
                for (int e4 = 0; e4 < 4; ++e4) {
                    const f32x4 f4 = *(const f32x4*)(sf + t * 128 + ds * 16 + e4 * 4), k4 = *(const f32x4*)(sk + t * 128 + ds * 16 + e4 * 4), q4 = *(const f32x4*)(sq + t * 128 + ds * 16 + e4 * 4);
#pragma unroll
                    for (int j = 0; j < 4; ++j) { S[e4 * 4 + j] = f4[j] * S[e4 * 4 + j] + k4[j] * vv; a += q4[j] * S[e4 * 4 + j]; }
                }
                a += __shfl_xor(a, 1); a += __shfl_xor(a, 2); a += __shfl_xor(a, 4);
                if (ds == 0) p.U[(rowbase + t0 + t) * D + h * 128 + vh * 64 + vc] = (bf16_t)(cvt_pk_bf16(a, 0.f) & 0xffffu);
            }
        }
    }
    __syncthreads();
}
__device__ void rec_norm_phase(const Params& p, const float* ogain) {
    const int tid_ = opaque_tid(); const int lane = tid_ & 63, gw = blockIdx.x * 8 + (tid_ >> 6), nw = gridDim.x * 8;
    for (int row = gw; row < MTOK; row += nw) {
        bf16_t* op = p.U + (size_t)row * D + lane * 16;
        const bf16_t* gp = p.Gh + (size_t)row * D + lane * 16;
        const u32x4 o0 = *(const u32x4*)op, o1 = *(const u32x4*)(op + 8), g0 = *(const u32x4*)gp, g1 = *(const u32x4*)(gp + 8);
        float ov[16], gv[16];
#pragma unroll
        for (int j = 0; j < 4; ++j) { ov[2 * j] = bflo(o0[j]); ov[2 * j + 1] = bfhi(o0[j]); ov[8 + 2 * j] = bflo(o1[j]); ov[8 + 2 * j + 1] = bfhi(o1[j]);
            gv[2 * j] = bflo(g0[j]); gv[2 * j + 1] = bfhi(g0[j]); gv[8 + 2 * j] = bflo(g1[j]); gv[8 + 2 * j + 1] = bfhi(g1[j]); }
        float ss = 0.f;
#pragma unroll
        for (int j = 0; j < 16; ++j) ss += ov[j] * ov[j];
        ss += __shfl_xor(ss, 1); ss += __shfl_xor(ss, 2); ss += __shfl_xor(ss, 4);
        const float rstd = rsqrtf(ss * (1.0f / 128.0f) + 1e-6f);
        const float* gn = ogain + (lane & 7) * 16;
        float r[16];
#pragma unroll
        for (int j = 0; j < 16; ++j) r[j] = ov[j] * rstd * gn[j] * gv[j];
        u32x4 w0, w1;
#pragma unroll
        for (int j = 0; j < 4; ++j) { w0[j] = cvt_pk_bf16(r[2 * j], r[2 * j + 1]); w1[j] = cvt_pk_bf16(r[8 + 2 * j], r[8 + 2 * j + 1]); }
        *(u32x4*)op = w0; *(u32x4*)(op + 8) = w1;
    }
}

__device__ void attn_phase(const Params& p, int jl, unsigned char* shm) {
    bf16_t* sK = (bf16_t*)shm;
    bf16_t* sVT = sK + 2 * 4608;
    float* sB = (float*)(sVT + 2 * 4608);
    const int tid = opaque_tid(), lane = tid & 63, w = tid >> 6, fr = lane & 15, fq = lane >> 4;
    const int cq = w >> 1, half = w & 1;
    const float LOG2E = 1.4426950408889634f;
    const int skey = tid >> 3, spiece = tid & 7, vkey = tid & 63, vpiece = tid >> 6;
    for (int task = blockIdx.x; task < 4096; task += gridDim.x) {
        const int g = task & 31, h = (task >> 5) & 15, b = task >> 9;
        const int c = 4 * g + cq;
        const int kt0 = (4 * g - 8 > 0) ? 4 * g - 8 : 0, kt1 = 4 * g + 3;
        __syncthreads();
        for (int i = tid; i < 320; i += 512) sB[i] = p.b_rel_bias[((size_t)jl * 320 + i) * 16 + h] * LOG2E;
        bf16x8 qf[2][2];
        {
            const bf16_t* qp = p.Qb + ((size_t)b * SEQ + c * 64 + half * 32) * D + h * 64;
#pragma unroll
            for (int qb = 0; qb < 2; ++qb)
#pragma unroll
                for (int ks = 0; ks < 2; ++ks) qf[qb][ks] = *(const bf16x8*)(qp + (size_t)(qb * 16 + fr) * D + ks * 32 + fq * 8);
        }
        f32x4 oacc[4][2];
#pragma unroll
        for (int db = 0; db < 4; ++db)
#pragma unroll
            for (int qb = 0; qb < 2; ++qb) oacc[db][qb] = (f32x4){0.f, 0.f, 0.f, 0.f};
        float mrun[2] = {-1e30f, -1e30f}, lrun[2] = {0.f, 0.f};
        u32x4 kreg, vreg;
        const size_t tokb = (size_t)b * SEQ;
        kreg = *(const u32x4*)(p.Kb + (tokb + kt0 * 64 + skey) * D + h * 64 + spiece * 8);
        vreg = *(const u32x4*)(p.Vb + (tokb + kt0 * 64 + vkey) * D + h * 64 + vpiece * 8);
        {
            *(u32x4*)(sK + skey * 72 + spiece * 8) = kreg;
            bf16_t* vt = sVT + (vpiece * 8) * 72 + vkey;
#pragma unroll
            for (int e = 0; e < 8; ++e) vt[e * 72] = (bf16_t)((e & 1) ? (vreg[e >> 1] >> 16) : (vreg[e >> 1] & 0xffffu));
        }
        __syncthreads();
        for (int kt = kt0; kt <= kt1; ++kt) {
            const int buf = (kt - kt0) & 1;
            if (kt < kt1) {
                kreg = *(const u32x4*)(p.Kb + (tokb + (kt + 1) * 64 + skey) * D + h * 64 + spiece * 8);
                vreg = *(const u32x4*)(p.Vb + (tokb + (kt + 1) * 64 + vkey) * D + h * 64 + vpiece * 8);
            }
            if (kt >= c - 8 && kt <= c) {
                const bf16_t* kb_ = sK + buf * 4608; const bf16_t* vb_ = sVT + buf * 4608;
                f32x4 sacc[4][2];
#pragma unroll
                for (int kb = 0; kb < 4; ++kb)
#pragma unroll
                    for (int qb = 0; qb < 2; ++qb) sacc[kb][qb] = (f32x4){0.f, 0.f, 0.f, 0.f};
#pragma unroll
                for (int kb = 0; kb < 4; ++kb)
#pragma unroll
                    for (int ks = 0; ks < 2; ++ks) {
                        const bf16x8 kf = *(const bf16x8*)(kb_ + (kb * 16 + fr) * 72 + ks * 32 + fq * 8);
#pragma unroll
                        for (int qb = 0; qb < 2; ++qb) sacc[kb][qb] = __builtin_amdgcn_mfma_f32_16x16x32_bf16(kf, qf[qb][ks], sacc[kb][qb], 0, 0, 0);
                    }
                const int dk = kt - c;
                if (dk <= -5) {
                    const float b0 = sB[0];
#pragma unroll
                    for (int kb = 0; kb < 4; ++kb)
#pragma unroll
                        for (int qb = 0; qb < 2; ++qb)
#pragma unroll
                            for (int j = 0; j < 4; ++j) sacc[kb][qb][j] = sacc[kb][qb][j] * LOG2E + b0;
                } else {
                    const int base = dk * 64 + fq * 4 - half * 32 - fr + 256;
#pragma unroll
                    for (int kb = 0; kb < 4; ++kb)
#pragma unroll
                        for (int qb = 0; qb < 2; ++qb)
#pragma unroll
                            for (int j = 0; j < 4; ++j) { int idx = base + kb * 16 + j - qb * 16; idx = idx < 0 ? 0 : (idx > 319 ? 319 : idx); sacc[kb][qb][j] = sacc[kb][qb][j] * LOG2E + sB[idx]; }
                }
                bf16x8 pf[2][2];
#pragma unroll
                for (int qb = 0; qb < 2; ++qb) {
                    float mx = sacc[0][qb][0];
#pragma unroll
                    for (int kb = 0; kb < 4; ++kb)
#pragma unroll
                        for (int j = 0; j < 4; ++j) mx = fmaxf(mx, sacc[kb][qb][j]);
                    mx = fmaxf(mx, __shfl_xor(mx, 16)); mx = fmaxf(mx, __shfl_xor(mx, 32));
                    const float mn = fmaxf(mrun[qb], mx), corr = __builtin_amdgcn_exp2f(mrun[qb] - mn);
                    mrun[qb] = mn;
                    float ps = 0.f;
#pragma unroll
                    for (int kb = 0; kb < 4; ++kb)
#pragma unroll
                        for (int j = 0; j < 4; ++j) { const float pv = __builtin_amdgcn_exp2f(sacc[kb][qb][j] - mn); sacc[kb][qb][j] = pv; ps += pv; }
                    lrun[qb] = lrun[qb] * corr + ps;
#pragma unroll
                    for (int db = 0; db < 4; ++db) oacc[db][qb] = oacc[db][qb] * corr;
#pragma unroll
                    for (int kk = 0; kk < 2; ++kk) {
                        u32x4 pw;
                        pw.x = cvt_pk_bf16(sacc[2 * kk][qb][0], sacc[2 * kk][qb][1]); pw.y = cvt_pk_bf16(sacc[2 * kk][qb][2], sacc[2 * kk][qb][3]);
                        pw.z = cvt_pk_bf16(sacc[2 * kk + 1][qb][0], sacc[2 * kk + 1][qb][1]); pw.w = cvt_pk_bf16(sacc[2 * kk + 1][qb][2], sacc[2 * kk + 1][qb][3]);
                        pf[qb][kk] = __builtin_bit_cast(bf16x8, pw);
                    }
                }
#pragma unroll
                for (int db = 0; db < 4; ++db)
#pragma unroll
                    for (int kk = 0; kk < 2; ++kk) {
                        const u32x2 lo = *(const u32x2*)(vb_ + (db * 16 + fr) * 72 + (2 * kk) * 16 + fq * 4);
                        const u32x2 hi = *(const u32x2*)(vb_ + (db * 16 + fr) * 72 + (2 * kk + 1) * 16 + fq * 4);
                        u32x4 vw; vw.x = lo.x; vw.y = lo.y; vw.z = hi.x; vw.w = hi.y;
                        const bf16x8 vf = __builtin_bit_cast(bf16x8, vw);
#pragma unroll
                        for (int qb = 0; qb < 2; ++qb) oacc[db][qb] = __builtin_amdgcn_mfma_f32_16x16x32_bf16(vf, pf[qb][kk], oacc[db][qb], 0, 0, 0);
                    }
            }
            if (kt < kt1) {
                *(u32x4*)(sK + (buf ^ 1) * 4608 + skey * 72 + spiece * 8) = kreg;
                bf16_t* vt = sVT + (buf ^ 1) * 4608 + (vpiece * 8) * 72 + vkey;
#pragma unroll
                for (int e = 0; e < 8; ++e) vt[e * 72] = (bf16_t)((e & 1) ? (vreg[e >> 1] >> 16) : (vreg[e >> 1] & 0xffffu));
            }
            __syncthreads();
        }
#pragma unroll
        for (int qb = 0; qb < 2; ++qb) {
            float lt = lrun[qb]; lt += __shfl_xor(lt, 16); lt += __shfl_xor(lt, 32);
            const float inv = 1.0f / lt;
            bf16_t* op = p.U + (tokb + c * 64 + half * 32 + qb * 16 + fr) * D + h * 64 + fq * 4;
#pragma unroll
            for (int db = 0; db < 4; ++db) {
                u32x2 ow; ow.x = cvt_pk_bf16(oacc[db][qb][0] * inv, oacc[db][qb][1] * inv); ow.y = cvt_pk_bf16(oacc[db][qb][2] * inv, oacc[db][qb][3] * inv);
                *(u32x2*)(op + db * 16) = ow;
            }
        }
    }
    __syncthreads();
}

__global__ void __launch_bounds__(512, 2) yoco_fwd(Params p) {
    extern __shared__ __attribute__((aligned(16))) unsigned char shm[];
    cg::grid_group grid = cg::this_grid();
    prep_phase(p, shm);
    grid.sync();
    for (int l = 0; l < 4; ++l) {
        const float* hsrc = (l == 0) ? p.x : p.h;
        const float* mv = p.modv + (size_t)l * 8 * 6144;
        if (l == 2) norm_phase(hsrc, p.U, p.norm_mix + l * D, mv, mv + D, 6144, p.U2, p.kv_norm, p.kvmod, p.kvmod + D, 2048);
        else norm_phase(hsrc, p.U, p.norm_mix + l * D, mv, mv + D, 6144, nullptr, nullptr, nullptr, nullptr, 0);
        grid.sync();
        if (l < 2) {
            pg8::EpiHgrnIn e; e.QVG = p.Qh; e.LF = p.LF; e.lb = p.lbv + l * D;
            run_gemm(shm, p.U, p.wb_a_in + (size_t)l * AIN * D, AIN, D, e);
            grid.sync();
            rec_simple_phase(p, shm);
            grid.sync();
            rec_norm_phase(p, p.a_out_norm + l * 128);
        } else {
            if (l == 2) { pg8::EpiBf16Split e; e.d0 = p.Kb; e.scale = 1.0f; run_gemm(shm, p.U2, p.wb_kv, 2048, D, e); }
            { pg8::EpiBf16Split e; e.d0 = p.Qb; e.scale = 0.125f; run_gemm(shm, p.U, p.wb_q + (size_t)(l - 2) * D * D, D, D, e); }
            grid.sync();
            attn_phase(p, l - 2, shm);
        }
        grid.sync();
        {
            pg8::EpiResid e; e.src = hsrc; e.dst = p.h; e.gate = mv + 2 * D;
            run_gemm(shm, p.U, (l < 2) ? p.wb_a_out + (size_t)l * D * D : p.wb_o + (size_t)(l - 2) * D * D, D, D, e);
        }
        grid.sync();
        norm_phase(p.h, p.U, p.norm_ffn + l * D, mv + 3 * D, mv + 4 * D, 6144, nullptr, nullptr, nullptr, nullptr, 0);
        grid.sync();
        { pg8::EpiSwiglu e; e.act = p.ACT; run_gemm(shm, p.U, p.wb_ffn_in + (size_t)l * 2 * FFN * D, 2 * FFN, D, e); }
        grid.sync();
        { pg8::EpiResid e; e.src = p.h; e.dst = p.h; e.gate = mv + 5 * D; run_gemm(shm, p.ACT, p.wb_ffn_out + (size_t)l * D * FFN, D, FFN, e); }
        grid.sync();
    }
    final_norm_phase(p.h, p.final_norm);
}

extern "C" void kernel_launch(void* const* d_in, const int* in_sizes, int n_in, void* d_out, int out_size, void* d_ws, size_t ws_size, hipStream_t stream) {
    static int grid_blocks = 0;
    if (!grid_blocks) {
        int dev = 0, cus = 0, per_cu = 0;
        hipGetDevice(&dev);
        hipDeviceGetAttribute(&cus, hipDeviceAttributeMultiprocessorCount, dev);
        hipFuncSetAttribute((const void*)yoco_fwd, hipFuncAttributeMaxDynamicSharedMemorySize, LDS_BYTES);
        hipOccupancyMaxActiveBlocksPerMultiprocessor(&per_cu, (const void*)yoco_fwd, 512, LDS_BYTES);
        if (per_cu < 1) per_cu = 1;
        grid_blocks = cus * per_cu;
        (void)hipGetLastError();
    }
    Params p{};
    const float* const* in = (const float* const*)d_in;
    p.x = in[0]; p.c = in[1]; p.mod_w = in[2]; p.mod_b = in[3]; p.norm_mix = in[4]; p.norm_ffn = in[5]; p.ffn_w_in = in[6]; p.ffn_w_out = in[7];
    p.a_w_in = in[8]; p.a_w_out = in[9]; p.a_lb = in[10]; p.a_out_norm = in[11]; p.kv_norm = in[12]; p.kv_mod_w = in[13]; p.kv_mod_b = in[14]; p.kv_w = in[15];
    p.b_w_q = in[16]; p.b_w_o = in[17]; p.b_rel_bias = in[18]; p.final_norm = in[19];
    p.h = (float*)d_out;
    unsigned char* ws = (unsigned char*)d_ws; size_t off = 0;
    auto take = [&](size_t bytes) { unsigned char* r = ws + off; off += (bytes + 255) & ~(size_t)255; return r; };
    p.wb_a_in = (bf16_t*)take((size_t)2 * AIN * D * 2);
    p.wb_a_out = (bf16_t*)take((size_t)2 * D * D * 2);
    p.wb_ffn_in = (bf16_t*)take((size_t)4 * 2 * FFN * D * 2);
    p.wb_ffn_out = (bf16_t*)take((size_t)4 * D * FFN * 2);
    p.wb_kv = (bf16_t*)take((size_t)2 * D * D * 2);
    p.wb_q = (bf16_t*)take((size_t)2 * D * D * 2);
    p.wb_o = (bf16_t*)take((size_t)2 * D * D * 2);
    p.modv = (float*)take((size_t)4 * 8 * 6144 * 4);
    p.kvmod = (float*)take((size_t)8 * 2048 * 4);
    p.lbv = (float*)take((size_t)2 * D * 4);
    const size_t act = (size_t)MTOK * D * 2;
    p.U = (bf16_t*)take(act);
    unsigned char* R = ws + off;
    p.Qh = (bf16_t*)R; p.Vh = (bf16_t*)(R + act); p.Gh = (bf16_t*)(R + 2 * act); p.LF = (float*)(R + 3 * act);
    p.ACT = (bf16_t*)R;
    p.U2 = (bf16_t*)R;
    p.Kb = (bf16_t*)(R + (size_t)MTOK * FFN * 2); p.Vb = p.Kb + (size_t)MTOK * D; p.Qb = p.Vb + (size_t)MTOK * D;
    p.wg[0] = WGroup{p.a_w_in, p.wb_a_in, D, AIN, 2, 0};
    p.wg[1] = WGroup{p.a_w_out, p.wb_a_out, D, D, 2, 0};
    p.wg[2] = WGroup{p.ffn_w_in, p.wb_ffn_in, D, 2 * FFN, 4, 1};
    p.wg[3] = WGroup{p.ffn_w_out, p.wb_ffn_out, FFN, D, 4, 0};
    p.wg[4] = WGroup{p.kv_w, p.wb_kv, D, 2 * D, 1, 0};
    p.wg[5] = WGroup{p.b_w_q, p.wb_q, D, D, 2, 0};
    p.wg[6] = WGroup{p.b_w_o, p.wb_o, D, D, 2, 0};
    void* args[] = {&p};
    hipError_t e = hipLaunchCooperativeKernel((const void*)yoco_fwd, dim3(grid_blocks), dim3(512), args, LDS_BYTES, stream);
    if (e != hipSuccess) fprintf(stderr, "cooperative launch failed: %s (grid %d)\n", hipGetErrorString(e), grid_blocks);
}
```

```cpp
#include <hip/hip_runtime.h>
#include <hip/hip_cooperative_groups.h>
#include <cstdio>
namespace cg = cooperative_groups;

#define LAS __attribute__((address_space(3)))
typedef unsigned short bf16_t;
typedef short bf16x8 __attribute__((ext_vector_type(8)));
typedef float f32x4 __attribute__((ext_vector_type(4)));
typedef unsigned u32x4 __attribute__((ext_vector_type(4)));
typedef unsigned u32x2 __attribute__((ext_vector_type(2)));

constexpr int D = 1024, BATCH = 8, SEQ = 8192, MTOK = BATCH * SEQ, FFN = 2816, AIN = 4096;
constexpr int LDS_BYTES = 144 * 1024;

__device__ __forceinline__ unsigned cvt_pk_bf16(float lo, float hi) { unsigned r; asm volatile("v_cvt_pk_bf16_f32 %0, %1, %2" : "=v"(r) : "v"(lo), "v"(hi)); return r; }
__device__ __forceinline__ float bf2f(unsigned short h) { return __uint_as_float((unsigned)h << 16); }
__device__ __forceinline__ float bflo(unsigned w) { return __uint_as_float(w << 16); }
__device__ __forceinline__ float bfhi(unsigned w) { return __uint_as_float(w & 0xffff0000u); }
__device__ __forceinline__ float silu_f(float x) { return x * __builtin_amdgcn_rcpf(1.0f + __expf(-x)); }

__device__ __forceinline__ int opaque_tid() { int t = threadIdx.x; asm volatile("" : "+v"(t)); return t; }
struct WGroup { const float* src; bf16_t* dst; int K, N, L, mode; };

struct Params {
    const float *x, *c, *mod_w, *mod_b, *norm_mix, *norm_ffn, *ffn_w_in, *ffn_w_out, *a_w_in, *a_w_out, *a_lb, *a_out_norm,
                *kv_norm, *kv_mod_w, *kv_mod_b, *kv_w, *b_w_q, *b_w_o, *b_rel_bias, *final_norm;
    float* h;
    bf16_t *wb_a_in, *wb_a_out, *wb_ffn_in, *wb_ffn_out, *wb_kv, *wb_q, *wb_o;
    float *modv, *kvmod, *lbv;
    bf16_t *U, *U2, *Qh, *Vh, *Gh;
    float* LF;
    bf16_t *ACT, *Kb, *Vb, *Qb;
    float *Sloc, *Dlog;
    WGroup wg[7];
};

namespace pg8 {
constexpr int BM = 256, BK = 64, HALF = 128, HTB = HALF * BK * 2, STAGE_BYTES = 8 * HTB, NXCD = 8, WGM = 8;
__device__ __forceinline__ int lds_byte(int r, int c) { const int st = (r >> 4) * 2 + (c >> 5), rr = r & 15, cc = c & 31, ob = rr * 64 + cc * 2; return st * 1024 + (ob ^ (((ob >> 9) & 1) << 5)); }
__device__ __forceinline__ void stage_rc(int b, int& R, int& C) { const int st = b / 1024, sb = b % 1024, swz = sb ^ (((sb >> 9) & 1) << 5); R = (st >> 1) * 16 + swz / 64; C = (st & 1) * 32 + (swz % 64) / 2; }
__device__ __forceinline__ int perm32(int rho) { const int n = rho >> 4, i = rho & 15; return 8 * (i >> 2) + 4 * n + (i & 3); }
struct Unit { int pm, pn; };
struct Gemm { const bf16_t* A; const bf16_t* Bt; int M, N, K; };
struct StaticOrder {
    int nM, nN, nwg, G, c;
    __device__ void init(int M, int N, int G_, int c_) { nM = M / BM; nN = N / BM; nwg = nM * nN; G = G_; c = c_; }
    __device__ bool next(int i, Unit& u) const {
        const long L = (long)i * G + c; if (L >= nwg) return false;
        int wgid = (int)L; { const int q = nwg / NXCD, r = nwg % NXCD, xcd = wgid % NXCD, off = wgid / NXCD; wgid = (xcd < r ? xcd * (q + 1) : r * (q + 1) + (xcd - r) * q) + off; }
        const int nig = WGM * nN, gid = wgid / nig, fm = gid * WGM, gsz = (nM - fm) < WGM ? (nM - fm) : WGM;
        u.pm = fm + ((wgid % nig) % gsz); u.pn = (wgid % nig) / gsz; return true;
    }
};

template <class Epi>
__device__ __forceinline__ void gemm_phase(LAS unsigned char* lds, const Gemm g, const StaticOrder& S, const Epi& E) {
    const int tid = opaque_tid(), wid = __builtin_amdgcn_readfirstlane(tid >> 6), lane = tid & 63, wr = wid >> 2, wc = wid & 3, fr = lane & 15, fq = lane >> 4;
    const int K = g.K, nt = K / BK;
    unsigned voffA[2], voffB[2];
#pragma unroll
    for (int i = 0; i < 2; ++i) { int R, C; stage_rc(tid * 16 + i * 8192, R, C); const int Rb = Epi::PERM ? ((R & ~31) + perm32(R & 31)) : R;
        voffA[i] = (unsigned)(R * K + C) * 2u; voffB[i] = (unsigned)(Rb * K + C) * 2u; }
    const size_t kstep = (size_t)(BK * 2);
    const size_t hstep = (size_t)HALF * K * 2;
    const size_t tstep = 2 * hstep;
    const unsigned ldsw = (unsigned)wid * 1024u;
    const int aoff = lds_byte(wr * 64 + fr, fq * 8), boff = lds_byte(wc * 32 + fr, fq * 8);
#define PG8_SA(b, h) (((b) * 2 + (h)) * HTB)
#define PG8_SB(b, h) ((4 + (b) * 2 + (h)) * HTB)
#define PG8_STAGE(bufoff, gbase, voff) do { _Pragma("unroll") for (int _i = 0; _i < 2; ++_i) \
        __builtin_amdgcn_global_load_lds((const unsigned*)((const char*)(gbase) + (voff)[_i]), (LAS unsigned*)(lds + (bufoff) + ldsw + _i * 8192), 16, 0, 0); } while (0)
#define PG8_LDA(dst, b, h) do { _Pragma("unroll") for (int m = 0; m < 4; ++m) _Pragma("unroll") for (int k = 0; k < 2; ++k) dst[m][k] = *(const LAS bf16x8*)(lds + PG8_SA(b, h) + aoff + m * 2048 + k * 1024); } while (0)
#define PG8_LDB(dst, b, h) do { _Pragma("unroll") for (int n = 0; n < 2; ++n) _Pragma("unroll") for (int k = 0; k < 2; ++k) dst[n][k] = *(const LAS bf16x8*)(lds + PG8_SB(b, h) + boff + n * 2048 + k * 1024); } while (0)
#define PG8_MMA(ai, bj, At, Bt) do { __builtin_amdgcn_s_setprio(1); _Pragma("unroll") for (int m = 0; m < 4; ++m) _Pragma("unroll") for (int n = 0; n < 2; ++n) _Pragma("unroll") for (int k = 0; k < 2; ++k) \
        acc[ai][bj][m][n] = __builtin_amdgcn_mfma_f32_16x16x32_bf16(Bt[n][k], At[m][k], acc[ai][bj][m][n], 0, 0, 0); __builtin_amdgcn_s_setprio(0); } while (0)
#define PG8_WAIT_V(n) asm volatile("s_waitcnt vmcnt(" #n ")" ::: "memory")
#define PG8_WAIT_L(n) asm volatile("s_waitcnt lgkmcnt(" #n ")" ::: "memory")
#define PG8_BAR __builtin_amdgcn_s_barrier()
#define PG8_SCHED __builtin_amdgcn_sched_barrier(0)
    Unit cur, nxt; int ui = 0;
    if (!S.next(0, cur)) return;
    f32x4 acc[2][2][4][2];
#pragma unroll
    for (int a = 0; a < 2; ++a)
#pragma unroll
        for (int b = 0; b < 2; ++b)
#pragma unroll
            for (int m = 0; m < 4; ++m)
#pragma unroll
                for (int n = 0; n < 2; ++n) acc[a][b][m][n] = (f32x4){0.f, 0.f, 0.f, 0.f};
    bf16x8 At[4][2], B0[2][2], B1[2][2];
    const char* cA = (const char*)g.A + (size_t)cur.pm * tstep; const char* cB = (const char*)g.Bt + (size_t)cur.pn * tstep;
    PG8_STAGE(PG8_SB(0, 0), cB, voffB); PG8_STAGE(PG8_SA(0, 0), cA, voffA); PG8_STAGE(PG8_SB(0, 1), cB + hstep, voffB); PG8_STAGE(PG8_SA(0, 1), cA + hstep, voffA);
    if (wr == 1) PG8_BAR;
    PG8_WAIT_V(4); PG8_BAR;
    PG8_STAGE(PG8_SB(1, 0), cB + kstep, voffB); PG8_STAGE(PG8_SA(1, 0), cA + kstep, voffA); PG8_STAGE(PG8_SB(1, 1), cB + hstep + kstep, voffB);
    PG8_WAIT_V(6); PG8_BAR;
    for (;;) {
        const bool has_next = S.next(ui + 1, nxt);
        const char* nA = has_next ? (const char*)g.A + (size_t)nxt.pm * tstep : cA; const char* nB = has_next ? (const char*)g.Bt + (size_t)nxt.pn * tstep : cB;
        for (int t = 0; t < nt; t += 2) {
            const bool last = (t == nt - 2);
            const char* a1 = cA + (size_t)(t + 1) * kstep;
            const char* a2 = last ? nA : cA + (size_t)(t + 2) * kstep; const char* b2 = last ? nB : cB + (size_t)(t + 2) * kstep;
            const char* a3 = a2 + kstep; const char* b3 = b2 + kstep;
            PG8_LDB(B0, 0, 0); PG8_SCHED; PG8_LDA(At, 0, 0); PG8_STAGE(PG8_SA(1, 1), a1 + hstep, voffA);
            PG8_WAIT_L(8); PG8_BAR; PG8_WAIT_L(0); PG8_MMA(0, 0, At, B0); PG8_BAR; PG8_SCHED;
            PG8_LDB(B1, 0, 1); PG8_STAGE(PG8_SB(0, 0), b2, voffB);
            PG8_BAR; PG8_WAIT_L(0); PG8_MMA(0, 1, At, B1); PG8_BAR;
            PG8_LDA(At, 0, 1); PG8_STAGE(PG8_SA(0, 0), a2, voffA);
            PG8_BAR; PG8_WAIT_L(0); PG8_MMA(1, 0, At, B0); PG8_BAR; PG8_SCHED;
            PG8_STAGE(PG8_SB(0, 1), b2 + hstep, voffB);
            PG8_WAIT_V(6); PG8_BAR; PG8_MMA(1, 1, At, B1); PG8_BAR;
            PG8_LDB(B0, 1, 0); PG8_SCHED; PG8_LDA(At, 1, 0); PG8_STAGE(PG8_SA(0, 1), a2 + hstep, voffA);
            PG8_WAIT_L(8); PG8_BAR; PG8_WAIT_L(0); PG8_MMA(0, 0, At, B0); PG8_BAR; PG8_SCHED;
            PG8_LDB(B1, 1, 1); PG8_STAGE(PG8_SB(1, 0), b3, voffB);
            PG8_BAR; PG8_WAIT_L(0); PG8_MMA(0, 1, At, B1); PG8_BAR;
            PG8_LDA(At, 1, 1); PG8_STAGE(PG8_SA(1, 0), a3, voffA);
            PG8_BAR; PG8_WAIT_L(0); PG8_MMA(1, 0, At, B0); PG8_BAR; PG8_SCHED;
            PG8_STAGE(PG8_SB(1, 1), b3 + hstep, voffB);
            PG8_WAIT_V(6); PG8_BAR; PG8_MMA(1, 1, At, B1); PG8_BAR;
        }
        E(acc, cur, wr, wc, fr, fq);
        if (!has_next) break;
#pragma unroll
        for (int a = 0; a < 2; ++a)
#pragma unroll
            for (int b = 0; b < 2; ++b)
#pragma unroll
                for (int m = 0; m < 4; ++m)
#pragma unroll
                    for (int n = 0; n < 2; ++n) acc[a][b][m][n] = (f32x4){0.f, 0.f, 0.f, 0.f};
        cur = nxt; cA = nA; cB = nB; ++ui;
    }
    PG8_WAIT_V(0);
    if (wr == 0) PG8_BAR;
    PG8_BAR;
#undef PG8_SA
#undef PG8_SB
#undef PG8_STAGE
#undef PG8_LDA
#undef PG8_LDB
#undef PG8_MMA
#undef PG8_WAIT_V
#undef PG8_WAIT_L
#undef PG8_BAR
#undef PG8_SCHED
}

struct EpiHgrnIn {
    static constexpr bool PERM = true;
    bf16_t* QVG; float* LF; const float* lb;
    __device__ __forceinline__ void operator()(const f32x4 (&acc)[2][2][4][2], const Unit& u, int wr, int wc, int fr, int fq) const {
        const int seg = u.pn >> 2, colt = (u.pn & 3) * 256;
        const int row0 = u.pm * BM + wr * 64 + fr, col0 = colt + wc * 32 + 8 * fq;
        if (seg == 1) {
#pragma unroll
            for (int bj = 0; bj < 2; ++bj) {
                const f32x4 l0 = *(const f32x4*)(lb + col0 + bj * HALF), l1 = *(const f32x4*)(lb + col0 + bj * HALF + 4);
#pragma unroll
                for (int ai = 0; ai < 2; ++ai)
#pragma unroll
                    for (int m = 0; m < 4; ++m) {
                        float* rowp = LF + (size_t)(row0 + ai * HALF + m * 16) * D + col0 + bj * HALF;
                        f32x4 o0, o1;
#pragma unroll
                        for (int j = 0; j < 4; ++j) {
                            float z = acc[ai][bj][m][0][j]; float sg = __builtin_amdgcn_rcpf(1.0f + __expf(-z)); float f = l0[j] + (1.0f - l0[j]) * sg; o0[j] = logf(fmaxf(f, 1e-30f));
                            z = acc[ai][bj][m][1][j]; sg = __builtin_amdgcn_rcpf(1.0f + __expf(-z)); f = l1[j] + (1.0f - l1[j]) * sg; o1[j] = logf(fmaxf(f, 1e-30f));
                        }
                        *(f32x4*)rowp = o0; *(f32x4*)(rowp + 4) = o1;
                    }
            }
        } else {
            bf16_t* base = QVG + (size_t)(seg == 0 ? 0 : (seg == 2 ? 1 : 2)) * ((size_t)MTOK * D);
            const bool act = (seg != 2);
#pragma unroll
            for (int ai = 0; ai < 2; ++ai)
#pragma unroll
                for (int m = 0; m < 4; ++m)
#pragma unroll
                    for (int bj = 0; bj < 2; ++bj) {
                        f32x4 v0 = acc[ai][bj][m][0], v1 = acc[ai][bj][m][1];
                        if (act) {
#pragma unroll
                            for (int j = 0; j < 4; ++j) { v0[j] = silu_f(v0[j]); v1[j] = silu_f(v1[j]); }
                        }
                        u32x4 w; w.x = cvt_pk_bf16(v0[0], v0[1]); w.y = cvt_pk_bf16(v0[2], v0[3]); w.z = cvt_pk_bf16(v1[0], v1[1]); w.w = cvt_pk_bf16(v1[2], v1[3]);
                        *(u32x4*)(base + (size_t)(row0 + ai * HALF + m * 16) * D + col0 + bj * HALF) = w;
                    }
        }
    }
};
struct EpiResid {
    static constexpr bool PERM = true;
    const float* src; float* dst; const float* gate;
    __device__ __forceinline__ void operator()(const f32x4 (&acc)[2][2][4][2], const Unit& u, int wr, int wc, int fr, int fq) const {
        const int b = u.pm >> 5;
        const float* gp = gate + (size_t)b * 6144;
        const int row0 = u.pm * BM + wr * 64 + fr, col0 = u.pn * BM + wc * 32 + 8 * fq;
        f32x4 gv[2][2];
#pragma unroll
        for (int bj = 0; bj < 2; ++bj)
#pragma unroll
            for (int n = 0; n < 2; ++n) gv[bj][n] = *(const f32x4*)(gp + col0 + bj * HALF + 4 * n);
#pragma unroll
        for (int ai = 0; ai < 2; ++ai)
#pragma unroll
            for (int m = 0; m < 4; ++m) {
                const size_t ro = (size_t)(row0 + ai * HALF + m * 16) * D + col0;
#pragma unroll
                for (int bj = 0; bj < 2; ++bj)
#pragma unroll
                    for (int n = 0; n < 2; ++n) {
                        const f32x4 s = *(const f32x4*)(src + ro + bj * HALF + 4 * n);
                        *(f32x4*)(dst + ro + bj * HALF + 4 * n) = s + gv[bj][n] * acc[ai][bj][m][n];
                    }
            }
    }
};
struct EpiSwiglu {
    static constexpr bool PERM = true;
    bf16_t* act;
    __device__ __forceinline__ void operator()(const f32x4 (&acc)[2][2][4][2], const Unit& u, int wr, int wc, int fr, int fq) const {
        const int row0 = u.pm * BM + wr * 64 + fr, col0 = u.pn * HALF + wc * 32 + 8 * fq;
#pragma unroll
        for (int ai = 0; ai < 2; ++ai)
#pragma unroll
            for (int m = 0; m < 4; ++m) {
                f32x4 r0, r1;
#pragma unroll
                for (int j = 0; j < 4; ++j) { r0[j] = silu_f(acc[ai][0][m][0][j]) * acc[ai][1][m][0][j]; r1[j] = silu_f(acc[ai][0][m][1][j]) * acc[ai][1][m][1][j]; }
                u32x4 w; w.x = cvt_pk_bf16(r0[0], r0[1]); w.y = cvt_pk_bf16(r0[2], r0[3]); w.z = cvt_pk_bf16(r1[0], r1[1]); w.w = cvt_pk_bf16(r1[2], r1[3]);
                *(u32x4*)(act + (size_t)(row0 + ai * HALF + m * 16) * FFN + col0) = w;
            }
    }
};
struct EpiBf16Split {
    static constexpr bool PERM = true;
    bf16_t* d0; float scale;
    __device__ __forceinline__ void operator()(const f32x4 (&acc)[2][2][4][2], const Unit& u, int wr, int wc, int fr, int fq) const {
        bf16_t* base = d0 + (size_t)(u.pn >> 2) * ((size_t)MTOK * D);
        const int row0 = u.pm * BM + wr * 64 + fr, col0 = (u.pn & 3) * 256 + wc * 32 + 8 * fq;
#pragma unroll
        for (int ai = 0; ai < 2; ++ai)
#pragma unroll
            for (int m = 0; m < 4; ++m)
#pragma unroll
                for (int bj = 0; bj < 2; ++bj) {
                    const f32x4 v0 = acc[ai][bj][m][0] * scale, v1 = acc[ai][bj][m][1] * scale;
                    u32x4 w; w.x = cvt_pk_bf16(v0[0], v0[1]); w.y = cvt_pk_bf16(v0[2], v0[3]); w.z = cvt_pk_bf16(v1[0], v1[1]); w.w = cvt_pk_bf16(v1[2], v1[3]);
                    *(u32x4*)(base + (size_t)(row0 + ai * HALF + m * 16) * D + col0 + bj * HALF) = w;
                }
    }
};
}

template <class Epi>
__device__ __forceinline__ void run_gemm(unsigned char* shm, const bf16_t* A, const bf16_t* Bt, int N, int K, const Epi& E) {
    pg8::Gemm g; g.A = A; g.Bt = Bt; g.M = MTOK; g.N = N; g.K = K;
    pg8::StaticOrder S; S.init(MTOK, N, (int)gridDim.x, (int)blockIdx.x);
    pg8::gemm_phase<Epi>((LAS unsigned char*)shm, g, S, E);
    __syncthreads();
}

__device__ __forceinline__ int ffnmap(int nn) { return nn < FFN ? ((nn >> 7) * 256 + (nn & 127)) : (((nn - FFN) >> 7) * 256 + 128 + ((nn - FFN) & 127)); }

__device__ void prep_phase(const Params& p, unsigned char* shm) {
    const int tid = opaque_tid();
    {
        float* cact = (float*)shm;
        float* red = cact + 8192;
        bool loaded = false;
        const int wv = tid >> 6, lane = tid & 63;
        for (int task = blockIdx.x; task < 416; task += gridDim.x) {
            if (!loaded) {
                for (int i = tid; i < 8192; i += 512) { const int k = i >> 3, b = i & 7; cact[i] = silu_f(p.c[b * D + k]); }
                loaded = true;
            }
            __syncthreads();
            const int c0 = task * 64;
            const float* src; const float* bias; float* dst; int stride, dstride;
            if (c0 < 24576) { const int l = c0 / 6144, j = c0 % 6144; src = p.mod_w + (size_t)l * D * 6144 + j; stride = 6144; bias = p.mod_b + l * 6144 + j; dst = p.modv + (size_t)l * 8 * 6144 + j; dstride = 6144; }
            else { const int j = c0 - 24576; src = p.kv_mod_w + j; stride = 2048; bias = p.kv_mod_b + j; dst = p.kvmod + j; dstride = 2048; }
            float a[8];
#pragma unroll
            for (int b = 0; b < 8; ++b) a[b] = 0.f;
            const float* sp = src + (size_t)(wv * 128) * stride + lane;
#pragma unroll 8
            for (int k = 0; k < 128; ++k) {
                const float w = sp[(size_t)k * stride];
                const f32x4 c0v = *(const f32x4*)(cact + (wv * 128 + k) * 8), c1v = *(const f32x4*)(cact + (wv * 128 + k) * 8 + 4);
                a[0] += w * c0v[0]; a[1] += w * c0v[1]; a[2] += w * c0v[2]; a[3] += w * c0v[3];
                a[4] += w * c1v[0]; a[5] += w * c1v[1]; a[6] += w * c1v[2]; a[7] += w * c1v[3];
            }
#pragma unroll
            for (int b = 0; b < 8; ++b) red[(wv * 8 + b) * 64 + lane] = a[b];
            __syncthreads();
            {
                const int b = tid >> 6, col = tid & 63;
                float s = bias[col];
#pragma unroll
                for (int w = 0; w < 8; ++w) s += red[(w * 8 + b) * 64 + col];
                dst[(size_t)b * dstride + col] = s;
            }
        }
        __syncthreads();
    }
    for (int i = blockIdx.x * 512 + tid; i < 1024; i += gridDim.x * 512) {
        const float a0 = p.a_lb[i], a1 = p.a_lb[1024 + i];
        const float mx = fmaxf(a0, a1), e0 = __expf(a0 - mx), e1 = __expf(a1 - mx);
        p.lbv[i] = 0.f; p.lbv[1024 + i] = e1 / (e0 + e1);
    }
    {
        float* st = (float*)shm;
        int total = 0;
        for (int g = 0; g < 7; ++g) total += p.wg[g].L * (p.wg[g].K / 64) * (p.wg[g].N / 64);
        for (int tile = blockIdx.x; tile < total; tile += gridDim.x) {
            int g = 0, rem = tile;
            for (;;) { const int cnt = p.wg[g].L * (p.wg[g].K / 64) * (p.wg[g].N / 64); if (rem < cnt) break; rem -= cnt; ++g; }
            const int K = p.wg[g].K, N = p.wg[g].N, mode = p.wg[g].mode;
            const int per = (K / 64) * (N / 64), l = rem / per, tt = rem % per, ntn = N / 64, k0 = (tt / ntn) * 64, n0 = (tt % ntn) * 64;
            const float* src = p.wg[g].src + (size_t)l * K * N; bf16_t* dst = p.wg[g].dst + (size_t)l * K * N;
            __syncthreads();
            for (int i = tid; i < 4096; i += 512) { const int k = i >> 6, n = i & 63; st[k * 65 + n] = src[(size_t)(k0 + k) * N + n0 + n]; }
            __syncthreads();
            for (int i = tid; i < 2048; i += 512) { const int n = i >> 5, kp = i & 31; const int nn = n0 + n; const int drow = mode ? ffnmap(nn) : nn;
                *(unsigned*)(dst + (size_t)drow * K + k0 + 2 * kp) = cvt_pk_bf16(st[(2 * kp) * 65 + n], st[(2 * kp + 1) * 65 + n]); }
        }
        __syncthreads();
    }
}

__device__ void norm_phase(const float* src, bf16_t* U1, const float* gain1, const float* sh1, const float* sc1, int bs1,
                           bf16_t* U2, const float* gain2, const float* sh2, const float* sc2, int bs2) {
    const int tid_ = opaque_tid(); const int lane = tid_ & 63, gw = blockIdx.x * 8 + (tid_ >> 6), nw = gridDim.x * 8;
    for (int row = gw; row < MTOK; row += nw) {
        const int b = row >> 13;
        const float* xp = src + (size_t)row * D;
        f32x4 xv[4]; float ss = 0.f;
#pragma unroll
        for (int i = 0; i < 4; ++i) { xv[i] = *(const f32x4*)(xp + i * 256 + lane * 4); ss += xv[i][0] * xv[i][0] + xv[i][1] * xv[i][1] + xv[i][2] * xv[i][2] + xv[i][3] * xv[i][3]; }
#pragma unroll
        for (int o = 1; o < 64; o <<= 1) ss += __shfl_xor(ss, o);
        const float rstd = rsqrtf(ss * (1.0f / D) + 1e-6f);
#pragma unroll
        for (int i = 0; i < 4; ++i) {
            const int k = i * 256 + lane * 4;
            const f32x4 g = *(const f32x4*)(gain1 + k), s = *(const f32x4*)(sc1 + (size_t)b * bs1 + k), t = *(const f32x4*)(sh1 + (size_t)b * bs1 + k);
            f32x4 u;
#pragma unroll
            for (int j = 0; j < 4; ++j) u[j] = (xv[i][j] * rstd * g[j]) * (1.0f + s[j]) + t[j];
            u32x2 w; w.x = cvt_pk_bf16(u[0], u[1]); w.y = cvt_pk_bf16(u[2], u[3]);
            *(u32x2*)(U1 + (size_t)row * D + k) = w;
        }
        if (U2) {
#pragma unroll
            for (int i = 0; i < 4; ++i) {
                const int k = i * 256 + lane * 4;
                const f32x4 g = *(const f32x4*)(gain2 + k), s = *(const f32x4*)(sc2 + (size_t)b * bs2 + k), t = *(const f32x4*)(sh2 + (size_t)b * bs2 + k);
                f32x4 u;
#pragma unroll
                for (int j = 0; j < 4; ++j) u[j] = (xv[i][j] * rstd * g[j]) * (1.0f + s[j]) + t[j];
                u32x2 w; w.x = cvt_pk_bf16(u[0], u[1]); w.y = cvt_pk_bf16(u[2], u[3]);
                *(u32x2*)(U2 + (size_t)row * D + k) = w;
            }
        }
    }
}
__device__ void final_norm_phase(float* h, const float* gain) {
    const int tid_ = opaque_tid(); const int lane = tid_ & 63, gw = blockIdx.x * 8 + (tid_ >> 6), nw = gridDim.x * 8;
    for (int row = gw; row < MTOK; row += nw) {
        float* xp = h + (size_t)row * D;
        f32x4 xv[4]; float ss = 0.f;
#pragma unroll
        for (int i = 0; i < 4; ++i) { xv[i] = *(const f32x4*)(xp + i * 256 + lane * 4); ss += xv[i][0] * xv[i][0] + xv[i][1] * xv[i][1] + xv[i][2] * xv[i][2] + xv[i][3] * xv[i][3]; }
#pragma unroll
        for (int o = 1; o < 64; o <<= 1) ss += __shfl_xor(ss, o);
        const float rstd = rsqrtf(ss * (1.0f / D) + 1e-6f);
#pragma unroll
        for (int i = 0; i < 4; ++i) {
            const int k = i * 256 + lane * 4;
            const f32x4 g = *(const f32x4*)(gain + k);
            f32x4 u;
#pragma unroll
            for (int j = 0; j < 4; ++j) u[j] = xv[i][j] * rstd * g[j];
            *(f32x4*)(xp + k) = u;
        }
    }
}

template <bool OUT>
__device__ void rec_pass(const Params& p, int layer, unsigned char* shm) {
    float* sB = (float*)shm;
    float* sKm = (float*)(shm + 33792);
    bf16_t* sST = (bf16_t*)shm;
    bf16_t* sQb = (bf16_t*)(shm + 67584);
    bf16_t* sA = (bf16_t*)(shm + 84992);
    bf16_t* sKT = (bf16_t*)(shm + 94208);
    bf16_t* sVT = (bf16_t*)(shm + 112640);
    float* sE = (float*)(shm + 131072);
    float* sPart = (float*)(shm + 131584);
    float* sNrm = (float*)(shm + 133632);
    const int tid = opaque_tid(), lane = tid & 63, w = tid >> 6, fr = lane & 15, fq = lane >> 4;
    const int wi = w >> 1, wh = w & 1;
    const int ntask = OUT ? 256 : 192;
    const float* ogain = p.a_out_norm + layer * 128;
    for (int task = blockIdx.x; task < ntask; task += gridDim.x) {
        int sc, bh; if (OUT) { sc = task & 3; bh = task >> 2; } else { sc = task % 3; bh = task / 3; }
        const int b = bh >> 3, h = bh & 7;
        f32x4 S[8];
#pragma unroll
        for (int db = 0; db < 8; ++db) S[db] = (f32x4){0.f, 0.f, 0.f, 0.f};
        if (OUT) {
            for (int s2 = 0; s2 < sc; ++s2) {
                const float* sl = p.Sloc + (size_t)(bh * 4 + s2) * 16384; const float* dl = p.Dlog + (bh * 4 + s2) * 128;
#pragma unroll
                for (int db = 0; db < 8; ++db) {
                    const f32x4 x = *(const f32x4*)(sl + ((w * 8 + db) * 64 + lane) * 4), dv = *(const f32x4*)(dl + 16 * db + fq * 4);
#pragma unroll
                    for (int j = 0; j < 4; ++j) S[db][j] = S[db][j] * __expf(dv[j]) + x[j];
                }
            }
        }
        float dlacc = 0.f;
        for (int ch = sc * 32; ch < sc * 32 + 32; ++ch) {
            const size_t row0 = (size_t)b * SEQ + (size_t)ch * 64;
            float lfv[16];
            {
                const float* lp = p.LF + (row0 + 16 * (tid >> 7)) * D + h * 128 + (tid & 127);
#pragma unroll
                for (int e = 0; e < 16; ++e) lfv[e] = lp[(size_t)e * D];
            }
            const u32x4 vr0 = *(const u32x4*)(p.Vh + (row0 + (tid & 63)) * D + h * 128 + (tid >> 6) * 8);
            const u32x4 vr1 = *(const u32x4*)(p.Vh + (row0 + (tid & 63)) * D + h * 128 + 64 + (tid >> 6) * 8);
            u32x4 qraw[4]; u32x2 graw[4];
            if (OUT) {
#pragma unroll
                for (int ks = 0; ks < 4; ++ks) qraw[ks] = *(const u32x4*)(p.Qh + (row0 + 16 * wi + fr) * D + h * 128 + ks * 32 + fq * 8);
#pragma unroll
                for (int vb = 0; vb < 4; ++vb) graw[vb] = *(const u32x2*)(p.Gh + (row0 + 16 * wi + fr) * D + h * 128 + 64 * wh + 16 * vb + fq * 4);
            }
            {
                const int d_ = tid & 127, tq = tid >> 7;
                float run = 0.f;
#pragma unroll
                for (int e = 0; e < 16; ++e) { sKm[(16 * tq + e) * 132 + d_] = 1.0f - __expf(lfv[e]); run += lfv[e]; lfv[e] = run; }
                sPart[tq * 128 + d_] = run;
                {
                    const int s_ = tid & 63, pc = tid >> 6;
#pragma unroll
                    for (int e = 0; e < 8; ++e) {
                        sVT[(pc * 8 + e) * 72 + s_] = (bf16_t)((e & 1) ? (vr0[e >> 1] >> 16) : (vr0[e >> 1] & 0xffffu));
                        sVT[(64 + pc * 8 + e) * 72 + s_] = (bf16_t)((e & 1) ? (vr1[e >> 1] >> 16) : (vr1[e >> 1] & 0xffffu));
                    }
                }
                __syncthreads();
                float off = 0.f;
                for (int q = 0; q < tq; ++q) off += sPart[q * 128 + d_];
#pragma unroll
                for (int e = 0; e < 16; ++e) sB[(16 * tq + e) * 132 + d_] = lfv[e] + off;
            }
            __syncthreads();
            if (tid < 128) { const float bl = sB[63 * 132 + tid]; sE[tid] = __expf(bl); dlacc += bl; }
            {
                const int s_ = tid & 63, dp = tid >> 6;
#pragma unroll
                for (int q4 = 0; q4 < 4; ++q4) {
                    const f32x4 k4 = *(const f32x4*)(sKm + s_ * 132 + 16 * dp + 4 * q4), b4 = *(const f32x4*)(sB + s_ * 132 + 16 * dp + 4 * q4), l4 = *(const f32x4*)(sB + 63 * 132 + 16 * dp + 4 * q4);
#pragma unroll
                    for (int j = 0; j < 4; ++j) sKT[(16 * dp + 4 * q4 + j) * 72 + s_] = (bf16_t)(cvt_pk_bf16(k4[j] * __expf(l4[j] - b4[j]), 0.f) & 0xffffu);
                }
            }
            if (OUT) {
                const int i = wi, hh = wh, t_ = 16 * i + fr;
                bf16x8 qt[4];
#pragma unroll
                for (int ks = 0; ks < 4; ++ks) {
                    const int d0 = ks * 32 + fq * 8;
                    const f32x4 b0 = *(const f32x4*)(sB + t_ * 132 + d0), b1 = *(const f32x4*)(sB + t_ * 132 + d0 + 4);
                    f32x4 r0 = (f32x4){0.f, 0.f, 0.f, 0.f}, r1 = r0;
                    if (i > 0) { r0 = *(const f32x4*)(sB + (16 * i - 1) * 132 + d0); r1 = *(const f32x4*)(sB + (16 * i - 1) * 132 + d0 + 4); }
                    float qv[8], ql[8];
#pragma unroll
                    for (int e = 0; e < 4; ++e) { qv[2 * e] = bflo(qraw[ks][e]); qv[2 * e + 1] = bfhi(qraw[ks][e]); }
#pragma unroll
                    for (int e = 0; e < 4; ++e) { ql[e] = qv[e] * __expf(b0[e] - r0[e]); ql[4 + e] = qv[4 + e] * __expf(b1[e] - r1[e]); }
                    u32x4 pw; pw.x = cvt_pk_bf16(ql[0], ql[1]); pw.y = cvt_pk_bf16(ql[2], ql[3]); pw.z = cvt_pk_bf16(ql[4], ql[5]); pw.w = cvt_pk_bf16(ql[6], ql[7]);
                    qt[ks] = __builtin_bit_cast(bf16x8, pw);
                    if ((ks >> 1) == hh) {
#pragma unroll
                        for (int e = 0; e < 4; ++e) { ql[e] = qv[e] * __expf(b0[e]); ql[4 + e] = qv[4 + e] * __expf(b1[e]); }
                        u32x4 qw; qw.x = cvt_pk_bf16(ql[0], ql[1]); qw.y = cvt_pk_bf16(ql[2], ql[3]); qw.z = cvt_pk_bf16(ql[4], ql[5]); qw.w = cvt_pk_bf16(ql[6], ql[7]);
                        *(u32x4*)(sQb + t_ * 136 + d0) = qw;
                    }
                }
#pragma unroll
                for (int j2 = 0; j2 < 2; ++j2) {
                    const int j = hh + 2 * j2;
                    if (j <= i) {
                        f32x4 acc = (f32x4){0.f, 0.f, 0.f, 0.f};
                        const int s_ = 16 * j + fr;
#pragma unroll
                        for (int ks = 0; ks < 4; ++ks) {
                            const int d0 = ks * 32 + fq * 8;
                            const f32x4 k0 = *(const f32x4*)(sKm + s_ * 132 + d0), k1 = *(const f32x4*)(sKm + s_ * 132 + d0 + 4);
                            const f32x4 b0 = *(const f32x4*)(sB + s_ * 132 + d0), b1 = *(const f32x4*)(sB + s_ * 132 + d0 + 4);
                            f32x4 r0 = (f32x4){0.f, 0.f, 0.f, 0.f}, r1 = r0;
                            if (i > 0) { r0 = *(const f32x4*)(sB + (16 * i - 1) * 132 + d0); r1 = *(const f32x4*)(sB + (16 * i - 1) * 132 + d0 + 4); }
                            float kl[8];
#pragma unroll
                            for (int e = 0; e < 4; ++e) { kl[e] = k0[e] * __expf(fminf(r0[e] - b0[e], 80.f)); kl[4 + e] = k1[e] * __expf(fminf(r1[e] - b1[e], 80.f)); }
                            u32x4 kw; kw.x = cvt_pk_bf16(kl[0], kl[1]); kw.y = cvt_pk_bf16(kl[2], kl[3]); kw.z = cvt_pk_bf16(kl[4], kl[5]); kw.w = cvt_pk_bf16(kl[6], kl[7]);
                            acc = __builtin_amdgcn_mfma_f32_16x16x32_bf16(qt[ks], __builtin_bit_cast(bf16x8, kw), acc, 0, 0, 0);
                        }
#pragma unroll
                        for (int jj = 0; jj < 4; ++jj) {
                            float vv = acc[jj];
                            if (i == j && fr > fq * 4 + jj) vv = 0.f;
                            sA[(16 * i + fq * 4 + jj) * 72 + 16 * j + fr] = (bf16_t)(cvt_pk_bf16(vv, 0.f) & 0xffffu);
                        }
                    } else {
#pragma unroll
                        for (int jj = 0; jj < 4; ++jj) sA[(16 * i + fq * 4 + jj) * 72 + 16 * j + fr] = (bf16_t)0;
                    }
                }
            }
            __syncthreads();
            if (OUT) {
#pragma unroll
                for (int db = 0; db < 8; ++db) { u32x2 sw; sw.x = cvt_pk_bf16(S[db][0], S[db][1]); sw.y = cvt_pk_bf16(S[db][2], S[db][3]); *(u32x2*)(sST + (16 * w + fr) * 136 + 16 * db + fq * 4) = sw; }
                __syncthreads();
            }
            f32x4 o[4];
            if (OUT) {
                const int i = wi;
#pragma unroll
                for (int vb = 0; vb < 4; ++vb) o[vb] = (f32x4){0.f, 0.f, 0.f, 0.f};
#pragma unroll
                for (int kk = 0; kk < 2; ++kk) {
                    if (kk <= (i >> 1)) {
                        const bf16x8 af = *(const bf16x8*)(sA + (16 * i + fr) * 72 + kk * 32 + fq * 8);
#pragma unroll
                        for (int vb = 0; vb < 4; ++vb) { const bf16x8 vf = *(const bf16x8*)(sVT + (64 * wh + 16 * vb + fr) * 72 + kk * 32 + fq * 8); o[vb] = __builtin_amdgcn_mfma_f32_16x16x32_bf16(vf, af, o[vb], 0, 0, 0); }
                    }
                }
#pragma unroll
                for (int ks = 0; ks < 4; ++ks) {
                    const bf16x8 qf = *(const bf16x8*)(sQb + (16 * i + fr) * 136 + ks * 32 + fq * 8);
#pragma unroll
                    for (int vb = 0; vb < 4; ++vb) { const bf16x8 sf = *(const bf16x8*)(sST + (64 * wh + 16 * vb + fr) * 136 + ks * 32 + fq * 8); o[vb] = __builtin_amdgcn_mfma_f32_16x16x32_bf16(sf, qf, o[vb], 0, 0, 0); }
                }
                float ss = 0.f;
#pragma unroll
                for (int vb = 0; vb < 4; ++vb)
#pragma unroll
                    for (int jj = 0; jj < 4; ++jj) ss += o[vb][jj] * o[vb][jj];
                ss += __shfl_xor(ss, 16); ss += __shfl_xor(ss, 32);
                if (fq == 0) sNrm[wh * 64 + 16 * i + fr] = ss;
            }
#pragma unroll
            for (int db = 0; db < 8; ++db) { const f32x4 e4 = *(const f32x4*)(sE + 16 * db + fq * 4); S[db] = S[db] * e4; }
#pragma unroll
            for (int ks = 0; ks < 2; ++ks) {
                const bf16x8 vf = *(const bf16x8*)(sVT + (16 * w + fr) * 72 + ks * 32 + fq * 8);
#pragma unroll
                for (int db = 0; db < 8; ++db) { const bf16x8 kf = *(const bf16x8*)(sKT + (16 * db + fr) * 72 + ks * 32 + fq * 8); S[db] = __builtin_amdgcn_mfma_f32_16x16x32_bf16(kf, vf, S[db], 0, 0, 0); }
            }
            __syncthreads();
            if (OUT) {
                const int i = wi;
                const float tot = sNrm[16 * i + fr] + sNrm[64 + 16 * i + fr];
                const float rstd = rsqrtf(tot * (1.0f / 128.0f) + 1e-6f);
                bf16_t* op = p.U + (row0 + 16 * i + fr) * D + h * 128 + 64 * wh + fq * 4;
#pragma unroll
                for (int vb = 0; vb < 4; ++vb) {
                    const f32x4 gn = *(const f32x4*)(ogain + 64 * wh + 16 * vb + fq * 4);
                    const float g0 = bflo(graw[vb].x), g1 = bfhi(graw[vb].x), g2 = bflo(graw[vb].y), g3 = bfhi(graw[vb].y);
                    u32x2 ow; ow.x = cvt_pk_bf16(o[vb][0] * rstd * gn[0] * g0, o[vb][1] * rstd * gn[1] * g1); ow.y = cvt_pk_bf16(o[vb][2] * rstd * gn[2] * g2, o[vb][3] * rstd * gn[3] * g3);
                    *(u32x2*)(op + 16 * vb) = ow;
                }
            }
        }
        if (!OUT) {
            float* sl = p.Sloc + (size_t)(bh * 4 + sc) * 16384;
#pragma unroll
            for (int db = 0; db < 8; ++db) *(f32x4*)(sl + ((w * 8 + db) * 64 + lane) * 4) = S[db];
            if (tid < 128) p.Dlog[(bh * 4 + sc) * 128 + tid] = dlacc;
        }
    }
    __syncthreads();
}

__device__ void attn_phase(const Params& p, int jl, unsigned char* shm) {
    bf16_t* sK = (bf16_t*)shm;
    bf16_t* sVT = sK + 2 * 4608;
    float* sB = (float*)(sVT + 2 * 4608);
    const int tid = opaque_tid(), lane = tid & 63, w = tid >> 6, fr = lane & 15, fq = lane >> 4;
    const int cq = w >> 1, half = w & 1;
    const float LOG2E = 1.4426950408889634f;
    const int skey = tid >> 3, spiece = tid & 7, vkey = tid & 63, vpiece = tid >> 6;
    for (int task = blockIdx.x; task < 4096; task += gridDim.x) {
        const int g = task & 31, h = (task >> 5) & 15, b = task >> 9;
        const int c = 4 * g + cq;
        const int kt0 = (4 * g - 8 > 0) ? 4 * g - 8 : 0, kt1 = 4 * g + 3;
        __syncthreads();
        for (int i = tid; i < 320; i += 512) sB[i] = p.b_rel_bias[((size_t)jl * 320 + i) * 16 + h] * LOG2E;
        bf16x8 qf[2][2];
        {
            const bf16_t* qp = p.Qb + ((size_t)b * SEQ + c * 64 + half * 32) * D + h * 64;
#pragma unroll
            for (int qb = 0; qb < 2; ++qb)
#pragma unroll
                for (int ks = 0; ks < 2; ++ks) qf[qb][ks] = *(const bf16x8*)(qp + (size_t)(qb * 16 + fr) * D + ks * 32 + fq * 8);
        }
        f32x4 oacc[4][2];
#pragma unroll
        for (int db = 0; db < 4; ++db)
#pragma unroll
            for (int qb = 0; qb < 2; ++qb) oacc[db][qb] = (f32x4){0.f, 0.f, 0.f, 0.f};
        float mrun[2] = {-1e30f, -1e30f}, lrun[2] = {0.f, 0.f};
        u32x4 kreg, vreg;
        const size_t tokb = (size_t)b * SEQ;
        kreg = *(const u32x4*)(p.Kb + (tokb + kt0 * 64 + skey) * D + h * 64 + spiece * 8);
        vreg = *(const u32x4*)(p.Vb + (tokb + kt0 * 64 + vkey) * D + h * 64 + vpiece * 8);
        {
            *(u32x4*)(sK + skey * 72 + spiece * 8) = kreg;
            bf16_t* vt = sVT + (vpiece * 8) * 72 + vkey;
#pragma unroll
            for (int e = 0; e < 8; ++e) vt[e * 72] = (bf16_t)((e & 1) ? (vreg[e >> 1] >> 16) : (vreg[e >> 1] & 0xffffu));
        }
        __syncthreads();
        for (int kt = kt0; kt <= kt1; ++kt) {
            const int buf = (kt - kt0) & 1;
            if (kt < kt1) {
                kreg = *(const u32x4*)(p.Kb + (tokb + (kt + 1) * 64 + skey) * D + h * 64 + spiece * 8);
                vreg = *(const u32x4*)(p.Vb + (tokb + (kt + 1) * 64 + vkey) * D + h * 64 + vpiece * 8);
            }
            if (kt >= c - 8 && kt <= c) {
                const bf16_t* kb_ = sK + buf * 4608; const bf16_t* vb_ = sVT + buf * 4608;
                f32x4 sacc[4][2];
#pragma unroll
                for (int kb = 0; kb < 4; ++kb)
#pragma unroll
                    for (int qb = 0; qb < 2; ++qb) sacc[kb][qb] = (f32x4){0.f, 0.f, 0.f, 0.f};
#pragma unroll
                for (int kb = 0; kb < 4; ++kb)
#pragma unroll
                    for (int ks = 0; ks < 2; ++ks) {
                        const bf16x8 kf = *(const bf16x8*)(kb_ + (kb * 16 + fr) * 72 + ks * 32 + fq * 8);
#pragma unroll
                        for (int qb = 0; qb < 2; ++qb) sacc[kb][qb] = __builtin_amdgcn_mfma_f32_16x16x32_bf16(kf, qf[qb][ks], sacc[kb][qb], 0, 0, 0);
                    }
                const int dk = kt - c;
                if (dk <= -5) {
                    const float b0 = sB[0];
#pragma unroll
                    for (int kb = 0; kb < 4; ++kb)
#pragma unroll
                        for (int qb = 0; qb < 2; ++qb)
#pragma unroll
                            for (int j = 0; j < 4; ++j) sacc[kb][qb][j] = sacc[kb][qb][j] * LOG2E + b0;
                } else {
                    const int base = dk * 64 + fq * 4 - half * 32 - fr + 256;
#pragma unroll
                    for (int kb = 0; kb < 4; ++kb)
#pragma unroll
                        for (int qb = 0; qb < 2; ++qb)
#pragma unroll
                            for (int j = 0; j < 4; ++j) { int idx = base + kb * 16 + j - qb * 16; idx = idx < 0 ? 0 : (idx > 319 ? 319 : idx); sacc[kb][qb][j] = sacc[kb][qb][j] * LOG2E + sB[idx]; }
                }
                bf16x8 pf[2][2];
#pragma unroll
                for (int qb = 0; qb < 2; ++qb) {
                    float mx = sacc[0][qb][0];
#pragma unroll
                    for (int kb = 0; kb < 4; ++kb)
#pragma unroll
                        for (int j = 0; j < 4; ++j) mx = fmaxf(mx, sacc[kb][qb][j]);
                    mx = fmaxf(mx, __shfl_xor(mx, 16)); mx = fmaxf(mx, __shfl_xor(mx, 32));
                    const float mn = fmaxf(mrun[qb], mx), corr = __builtin_amdgcn_exp2f(mrun[qb] - mn);
                    mrun[qb] = mn;
                    float ps = 0.f;
#pragma unroll
                    for (int kb = 0; kb < 4; ++kb)
#pragma unroll
                        for (int j = 0; j < 4; ++j) { const float pv = __builtin_amdgcn_exp2f(sacc[kb][qb][j] - mn); sacc[kb][qb][j] = pv; ps += pv; }
                    lrun[qb] = lrun[qb] * corr + ps;
#pragma unroll
                    for (int db = 0; db < 4; ++db) oacc[db][qb] = oacc[db][qb] * corr;
#pragma unroll
                    for (int kk = 0; kk < 2; ++kk) {
                        u32x4 pw;
                        pw.x = cvt_pk_bf16(sacc[2 * kk][qb][0], sacc[2 * kk][qb][1]); pw.y = cvt_pk_bf16(sacc[2 * kk][qb][2], sacc[2 * kk][qb][3]);
                        pw.z = cvt_pk_bf16(sacc[2 * kk + 1][qb][0], sacc[2 * kk + 1][qb][1]); pw.w = cvt_pk_bf16(sacc[2 * kk + 1][qb][2], sacc[2 * kk + 1][qb][3]);
                        pf[qb][kk] = __builtin_bit_cast(bf16x8, pw);
                    }
                }
#pragma unroll
                for (int db = 0; db < 4; ++db)
#pragma unroll
                    for (int kk = 0; kk < 2; ++kk) {
                        const u32x2 lo = *(const u32x2*)(vb_ + (db * 16 + fr) * 72 + (2 * kk) * 16 + fq * 4);
                        const u32x2 hi = *(const u32x2*)(vb_ + (db * 16 + fr) * 72 + (2 * kk + 1) * 16 + fq * 4);
                        u32x4 vw; vw.x = lo.x; vw.y = lo.y; vw.z = hi.x; vw.w = hi.y;
                        const bf16x8 vf = __builtin_bit_cast(bf16x8, vw);
#pragma unroll
                        for (int qb = 0; qb < 2; ++qb) oacc[db][qb] = __builtin_amdgcn_mfma_f32_16x16x32_bf16(vf, pf[qb][kk], oacc[db][qb], 0, 0, 0);
                    }
            }
            if (kt < kt1) {
                *(u32x4*)(sK + (buf ^ 1) * 4608 + skey * 72 + spiece * 8) = kreg;
                bf16_t* vt = sVT + (buf ^ 1) * 4608 + (vpiece * 8) * 72 + vkey;
#pragma unroll
                for (int e = 0; e < 8; ++e) vt[e * 72] = (bf16_t)((e & 1) ? (vreg[e >> 1] >> 16) : (vreg[e >> 1] & 0xffffu));
            }
            __syncthreads();
        }
#pragma unroll
        for (int qb = 0; qb < 2; ++qb) {
            float lt = lrun[qb]; lt += __shfl_xor(lt, 16); lt += __shfl_xor(lt, 32);
            const float inv = 1.0f / lt;
            bf16_t* op = p.U + (tokb + c * 64 + half * 32 + qb * 16 + fr) * D + h * 64 + fq * 4;
#pragma unroll
            for (int db = 0; db < 4; ++db) {
                u32x2 ow; ow.x = cvt_pk_bf16(oacc[db][qb][0] * inv, oacc[db][qb][1] * inv); ow.y = cvt_pk_bf16(oacc[db][qb][2] * inv, oacc[db][qb][3] * inv);
                *(u32x2*)(op + db * 16) = ow;
            }
        }
    }
    __syncthreads();
}

__global__ void __launch_bounds__(512, 2) yoco_fwd(Params p) {
    extern __shared__ __attribute__((aligned(16))) unsigned char shm[];
    cg::grid_group grid = cg::this_grid();
    prep_phase(p, shm);
    grid.sync();
    for (int l = 0; l < 4; ++l) {
        const float* hsrc = (l == 0) ? p.x : p.h;
        const float* mv = p.modv + (size_t)l * 8 * 6144;
        if (l == 2) norm_phase(hsrc, p.U, p.norm_mix + l * D, mv, mv + D, 6144, p.U2, p.kv_norm, p.kvmod, p.kvmod + D, 2048);
        else norm_phase(hsrc, p.U, p.norm_mix + l * D, mv, mv + D, 6144, nullptr, nullptr, nullptr, nullptr, 0);
        grid.sync();
        if (l < 2) {
            pg8::EpiHgrnIn e; e.QVG = p.Qh; e.LF = p.LF; e.lb = p.lbv + l * D;
            run_gemm(shm, p.U, p.wb_a_in + (size_t)l * AIN * D, AIN, D, e);
            grid.sync();
            rec_pass<false>(p, l, shm);
            grid.sync();
            rec_pass<true>(p, l, shm);
        } else {
            if (l == 2) { pg8::EpiBf16Split e; e.d0 = p.Kb; e.scale = 1.0f; run_gemm(shm, p.U2, p.wb_kv, 2048, D, e); }
            { pg8::EpiBf16Split e; e.d0 = p.Qb; e.scale = 0.125f; run_gemm(shm, p.U, p.wb_q + (size_t)(l - 2) * D * D, D, D, e); }
            grid.sync();
            attn_phase(p, l - 2, shm);
        }
        grid.sync();
        {
            pg8::EpiResid e; e.src = hsrc; e.dst = p.h; e.gate = mv + 2 * D;
            run_gemm(shm, p.U, (l < 2) ? p.wb_a_out + (size_t)l * D * D : p.wb_o + (size_t)(l - 2) * D * D, D, D, e);
        }
        grid.sync();
        norm_phase(p.h, p.U, p.norm_ffn + l * D, mv + 3 * D, mv + 4 * D, 6144, nullptr, nullptr, nullptr, nullptr, 0);
        grid.sync();
        { pg8::EpiSwiglu e; e.act = p.ACT; run_gemm(shm, p.U, p.wb_ffn_in + (size_t)l * 2 * FFN * D, 2 * FFN, D, e); }
        grid.sync();
        { pg8::EpiResid e; e.src = p.h; e.dst = p.h; e.gate = mv + 5 * D; run_gemm(shm, p.ACT, p.wb_ffn_out + (size_t)l * D * FFN, D, FFN, e); }
        grid.sync();
    }
    final_norm_phase(p.h, p.final_norm);
}

extern "C" void kernel_launch(void* const* d_in, const int* in_sizes, int n_in, void* d_out, int out_size, void* d_ws, size_t ws_size, hipStream_t stream) {
    static int grid_blocks = 0;
    if (!grid_blocks) {
        int dev = 0, cus = 0, per_cu = 0;
        hipGetDevice(&dev);
        hipDeviceGetAttribute(&cus, hipDeviceAttributeMultiprocessorCount, dev);
        hipFuncSetAttribute((const void*)yoco_fwd, hipFuncAttributeMaxDynamicSharedMemorySize, LDS_BYTES);
        hipOccupancyMaxActiveBlocksPerMultiprocessor(&per_cu, (const void*)yoco_fwd, 512, LDS_BYTES);
        if (per_cu < 1) per_cu = 1;
        grid_blocks = cus * per_cu;
        (void)hipGetLastError();
    }
    Params p{};
    const float* const* in = (const float* const*)d_in;
    p.x = in[0]; p.c = in[1]; p.mod_w = in[2]; p.mod_b = in[3]; p.norm_mix = in[4]; p.norm_ffn = in[5]; p.ffn_w_in = in[6]; p.ffn_w_out = in[7];
    p.a_w_in = in[8]; p.a_w_out = in[9]; p.a_lb = in[10]; p.a_out_norm = in[11]; p.kv_norm = in[12]; p.kv_mod_w = in[13]; p.kv_mod_b = in[14]; p.kv_w = in[15];
    p.b_w_q = in[16]; p.b_w_o = in[17]; p.b_rel_bias = in[18]; p.final_norm = in[19];
    p.h = (float*)d_out;
    unsigned char* ws = (unsigned char*)d_ws; size_t off = 0;
    auto take = [&](size_t bytes) { unsigned char* r = ws + off; off += (bytes + 255) & ~(size_t)255; return r; };
    p.wb_a_in = (bf16_t*)take((size_t)2 * AIN * D * 2);
    p.wb_a_out = (bf16_t*)take((size_t)2 * D * D * 2);
    p.wb_ffn_in = (bf16_t*)take((size_t)4 * 2 * FFN * D * 2);
    p.wb_ffn_out = (bf16_t*)take((size_t)4 * D * FFN * 2);
    p.wb_kv = (bf16_t*)take((size_t)2 * D * D * 2);
    p.wb_q = (bf16_t*)take((size_t)2 * D * D * 2);
    p.wb_o = (bf16_t*)take((size_t)2 * D * D * 2);
    p.modv = (float*)take((size_t)4 * 8 * 6144 * 4);
    p.kvmod = (float*)take((size_t)8 * 2048 * 4);
    p.lbv = (float*)take((size_t)2 * D * 4);
    const size_t act = (size_t)MTOK * D * 2;
    p.U = (bf16_t*)take(act);
    unsigned char* R = ws + off;
    p.Qh = (bf16_t*)R; p.Vh = (bf16_t*)(R + act); p.Gh = (bf16_t*)(R + 2 * act); p.LF = (float*)(R + 3 * act);
    p.ACT = (bf16_t*)R;
    p.U2 = (bf16_t*)R;
    p.Kb = (bf16_t*)(R + (size_t)MTOK * FFN * 2); p.Vb = p.Kb + (size_t)MTOK * D; p.Qb = p.Vb + (size_t)MTOK * D;
    p.Sloc = (float*)(R + 5 * act); p.Dlog = p.Sloc + (size_t)256 * 16384;
    p.wg[0] = WGroup{p.a_w_in, p.wb_a_in, D, AIN, 2, 0};
    p.wg[1] = WGroup{p.a_w_out, p.wb_a_out, D, D, 2, 0};
    p.wg[2] = WGroup{p.ffn_w_in, p.wb_ffn_in, D, 2 * FFN, 4, 1};
    p.wg[3] = WGroup{p.ffn_w_out, p.wb_ffn_out, FFN, D, 4, 0};
    p.wg[4] = WGroup{p.kv_w, p.wb_kv, D, 2 * D, 1, 0};
    p.wg[5] = WGroup{p.b_w_q, p.wb_q, D, D, 2, 0};
    p.wg[6] = WGroup{p.b_w_o, p.wb_o, D, D, 2, 0};
    void* args[] = {&p};
    hipError_t e = hipLaunchCooperativeKernel((const void*)yoco_fwd, dim3(grid_blocks), dim3(512), args, LDS_BYTES, stream);
    if (e != hipSuccess) fprintf(stderr, "cooperative launch failed: %s (grid %d)\n", hipGetErrorString(e), grid_blocks);
}
```

```cpp
#include <hip/hip_runtime.h>
#include <hip/hip_cooperative_groups.h>
#include <cstdio>
namespace cg = cooperative_groups;

#define LAS __attribute__((address_space(3)))
typedef unsigned short bf16_t;
typedef short bf16x8 __attribute__((ext_vector_type(8)));
typedef float f32x4 __attribute__((ext_vector_type(4)));
typedef unsigned u32x4 __attribute__((ext_vector_type(4)));
typedef unsigned u32x2 __attribute__((ext_vector_type(2)));

constexpr int D = 1024, BATCH = 8, SEQ = 8192, MTOK = BATCH * SEQ, FFN = 2816, AIN = 4096;
constexpr int LDS_BYTES = 144 * 1024;
constexpr int XCD_BAR_WORDS_C = 3456;

__device__ __forceinline__ unsigned cvt_pk_bf16(float lo, float hi) { unsigned r; asm volatile("v_cvt_pk_bf16_f32 %0, %1, %2" : "=v"(r) : "v"(lo), "v"(hi)); return r; }
__device__ __forceinline__ float bf2f(unsigned short h) { return __uint_as_float((unsigned)h << 16); }
__device__ __forceinline__ float bflo(unsigned w) { return __uint_as_float(w << 16); }
__device__ __forceinline__ float bfhi(unsigned w) { return __uint_as_float(w & 0xffff0000u); }
__device__ __forceinline__ float silu_f(float x) { return x * __builtin_amdgcn_rcpf(1.0f + __expf(-x)); }

__device__ __forceinline__ int opaque_tid() { int t = threadIdx.x; asm volatile("" : "+v"(t)); return t; }
struct Params { const float* in[20]; float* h; unsigned char* ws; };
constexpr size_t ACTB = (size_t)MTOK * D * 2;
constexpr size_t OFF_WB_A_IN = 0;
constexpr size_t OFF_WB_A_OUT = OFF_WB_A_IN + (size_t)2 * AIN * D * 2;
constexpr size_t OFF_WB_FFN_IN = OFF_WB_A_OUT + (size_t)2 * D * D * 2;
constexpr size_t OFF_WB_FFN_OUT = OFF_WB_FFN_IN + (size_t)4 * 2 * FFN * D * 2;
constexpr size_t OFF_WB_KV = OFF_WB_FFN_OUT + (size_t)4 * D * FFN * 2;
constexpr size_t OFF_WB_Q = OFF_WB_KV + (size_t)2 * D * D * 2;
constexpr size_t OFF_WB_O = OFF_WB_Q + (size_t)2 * D * D * 2;
constexpr size_t OFF_MODV = OFF_WB_O + (size_t)2 * D * D * 2;
constexpr size_t OFF_KVMOD = OFF_MODV + (size_t)4 * 8 * 6144 * 4;
constexpr size_t OFF_LBV = OFF_KVMOD + (size_t)8 * 2048 * 4;
constexpr size_t OFF_U = OFF_LBV + (size_t)2 * D * 4;
constexpr size_t OFF_R = OFF_U + ACTB;
constexpr size_t OFF_QH = OFF_R, OFF_VH = OFF_R + ACTB, OFF_GH = OFF_R + 2 * ACTB, OFF_LF = OFF_R + 3 * ACTB;
constexpr size_t OFF_ACT = OFF_R;
constexpr size_t OFF_U2 = OFF_R;
constexpr size_t OFF_KB = OFF_R + (size_t)MTOK * FFN * 2, OFF_VB = OFF_KB + ACTB, OFF_QB = OFF_VB + ACTB;
constexpr size_t OFF_SLOC = OFF_R + 5 * ACTB, OFF_DLOG = OFF_SLOC + (size_t)256 * 16384 * 4;
constexpr size_t OFF_BAR = OFF_QB + ACTB;
constexpr size_t WS_END = OFF_BAR + (size_t)XCD_BAR_WORDS_C * 4;


#define XB_TMO      128
#define XB_XCNT(j)  (256  + 64 * (j))
#define XB_XSUB(j)  (1280 + 64 * (j))
#define XB_XGEN(j)  (2304 + 64 * (j))
#define XB_TOP      3328
#define XB_TOPGEN   3392
#define XCD_BAR_WORDS 3456
#define XB_SPIN_CAP (1u << 18)
__device__ __forceinline__ unsigned xb_ld(unsigned* p)              { return __hip_atomic_load(p, __ATOMIC_RELAXED, __HIP_MEMORY_SCOPE_AGENT); }
__device__ __forceinline__ unsigned xb_add(unsigned* p, unsigned v) { return __hip_atomic_fetch_add(p, v, __ATOMIC_RELAXED, __HIP_MEMORY_SCOPE_AGENT); }
__device__ __forceinline__ unsigned xb_xcc_id() { return (unsigned)__builtin_amdgcn_s_getreg((3 << 11) | 20) & 0xFu; }
#define XB_SPIN(cond, bar) do { unsigned _sp = 0; while (cond) { __builtin_amdgcn_s_sleep(1); \
    if ((++_sp & 255u) == 0u) { if (xb_ld(&(bar)[XB_TMO])) break; if (_sp > XB_SPIN_CAP) { atomicAdd(&(bar)[XB_TMO], 1u); break; } } } } while (0)
struct XcdBarrier { unsigned* bar; unsigned x; volatile LAS unsigned* st; };
__device__ __forceinline__ XcdBarrier xcd_barrier_post(unsigned* bar, volatile LAS unsigned* st) {
    XcdBarrier b; b.bar = bar; b.x = xb_xcc_id(); b.st = st;
    if (threadIdx.x == 0) (void)xb_add(&bar[XB_XCNT(b.x)], 1u);
    return b;
}
__device__ __forceinline__ void xcd_barrier_complete(unsigned* bar, unsigned x, unsigned& nloc, unsigned& nx) {
    const unsigned G = gridDim.x * gridDim.y * gridDim.z;
    unsigned sum, cnt, mine, sp = 0u;
    for (;;) {
        sum = 0u; cnt = 0u; mine = 0u;
#pragma unroll
        for (unsigned j = 0; j < 16; ++j) { const unsigned c = xb_ld(&bar[XB_XCNT(j)]); sum += c; cnt += (c > 0u) ? 1u : 0u; mine = (j == x) ? c : mine; }
        if (sum == G) break;
        __builtin_amdgcn_s_sleep(1);
        if ((++sp & 255u) == 0u) { if (xb_ld(&bar[XB_TMO])) break; if (sp > XB_SPIN_CAP) { atomicAdd(&bar[XB_TMO], 1u); break; } }
    }
    nloc = mine > 0u ? mine : 1u; nx = cnt > 0u ? cnt : 1u;
}
__device__ __forceinline__ void xcd_barrier(const XcdBarrier& b) {
    asm volatile("s_waitcnt vmcnt(0)" ::: "memory");
    __syncthreads();
    if (threadIdx.x == 0) {
        unsigned* bar = b.bar;
        __builtin_amdgcn_s_waitcnt(0);
        unsigned nloc = b.st[0], nx = b.st[1];
        if (nloc == 0u) { xcd_barrier_complete(bar, b.x, nloc, nx); b.st[0] = nloc; b.st[1] = nx; }
        const unsigned old = xb_add(&bar[XB_XSUB(b.x)], 1u);
        const unsigned gen = old / nloc;
        if (old + 1u == (gen + 1u) * nloc) {
            __builtin_amdgcn_fence(__ATOMIC_RELEASE, "agent");
            asm volatile("s_waitcnt vmcnt(0)" ::: "memory");
            const unsigned og = xb_add(&bar[XB_TOP], 1u);
            const unsigned tg = og / nx;
            if (og + 1u == (tg + 1u) * nx) xb_add(&bar[XB_TOPGEN], 1u);
            else XB_SPIN(xb_ld(&bar[XB_TOPGEN]) == tg, bar);
            __builtin_amdgcn_fence(__ATOMIC_ACQUIRE, "agent");
            xb_add(&bar[XB_XGEN(b.x)], 1u);
            asm volatile("s_waitcnt vmcnt(0)" ::: "memory");
        } else {
            XB_SPIN(xb_ld(&bar[XB_XGEN(b.x)]) == gen, bar);
            __builtin_amdgcn_fence(__ATOMIC_ACQUIRE, "agent");
            asm volatile("s_waitcnt vmcnt(0)" ::: "memory");
        }
    }
    __syncthreads();
}

namespace pg8 {
constexpr int BM = 256, BK = 64, HALF = 128, HTB = HALF * BK * 2, STAGE_BYTES = 8 * HTB, NXCD = 8, WGM = 8;
__device__ __forceinline__ int lds_byte(int r, int c) { const int st = (r >> 4) * 2 + (c >> 5), rr = r & 15, cc = c & 31, ob = rr * 64 + cc * 2; return st * 1024 + (ob ^ (((ob >> 9) & 1) << 5)); }
__device__ __forceinline__ void stage_rc(int b, int& R, int& C) { const int st = b / 1024, sb = b % 1024, swz = sb ^ (((sb >> 9) & 1) << 5); R = (st >> 1) * 16 + swz / 64; C = (st & 1) * 32 + (swz % 64) / 2; }
__device__ __forceinline__ int perm32(int rho) { const int n = rho >> 4, i = rho & 15; return 8 * (i >> 2) + 4 * n + (i & 3); }
struct Unit { int pm, pn; };
struct Gemm { const bf16_t* A; const bf16_t* Bt; int M, N, K; };
struct StaticOrder {
    int nM, nN, nwg, G, c;
    __device__ void init(int M, int N, int G_, int c_) { nM = M / BM; nN = N / BM; nwg = nM * nN; G = G_; c = c_; }
    __device__ bool next(int i, Unit& u) const {
        const long L = (long)i * G + c; if (L >= nwg) return false;
        int wgid = (int)L; { const int q = nwg / NXCD, r = nwg % NXCD, xcd = wgid % NXCD, off = wgid / NXCD; wgid = (xcd < r ? xcd * (q + 1) : r * (q + 1) + (xcd - r) * q) + off; }
        const int nig = WGM * nN, gid = wgid / nig, fm = gid * WGM, gsz = (nM - fm) < WGM ? (nM - fm) : WGM;
        u.pm = fm + ((wgid % nig) % gsz); u.pn = (wgid % nig) / gsz; return true;
    }
};

template <class Epi>
__device__ __forceinline__ void gemm_phase(LAS unsigned char* lds, const Gemm g, const StaticOrder& S, const Epi& E) {
    const int tid = opaque_tid(), wid = __builtin_amdgcn_readfirstlane(tid >> 6), lane = tid & 63, wr = wid >> 2, wc = wid & 3, fr = lane & 15, fq = lane >> 4;
    const int K = g.K, nt = K / BK;
    unsigned voffA[2], voffB[2];
#pragma unroll
    for (int i = 0; i < 2; ++i) { int R, C; stage_rc(tid * 16 + i * 8192, R, C); const int Rb = Epi::PERM ? ((R & ~31) + perm32(R & 31)) : R;
        voffA[i] = (unsigned)(R * K + C) * 2u; voffB[i] = (unsigned)(Rb * K + C) * 2u; }
    const size_t kstep = (size_t)(BK * 2);
    const size_t hstep = (size_t)HALF * K * 2;
    const size_t tstep = 2 * hstep;
    const unsigned ldsw = (unsigned)wid * 1024u;
    const int aoff = lds_byte(wr * 64 + fr, fq * 8), boff = lds_byte(wc * 32 + fr, fq * 8);
#define PG8_SA(b, h) (((b) * 2 + (h)) * HTB)
#define PG8_SB(b, h) ((4 + (b) * 2 + (h)) * HTB)
#define PG8_STAGE(bufoff, gbase, voff) do { _Pragma("unroll") for (int _i = 0; _i < 2; ++_i) \
        __builtin_amdgcn_global_load_lds((const unsigned*)((const char*)(gbase) + (voff)[_i]), (LAS unsigned*)(lds + (bufoff) + ldsw + _i * 8192), 16, 0, 0); } while (0)
#define PG8_LDA(dst, b, h) do { _Pragma("unroll") for (int m = 0; m < 4; ++m) _Pragma("unroll") for (int k = 0; k < 2; ++k) dst[m][k] = *(const LAS bf16x8*)(lds + PG8_SA(b, h) + aoff + m * 2048 + k * 1024); } while (0)
#define PG8_LDB(dst, b, h) do { _Pragma("unroll") for (int n = 0; n < 2; ++n) _Pragma("unroll") for (int k = 0; k < 2; ++k) dst[n][k] = *(const LAS bf16x8*)(lds + PG8_SB(b, h) + boff + n * 2048 + k * 1024); } while (0)
#define PG8_MMA(ai, bj, At, Bt) do { __builtin_amdgcn_s_setprio(1); _Pragma("unroll") for (int m = 0; m < 4; ++m) _Pragma("unroll") for (int n = 0; n < 2; ++n) _Pragma("unroll") for (int k = 0; k < 2; ++k) \
        acc[ai][bj][m][n] = __builtin_amdgcn_mfma_f32_16x16x32_bf16(Bt[n][k], At[m][k], acc[ai][bj][m][n], 0, 0, 0); __builtin_amdgcn_s_setprio(0); } while (0)
#define PG8_WAIT_V(n) asm volatile("s_waitcnt vmcnt(" #n ")" ::: "memory")
#define PG8_WAIT_L(n) asm volatile("s_waitcnt lgkmcnt(" #n ")" ::: "memory")
#define PG8_BAR __builtin_amdgcn_s_barrier()
#define PG8_SCHED __builtin_amdgcn_sched_barrier(0)
    Unit cur, nxt; int ui = 0;
    if (!S.next(0, cur)) return;
    f32x4 acc[2][2][4][2];
#pragma unroll
    for (int a = 0; a < 2; ++a)
#pragma unroll
        for (int b = 0; b < 2; ++b)
#pragma unroll
            for (int m = 0; m < 4; ++m)
#pragma unroll
                for (int n = 0; n < 2; ++n) acc[a][b][m][n] = (f32x4){0.f, 0.f, 0.f, 0.f};
    bf16x8 At[4][2], B0[2][2], B1[2][2];
    const char* cA = (const char*)g.A + (size_t)cur.pm * tstep; const char* cB = (const char*)g.Bt + (size_t)cur.pn * tstep;
    PG8_STAGE(PG8_SB(0, 0), cB, voffB); PG8_STAGE(PG8_SA(0, 0), cA, voffA); PG8_STAGE(PG8_SB(0, 1), cB + hstep, voffB); PG8_STAGE(PG8_SA(0, 1), cA + hstep, voffA);
    if (wr == 1) PG8_BAR;
    PG8_WAIT_V(4); PG8_BAR;
    PG8_STAGE(PG8_SB(1, 0), cB + kstep, voffB); PG8_STAGE(PG8_SA(1, 0), cA + kstep, voffA); PG8_STAGE(PG8_SB(1, 1), cB + hstep + kstep, voffB);
    PG8_WAIT_V(6); PG8_BAR;
    for (;;) {
        const bool has_next = S.next(ui + 1, nxt);
        const char* nA = has_next ? (const char*)g.A + (size_t)nxt.pm * tstep : cA; const char* nB = has_next ? (const char*)g.Bt + (size_t)nxt.pn * tstep : cB;
        for (int t = 0; t < nt; t += 2) {
            const bool last = (t == nt - 2);
            const char* a1 = cA + (size_t)(t + 1) * kstep;
            const char* a2 = last ? nA : cA + (size_t)(t + 2) * kstep; const char* b2 = last ? nB : cB + (size_t)(t + 2) * kstep;
            const char* a3 = a2 + kstep; const char* b3 = b2 + kstep;
            PG8_LDB(B0, 0, 0); PG8_SCHED; PG8_LDA(At, 0, 0); PG8_STAGE(PG8_SA(1, 1), a1 + hstep, voffA);
            PG8_WAIT_L(8); PG8_BAR; PG8_WAIT_L(0); PG8_MMA(0, 0, At, B0); PG8_BAR; PG8_SCHED;
            PG8_LDB(B1, 0, 1); PG8_STAGE(PG8_SB(0, 0), b2, voffB);
            PG8_BAR; PG8_WAIT_L(0); PG8_MMA(0, 1, At, B1); PG8_BAR;
            PG8_LDA(At, 0, 1); PG8_STAGE(PG8_SA(0, 0), a2, voffA);
            PG8_BAR; PG8_WAIT_L(0); PG8_MMA(1, 0, At, B0); PG8_BAR; PG8_SCHED;
            PG8_STAGE(PG8_SB(0, 1), b2 + hstep, voffB);
            PG8_WAIT_V(6); PG8_BAR; PG8_MMA(1, 1, At, B1); PG8_BAR;
            PG8_LDB(B0, 1, 0); PG8_SCHED; PG8_LDA(At, 1, 0); PG8_STAGE(PG8_SA(0, 1), a2 + hstep, voffA);
            PG8_WAIT_L(8); PG8_BAR; PG8_WAIT_L(0); PG8_MMA(0, 0, At, B0); PG8_BAR; PG8_SCHED;
            PG8_LDB(B1, 1, 1); PG8_STAGE(PG8_SB(1, 0), b3, voffB);
            PG8_BAR; PG8_WAIT_L(0); PG8_MMA(0, 1, At, B1); PG8_BAR;
            PG8_LDA(At, 1, 1); PG8_STAGE(PG8_SA(1, 0), a3, voffA);
            PG8_BAR; PG8_WAIT_L(0); PG8_MMA(1, 0, At, B0); PG8_BAR; PG8_SCHED;
            PG8_STAGE(PG8_SB(1, 1), b3 + hstep, voffB);
            PG8_WAIT_V(6); PG8_BAR; PG8_MMA(1, 1, At, B1); PG8_BAR;
        }
        E(acc, cur, wr, wc, fr, fq);
        if (!has_next) break;
#pragma unroll
        for (int a = 0; a < 2; ++a)
#pragma unroll
            for (int b = 0; b < 2; ++b)
#pragma unroll
                for (int m = 0; m < 4; ++m)
#pragma unroll
                    for (int n = 0; n < 2; ++n) acc[a][b][m][n] = (f32x4){0.f, 0.f, 0.f, 0.f};
        cur = nxt; cA = nA; cB = nB; ++ui;
    }
    PG8_WAIT_V(0);
    if (wr == 0) PG8_BAR;
    PG8_BAR;
#undef PG8_SA
#undef PG8_SB
#undef PG8_STAGE
#undef PG8_LDA
#undef PG8_LDB
#undef PG8_MMA
#undef PG8_WAIT_V
#undef PG8_WAIT_L
#undef PG8_BAR
#undef PG8_SCHED
}

struct EpiHgrnIn {
    static constexpr bool PERM = true;
    bf16_t* QVG; float* LF; const float* lb;
    __device__ __forceinline__ void operator()(const f32x4 (&acc)[2][2][4][2], const Unit& u, int wr, int wc, int fr, int fq) const {
        const int seg = u.pn >> 2, colt = (u.pn & 3) * 256;
        const int row0 = u.pm * BM + wr * 64 + fr, col0 = colt + wc * 32 + 8 * fq;
        if (seg == 1) {
#pragma unroll
            for (int bj = 0; bj < 2; ++bj) {
                const f32x4 l0 = *(const f32x4*)(lb + col0 + bj * HALF), l1 = *(const f32x4*)(lb + col0 + bj * HALF + 4);
#pragma unroll
                for (int ai = 0; ai < 2; ++ai)
#pragma unroll
                    for (int m = 0; m < 4; ++m) {
                        float* rowp = LF + (size_t)(row0 + ai * HALF + m * 16) * D + col0 + bj * HALF;
                        f32x4 o0, o1;
#pragma unroll
                        for (int j = 0; j < 4; ++j) {
                            float z = acc[ai][bj][m][0][j]; float sg = __builtin_amdgcn_rcpf(1.0f + __expf(-z)); float f = l0[j] + (1.0f - l0[j]) * sg; o0[j] = logf(fmaxf(f, 1e-30f));
                            z = acc[ai][bj][m][1][j]; sg = __builtin_amdgcn_rcpf(1.0f + __expf(-z)); f = l1[j] + (1.0f - l1[j]) * sg; o1[j] = logf(fmaxf(f, 1e-30f));
                        }
                        *(f32x4*)rowp = o0; *(f32x4*)(rowp + 4) = o1;
                    }
            }
        } else {
            bf16_t* base = QVG + (size_t)(seg == 0 ? 0 : (seg == 2 ? 1 : 2)) * ((size_t)MTOK * D);
            const bool act = (seg != 2);
#pragma unroll
            for (int ai = 0; ai < 2; ++ai)
#pragma unroll
                for (int m = 0; m < 4; ++m)
#pragma unroll
                    for (int bj = 0; bj < 2; ++bj) {
                        f32x4 v0 = acc[ai][bj][m][0], v1 = acc[ai][bj][m][1];
                        if (act) {
#pragma unroll
                            for (int j = 0; j < 4; ++j) { v0[j] = silu_f(v0[j]); v1[j] = silu_f(v1[j]); }
                        }
                        u32x4 w; w.x = cvt_pk_bf16(v0[0], v0[1]); w.y = cvt_pk_bf16(v0[2], v0[3]); w.z = cvt_pk_bf16(v1[0], v1[1]); w.w = cvt_pk_bf16(v1[2], v1[3]);
                        *(u32x4*)(base + (size_t)(row0 + ai * HALF + m * 16) * D + col0 + bj * HALF) = w;
                    }
        }
    }
};
struct EpiResid {
    static constexpr bool PERM = true;
    const float* src; float* dst; const float* gate;
    __device__ __forceinline__ void operator()(const f32x4 (&acc)[2][2][4][2], const Unit& u, int wr, int wc, int fr, int fq) const {
        const int b = u.pm >> 5;
        const float* gp = gate + (size_t)b * 6144;
        const int row0 = u.pm * BM + wr * 64 + fr, col0 = u.pn * BM + wc * 32 + 8 * fq;
        f32x4 gv[2][2];
#pragma unroll
        for (int bj = 0; bj < 2; ++bj)
#pragma unroll
            for (int n = 0; n < 2; ++n) gv[bj][n] = *(const f32x4*)(gp + col0 + bj * HALF + 4 * n);
#pragma unroll
        for (int ai = 0; ai < 2; ++ai)
#pragma unroll
            for (int m = 0; m < 4; ++m) {
                const size_t ro = (size_t)(row0 + ai * HALF + m * 16) * D + col0;
#pragma unroll
                for (int bj = 0; bj < 2; ++bj)
#pragma unroll
                    for (int n = 0; n < 2; ++n) {
                        const f32x4 s = *(const f32x4*)(src + ro + bj * HALF + 4 * n);
                        *(f32x4*)(dst + ro + bj * HALF + 4 * n) = s + gv[bj][n] * acc[ai][bj][m][n];
                    }
            }
    }
};
struct EpiSwiglu {
    static constexpr bool PERM = true;
    bf16_t* act;
    __device__ __forceinline__ void operator()(const f32x4 (&acc)[2][2][4][2], const Unit& u, int wr, int wc, int fr, int fq) const {
        const int row0 = u.pm * BM + wr * 64 + fr, col0 = u.pn * HALF + wc * 32 + 8 * fq;
#pragma unroll
        for (int ai = 0; ai < 2; ++ai)
#pragma unroll
            for (int m = 0; m < 4; ++m) {
                f32x4 r0, r1;
#pragma unroll
                for (int j = 0; j < 4; ++j) { r0[j] = silu_f(acc[ai][0][m][0][j]) * acc[ai][1][m][0][j]; r1[j] = silu_f(acc[ai][0][m][1][j]) * acc[ai][1][m][1][j]; }
                u32x4 w; w.x = cvt_pk_bf16(r0[0], r0[1]); w.y = cvt_pk_bf16(r0[2], r0[3]); w.z = cvt_pk_bf16(r1[0], r1[1]); w.w = cvt_pk_bf16(r1[2], r1[3]);
                *(u32x4*)(act + (size_t)(row0 + ai * HALF + m * 16) * FFN + col0) = w;
            }
    }
};
struct EpiBf16Split {
    static constexpr bool PERM = true;
    bf16_t* d0; float scale;
    __device__ __forceinline__ void operator()(const f32x4 (&acc)[2][2][4][2], const Unit& u, int wr, int wc, int fr, int fq) const {
        bf16_t* base = d0 + (size_t)(u.pn >> 2) * ((size_t)MTOK * D);
        const int row0 = u.pm * BM + wr * 64 + fr, col0 = (u.pn & 3) * 256 + wc * 32 + 8 * fq;
#pragma unroll
        for (int ai = 0; ai < 2; ++ai)
#pragma unroll
            for (int m = 0; m < 4; ++m)
#pragma unroll
                for (int bj = 0; bj < 2; ++bj) {
                    const f32x4 v0 = acc[ai][bj][m][0] * scale, v1 = acc[ai][bj][m][1] * scale;
                    u32x4 w; w.x = cvt_pk_bf16(v0[0], v0[1]); w.y = cvt_pk_bf16(v0[2], v0[3]); w.z = cvt_pk_bf16(v1[0], v1[1]); w.w = cvt_pk_bf16(v1[2], v1[3]);
                    *(u32x4*)(base + (size_t)(row0 + ai * HALF + m * 16) * D + col0 + bj * HALF) = w;
                }
    }
};
}

template <class Epi>
__device__ __forceinline__ void run_gemm(unsigned char* shm, const bf16_t* A, const bf16_t* Bt, int N, int K, const Epi& E) {
    pg8::Gemm g; g.A = A; g.Bt = Bt; g.M = MTOK; g.N = N; g.K = K;
    pg8::StaticOrder S; S.init(MTOK, N, (int)gridDim.x, (int)blockIdx.x);
    pg8::gemm_phase<Epi>((LAS unsigned char*)shm, g, S, E);
    __syncthreads();
}

__device__ __forceinline__ int ffnmap(int nn) { return nn < FFN ? ((nn >> 7) * 256 + (nn & 127)) : (((nn - FFN) >> 7) * 256 + 128 + ((nn - FFN) & 127)); }

__device__ __forceinline__ void conv_group(const float* src0, bf16_t* dst0, const int K, const int N, const int L, const int mode, unsigned char* shm, const int tid) {
    float* st = (float*)shm;
    const int per = (K / 128) * (N / 64), total = L * per, ntn = N / 64;
    for (int tile = blockIdx.x; tile < total; tile += gridDim.x) {
        const int l = tile / per, tt = tile % per, k0 = (tt / ntn) * 128, n0 = (tt % ntn) * 64;
        const float* src = src0 + (size_t)l * K * N; bf16_t* dst = dst0 + (size_t)l * K * N;
        f32x4 v[4];
#pragma unroll
        for (int it = 0; it < 4; ++it) { const int idx = tid + it * 512, k = idx >> 4, n4 = idx & 15; v[it] = *(const f32x4*)(src + (size_t)(k0 + k) * N + n0 + 4 * n4); }
        __syncthreads();
#pragma unroll
        for (int it = 0; it < 4; ++it) { const int idx = tid + it * 512, k = idx >> 4, n4 = idx & 15;
#pragma unroll
            for (int e = 0; e < 4; ++e) st[k * 65 + 4 * n4 + e] = v[it][e]; }
        __syncthreads();
#pragma unroll
        for (int it = 0; it < 2; ++it) { const int idx = tid + it * 512, n = idx >> 4, kg = idx & 15; const int nn = n0 + n; const int drow = mode ? ffnmap(nn) : nn;
            u32x4 w;
#pragma unroll
            for (int e = 0; e < 4; ++e) w[e] = cvt_pk_bf16(st[(8 * kg + 2 * e) * 65 + n], st[(8 * kg + 2 * e + 1) * 65 + n]);
            *(u32x4*)(dst + (size_t)drow * K + k0 + 8 * kg) = w; }
    }
}

__device__ void prep_phase(const Params& p, unsigned char* shm) {
    const int tid = opaque_tid();
    {
        float* cact = (float*)shm;
        float* red = cact + 8192;
        bool loaded = false;
        const int wv = tid >> 6, lane = tid & 63;
        for (int task = blockIdx.x; task < 416; task += gridDim.x) {
            if (!loaded) {
                for (int i = tid; i < 8192; i += 512) { const int k = i >> 3, b = i & 7; cact[i] = silu_f(p.in[1][b * D + k]); }
                loaded = true;
            }
            __syncthreads();
            const int c0 = task * 64;
            const float* src; const float* bias; float* dst; int stride, dstride;
            if (c0 < 24576) { const int l = c0 / 6144, j = c0 % 6144; src = p.in[2] + (size_t)l * D * 6144 + j; stride = 6144; bias = p.in[3] + l * 6144 + j; dst = ((float*)(p.ws + OFF_MODV)) + (size_t)l * 8 * 6144 + j; dstride = 6144; }
            else { const int j = c0 - 24576; src = p.in[13] + j; stride = 2048; bias = p.in[14] + j; dst = ((float*)(p.ws + OFF_KVMOD)) + j; dstride = 2048; }
            float a[8];
#pragma unroll
            for (int b = 0; b < 8; ++b) a[b] = 0.f;
            const float* sp = src + (size_t)(wv * 128) * stride + lane;
#pragma unroll 8
            for (int k = 0; k < 128; ++k) {
                const float w = sp[(size_t)k * stride];
                const f32x4 c0v = *(const f32x4*)(cact + (wv * 128 + k) * 8), c1v = *(const f32x4*)(cact + (wv * 128 + k) * 8 + 4);
                a[0] += w * c0v[0]; a[1] += w * c0v[1]; a[2] += w * c0v[2]; a[3] += w * c0v[3];
                a[4] += w * c1v[0]; a[5] += w * c1v[1]; a[6] += w * c1v[2]; a[7] += w * c1v[3];
            }
#pragma unroll
            for (int b = 0; b < 8; ++b) red[(wv * 8 + b) * 64 + lane] = a[b];
            __syncthreads();
            {
                const int b = tid >> 6, col = tid & 63;
                float s = bias[col];
#pragma unroll
                for (int w = 0; w < 8; ++w) s += red[(w * 8 + b) * 64 + col];
                dst[(size_t)b * dstride + col] = s;
            }
        }
        __syncthreads();
    }
    for (int i = blockIdx.x * 512 + tid; i < 1024; i += gridDim.x * 512) {
        const float a0 = p.in[10][i], a1 = p.in[10][1024 + i];
        const float mx = fmaxf(a0, a1), e0 = __expf(a0 - mx), e1 = __expf(a1 - mx);
        ((float*)(p.ws + OFF_LBV))[i] = 0.f; ((float*)(p.ws + OFF_LBV))[1024 + i] = e1 / (e0 + e1);
    }
    conv_group(p.in[8], (bf16_t*)(p.ws + OFF_WB_A_IN), D, AIN, 2, 0, shm, tid);
    conv_group(p.in[9], (bf16_t*)(p.ws + OFF_WB_A_OUT), D, D, 2, 0, shm, tid);
    conv_group(p.in[6], (bf16_t*)(p.ws + OFF_WB_FFN_IN), D, 2 * FFN, 4, 1, shm, tid);
    conv_group(p.in[7], (bf16_t*)(p.ws + OFF_WB_FFN_OUT), FFN, D, 4, 0, shm, tid);
    conv_group(p.in[15], (bf16_t*)(p.ws + OFF_WB_KV), D, 2 * D, 1, 0, shm, tid);
    conv_group(p.in[16], (bf16_t*)(p.ws + OFF_WB_Q), D, D, 2, 0, shm, tid);
    conv_group(p.in[17], (bf16_t*)(p.ws + OFF_WB_O), D, D, 2, 0, shm, tid);
    __syncthreads();
}

__device__ void norm_phase(const float* src, bf16_t* U1, const float* gain1, const float* sh1, const float* sc1, int bs1,
                           bf16_t* U2, const float* gain2, const float* sh2, const float* sc2, int bs2) {
    const int tid_ = opaque_tid(); const int lane = tid_ & 63, gw = blockIdx.x * 8 + (tid_ >> 6), nw = gridDim.x * 8;
    for (int row = 2 * gw; row < MTOK; row += 2 * nw) {
        const int b = row >> 13;
        const float* xp = src + (size_t)row * D;
        f32x4 xv[2][4]; float ss[2] = {0.f, 0.f};
#pragma unroll
        for (int r = 0; r < 2; ++r)
#pragma unroll
            for (int i = 0; i < 4; ++i) xv[r][i] = *(const f32x4*)(xp + (size_t)r * D + i * 256 + lane * 4);
#pragma unroll
        for (int r = 0; r < 2; ++r)
#pragma unroll
            for (int i = 0; i < 4; ++i) ss[r] += xv[r][i][0] * xv[r][i][0] + xv[r][i][1] * xv[r][i][1] + xv[r][i][2] * xv[r][i][2] + xv[r][i][3] * xv[r][i][3];
#pragma unroll
        for (int o = 1; o < 64; o <<= 1) { ss[0] += __shfl_xor(ss[0], o); ss[1] += __shfl_xor(ss[1], o); }
        const float rstd0 = rsqrtf(ss[0] * (1.0f / D) + 1e-6f), rstd1 = rsqrtf(ss[1] * (1.0f / D) + 1e-6f);
#pragma unroll
        for (int i = 0; i < 4; ++i) {
            const int k = i * 256 + lane * 4;
            const f32x4 g = *(const f32x4*)(gain1 + k), s = *(const f32x4*)(sc1 + (size_t)b * bs1 + k), t = *(const f32x4*)(sh1 + (size_t)b * bs1 + k);
            f32x4 u0, u1;
#pragma unroll
            for (int j = 0; j < 4; ++j) { const float ga = g[j] * (1.0f + s[j]); u0[j] = (xv[0][i][j] * rstd0) * ga + t[j]; u1[j] = (xv[1][i][j] * rstd1) * ga + t[j]; }
            u32x2 w0, w1; w0.x = cvt_pk_bf16(u0[0], u0[1]); w0.y = cvt_pk_bf16(u0[2], u0[3]); w1.x = cvt_pk_bf16(u1[0], u1[1]); w1.y = cvt_pk_bf16(u1[2], u1[3]);
            *(u32x2*)(U1 + (size_t)row * D + k) = w0; *(u32x2*)(U1 + (size_t)(row + 1) * D + k) = w1;
        }
        if (U2) {
#pragma unroll
            for (int i = 0; i < 4; ++i) {
                const int k = i * 256 + lane * 4;
                const f32x4 g = *(const f32x4*)(gain2 + k), s = *(const f32x4*)(sc2 + (size_t)b * bs2 + k), t = *(const f32x4*)(sh2 + (size_t)b * bs2 + k);
                f32x4 u0, u1;
#pragma unroll
                for (int j = 0; j < 4; ++j) { const float ga = g[j] * (1.0f + s[j]); u0[j] = (xv[0][i][j] * rstd0) * ga + t[j]; u1[j] = (xv[1][i][j] * rstd1) * ga + t[j]; }
                u32x2 w0, w1; w0.x = cvt_pk_bf16(u0[0], u0[1]); w0.y = cvt_pk_bf16(u0[2], u0[3]); w1.x = cvt_pk_bf16(u1[0], u1[1]); w1.y = cvt_pk_bf16(u1[2], u1[3]);
                *(u32x2*)(U2 + (size_t)row * D + k) = w0; *(u32x2*)(U2 + (size_t)(row + 1) * D + k) = w1;
            }
        }
    }
}
__device__ void final_norm_phase(float* h, const float* gain) {
    const int tid_ = opaque_tid(); const int lane = tid_ & 63, gw = blockIdx.x * 8 + (tid_ >> 6), nw = gridDim.x * 8;
    for (int row = gw; row < MTOK; row += nw) {
        float* xp = h + (size_t)row * D;
        f32x4 xv[4]; float ss = 0.f;
#pragma unroll
        for (int i = 0; i < 4; ++i) { xv[i] = *(const f32x4*)(xp + i * 256 + lane * 4); ss += xv[i][0] * xv[i][0] + xv[i][1] * xv[i][1] + xv[i][2] * xv[i][2] + xv[i][3] * xv[i][3]; }
#pragma unroll
        for (int o = 1; o < 64; o <<= 1) ss += __shfl_xor(ss, o);
        const float rstd = rsqrtf(ss * (1.0f / D) + 1e-6f);
#pragma unroll
        for (int i = 0; i < 4; ++i) {
            const int k = i * 256 + lane * 4;
            const f32x4 g = *(const f32x4*)(gain + k);
            f32x4 u;
#pragma unroll
            for (int j = 0; j < 4; ++j) u[j] = xv[i][j] * rstd * g[j];
            *(f32x4*)(xp + k) = u;
        }
    }
}

template <bool OUT>
__device__ void rec_pass(const Params& p, int layer, unsigned char* shm) {
    float* sB = (float*)shm;
    float* sKm = (float*)(shm + 33792);
    bf16_t* sST = (bf16_t*)shm;
    bf16_t* sQb = (bf16_t*)(shm + 67584);
    bf16_t* sA = (bf16_t*)(shm + 84992);
    bf16_t* sKT = (bf16_t*)(shm + 94208);
    bf16_t* sVT = (bf16_t*)(shm + 112640);
    float* sE = (float*)(shm + 131072);
    float* sPart = (float*)(shm + 131584);
    float* sNrm = (float*)(shm + 133632);
    const int tid = opaque_tid(), lane = tid & 63, w = tid >> 6, fr = lane & 15, fq = lane >> 4;
    const int wi = w >> 1, wh = w & 1;
    const int ntask = OUT ? 256 : 192;
    const float* ogain = p.in[11] + layer * 128;
    for (int task = blockIdx.x; task < ntask; task += gridDim.x) {
        int sc, bh; if (OUT) { sc = task & 3; bh = task >> 2; } else { sc = task % 3; bh = task / 3; }
        const int b = bh >> 3, h = bh & 7;
        f32x4 S[8];
#pragma unroll
        for (int db = 0; db < 8; ++db) S[db] = (f32x4){0.f, 0.f, 0.f, 0.f};
        if (OUT) {
            for (int s2 = 0; s2 < sc; ++s2) {
                const float* sl = ((float*)(p.ws + OFF_SLOC)) + (size_t)(bh * 4 + s2) * 16384; const float* dl = ((float*)(p.ws + OFF_DLOG)) + (bh * 4 + s2) * 128;
#pragma unroll
                for (int db = 0; db < 8; ++db) {
                    const f32x4 x = *(const f32x4*)(sl + ((w * 8 + db) * 64 + lane) * 4), dv = *(const f32x4*)(dl + 16 * db + fq * 4);
#pragma unroll
                    for (int j = 0; j < 4; ++j) S[db][j] = S[db][j] * __expf(dv[j]) + x[j];
                }
            }
        }
        float dlacc = 0.f;
        for (int ch = sc * 32; ch < sc * 32 + 32; ++ch) {
            const size_t row0 = (size_t)b * SEQ + (size_t)ch * 64;
            float lfv[16];
            {
                const float* lp = ((float*)(p.ws + OFF_LF)) + (row0 + 16 * (tid >> 7)) * D + h * 128 + (tid & 127);
#pragma unroll
                for (int e = 0; e < 16; ++e) lfv[e] = lp[(size_t)e * D];
            }
            const u32x4 vr0 = *(const u32x4*)(((bf16_t*)(p.ws + OFF_VH)) + (row0 + (tid & 63)) * D + h * 128 + (tid >> 6) * 8);
            const u32x4 vr1 = *(const u32x4*)(((bf16_t*)(p.ws + OFF_VH)) + (row0 + (tid & 63)) * D + h * 128 + 64 + (tid >> 6) * 8);
            u32x4 qraw[4]; u32x2 graw[4];
            if (OUT) {
#pragma unroll
                for (int ks = 0; ks < 4; ++ks) qraw[ks] = *(const u32x4*)(((bf16_t*)(p.ws + OFF_QH)) + (row0 + 16 * wi + fr) * D + h * 128 + ks * 32 + fq * 8);
#pragma unroll
                for (int vb = 0; vb < 4; ++vb) graw[vb] = *(const u32x2*)(((bf16_t*)(p.ws + OFF_GH)) + (row0 + 16 * wi + fr) * D + h * 128 + 64 * wh + 16 * vb + fq * 4);
            }
            {
                const int d_ = tid & 127, tq = tid >> 7;
                float run = 0.f;
#pragma unroll
                for (int e = 0; e < 16; ++e) { sKm[(16 * tq + e) * 132 + d_] = 1.0f - __expf(lfv[e]); run += lfv[e]; lfv[e] = run; }
                sPart[tq * 128 + d_] = run;
                {
                    const int s_ = tid & 63, pc = tid >> 6;
#pragma unroll
                    for (int e = 0; e < 8; ++e) {
                        sVT[(pc * 8 + e) * 72 + s_] = (bf16_t)((e & 1) ? (vr0[e >> 1] >> 16) : (vr0[e >> 1] & 0xffffu));
                        sVT[(64 + pc * 8 + e) * 72 + s_] = (bf16_t)((e & 1) ? (vr1[e >> 1] >> 16) : (vr1[e >> 1] & 0xffffu));
                    }
                }
                __syncthreads();
                float off = 0.f;
                for (int q = 0; q < tq; ++q) off += sPart[q * 128 + d_];
#pragma unroll
                for (int e = 0; e < 16; ++e) sB[(16 * tq + e) * 132 + d_] = lfv[e] + off;
            }
            __syncthreads();
            if (tid < 128) { const float bl = sB[63 * 132 + tid]; sE[tid] = __expf(bl); dlacc += bl; }
            {
                const int s_ = tid & 63, dp = tid >> 6;
#pragma unroll
                for (int q4 = 0; q4 < 4; ++q4) {
                    const f32x4 k4 = *(const f32x4*)(sKm + s_ * 132 + 16 * dp + 4 * q4), b4 = *(const f32x4*)(sB + s_ * 132 + 16 * dp + 4 * q4), l4 = *(const f32x4*)(sB + 63 * 132 + 16 * dp + 4 * q4);
#pragma unroll
                    for (int j = 0; j < 4; ++j) sKT[(16 * dp + 4 * q4 + j) * 72 + s_] = (bf16_t)(cvt_pk_bf16(k4[j] * __expf(l4[j] - b4[j]), 0.f) & 0xffffu);
                }
            }
            if (OUT) {
                const int i = wi, hh = wh, t_ = 16 * i + fr;
                bf16x8 qt[4];
#pragma unroll
                for (int ks = 0; ks < 4; ++ks) {
                    const int d0 = ks * 32 + fq * 8;
                    const f32x4 b0 = *(const f32x4*)(sB + t_ * 132 + d0), b1 = *(const f32x4*)(sB + t_ * 132 + d0 + 4);
                    f32x4 r0 = (f32x4){0.f, 0.f, 0.f, 0.f}, r1 = r0;
                    if (i > 0) { r0 = *(const f32x4*)(sB + (16 * i - 1) * 132 + d0); r1 = *(const f32x4*)(sB + (16 * i - 1) * 132 + d0 + 4); }
                    float qv[8], ql[8];
#pragma unroll
                    for (int e = 0; e < 4; ++e) { qv[2 * e] = bflo(qraw[ks][e]); qv[2 * e + 1] = bfhi(qraw[ks][e]); }
#pragma unroll
                    for (int e = 0; e < 4; ++e) { ql[e] = qv[e] * __expf(b0[e] - r0[e]); ql[4 + e] = qv[4 + e] * __expf(b1[e] - r1[e]); }
                    u32x4 pw; pw.x = cvt_pk_bf16(ql[0], ql[1]); pw.y = cvt_pk_bf16(ql[2], ql[3]); pw.z = cvt_pk_bf16(ql[4], ql[5]); pw.w = cvt_pk_bf16(ql[6], ql[7]);
                    qt[ks] = __builtin_bit_cast(bf16x8, pw);
                    if ((ks >> 1) == hh) {
#pragma unroll
                        for (int e = 0; e < 4; ++e) { ql[e] = qv[e] * __expf(b0[e]); ql[4 + e] = qv[4 + e] * __expf(b1[e]); }
                        u32x4 qw; qw.x = cvt_pk_bf16(ql[0], ql[1]); qw.y = cvt_pk_bf16(ql[2], ql[3]); qw.z = cvt_pk_bf16(ql[4], ql[5]); qw.w = cvt_pk_bf16(ql[6], ql[7]);
                        *(u32x4*)(sQb + t_ * 136 + d0) = qw;
                    }
                }
#pragma unroll
                for (int j2 = 0; j2 < 2; ++j2) {
                    const int j = hh + 2 * j2;
                    if (j <= i) {
                        f32x4 acc = (f32x4){0.f, 0.f, 0.f, 0.f};
                        const int s_ = 16 * j + fr;
#pragma unroll
                        for (int ks = 0; ks < 4; ++ks) {
                            const int d0 = ks * 32 + fq * 8;
                            const f32x4 k0 = *(const f32x4*)(sKm + s_ * 132 + d0), k1 = *(const f32x4*)(sKm + s_ * 132 + d0 + 4);
                            const f32x4 b0 = *(const f32x4*)(sB + s_ * 132 + d0), b1 = *(const f32x4*)(sB + s_ * 132 + d0 + 4);
                            f32x4 r0 = (f32x4){0.f, 0.f, 0.f, 0.f}, r1 = r0;
                            if (i > 0) { r0 = *(const f32x4*)(sB + (16 * i - 1) * 132 + d0); r1 = *(const f32x4*)(sB + (16 * i - 1) * 132 + d0 + 4); }
                            float kl[8];
#pragma unroll
                            for (int e = 0; e < 4; ++e) { kl[e] = k0[e] * __expf(fminf(r0[e] - b0[e], 80.f)); kl[4 + e] = k1[e] * __expf(fminf(r1[e] - b1[e], 80.f)); }
                            u32x4 kw; kw.x = cvt_pk_bf16(kl[0], kl[1]); kw.y = cvt_pk_bf16(kl[2], kl[3]); kw.z = cvt_pk_bf16(kl[4], kl[5]); kw.w = cvt_pk_bf16(kl[6], kl[7]);
                            acc = __builtin_amdgcn_mfma_f32_16x16x32_bf16(qt[ks], __builtin_bit_cast(bf16x8, kw), acc, 0, 0, 0);
                        }
#pragma unroll
                        for (int jj = 0; jj < 4; ++jj) {
                            float vv = acc[jj];
                            if (i == j && fr > fq * 4 + jj) vv = 0.f;
                            sA[(16 * i + fq * 4 + jj) * 72 + 16 * j + fr] = (bf16_t)(cvt_pk_bf16(vv, 0.f) & 0xffffu);
                        }
                    } else {
#pragma unroll
                        for (int jj = 0; jj < 4; ++jj) sA[(16 * i + fq * 4 + jj) * 72 + 16 * j + fr] = (bf16_t)0;
                    }
                }
            }
            __syncthreads();
            if (OUT) {
#pragma unroll
                for (int db = 0; db < 8; ++db) { u32x2 sw; sw.x = cvt_pk_bf16(S[db][0], S[db][1]); sw.y = cvt_pk_bf16(S[db][2], S[db][3]); *(u32x2*)(sST + (16 * w + fr) * 136 + 16 * db + fq * 4) = sw; }
                __syncthreads();
            }
            f32x4 o[4];
            if (OUT) {
                const int i = wi;
#pragma unroll
                for (int vb = 0; vb < 4; ++vb) o[vb] = (f32x4){0.f, 0.f, 0.f, 0.f};
#pragma unroll
                for (int kk = 0; kk < 2; ++kk) {
                    if (kk <= (i >> 1)) {
                        const bf16x8 af = *(const bf16x8*)(sA + (16 * i + fr) * 72 + kk * 32 + fq * 8);
#pragma unroll
                        for (int vb = 0; vb < 4; ++vb) { const bf16x8 vf = *(const bf16x8*)(sVT + (64 * wh + 16 * vb + fr) * 72 + kk * 32 + fq * 8); o[vb] = __builtin_amdgcn_mfma_f32_16x16x32_bf16(vf, af, o[vb], 0, 0, 0); }
                    }
                }
#pragma unroll
                for (int ks = 0; ks < 4; ++ks) {
                    const bf16x8 qf = *(const bf16x8*)(sQb + (16 * i + fr) * 136 + ks * 32 + fq * 8);
#pragma unroll
                    for (int vb = 0; vb < 4; ++vb) { const bf16x8 sf = *(const bf16x8*)(sST + (64 * wh + 16 * vb + fr) * 136 + ks * 32 + fq * 8); o[vb] = __builtin_amdgcn_mfma_f32_16x16x32_bf16(sf, qf, o[vb], 0, 0, 0); }
                }
                float ss = 0.f;
#pragma unroll
                for (int vb = 0; vb < 4; ++vb)
#pragma unroll
                    for (int jj = 0; jj < 4; ++jj) ss += o[vb][jj] * o[vb][jj];
                ss += __shfl_xor(ss, 16); ss += __shfl_xor(ss, 32);
                if (fq == 0) sNrm[wh * 64 + 16 * i + fr] = ss;
            }
#pragma unroll
            for (int db = 0; db < 8; ++db) { const f32x4 e4 = *(const f32x4*)(sE + 16 * db + fq * 4); S[db] = S[db] * e4; }
#pragma unroll
            for (int ks = 0; ks < 2; ++ks) {
                const bf16x8 vf = *(const bf16x8*)(sVT + (16 * w + fr) * 72 + ks * 32 + fq * 8);
#pragma unroll
                for (int db = 0; db < 8; ++db) { const bf16x8 kf = *(const bf16x8*)(sKT + (16 * db + fr) * 72 + ks * 32 + fq * 8); S[db] = __builtin_amdgcn_mfma_f32_16x16x32_bf16(kf, vf, S[db], 0, 0, 0); }
            }
            __syncthreads();
            if (OUT) {
                const int i = wi;
                const float tot = sNrm[16 * i + fr] + sNrm[64 + 16 * i + fr];
                const float rstd = rsqrtf(tot * (1.0f / 128.0f) + 1e-6f);
                bf16_t* op = ((bf16_t*)(p.ws + OFF_U)) + (row0 + 16 * i + fr) * D + h * 128 + 64 * wh + fq * 4;
#pragma unroll
                for (int vb = 0; vb < 4; ++vb) {
                    const f32x4 gn = *(const f32x4*)(ogain + 64 * wh + 16 * vb + fq * 4);
                    const float g0 = bflo(graw[vb].x), g1 = bfhi(graw[vb].x), g2 = bflo(graw[vb].y), g3 = bfhi(graw[vb].y);
                    u32x2 ow; ow.x = cvt_pk_bf16(o[vb][0] * rstd * gn[0] * g0, o[vb][1] * rstd * gn[1] * g1); ow.y = cvt_pk_bf16(o[vb][2] * rstd * gn[2] * g2, o[vb][3] * rstd * gn[3] * g3);
                    *(u32x2*)(op + 16 * vb) = ow;
                }
            }
        }
        if (!OUT) {
            float* sl = ((float*)(p.ws + OFF_SLOC)) + (size_t)(bh * 4 + sc) * 16384;
#pragma unroll
            for (int db = 0; db < 8; ++db) *(f32x4*)(sl + ((w * 8 + db) * 64 + lane) * 4) = S[db];
            if (tid < 128) ((float*)(p.ws + OFF_DLOG))[(bh * 4 + sc) * 128 + tid] = dlacc;
        }
    }
    __syncthreads();
}

__device__ void attn_phase(const Params& p, int jl, unsigned char* shm) {
    bf16_t* sK = (bf16_t*)shm;
    bf16_t* sVT = sK + 2 * 4608;
    float* sB = (float*)(sVT + 2 * 4608);
    const int tid = opaque_tid(), lane = tid & 63, w = tid >> 6, fr = lane & 15, fq = lane >> 4;
    const int cq = w >> 1, half = w & 1;
    const float LOG2E = 1.4426950408889634f;
    const int skey = tid >> 3, spiece = tid & 7, vkey = tid & 63, vpiece = tid >> 6;
    for (int task = blockIdx.x; task < 4096; task += gridDim.x) {
        const int g = task & 31, h = (task >> 5) & 15, b = task >> 9;
        const int c = 4 * g + cq;
        const int kt0 = (4 * g - 8 > 0) ? 4 * g - 8 : 0, kt1 = 4 * g + 3;
        __syncthreads();
        for (int i = tid; i < 320; i += 512) sB[i] = p.in[18][((size_t)jl * 320 + i) * 16 + h] * LOG2E;
        bf16x8 qf[2][2];
        {
            const bf16_t* qp = ((bf16_t*)(p.ws + OFF_QB)) + ((size_t)b * SEQ + c * 64 + half * 32) * D + h * 64;
#pragma unroll
            for (int qb = 0; qb < 2; ++qb)
#pragma unroll
                for (int ks = 0; ks < 2; ++ks) qf[qb][ks] = *(const bf16x8*)(qp + (size_t)(qb * 16 + fr) * D + ks * 32 + fq * 8);
        }
        f32x4 oacc[4][2];
#pragma unroll
        for (int db = 0; db < 4; ++db)
#pragma unroll
            for (int qb = 0; qb < 2; ++qb) oacc[db][qb] = (f32x4){0.f, 0.f, 0.f, 0.f};
        float mrun[2] = {-1e30f, -1e30f}, lrun[2] = {0.f, 0.f};
        u32x4 kreg, vreg;
        const size_t tokb = (size_t)b * SEQ;
        kreg = *(const u32x4*)(((bf16_t*)(p.ws + OFF_KB)) + (tokb + kt0 * 64 + skey) * D + h * 64 + spiece * 8);
        vreg = *(const u32x4*)(((bf16_t*)(p.ws + OFF_VB)) + (tokb + kt0 * 64 + vkey) * D + h * 64 + vpiece * 8);
        {
            *(u32x4*)(sK + skey * 72 + spiece * 8) = kreg;
            bf16_t* vt = sVT + (vpiece * 8) * 72 + vkey;
#pragma unroll
            for (int e = 0; e < 8; ++e) vt[e * 72] = (bf16_t)((e & 1) ? (vreg[e >> 1] >> 16) : (vreg[e >> 1] & 0xffffu));
        }
        __syncthreads();
        for (int kt = kt0; kt <= kt1; ++kt) {
            const int buf = (kt - kt0) & 1;
            if (kt < kt1) {
                kreg = *(const u32x4*)(((bf16_t*)(p.ws + OFF_KB)) + (tokb + (kt + 1) * 64 + skey) * D + h * 64 + spiece * 8);
                vreg = *(const u32x4*)(((bf16_t*)(p.ws + OFF_VB)) + (tokb + (kt + 1) * 64 + vkey) * D + h * 64 + vpiece * 8);
            }
            if (kt >= c - 8 && kt <= c) {
                const bf16_t* kb_ = sK + buf * 4608; const bf16_t* vb_ = sVT + buf * 4608;
                f32x4 sacc[4][2];
#pragma unroll
                for (int kb = 0; kb < 4; ++kb)
#pragma unroll
                    for (int qb = 0; qb < 2; ++qb) sacc[kb][qb] = (f32x4){0.f, 0.f, 0.f, 0.f};
#pragma unroll
                for (int kb = 0; kb < 4; ++kb)
#pragma unroll
                    for (int ks = 0; ks < 2; ++ks) {
                        const bf16x8 kf = *(const bf16x8*)(kb_ + (kb * 16 + fr) * 72 + ks * 32 + fq * 8);
#pragma unroll
                        for (int qb = 0; qb < 2; ++qb) sacc[kb][qb] = __builtin_amdgcn_mfma_f32_16x16x32_bf16(kf, qf[qb][ks], sacc[kb][qb], 0, 0, 0);
                    }
                const int dk = kt - c;
                if (dk <= -5) {
                    const float b0 = sB[0];
#pragma unroll
                    for (int kb = 0; kb < 4; ++kb)
#pragma unroll
                        for (int qb = 0; qb < 2; ++qb)
#pragma unroll
                            for (int j = 0; j < 4; ++j) sacc[kb][qb][j] = sacc[kb][qb][j] * LOG2E + b0;
                } else {
                    const int base = dk * 64 + fq * 4 - half * 32 - fr + 256;
#pragma unroll
                    for (int kb = 0; kb < 4; ++kb)
#pragma unroll
                        for (int qb = 0; qb < 2; ++qb)
#pragma unroll
                            for (int j = 0; j < 4; ++j) { int idx = base + kb * 16 + j - qb * 16; idx = idx < 0 ? 0 : (idx > 319 ? 319 : idx); sacc[kb][qb][j] = sacc[kb][qb][j] * LOG2E + sB[idx]; }
                }
                bf16x8 pf[2][2];
#pragma unroll
                for (int qb = 0; qb < 2; ++qb) {
                    float mx = sacc[0][qb][0];
#pragma unroll
                    for (int kb = 0; kb < 4; ++kb)
#pragma unroll
                        for (int j = 0; j < 4; ++j) mx = fmaxf(mx, sacc[kb][qb][j]);
                    mx = fmaxf(mx, __shfl_xor(mx, 16)); mx = fmaxf(mx, __shfl_xor(mx, 32));
                    const float mn = fmaxf(mrun[qb], mx), corr = __builtin_amdgcn_exp2f(mrun[qb] - mn);
                    mrun[qb] = mn;
                    float ps = 0.f;
#pragma unroll
                    for (int kb = 0; kb < 4; ++kb)
#pragma unroll
                        for (int j = 0; j < 4; ++j) { const float pv = __builtin_amdgcn_exp2f(sacc[kb][qb][j] - mn); sacc[kb][qb][j] = pv; ps += pv; }
                    lrun[qb] = lrun[qb] * corr + ps;
#pragma unroll
                    for (int db = 0; db < 4; ++db) oacc[db][qb] = oacc[db][qb] * corr;
#pragma unroll
                    for (int kk = 0; kk < 2; ++kk) {
                        u32x4 pw;
                        pw.x = cvt_pk_bf16(sacc[2 * kk][qb][0], sacc[2 * kk][qb][1]); pw.y = cvt_pk_bf16(sacc[2 * kk][qb][2], sacc[2 * kk][qb][3]);
                        pw.z = cvt_pk_bf16(sacc[2 * kk + 1][qb][0], sacc[2 * kk + 1][qb][1]); pw.w = cvt_pk_bf16(sacc[2 * kk + 1][qb][2], sacc[2 * kk + 1][qb][3]);
                        pf[qb][kk] = __builtin_bit_cast(bf16x8, pw);
                    }
                }
#pragma unroll
                for (int db = 0; db < 4; ++db)
#pragma unroll
                    for (int kk = 0; kk < 2; ++kk) {
                        const u32x2 lo = *(const u32x2*)(vb_ + (db * 16 + fr) * 72 + (2 * kk) * 16 + fq * 4);
                        const u32x2 hi = *(const u32x2*)(vb_ + (db * 16 + fr) * 72 + (2 * kk + 1) * 16 + fq * 4);
                        u32x4 vw; vw.x = lo.x; vw.y = lo.y; vw.z = hi.x; vw.w = hi.y;
                        const bf16x8 vf = __builtin_bit_cast(bf16x8, vw);
#pragma unroll
                        for (int qb = 0; qb < 2; ++qb) oacc[db][qb] = __builtin_amdgcn_mfma_f32_16x16x32_bf16(vf, pf[qb][kk], oacc[db][qb], 0, 0, 0);
                    }
            }
            if (kt < kt1) {
                *(u32x4*)(sK + (buf ^ 1) * 4608 + skey * 72 + spiece * 8) = kreg;
                bf16_t* vt = sVT + (buf ^ 1) * 4608 + (vpiece * 8) * 72 + vkey;
#pragma unroll
                for (int e = 0; e < 8; ++e) vt[e * 72] = (bf16_t)((e & 1) ? (vreg[e >> 1] >> 16) : (vreg[e >> 1] & 0xffffu));
            }
            __syncthreads();
        }
#pragma unroll
        for (int qb = 0; qb < 2; ++qb) {
            float lt = lrun[qb]; lt += __shfl_xor(lt, 16); lt += __shfl_xor(lt, 32);
            const float inv = 1.0f / lt;
            bf16_t* op = ((bf16_t*)(p.ws + OFF_U)) + (tokb + c * 64 + half * 32 + qb * 16 + fr) * D + h * 64 + fq * 4;
#pragma unroll
            for (int db = 0; db < 4; ++db) {
                u32x2 ow; ow.x = cvt_pk_bf16(oacc[db][qb][0] * inv, oacc[db][qb][1] * inv); ow.y = cvt_pk_bf16(oacc[db][qb][2] * inv, oacc[db][qb][3] * inv);
                *(u32x2*)(op + db * 16) = ow;
            }
        }
    }
    __syncthreads();
}

#ifndef REP_ATTN
#define REP_ATTN 1
#endif
#ifndef REP_REC
#define REP_REC 1
#endif
#ifndef REP_NORM
#define REP_NORM 1
#endif
#ifndef REP_SYNC
#define REP_SYNC 1
#endif
#ifndef REP_PREP
#define REP_PREP 1
#endif
#ifndef REP_G3
#define REP_G3 1
#endif
#define GSYNC() do { for (int r_ = 0; r_ < REP_SYNC; ++r_) xcd_barrier(xb); } while (0)
__global__ void __launch_bounds__(512, 2) yoco_fwd(Params p) {
    extern __shared__ __attribute__((aligned(16))) unsigned char shm[];
    cg::grid_group grid = cg::this_grid();
    unsigned* barw = (unsigned*)(p.ws + OFF_BAR);
    for (int i = blockIdx.x * 512 + threadIdx.x; i < XCD_BAR_WORDS; i += gridDim.x * 512) barw[i] = 0u;
    volatile LAS unsigned* xst = (volatile LAS unsigned*)(LAS unsigned char*)(shm + LDS_BYTES - 16);
    if (threadIdx.x == 0) { xst[0] = 0u; xst[1] = 0u; }
    for (int r = 0; r < REP_PREP; ++r) prep_phase(p, shm);
    grid.sync();
    XcdBarrier xb = xcd_barrier_post(barw, xst);
    for (int l = 0; l < 4; ++l) {
        const float* hsrc = (l == 0) ? p.in[0] : p.h;
        const float* mv = ((float*)(p.ws + OFF_MODV)) + (size_t)l * 8 * 6144;
        for (int r = 0; r < REP_NORM; ++r) {
            if (l == 2) norm_phase(hsrc, ((bf16_t*)(p.ws + OFF_U)), p.in[4] + l * D, mv, mv + D, 6144, ((bf16_t*)(p.ws + OFF_U2)), p.in[12], ((float*)(p.ws + OFF_KVMOD)), ((float*)(p.ws + OFF_KVMOD)) + D, 2048);
            else norm_phase(hsrc, ((bf16_t*)(p.ws + OFF_U)), p.in[4] + l * D, mv, mv + D, 6144, nullptr, nullptr, nullptr, nullptr, 0);
        }
        GSYNC();
        if (l < 2) {
            pg8::EpiHgrnIn e; e.QVG = ((bf16_t*)(p.ws + OFF_QH)); e.LF = ((float*)(p.ws + OFF_LF)); e.lb = ((float*)(p.ws + OFF_LBV)) + l * D;
            run_gemm(shm, ((bf16_t*)(p.ws + OFF_U)), ((bf16_t*)(p.ws + OFF_WB_A_IN)) + (size_t)l * AIN * D, AIN, D, e);
            GSYNC();
            for (int r = 0; r < REP_REC; ++r) rec_pass<false>(p, l, shm);
            GSYNC();
            for (int r = 0; r < REP_REC; ++r) rec_pass<true>(p, l, shm);
        } else {
            if (l == 2) { pg8::EpiBf16Split e; e.d0 = ((bf16_t*)(p.ws + OFF_KB)); e.scale = 1.0f; run_gemm(shm, ((bf16_t*)(p.ws + OFF_U2)), ((bf16_t*)(p.ws + OFF_WB_KV)), 2048, D, e); }
            { pg8::EpiBf16Split e; e.d0 = ((bf16_t*)(p.ws + OFF_QB)); e.scale = 0.125f; run_gemm(shm, ((bf16_t*)(p.ws + OFF_U)), ((bf16_t*)(p.ws + OFF_WB_Q)) + (size_t)(l - 2) * D * D, D, D, e); }
            GSYNC();
            for (int r = 0; r < REP_ATTN; ++r) attn_phase(p, l - 2, shm);
        }
        GSYNC();
        {
            pg8::EpiResid e; e.src = hsrc; e.dst = p.h; e.gate = mv + 2 * D;
            run_gemm(shm, ((bf16_t*)(p.ws + OFF_U)), (l < 2) ? ((bf16_t*)(p.ws + OFF_WB_A_OUT)) + (size_t)l * D * D : ((bf16_t*)(p.ws + OFF_WB_O)) + (size_t)(l - 2) * D * D, D, D, e);
        }
        GSYNC();
        for (int r = 0; r < REP_NORM; ++r) norm_phase(p.h, ((bf16_t*)(p.ws + OFF_U)), p.in[5] + l * D, mv + 3 * D, mv + 4 * D, 6144, nullptr, nullptr, nullptr, nullptr, 0);
        GSYNC();
        for (int r = 0; r < REP_G3; ++r) { pg8::EpiSwiglu e; e.act = ((bf16_t*)(p.ws + OFF_ACT)); run_gemm(shm, ((bf16_t*)(p.ws + OFF_U)), ((bf16_t*)(p.ws + OFF_WB_FFN_IN)) + (size_t)l * 2 * FFN * D, 2 * FFN, D, e); }
        GSYNC();
        { pg8::EpiResid e; e.src = p.h; e.dst = p.h; e.gate = mv + 5 * D; run_gemm(shm, ((bf16_t*)(p.ws + OFF_ACT)), ((bf16_t*)(p.ws + OFF_WB_FFN_OUT)) + (size_t)l * D * FFN, D, FFN, e); }
        GSYNC();
    }
    final_norm_phase(p.h, p.in[19]);
}

extern "C" void kernel_launch(void* const* d_in, const int* in_sizes, int n_in, void* d_out, int out_size, void* d_ws, size_t ws_size, hipStream_t stream) {
    static int grid_blocks = 0;
    if (!grid_blocks) {
        int dev = 0, cus = 0, per_cu = 0;
        hipGetDevice(&dev);
        hipDeviceGetAttribute(&cus, hipDeviceAttributeMultiprocessorCount, dev);
        hipFuncSetAttribute((const void*)yoco_fwd, hipFuncAttributeMaxDynamicSharedMemorySize, LDS_BYTES);
        hipOccupancyMaxActiveBlocksPerMultiprocessor(&per_cu, (const void*)yoco_fwd, 512, LDS_BYTES);
        if (per_cu < 1) per_cu = 1;
        grid_blocks = cus * per_cu;
        (void)hipGetLastError();
    }
    Params p{};
    for (int i = 0; i < 20; ++i) p.in[i] = (const float*)d_in[i];
    p.h = (float*)d_out; p.ws = (unsigned char*)d_ws;
    if (ws_size < WS_END || n_in != 20) { fprintf(stderr, "kernel_launch: workspace too small (%zu < %zu) or unexpected inputs\n", ws_size, (size_t)WS_END); return; }
    void* args[] = {&p};
    hipError_t e = hipLaunchCooperativeKernel((const void*)yoco_fwd, dim3(grid_blocks), dim3(512), args, LDS_BYTES, stream);
    if (e != hipSuccess) fprintf(stderr, "cooperative launch failed: %s (grid %d)\n", hipGetErrorString(e), grid_blocks);
}
```

```cpp
#include <hip/hip_runtime.h>
#include <hip/hip_cooperative_groups.h>
#include <cstdio>
namespace cg = cooperative_groups;

#define LAS __attribute__((address_space(3)))
typedef unsigned short bf16_t;
typedef short bf16x8 __attribute__((ext_vector_type(8)));
typedef float f32x4 __attribute__((ext_vector_type(4)));
typedef unsigned u32x4 __attribute__((ext_vector_type(4)));
typedef unsigned u32x2 __attribute__((ext_vector_type(2)));

constexpr int D = 1024, BATCH = 8, SEQ = 8192, MTOK = BATCH * SEQ, FFN = 2816, AIN = 4096;
constexpr int LDS_BYTES = 144 * 1024;
constexpr int XCD_BAR_WORDS_C = 3456;

__device__ __forceinline__ unsigned cvt_pk_bf16(float lo, float hi) { unsigned r; asm volatile("v_cvt_pk_bf16_f32 %0, %1, %2" : "=v"(r) : "v"(lo), "v"(hi)); return r; }
__device__ __forceinline__ float bf2f(unsigned short h) { return __uint_as_float((unsigned)h << 16); }
__device__ __forceinline__ float bflo(unsigned w) { return __uint_as_float(w << 16); }
__device__ __forceinline__ float bfhi(unsigned w) { return __uint_as_float(w & 0xffff0000u); }
__device__ __forceinline__ float silu_f(float x) { return x * __builtin_amdgcn_rcpf(1.0f + __expf(-x)); }

__device__ __forceinline__ int opaque_tid() { int t = threadIdx.x; asm volatile("" : "+v"(t)); return t; }
struct Params { const float* in[20]; float* h; unsigned char* ws; };
constexpr size_t ACTB = (size_t)MTOK * D * 2;
constexpr size_t OFF_WB_A_IN = 0;
constexpr size_t OFF_WB_A_OUT = OFF_WB_A_IN + (size_t)2 * AIN * D * 2;
constexpr size_t OFF_WB_FFN_IN = OFF_WB_A_OUT + (size_t)2 * D * D * 2;
constexpr size_t OFF_WB_FFN_OUT = OFF_WB_FFN_IN + (size_t)4 * 2 * FFN * D * 2;
constexpr size_t OFF_WB_KV = OFF_WB_FFN_OUT + (size_t)4 * D * FFN * 2;
constexpr size_t OFF_WB_Q = OFF_WB_KV + (size_t)2 * D * D * 2;
constexpr size_t OFF_WB_O = OFF_WB_Q + (size_t)2 * D * D * 2;
constexpr size_t OFF_MODV = OFF_WB_O + (size_t)2 * D * D * 2;
constexpr size_t OFF_KVMOD = OFF_MODV + (size_t)4 * 8 * 6144 * 4;
constexpr size_t OFF_LBV = OFF_KVMOD + (size_t)8 * 2048 * 4;
constexpr size_t OFF_U = OFF_LBV + (size_t)2 * D * 4;
constexpr size_t OFF_R = OFF_U + ACTB;
constexpr size_t OFF_QH = OFF_R, OFF_VH = OFF_R + ACTB, OFF_GH = OFF_R + 2 * ACTB, OFF_LF = OFF_R + 3 * ACTB;
constexpr size_t OFF_ACT = OFF_R;
constexpr size_t OFF_U2 = OFF_R;
constexpr size_t OFF_KB = OFF_R + (size_t)MTOK * FFN * 2, OFF_VB = OFF_KB + ACTB, OFF_QB = OFF_VB + ACTB;
constexpr size_t OFF_SLOC = OFF_R + 5 * ACTB, OFF_DLOG = OFF_SLOC + (size_t)256 * 16384 * 4;
constexpr size_t OFF_BAR = OFF_QB + ACTB;
constexpr size_t WS_END = OFF_BAR + (size_t)XCD_BAR_WORDS_C * 4;


#define XB_TMO      128
#define XB_XCNT(j)  (256  + 64 * (j))
#define XB_XSUB(j)  (1280 + 64 * (j))
#define XB_XGEN(j)  (2304 + 64 * (j))
#define XB_TOP      3328
#define XB_TOPGEN   3392
#define XCD_BAR_WORDS 3456
#define XB_SPIN_CAP (1u << 18)
__device__ __forceinline__ unsigned xb_ld(unsigned* p)              { return __hip_atomic_load(p, __ATOMIC_RELAXED, __HIP_MEMORY_SCOPE_AGENT); }
__device__ __forceinline__ unsigned xb_add(unsigned* p, unsigned v) { return __hip_atomic_fetch_add(p, v, __ATOMIC_RELAXED, __HIP_MEMORY_SCOPE_AGENT); }
__device__ __forceinline__ unsigned xb_xcc_id() { return (unsigned)__builtin_amdgcn_s_getreg((3 << 11) | 20) & 0xFu; }
#define XB_SPIN(cond, bar) do { unsigned _sp = 0; while (cond) { __builtin_amdgcn_s_sleep(1); \
    if ((++_sp & 255u) == 0u) { if (xb_ld(&(bar)[XB_TMO])) break; if (_sp > XB_SPIN_CAP) { atomicAdd(&(bar)[XB_TMO], 1u); break; } } } } while (0)
struct XcdBarrier { unsigned* bar; unsigned x; volatile LAS unsigned* st; };
__device__ __forceinline__ XcdBarrier xcd_barrier_post(unsigned* bar, volatile LAS unsigned* st) {
    XcdBarrier b; b.bar = bar; b.x = xb_xcc_id(); b.st = st;
    if (threadIdx.x == 0) (void)xb_add(&bar[XB_XCNT(b.x)], 1u);
    return b;
}
__device__ __forceinline__ void xcd_barrier_complete(unsigned* bar, unsigned x, unsigned& nloc, unsigned& nx) {
    const unsigned G = gridDim.x * gridDim.y * gridDim.z;
    unsigned sum, cnt, mine, sp = 0u;
    for (;;) {
        sum = 0u; cnt = 0u; mine = 0u;
#pragma unroll
        for (unsigned j = 0; j < 16; ++j) { const unsigned c = xb_ld(&bar[XB_XCNT(j)]); sum += c; cnt += (c > 0u) ? 1u : 0u; mine = (j == x) ? c : mine; }
        if (sum == G) break;
        __builtin_amdgcn_s_sleep(1);
        if ((++sp & 255u) == 0u) { if (xb_ld(&bar[XB_TMO])) break; if (sp > XB_SPIN_CAP) { atomicAdd(&bar[XB_TMO], 1u); break; } }
    }
    nloc = mine > 0u ? mine : 1u; nx = cnt > 0u ? cnt : 1u;
}
__device__ __forceinline__ void xcd_barrier(const XcdBarrier& b) {
    asm volatile("s_waitcnt vmcnt(0)" ::: "memory");
    __syncthreads();
    if (threadIdx.x == 0) {
        unsigned* bar = b.bar;
        __builtin_amdgcn_s_waitcnt(0);
        unsigned nloc = b.st[0], nx = b.st[1];
        if (nloc == 0u) { xcd_barrier_complete(bar, b.x, nloc, nx); b.st[0] = nloc; b.st[1] = nx; }
        const unsigned old = xb_add(&bar[XB_XSUB(b.x)], 1u);
        const unsigned gen = old / nloc;
        if (old + 1u == (gen + 1u) * nloc) {
            __builtin_amdgcn_fence(__ATOMIC_RELEASE, "agent");
            asm volatile("s_waitcnt vmcnt(0)" ::: "memory");
            const unsigned og = xb_add(&bar[XB_TOP], 1u);
            const unsigned tg = og / nx;
            if (og + 1u == (tg + 1u) * nx) xb_add(&bar[XB_TOPGEN], 1u);
            else XB_SPIN(xb_ld(&bar[XB_TOPGEN]) == tg, bar);
            __builtin_amdgcn_fence(__ATOMIC_ACQUIRE, "agent");
            xb_add(&bar[XB_XGEN(b.x)], 1u);
            asm volatile("s_waitcnt vmcnt(0)" ::: "memory");
        } else {
            XB_SPIN(xb_ld(&bar[XB_XGEN(b.x)]) == gen, bar);
            __builtin_amdgcn_fence(__ATOMIC_ACQUIRE, "agent");
            asm volatile("s_waitcnt vmcnt(0)" ::: "memory");
        }
    }
    __syncthreads();
}

namespace pg8 {
constexpr int BM = 256, BK = 64, HALF = 128, HTB = HALF * BK * 2, STAGE_BYTES = 8 * HTB, NXCD = 8, WGM = 8;
__device__ __forceinline__ int lds_byte(int r, int c) { const int st = (r >> 4) * 2 + (c >> 5), rr = r & 15, cc = c & 31, ob = rr * 64 + cc * 2; return st * 1024 + (ob ^ (((ob >> 9) & 1) << 5)); }
__device__ __forceinline__ void stage_rc(int b, int& R, int& C) { const int st = b / 1024, sb = b % 1024, swz = sb ^ (((sb >> 9) & 1) << 5); R = (st >> 1) * 16 + swz / 64; C = (st & 1) * 32 + (swz % 64) / 2; }
__device__ __forceinline__ int perm32(int rho) { const int n = rho >> 4, i = rho & 15; return 8 * (i >> 2) + 4 * n + (i & 3); }
struct Unit { int pm, pn; };
struct Gemm { const bf16_t* A; const bf16_t* Bt; int M, N, K; };
struct StaticOrder {
    int nM, nN, nwg, G, c;
    __device__ void init(int M, int N, int G_, int c_) { nM = M / BM; nN = N / BM; nwg = nM * nN; G = G_; c = c_; }
    __device__ bool next(int i, Unit& u) const {
        const long L = (long)i * G + c; if (L >= nwg) return false;
        int wgid = (int)L; { const int q = nwg / NXCD, r = nwg % NXCD, xcd = wgid % NXCD, off = wgid / NXCD; wgid = (xcd < r ? xcd * (q + 1) : r * (q + 1) + (xcd - r) * q) + off; }
        const int nig = WGM * nN, gid = wgid / nig, fm = gid * WGM, gsz = (nM - fm) < WGM ? (nM - fm) : WGM;
        u.pm = fm + ((wgid % nig) % gsz); u.pn = (wgid % nig) / gsz; return true;
    }
};

template <class Epi>
__device__ __forceinline__ void gemm_phase(LAS unsigned char* lds, const Gemm g, const StaticOrder& S, const Epi& E) {
    const int tid = opaque_tid(), wid = __builtin_amdgcn_readfirstlane(tid >> 6), lane = tid & 63, wr = wid >> 2, wc = wid & 3, fr = lane & 15, fq = lane >> 4;
    const int K = g.K, nt = K / BK;
    unsigned voffA[2], voffB[2];
#pragma unroll
    for (int i = 0; i < 2; ++i) { int R, C; stage_rc(tid * 16 + i * 8192, R, C); const int Rb = Epi::PERM ? ((R & ~31) + perm32(R & 31)) : R;
        voffA[i] = (unsigned)(R * K + C) * 2u; voffB[i] = (unsigned)(Rb * K + C) * 2u; }
    const size_t kstep = (size_t)(BK * 2);
    const size_t hstep = (size_t)HALF * K * 2;
    const size_t tstep = 2 * hstep;
    const unsigned ldsw = (unsigned)wid * 1024u;
    const int aoff = lds_byte(wr * 64 + fr, fq * 8), boff = lds_byte(wc * 32 + fr, fq * 8);
#define PG8_SA(b, h) (((b) * 2 + (h)) * HTB)
#define PG8_SB(b, h) ((4 + (b) * 2 + (h)) * HTB)
#define PG8_STAGE(bufoff, gbase, voff) do { _Pragma("unroll") for (int _i = 0; _i < 2; ++_i) \
        __builtin_amdgcn_global_load_lds((const unsigned*)((const char*)(gbase) + (voff)[_i]), (LAS unsigned*)(lds + (bufoff) + ldsw + _i * 8192), 16, 0, 0); } while (0)
#define PG8_LDA(dst, b, h) do { _Pragma("unroll") for (int m = 0; m < 4; ++m) _Pragma("unroll") for (int k = 0; k < 2; ++k) dst[m][k] = *(const LAS bf16x8*)(lds + PG8_SA(b, h) + aoff + m * 2048 + k * 1024); } while (0)
#define PG8_LDB(dst, b, h) do { _Pragma("unroll") for (int n = 0; n < 2; ++n) _Pragma("unroll") for (int k = 0; k < 2; ++k) dst[n][k] = *(const LAS bf16x8*)(lds + PG8_SB(b, h) + boff + n * 2048 + k * 1024); } while (0)
#define PG8_MMA(ai, bj, At, Bt) do { __builtin_amdgcn_s_setprio(1); _Pragma("unroll") for (int m = 0; m < 4; ++m) _Pragma("unroll") for (int n = 0; n < 2; ++n) _Pragma("unroll") for (int k = 0; k < 2; ++k) \
        acc[ai][bj][m][n] = __builtin_amdgcn_mfma_f32_16x16x32_bf16(Bt[n][k], At[m][k], acc[ai][bj][m][n], 0, 0, 0); __builtin_amdgcn_s_setprio(0); } while (0)
#define PG8_WAIT_V(n) asm volatile("s_waitcnt vmcnt(" #n ")" ::: "memory")
#define PG8_WAIT_L(n) asm volatile("s_waitcnt lgkmcnt(" #n ")" ::: "memory")
#define PG8_BAR __builtin_amdgcn_s_barrier()
#define PG8_SCHED __builtin_amdgcn_sched_barrier(0)
    Unit cur, nxt; int ui = 0;
    if (!S.next(0, cur)) return;
    f32x4 acc[2][2][4][2];
#pragma unroll
    for (int a = 0; a < 2; ++a)
#pragma unroll
        for (int b = 0; b < 2; ++b)
#pragma unroll
            for (int m = 0; m < 4; ++m)
#pragma unroll
                for (int n = 0; n < 2; ++n) acc[a][b][m][n] = (f32x4){0.f, 0.f, 0.f, 0.f};
    bf16x8 At[4][2], B0[2][2], B1[2][2];
    const char* cA = (const char*)g.A + (size_t)cur.pm * tstep; const char* cB = (const char*)g.Bt + (size_t)cur.pn * tstep;
    PG8_STAGE(PG8_SB(0, 0), cB, voffB); PG8_STAGE(PG8_SA(0, 0), cA, voffA); PG8_STAGE(PG8_SB(0, 1), cB + hstep, voffB); PG8_STAGE(PG8_SA(0, 1), cA + hstep, voffA);
    if (wr == 1) PG8_BAR;
    PG8_WAIT_V(4); PG8_BAR;
    PG8_STAGE(PG8_SB(1, 0), cB + kstep, voffB); PG8_STAGE(PG8_SA(1, 0), cA + kstep, voffA); PG8_STAGE(PG8_SB(1, 1), cB + hstep + kstep, voffB);
    PG8_WAIT_V(6); PG8_BAR;
    for (;;) {
        const bool has_next = S.next(ui + 1, nxt);
        const char* nA = has_next ? (const char*)g.A + (size_t)nxt.pm * tstep : cA; const char* nB = has_next ? (const char*)g.Bt + (size_t)nxt.pn * tstep : cB;
        for (int t = 0; t < nt; t += 2) {
            const bool last = (t == nt - 2);
            const char* a1 = cA + (size_t)(t + 1) * kstep;
            const char* a2 = last ? nA : cA + (size_t)(t + 2) * kstep; const char* b2 = last ? nB : cB + (size_t)(t + 2) * kstep;
            const char* a3 = a2 + kstep; const char* b3 = b2 + kstep;
            PG8_LDB(B0, 0, 0); PG8_SCHED; PG8_LDA(At, 0, 0); PG8_STAGE(PG8_SA(1, 1), a1 + hstep, voffA);
            PG8_WAIT_L(8); PG8_BAR; PG8_WAIT_L(0); PG8_MMA(0, 0, At, B0); PG8_BAR; PG8_SCHED;
            PG8_LDB(B1, 0, 1); PG8_STAGE(PG8_SB(0, 0), b2, voffB);
            PG8_BAR; PG8_WAIT_L(0); PG8_MMA(0, 1, At, B1); PG8_BAR;
            PG8_LDA(At, 0, 1); PG8_STAGE(PG8_SA(0, 0), a2, voffA);
            PG8_BAR; PG8_WAIT_L(0); PG8_MMA(1, 0, At, B0); PG8_BAR; PG8_SCHED;
            PG8_STAGE(PG8_SB(0, 1), b2 + hstep, voffB);
            PG8_WAIT_V(6); PG8_BAR; PG8_MMA(1, 1, At, B1); PG8_BAR;
            PG8_LDB(B0, 1, 0); PG8_SCHED; PG8_LDA(At, 1, 0); PG8_STAGE(PG8_SA(0, 1), a2 + hstep, voffA);
            PG8_WAIT_L(8); PG8_BAR; PG8_WAIT_L(0); PG8_MMA(0, 0, At, B0); PG8_BAR; PG8_SCHED;
            PG8_LDB(B1, 1, 1); PG8_STAGE(PG8_SB(1, 0), b3, voffB);
            PG8_BAR; PG8_WAIT_L(0); PG8_MMA(0, 1, At, B1); PG8_BAR;
            PG8_LDA(At, 1, 1); PG8_STAGE(PG8_SA(1, 0), a3, voffA);
            PG8_BAR; PG8_WAIT_L(0); PG8_MMA(1, 0, At, B0); PG8_BAR; PG8_SCHED;
            PG8_STAGE(PG8_SB(1, 1), b3 + hstep, voffB);
            PG8_WAIT_V(6); PG8_BAR; PG8_MMA(1, 1, At, B1); PG8_BAR;
        }
        E(acc, cur, wr, wc, fr, fq);
        if (!has_next) break;
#pragma unroll
        for (int a = 0; a < 2; ++a)
#pragma unroll
            for (int b = 0; b < 2; ++b)
#pragma unroll
                for (int m = 0; m < 4; ++m)
#pragma unroll
                    for (int n = 0; n < 2; ++n) acc[a][b][m][n] = (f32x4){0.f, 0.f, 0.f, 0.f};
        cur = nxt; cA = nA; cB = nB; ++ui;
    }
    PG8_WAIT_V(0);
    if (wr == 0) PG8_BAR;
    PG8_BAR;
#undef PG8_SA
#undef PG8_SB
#undef PG8_STAGE
#undef PG8_LDA
#undef PG8_LDB
#undef PG8_MMA
#undef PG8_WAIT_V
#undef PG8_WAIT_L
#undef PG8_BAR
#undef PG8_SCHED
}

struct EpiHgrnIn {
    static constexpr bool PERM = true;
    bf16_t* QVG; float* LF; const float* lb;
    __device__ __forceinline__ void operator()(const f32x4 (&acc)[2][2][4][2], const Unit& u, int wr, int wc, int fr, int fq) const {
        const int seg = u.pn >> 2, colt = (u.pn & 3) * 256;
        const int row0 = u.pm * BM + wr * 64 + fr, col0 = colt + wc * 32 + 8 * fq;
        if (seg == 1) {
#pragma unroll
            for (int bj = 0; bj < 2; ++bj) {
                const f32x4 l0 = *(const f32x4*)(lb + col0 + bj * HALF), l1 = *(const f32x4*)(lb + col0 + bj * HALF + 4);
#pragma unroll
                for (int ai = 0; ai < 2; ++ai)
#pragma unroll
                    for (int m = 0; m < 4; ++m) {
                        float* rowp = LF + (size_t)(row0 + ai * HALF + m * 16) * D + col0 + bj * HALF;
                        f32x4 o0, o1;
#pragma unroll
                        for (int j = 0; j < 4; ++j) {
                            float z = acc[ai][bj][m][0][j]; float sg = __builtin_amdgcn_rcpf(1.0f + __expf(-z)); float f = l0[j] + (1.0f - l0[j]) * sg; o0[j] = logf(fmaxf(f, 1e-30f));
                            z = acc[ai][bj][m][1][j]; sg = __builtin_amdgcn_rcpf(1.0f + __expf(-z)); f = l1[j] + (1.0f - l1[j]) * sg; o1[j] = logf(fmaxf(f, 1e-30f));
                        }
                        *(f32x4*)rowp = o0; *(f32x4*)(rowp + 4) = o1;
                    }
            }
        } else {
            bf16_t* base = QVG + (size_t)(seg == 0 ? 0 : (seg == 2 ? 1 : 2)) * ((size_t)MTOK * D);
            const bool act = (seg != 2);
#pragma unroll
            for (int ai = 0; ai < 2; ++ai)
#pragma unroll
                for (int m = 0; m < 4; ++m)
#pragma unroll
                    for (int bj = 0; bj < 2; ++bj) {
                        f32x4 v0 = acc[ai][bj][m][0], v1 = acc[ai][bj][m][1];
                        if (act) {
#pragma unroll
                            for (int j = 0; j < 4; ++j) { v0[j] = silu_f(v0[j]); v1[j] = silu_f(v1[j]); }
                        }
                        u32x4 w; w.x = cvt_pk_bf16(v0[0], v0[1]); w.y = cvt_pk_bf16(v0[2], v0[3]); w.z = cvt_pk_bf16(v1[0], v1[1]); w.w = cvt_pk_bf16(v1[2], v1[3]);
                        *(u32x4*)(base + (size_t)(row0 + ai * HALF + m * 16) * D + col0 + bj * HALF) = w;
                    }
        }
    }
};
struct EpiResid {
    static constexpr bool PERM = true;
    const float* src; float* dst; const float* gate;
    __device__ __forceinline__ void operator()(const f32x4 (&acc)[2][2][4][2], const Unit& u, int wr, int wc, int fr, int fq) const {
        const int b = u.pm >> 5;
        const float* gp = gate + (size_t)b * 6144;
        const int row0 = u.pm * BM + wr * 64 + fr, col0 = u.pn * BM + wc * 32 + 8 * fq;
        f32x4 gv[2][2];
#pragma unroll
        for (int bj = 0; bj < 2; ++bj)
#pragma unroll
            for (int n = 0; n < 2; ++n) gv[bj][n] = *(const f32x4*)(gp + col0 + bj * HALF + 4 * n);
#pragma unroll
        for (int ai = 0; ai < 2; ++ai)
#pragma unroll
            for (int m = 0; m < 4; ++m) {
                const size_t ro = (size_t)(row0 + ai * HALF + m * 16) * D + col0;
#pragma unroll
                for (int bj = 0; bj < 2; ++bj)
#pragma unroll
                    for (int n = 0; n < 2; ++n) {
                        const f32x4 s = *(const f32x4*)(src + ro + bj * HALF + 4 * n);
                        *(f32x4*)(dst + ro + bj * HALF + 4 * n) = s + gv[bj][n] * acc[ai][bj][m][n];
                    }
            }
    }
};
struct EpiSwiglu {
    static constexpr bool PERM = true;
    bf16_t* act;
    __device__ __forceinline__ void operator()(const f32x4 (&acc)[2][2][4][2], const Unit& u, int wr, int wc, int fr, int fq) const {
        const int row0 = u.pm * BM + wr * 64 + fr, col0 = u.pn * HALF + wc * 32 + 8 * fq;
#pragma unroll
        for (int ai = 0; ai < 2; ++ai)
#pragma unroll
            for (int m = 0; m < 4; ++m) {
                f32x4 r0, r1;
#pragma unroll
                for (int j = 0; j < 4; ++j) { r0[j] = silu_f(acc[ai][0][m][0][j]) * acc[ai][1][m][0][j]; r1[j] = silu_f(acc[ai][0][m][1][j]) * acc[ai][1][m][1][j]; }
                u32x4 w; w.x = cvt_pk_bf16(r0[0], r0[1]); w.y = cvt_pk_bf16(r0[2], r0[3]); w.z = cvt_pk_bf16(r1[0], r1[1]); w.w = cvt_pk_bf16(r1[2], r1[3]);
                *(u32x4*)(act + (size_t)(row0 + ai * HALF + m * 16) * FFN + col0) = w;
            }
    }
};
struct EpiBf16Split {
    static constexpr bool PERM = true;
    bf16_t* d0; float scale;
    __device__ __forceinline__ void operator()(const f32x4 (&acc)[2][2][4][2], const Unit& u, int wr, int wc, int fr, int fq) const {
        bf16_t* base = d0 + (size_t)(u.pn >> 2) * ((size_t)MTOK * D);
        const int row0 = u.pm * BM + wr * 64 + fr, col0 = (u.pn & 3) * 256 + wc * 32 + 8 * fq;
#pragma unroll
        for (int ai = 0; ai < 2; ++ai)
#pragma unroll
            for (int m = 0; m < 4; ++m)
#pragma unroll
                for (int bj = 0; bj < 2; ++bj) {
                    const f32x4 v0 = acc[ai][bj][m][0] * scale, v1 = acc[ai][bj][m][1] * scale;
                    u32x4 w; w.x = cvt_pk_bf16(v0[0], v0[1]); w.y = cvt_pk_bf16(v0[2], v0[3]); w.z = cvt_pk_bf16(v1[0], v1[1]); w.w = cvt_pk_bf16(v1[2], v1[3]);
                    *(u32x4*)(base + (size_t)(row0 + ai * HALF + m * 16) * D + col0 + bj * HALF) = w;
                }
    }
};
}

template <class Epi>
__device__ __forceinline__ void run_gemm(unsigned char* shm, const bf16_t* A, const bf16_t* Bt, int N, int K, const Epi& E) {
    pg8::Gemm g; g.A = A; g.Bt = Bt; g.M = MTOK; g.N = N; g.K = K;
    pg8::StaticOrder S; S.init(MTOK, N, (int)gridDim.x, (int)blockIdx.x);
    pg8::gemm_phase<Epi>((LAS unsigned char*)shm, g, S, E);
    __syncthreads();
}

__device__ __forceinline__ int ffnmap(int nn) { return nn < FFN ? ((nn >> 7) * 256 + (nn & 127)) : (((nn - FFN) >> 7) * 256 + 128 + ((nn - FFN) & 127)); }

__device__ __forceinline__ void conv_group(const float* src0, bf16_t* dst0, const int K, const int N, const int L, const int mode, unsigned char* shm, const int tid) {
    float* st = (float*)shm;
    const int per = (K / 128) * (N / 64), total = L * per, ntn = N / 64;
    for (int tile = blockIdx.x; tile < total; tile += gridDim.x) {
        const int l = tile / per, tt = tile % per, k0 = (tt / ntn) * 128, n0 = (tt % ntn) * 64;
        const float* src = src0 + (size_t)l * K * N; bf16_t* dst = dst0 + (size_t)l * K * N;
        f32x4 v[4];
#pragma unroll
        for (int it = 0; it < 4; ++it) { const int idx = tid + it * 512, k = idx >> 4, n4 = idx & 15; v[it] = *(const f32x4*)(src + (size_t)(k0 + k) * N + n0 + 4 * n4); }
        __syncthreads();
#pragma unroll
        for (int it = 0; it < 4; ++it) { const int idx = tid + it * 512, k = idx >> 4, n4 = idx & 15;
#pragma unroll
            for (int e = 0; e < 4; ++e) st[k * 65 + 4 * n4 + e] = v[it][e]; }
        __syncthreads();
#pragma unroll
        for (int it = 0; it < 2; ++it) { const int idx = tid + it * 512, n = idx >> 4, kg = idx & 15; const int nn = n0 + n; const int drow = mode ? ffnmap(nn) : nn;
            u32x4 w;
#pragma unroll
            for (int e = 0; e < 4; ++e) w[e] = cvt_pk_bf16(st[(8 * kg + 2 * e) * 65 + n], st[(8 * kg + 2 * e + 1) * 65 + n]);
            *(u32x4*)(dst + (size_t)drow * K + k0 + 8 * kg) = w; }
    }
}

__device__ void prep_phase(const Params& p, unsigned char* shm) {
    const int tid = opaque_tid();
    {
        float* cact = (float*)shm;
        float* red = cact + 8192;
        bool loaded = false;
        const int wv = tid >> 6, lane = tid & 63;
        for (int task = blockIdx.x; task < 416; task += gridDim.x) {
            if (!loaded) {
                for (int i = tid; i < 8192; i += 512) { const int k = i >> 3, b = i & 7; cact[i] = silu_f(p.in[1][b * D + k]); }
                loaded = true;
            }
            __syncthreads();
            const int c0 = task * 64;
            const float* src; const float* bias; float* dst; int stride, dstride;
            if (c0 < 24576) { const int l = c0 / 6144, j = c0 % 6144; src = p.in[2] + (size_t)l * D * 6144 + j; stride = 6144; bias = p.in[3] + l * 6144 + j; dst = ((float*)(p.ws + OFF_MODV)) + (size_t)l * 8 * 6144 + j; dstride = 6144; }
            else { const int j = c0 - 24576; src = p.in[13] + j; stride = 2048; bias = p.in[14] + j; dst = ((float*)(p.ws + OFF_KVMOD)) + j; dstride = 2048; }
            float a[8];
#pragma unroll
            for (int b = 0; b < 8; ++b) a[b] = 0.f;
            const float* sp = src + (size_t)(wv * 128) * stride + lane;
#pragma unroll 8
            for (int k = 0; k < 128; ++k) {
                const float w = sp[(size_t)k * stride];
                const f32x4 c0v = *(const f32x4*)(cact + (wv * 128 + k) * 8), c1v = *(const f32x4*)(cact + (wv * 128 + k) * 8 + 4);
                a[0] += w * c0v[0]; a[1] += w * c0v[1]; a[2] += w * c0v[2]; a[3] += w * c0v[3];
                a[4] += w * c1v[0]; a[5] += w * c1v[1]; a[6] += w * c1v[2]; a[7] += w * c1v[3];
            }
#pragma unroll
            for (int b = 0; b < 8; ++b) red[(wv * 8 + b) * 64 + lane] = a[b];
            __syncthreads();
            {
                const int b = tid >> 6, col = tid & 63;
                float s = bias[col];
#pragma unroll
                for (int w = 0; w < 8; ++w) s += red[(w * 8 + b) * 64 + col];
                dst[(size_t)b * dstride + col] = s;
            }
        }
        __syncthreads();
    }
    for (int i = blockIdx.x * 512 + tid; i < 1024; i += gridDim.x * 512) {
        const float a0 = p.in[10][i], a1 = p.in[10][1024 + i];
        const float mx = fmaxf(a0, a1), e0 = __expf(a0 - mx), e1 = __expf(a1 - mx);
        ((float*)(p.ws + OFF_LBV))[i] = 0.f; ((float*)(p.ws + OFF_LBV))[1024 + i] = e1 / (e0 + e1);
    }
    conv_group(p.in[8], (bf16_t*)(p.ws + OFF_WB_A_IN), D, AIN, 2, 0, shm, tid);
    conv_group(p.in[9], (bf16_t*)(p.ws + OFF_WB_A_OUT), D, D, 2, 0, shm, tid);
    conv_group(p.in[6], (bf16_t*)(p.ws + OFF_WB_FFN_IN), D, 2 * FFN, 4, 1, shm, tid);
    conv_group(p.in[7], (bf16_t*)(p.ws + OFF_WB_FFN_OUT), FFN, D, 4, 0, shm, tid);
    conv_group(p.in[15], (bf16_t*)(p.ws + OFF_WB_KV), D, 2 * D, 1, 0, shm, tid);
    conv_group(p.in[16], (bf16_t*)(p.ws + OFF_WB_Q), D, D, 2, 0, shm, tid);
    conv_group(p.in[17], (bf16_t*)(p.ws + OFF_WB_O), D, D, 2, 0, shm, tid);
    __syncthreads();
}

__device__ void norm_phase(const float* src, bf16_t* U1, const float* gain1, const float* sh1, const float* sc1, int bs1,
                           bf16_t* U2, const float* gain2, const float* sh2, const float* sc2, int bs2) {
    const int tid_ = opaque_tid(); const int lane = tid_ & 63, gw = blockIdx.x * 8 + (tid_ >> 6), nw = gridDim.x * 8;
    for (int row = 2 * gw; row < MTOK; row += 2 * nw) {
        const int b = row >> 13;
        const float* xp = src + (size_t)row * D;
        f32x4 xv[2][4]; float ss[2] = {0.f, 0.f};
#pragma unroll
        for (int r = 0; r < 2; ++r)
#pragma unroll
            for (int i = 0; i < 4; ++i) xv[r][i] = *(const f32x4*)(xp + (size_t)r * D + i * 256 + lane * 4);
#pragma unroll
        for (int r = 0; r < 2; ++r)
#pragma unroll
            for (int i = 0; i < 4; ++i) ss[r] += xv[r][i][0] * xv[r][i][0] + xv[r][i][1] * xv[r][i][1] + xv[r][i][2] * xv[r][i][2] + xv[r][i][3] * xv[r][i][3];
#pragma unroll
        for (int o = 1; o < 64; o <<= 1) { ss[0] += __shfl_xor(ss[0], o); ss[1] += __shfl_xor(ss[1], o); }
        const float rstd0 = rsqrtf(ss[0] * (1.0f / D) + 1e-6f), rstd1 = rsqrtf(ss[1] * (1.0f / D) + 1e-6f);
#pragma unroll
        for (int i = 0; i < 4; ++i) {
            const int k = i * 256 + lane * 4;
            const f32x4 g = *(const f32x4*)(gain1 + k), s = *(const f32x4*)(sc1 + (size_t)b * bs1 + k), t = *(const f32x4*)(sh1 + (size_t)b * bs1 + k);
            f32x4 u0, u1;
#pragma unroll
            for (int j = 0; j < 4; ++j) { const float ga = g[j] * (1.0f + s[j]); u0[j] = (xv[0][i][j] * rstd0) * ga + t[j]; u1[j] = (xv[1][i][j] * rstd1) * ga + t[j]; }
            u32x2 w0, w1; w0.x = cvt_pk_bf16(u0[0], u0[1]); w0.y = cvt_pk_bf16(u0[2], u0[3]); w1.x = cvt_pk_bf16(u1[0], u1[1]); w1.y = cvt_pk_bf16(u1[2], u1[3]);
            *(u32x2*)(U1 + (size_t)row * D + k) = w0; *(u32x2*)(U1 + (size_t)(row + 1) * D + k) = w1;
        }
        if (U2) {
#pragma unroll
            for (int i = 0; i < 4; ++i) {
                const int k = i * 256 + lane * 4;
                const f32x4 g = *(const f32x4*)(gain2 + k), s = *(const f32x4*)(sc2 + (size_t)b * bs2 + k), t = *(const f32x4*)(sh2 + (size_t)b * bs2 + k);
                f32x4 u0, u1;
#pragma unroll
                for (int j = 0; j < 4; ++j) { const float ga = g[j] * (1.0f + s[j]); u0[j] = (xv[0][i][j] * rstd0) * ga + t[j]; u1[j] = (xv[1][i][j] * rstd1) * ga + t[j]; }
                u32x2 w0, w1; w0.x = cvt_pk_bf16(u0[0], u0[1]); w0.y = cvt_pk_bf16(u0[2], u0[3]); w1.x = cvt_pk_bf16(u1[0], u1[1]); w1.y = cvt_pk_bf16(u1[2], u1[3]);
                *(u32x2*)(U2 + (size_t)row * D + k) = w0; *(u32x2*)(U2 + (size_t)(row + 1) * D + k) = w1;
            }
        }
    }
}
__device__ void final_norm_phase(float* h, const float* gain) {
    const int tid_ = opaque_tid(); const int lane = tid_ & 63, gw = blockIdx.x * 8 + (tid_ >> 6), nw = gridDim.x * 8;
    for (int row = gw; row < MTOK; row += nw) {
        float* xp = h + (size_t)row * D;
        f32x4 xv[4]; float ss = 0.f;
#pragma unroll
        for (int i = 0; i < 4; ++i) { xv[i] = *(const f32x4*)(xp + i * 256 + lane * 4); ss += xv[i][0] * xv[i][0] + xv[i][1] * xv[i][1] + xv[i][2] * xv[i][2] + xv[i][3] * xv[i][3]; }
#pragma unroll
        for (int o = 1; o < 64; o <<= 1) ss += __shfl_xor(ss, o);
        const float rstd = rsqrtf(ss * (1.0f / D) + 1e-6f);
#pragma unroll
        for (int i = 0; i < 4; ++i) {
            const int k = i * 256 + lane * 4;
            const f32x4 g = *(const f32x4*)(gain + k);
            f32x4 u;
#pragma unroll
            for (int j = 0; j < 4; ++j) u[j] = xv[i][j] * rstd * g[j];
            *(f32x4*)(xp + k) = u;
        }
    }
}

template <bool OUT>
__device__ void rec_pass(const Params& p, int layer, unsigned char* shm) {
    float* sB = (float*)shm;
    float* sKm = (float*)(shm + 33792);
    bf16_t* sST = (bf16_t*)shm;
    bf16_t* sQb = (bf16_t*)(shm + 67584);
    bf16_t* sA = (bf16_t*)(shm + 84992);
    bf16_t* sKT = (bf16_t*)(shm + 94208);
    bf16_t* sVT = (bf16_t*)(shm + 112640);
    float* sE = (float*)(shm + 131072);
    float* sPart = (float*)(shm + 131584);
    float* sNrm = (float*)(shm + 133632);
    const int tid = opaque_tid(), lane = tid & 63, w = tid >> 6, fr = lane & 15, fq = lane >> 4;
    const int wi = w >> 1, wh = w & 1;
    const int ntask = OUT ? 256 : 192;
    const float* ogain = p.in[11] + layer * 128;
    for (int task = blockIdx.x; task < ntask; task += gridDim.x) {
        int sc, bh; if (OUT) { sc = task & 3; bh = task >> 2; } else { sc = task % 3; bh = task / 3; }
        const int b = bh >> 3, h = bh & 7;
        f32x4 S[8];
#pragma unroll
        for (int db = 0; db < 8; ++db) S[db] = (f32x4){0.f, 0.f, 0.f, 0.f};
        if (OUT) {
            for (int s2 = 0; s2 < sc; ++s2) {
                const float* sl = ((float*)(p.ws + OFF_SLOC)) + (size_t)(bh * 4 + s2) * 16384; const float* dl = ((float*)(p.ws + OFF_DLOG)) + (bh * 4 + s2) * 128;
#pragma unroll
                for (int db = 0; db < 8; ++db) {
                    const f32x4 x = *(const f32x4*)(sl + ((w * 8 + db) * 64 + lane) * 4), dv = *(const f32x4*)(dl + 16 * db + fq * 4);
#pragma unroll
                    for (int j = 0; j < 4; ++j) S[db][j] = S[db][j] * __expf(dv[j]) + x[j];
                }
            }
        }
        float dlacc = 0.f;
        float lfn[16]; u32x4 vn0, vn1;
        {
            const size_t r0 = (size_t)b * SEQ + (size_t)(sc * 32) * 64;
            const float* lp = ((float*)(p.ws + OFF_LF)) + (r0 + 16 * (tid >> 7)) * D + h * 128 + (tid & 127);
#pragma unroll
            for (int e = 0; e < 16; ++e) lfn[e] = lp[(size_t)e * D];
            vn0 = *(const u32x4*)(((bf16_t*)(p.ws + OFF_VH)) + (r0 + (tid & 63)) * D + h * 128 + (tid >> 6) * 8);
            vn1 = *(const u32x4*)(((bf16_t*)(p.ws + OFF_VH)) + (r0 + (tid & 63)) * D + h * 128 + 64 + (tid >> 6) * 8);
        }
        for (int ch = sc * 32; ch < sc * 32 + 32; ++ch) {
            const size_t row0 = (size_t)b * SEQ + (size_t)ch * 64;
            float lfv[16];
#pragma unroll
            for (int e = 0; e < 16; ++e) lfv[e] = lfn[e];
            const u32x4 vr0 = vn0, vr1 = vn1;
            u32x4 qraw[4]; u32x2 graw[4];
            if (OUT) {
#pragma unroll
                for (int ks = 0; ks < 4; ++ks) qraw[ks] = *(const u32x4*)(((bf16_t*)(p.ws + OFF_QH)) + (row0 + 16 * wi + fr) * D + h * 128 + ks * 32 + fq * 8);
#pragma unroll
                for (int vb = 0; vb < 4; ++vb) graw[vb] = *(const u32x2*)(((bf16_t*)(p.ws + OFF_GH)) + (row0 + 16 * wi + fr) * D + h * 128 + 64 * wh + 16 * vb + fq * 4);
            }
            {
                const int d_ = tid & 127, tq = tid >> 7;
                float run = 0.f;
#pragma unroll
                for (int e = 0; e < 16; ++e) { sKm[(16 * tq + e) * 132 + d_] = 1.0f - __expf(lfv[e]); run += lfv[e]; lfv[e] = run; }
                sPart[tq * 128 + d_] = run;
                {
                    const int s_ = tid & 63, pc = tid >> 6;
#pragma unroll
                    for (int e = 0; e < 8; ++e) {
                        sVT[(pc * 8 + e) * 72 + s_] = (bf16_t)((e & 1) ? (vr0[e >> 1] >> 16) : (vr0[e >> 1] & 0xffffu));
                        sVT[(64 + pc * 8 + e) * 72 + s_] = (bf16_t)((e & 1) ? (vr1[e >> 1] >> 16) : (vr1[e >> 1] & 0xffffu));
                    }
                }
                __syncthreads();
                float off = 0.f;
                for (int q = 0; q < tq; ++q) off += sPart[q * 128 + d_];
#pragma unroll
                for (int e = 0; e < 16; ++e) sB[(16 * tq + e) * 132 + d_] = lfv[e] + off;
            }
            __syncthreads();
            if (ch + 1 < sc * 32 + 32) {
                const size_t r1 = row0 + 64;
                const float* lp = ((float*)(p.ws + OFF_LF)) + (r1 + 16 * (tid >> 7)) * D + h * 128 + (tid & 127);
#pragma unroll
                for (int e = 0; e < 16; ++e) lfn[e] = lp[(size_t)e * D];
                vn0 = *(const u32x4*)(((bf16_t*)(p.ws + OFF_VH)) + (r1 + (tid & 63)) * D + h * 128 + (tid >> 6) * 8);
                vn1 = *(const u32x4*)(((bf16_t*)(p.ws + OFF_VH)) + (r1 + (tid & 63)) * D + h * 128 + 64 + (tid >> 6) * 8);
            }
            if (tid < 128) { const float bl = sB[63 * 132 + tid]; sE[tid] = __expf(bl); dlacc += bl; }
            {
                const int s_ = tid & 63, dp = tid >> 6;
#pragma unroll
                for (int q4 = 0; q4 < 4; ++q4) {
                    const f32x4 k4 = *(const f32x4*)(sKm + s_ * 132 + 16 * dp + 4 * q4), b4 = *(const f32x4*)(sB + s_ * 132 + 16 * dp + 4 * q4), l4 = *(const f32x4*)(sB + 63 * 132 + 16 * dp + 4 * q4);
#pragma unroll
                    for (int j = 0; j < 4; ++j) sKT[(16 * dp + 4 * q4 + j) * 72 + s_] = (bf16_t)(cvt_pk_bf16(k4[j] * __expf(l4[j] - b4[j]), 0.f) & 0xffffu);
                }
            }
            if (OUT) {
                const int i = wi, hh = wh, t_ = 16 * i + fr;
                bf16x8 qt[4];
#pragma unroll
                for (int ks = 0; ks < 4; ++ks) {
                    const int d0 = ks * 32 + fq * 8;
                    const f32x4 b0 = *(const f32x4*)(sB + t_ * 132 + d0), b1 = *(const f32x4*)(sB + t_ * 132 + d0 + 4);
                    f32x4 r0 = (f32x4){0.f, 0.f, 0.f, 0.f}, r1 = r0;
                    if (i > 0) { r0 = *(const f32x4*)(sB + (16 * i - 1) * 132 + d0); r1 = *(const f32x4*)(sB + (16 * i - 1) * 132 + d0 + 4); }
                    float qv[8], ql[8];
#pragma unroll
                    for (int e = 0; e < 4; ++e) { qv[2 * e] = bflo(qraw[ks][e]); qv[2 * e + 1] = bfhi(qraw[ks][e]); }
#pragma unroll
                    for (int e = 0; e < 4; ++e) { ql[e] = qv[e] * __expf(b0[e] - r0[e]); ql[4 + e] = qv[4 + e] * __expf(b1[e] - r1[e]); }
                    u32x4 pw; pw.x = cvt_pk_bf16(ql[0], ql[1]); pw.y = cvt_pk_bf16(ql[2], ql[3]); pw.z = cvt_pk_bf16(ql[4], ql[5]); pw.w = cvt_pk_bf16(ql[6], ql[7]);
                    qt[ks] = __builtin_bit_cast(bf16x8, pw);
                    if ((ks >> 1) == hh) {
#pragma unroll
                        for (int e = 0; e < 4; ++e) { ql[e] = qv[e] * __expf(b0[e]); ql[4 + e] = qv[4 + e] * __expf(b1[e]); }
                        u32x4 qw; qw.x = cvt_pk_bf16(ql[0], ql[1]); qw.y = cvt_pk_bf16(ql[2], ql[3]); qw.z = cvt_pk_bf16(ql[4], ql[5]); qw.w = cvt_pk_bf16(ql[6], ql[7]);
                        *(u32x4*)(sQb + t_ * 136 + d0) = qw;
                    }
                }
#pragma unroll
                for (int j2 = 0; j2 < 2; ++j2) {
                    const int j = hh + 2 * j2;
                    if (j <= i) {
                        f32x4 acc = (f32x4){0.f, 0.f, 0.f, 0.f};
                        const int s_ = 16 * j + fr;
#pragma unroll
                        for (int ks = 0; ks < 4; ++ks) {
                            const int d0 = ks * 32 + fq * 8;
                            const f32x4 k0 = *(const f32x4*)(sKm + s_ * 132 + d0), k1 = *(const f32x4*)(sKm + s_ * 132 + d0 + 4);
                            const f32x4 b0 = *(const f32x4*)(sB + s_ * 132 + d0), b1 = *(const f32x4*)(sB + s_ * 132 + d0 + 4);
                            f32x4 r0 = (f32x4){0.f, 0.f, 0.f, 0.f}, r1 = r0;
                            if (i > 0) { r0 = *(const f32x4*)(sB + (16 * i - 1) * 132 + d0); r1 = *(const f32x4*)(sB + (16 * i - 1) * 132 + d0 + 4); }
                            float kl[8];
#pragma unroll
                            for (int e = 0; e < 4; ++e) { kl[e] = k0[e] * __expf(fminf(r0[e] - b0[e], 80.f)); kl[4 + e] = k1[e] * __expf(fminf(r1[e] - b1[e], 80.f)); }
                            u32x4 kw; kw.x = cvt_pk_bf16(kl[0], kl[1]); kw.y = cvt_pk_bf16(kl[2], kl[3]); kw.z = cvt_pk_bf16(kl[4], kl[5]); kw.w = cvt_pk_bf16(kl[6], kl[7]);
                            acc = __builtin_amdgcn_mfma_f32_16x16x32_bf16(qt[ks], __builtin_bit_cast(bf16x8, kw), acc, 0, 0, 0);
                        }
#pragma unroll
                        for (int jj = 0; jj < 4; ++jj) {
                            float vv = acc[jj];
                            if (i == j && fr > fq * 4 + jj) vv = 0.f;
                            sA[(16 * i + fq * 4 + jj) * 72 + 16 * j + fr] = (bf16_t)(cvt_pk_bf16(vv, 0.f) & 0xffffu);
                        }
                    } else {
#pragma unroll
                        for (int jj = 0; jj < 4; ++jj) sA[(16 * i + fq * 4 + jj) * 72 + 16 * j + fr] = (bf16_t)0;
                    }
                }
            }
            __syncthreads();
            if (OUT) {
#pragma unroll
                for (int db = 0; db < 8; ++db) { u32x2 sw; sw.x = cvt_pk_bf16(S[db][0], S[db][1]); sw.y = cvt_pk_bf16(S[db][2], S[db][3]); *(u32x2*)(sST + (16 * w + fr) * 136 + 16 * db + fq * 4) = sw; }
                __syncthreads();
            }
            f32x4 o[4];
            if (OUT) {
                const int i = wi;
#pragma unroll
                for (int vb = 0; vb < 4; ++vb) o[vb] = (f32x4){0.f, 0.f, 0.f, 0.f};
#pragma unroll
                for (int kk = 0; kk < 2; ++kk) {
                    if (kk <= (i >> 1)) {
                        const bf16x8 af = *(const bf16x8*)(sA + (16 * i + fr) * 72 + kk * 32 + fq * 8);
#pragma unroll
                        for (int vb = 0; vb < 4; ++vb) { const bf16x8 vf = *(const bf16x8*)(sVT + (64 * wh + 16 * vb + fr) * 72 + kk * 32 + fq * 8); o[vb] = __builtin_amdgcn_mfma_f32_16x16x32_bf16(vf, af, o[vb], 0, 0, 0); }
                    }
                }
#pragma unroll
                for (int ks = 0; ks < 4; ++ks) {
                    const bf16x8 qf = *(const bf16x8*)(sQb + (16 * i + fr) * 136 + ks * 32 + fq * 8);
#pragma unroll
                    for (int vb = 0; vb < 4; ++vb) { const bf16x8 sf = *(const bf16x8*)(sST + (64 * wh + 16 * vb + fr) * 136 + ks * 32 + fq * 8); o[vb] = __builtin_amdgcn_mfma_f32_16x16x32_bf16(sf, qf, o[vb], 0, 0, 0); }
                }
                float ss = 0.f;
#pragma unroll
                for (int vb = 0; vb < 4; ++vb)
#pragma unroll
                    for (int jj = 0; jj < 4; ++jj) ss += o[vb][jj] * o[vb][jj];
                ss += __shfl_xor(ss, 16); ss += __shfl_xor(ss, 32);
                if (fq == 0) sNrm[wh * 64 + 16 * i + fr] = ss;
            }
#pragma unroll
            for (int db = 0; db < 8; ++db) { const f32x4 e4 = *(const f32x4*)(sE + 16 * db + fq * 4); S[db] = S[db] * e4; }
#pragma unroll
            for (int ks = 0; ks < 2; ++ks) {
                const bf16x8 vf = *(const bf16x8*)(sVT + (16 * w + fr) * 72 + ks * 32 + fq * 8);
#pragma unroll
                for (int db = 0; db < 8; ++db) { const bf16x8 kf = *(const bf16x8*)(sKT + (16 * db + fr) * 72 + ks * 32 + fq * 8); S[db] = __builtin_amdgcn_mfma_f32_16x16x32_bf16(kf, vf, S[db], 0, 0, 0); }
            }
            __syncthreads();
            if (OUT) {
                const int i = wi;
                const float tot = sNrm[16 * i + fr] + sNrm[64 + 16 * i + fr];
                const float rstd = rsqrtf(tot * (1.0f / 128.0f) + 1e-6f);
                bf16_t* op = ((bf16_t*)(p.ws + OFF_U)) + (row0 + 16 * i + fr) * D + h * 128 + 64 * wh + fq * 4;
#pragma unroll
                for (int vb = 0; vb < 4; ++vb) {
                    const f32x4 gn = *(const f32x4*)(ogain + 64 * wh + 16 * vb + fq * 4);
                    const float g0 = bflo(graw[vb].x), g1 = bfhi(graw[vb].x), g2 = bflo(graw[vb].y), g3 = bfhi(graw[vb].y);
                    u32x2 ow; ow.x = cvt_pk_bf16(o[vb][0] * rstd * gn[0] * g0, o[vb][1] * rstd * gn[1] * g1); ow.y = cvt_pk_bf16(o[vb][2] * rstd * gn[2] * g2, o[vb][3] * rstd * gn[3] * g3);
                    *(u32x2*)(op + 16 * vb) = ow;
                }
            }
        }
        if (!OUT) {
            float* sl = ((float*)(p.ws + OFF_SLOC)) + (size_t)(bh * 4 + sc) * 16384;
#pragma unroll
            for (int db = 0; db < 8; ++db) *(f32x4*)(sl + ((w * 8 + db) * 64 + lane) * 4) = S[db];
            if (tid < 128) ((float*)(p.ws + OFF_DLOG))[(bh * 4 + sc) * 128 + tid] = dlacc;
        }
    }
    __syncthreads();
}

__device__ void attn_phase(const Params& p, int jl, unsigned char* shm) {
    bf16_t* sK = (bf16_t*)shm;
    bf16_t* sVT = sK + 2 * 4608;
    float* sB = (float*)(sVT + 2 * 4608);
    const int tid = opaque_tid(), lane = tid & 63, w = tid >> 6, fr = lane & 15, fq = lane >> 4;
    const int cq = w >> 1, half = w & 1;
    const float LOG2E = 1.4426950408889634f;
    const int skey = tid >> 3, spiece = tid & 7, vkey = tid & 63, vpiece = tid >> 6;
    for (int task = blockIdx.x; task < 4096; task += gridDim.x) {
        const int g = task & 31, h = (task >> 5) & 15, b = task >> 9;
        const int c = 4 * g + cq;
        const int kt0 = (4 * g - 8 > 0) ? 4 * g - 8 : 0, kt1 = 4 * g + 3;
        __syncthreads();
        for (int i = tid; i < 320; i += 512) sB[i] = p.in[18][((size_t)jl * 320 + i) * 16 + h] * LOG2E;
        bf16x8 qf[2][2];
        {
            const bf16_t* qp = ((bf16_t*)(p.ws + OFF_QB)) + ((size_t)b * SEQ + c * 64 + half * 32) * D + h * 64;
#pragma unroll
            for (int qb = 0; qb < 2; ++qb)
#pragma unroll
                for (int ks = 0; ks < 2; ++ks) qf[qb][ks] = *(const bf16x8*)(qp + (size_t)(qb * 16 + fr) * D + ks * 32 + fq * 8);
        }
        f32x4 oacc[4][2];
#pragma unroll
        for (int db = 0; db < 4; ++db)
#pragma unroll
            for (int qb = 0; qb < 2; ++qb) oacc[db][qb] = (f32x4){0.f, 0.f, 0.f, 0.f};
        float mrun[2] = {-1e30f, -1e30f}, lrun[2] = {0.f, 0.f};
        u32x4 kreg, vreg;
        const size_t tokb = (size_t)b * SEQ;
        kreg = *(const u32x4*)(((bf16_t*)(p.ws + OFF_KB)) + (tokb + kt0 * 64 + skey) * D + h * 64 + spiece * 8);
        vreg = *(const u32x4*)(((bf16_t*)(p.ws + OFF_VB)) + (tokb + kt0 * 64 + vkey) * D + h * 64 + vpiece * 8);
        {
            *(u32x4*)(sK + skey * 72 + spiece * 8) = kreg;
            bf16_t* vt = sVT + (vpiece * 8) * 72 + vkey;
#pragma unroll
            for (int e = 0; e < 8; ++e) vt[e * 72] = (bf16_t)((e & 1) ? (vreg[e >> 1] >> 16) : (vreg[e >> 1] & 0xffffu));
        }
        __syncthreads();
        for (int kt = kt0; kt <= kt1; ++kt) {
            const int buf = (kt - kt0) & 1;
            if (kt < kt1) {
                kreg = *(const u32x4*)(((bf16_t*)(p.ws + OFF_KB)) + (tokb + (kt + 1) * 64 + skey) * D + h * 64 + spiece * 8);
                vreg = *(const u32x4*)(((bf16_t*)(p.ws + OFF_VB)) + (tokb + (kt + 1) * 64 + vkey) * D + h * 64 + vpiece * 8);
            }
            if (kt >= c - 8 && kt <= c) {
                const bf16_t* kb_ = sK + buf * 4608; const bf16_t* vb_ = sVT + buf * 4608;
                f32x4 sacc[4][2];
#pragma unroll
                for (int kb = 0; kb < 4; ++kb)
#pragma unroll
                    for (int qb = 0; qb < 2; ++qb) sacc[kb][qb] = (f32x4){0.f, 0.f, 0.f, 0.f};
#pragma unroll
                for (int kb = 0; kb < 4; ++kb)
#pragma unroll
                    for (int ks = 0; ks < 2; ++ks) {
                        const bf16x8 kf = *(const bf16x8*)(kb_ + (kb * 16 + fr) * 72 + ks * 32 + fq * 8);
#pragma unroll
                        for (int qb = 0; qb < 2; ++qb) sacc[kb][qb] = __builtin_amdgcn_mfma_f32_16x16x32_bf16(kf, qf[qb][ks], sacc[kb][qb], 0, 0, 0);
                    }
                const int dk = kt - c;
                if (dk <= -5) {
                    const float b0 = sB[0];
#pragma unroll
                    for (int kb = 0; kb < 4; ++kb)
#pragma unroll
                        for (int qb = 0; qb < 2; ++qb)
#pragma unroll
                            for (int j = 0; j < 4; ++j) sacc[kb][qb][j] = sacc[kb][qb][j] * LOG2E + b0;
                } else {
                    const int base = dk * 64 + fq * 4 - half * 32 - fr + 256;
#pragma unroll
                    for (int kb = 0; kb < 4; ++kb)
#pragma unroll
                        for (int qb = 0; qb < 2; ++qb)
#pragma unroll
                            for (int j = 0; j < 4; ++j) { int idx = base + kb * 16 + j - qb * 16; idx = idx < 0 ? 0 : (idx > 319 ? 319 : idx); sacc[kb][qb][j] = sacc[kb][qb][j] * LOG2E + sB[idx]; }
                }
                bf16x8 pf[2][2];
                {
                    float mx[2];
#pragma unroll
                    for (int qb = 0; qb < 2; ++qb) {
                        mx[qb] = sacc[0][qb][0];
#pragma unroll
                        for (int kb = 0; kb < 4; ++kb)
#pragma unroll
                            for (int j = 0; j < 4; ++j) mx[qb] = fmaxf(mx[qb], sacc[kb][qb][j]);
                    }
                    if (__any((mx[0] > mrun[0] + 6.0f) || (mx[1] > mrun[1] + 6.0f))) {
#pragma unroll
                        for (int qb = 0; qb < 2; ++qb) {
                            float m2 = fmaxf(mx[qb], __shfl_xor(mx[qb], 16)); m2 = fmaxf(m2, __shfl_xor(m2, 32));
                            const float mn = fmaxf(mrun[qb], m2), corr = __builtin_amdgcn_exp2f(mrun[qb] - mn);
                            mrun[qb] = mn; lrun[qb] *= corr;
#pragma unroll
                            for (int db = 0; db < 4; ++db) oacc[db][qb] = oacc[db][qb] * corr;
                        }
                    }
                }
#pragma unroll
                for (int qb = 0; qb < 2; ++qb) {
                    const float mn = mrun[qb];
                    float ps = 0.f;
#pragma unroll
                    for (int kb = 0; kb < 4; ++kb)
#pragma unroll
                        for (int j = 0; j < 4; ++j) { const float pv = __builtin_amdgcn_exp2f(sacc[kb][qb][j] - mn); sacc[kb][qb][j] = pv; ps += pv; }
                    lrun[qb] += ps;
#pragma unroll
                    for (int kk = 0; kk < 2; ++kk) {
                        u32x4 pw;
                        pw.x = cvt_pk_bf16(sacc[2 * kk][qb][0], sacc[2 * kk][qb][1]); pw.y = cvt_pk_bf16(sacc[2 * kk][qb][2], sacc[2 * kk][qb][3]);
                        pw.z = cvt_pk_bf16(sacc[2 * kk + 1][qb][0], sacc[2 * kk + 1][qb][1]); pw.w = cvt_pk_bf16(sacc[2 * kk + 1][qb][2], sacc[2 * kk + 1][qb][3]);
                        pf[qb][kk] = __builtin_bit_cast(bf16x8, pw);
                    }
                }
#pragma unroll
                for (int db = 0; db < 4; ++db)
#pragma unroll
                    for (int kk = 0; kk < 2; ++kk) {
                        const u32x2 lo = *(const u32x2*)(vb_ + (db * 16 + fr) * 72 + (2 * kk) * 16 + fq * 4);
                        const u32x2 hi = *(const u32x2*)(vb_ + (db * 16 + fr) * 72 + (2 * kk + 1) * 16 + fq * 4);
                        u32x4 vw; vw.x = lo.x; vw.y = lo.y; vw.z = hi.x; vw.w = hi.y;
                        const bf16x8 vf = __builtin_bit_cast(bf16x8, vw);
#pragma unroll
                        for (int qb = 0; qb < 2; ++qb) oacc[db][qb] = __builtin_amdgcn_mfma_f32_16x16x32_bf16(vf, pf[qb][kk], oacc[db][qb], 0, 0, 0);
                    }
            }
            if (kt < kt1) {
                *(u32x4*)(sK + (buf ^ 1) * 4608 + skey * 72 + spiece * 8) = kreg;
                bf16_t* vt = sVT + (buf ^ 1) * 4608 + (vpiece * 8) * 72 + vkey;
#pragma unroll
                for (int e = 0; e < 8; ++e) vt[e * 72] = (bf16_t)((e & 1) ? (vreg[e >> 1] >> 16) : (vreg[e >> 1] & 0xffffu));
            }
            __syncthreads();
        }
#pragma unroll
        for (int qb = 0; qb < 2; ++qb) {
            float lt = lrun[qb]; lt += __shfl_xor(lt, 16); lt += __shfl_xor(lt, 32);
            const float inv = 1.0f / lt;
            bf16_t* op = ((bf16_t*)(p.ws + OFF_U)) + (tokb + c * 64 + half * 32 + qb * 16 + fr) * D + h * 64 + fq * 4;
#pragma unroll
            for (int db = 0; db < 4; ++db) {
                u32x2 ow; ow.x = cvt_pk_bf16(oacc[db][qb][0] * inv, oacc[db][qb][1] * inv); ow.y = cvt_pk_bf16(oacc[db][qb][2] * inv, oacc[db][qb][3] * inv);
                *(u32x2*)(op + db * 16) = ow;
            }
        }
    }
    __syncthreads();
}

#ifndef REP_ATTN
#define REP_ATTN 1
#endif
#ifndef REP_REC
#define REP_REC 1
#endif
#ifndef REP_NORM
#define REP_NORM 1
#endif
#ifndef REP_SYNC
#define REP_SYNC 1
#endif
#ifndef REP_PREP
#define REP_PREP 1
#endif
#ifndef REP_G3
#define REP_G3 1
#endif
#define GSYNC() do { for (int r_ = 0; r_ < REP_SYNC; ++r_) xcd_barrier(xb); } while (0)
__global__ void __launch_bounds__(512, 2) yoco_fwd(Params p) {
    extern __shared__ __attribute__((aligned(16))) unsigned char shm[];
    cg::grid_group grid = cg::this_grid();
    unsigned* barw = (unsigned*)(p.ws + OFF_BAR);
    for (int i = blockIdx.x * 512 + threadIdx.x; i < XCD_BAR_WORDS; i += gridDim.x * 512) barw[i] = 0u;
    volatile LAS unsigned* xst = (volatile LAS unsigned*)(LAS unsigned char*)(shm + LDS_BYTES - 16);
    if (threadIdx.x == 0) { xst[0] = 0u; xst[1] = 0u; }
    for (int r = 0; r < REP_PREP; ++r) prep_phase(p, shm);
    grid.sync();
    XcdBarrier xb = xcd_barrier_post(barw, xst);
    for (int l = 0; l < 4; ++l) {
        const float* hsrc = (l == 0) ? p.in[0] : p.h;
        const float* mv = ((float*)(p.ws + OFF_MODV)) + (size_t)l * 8 * 6144;
        for (int r = 0; r < REP_NORM; ++r) {
            if (l == 2) norm_phase(hsrc, ((bf16_t*)(p.ws + OFF_U)), p.in[4] + l * D, mv, mv + D, 6144, ((bf16_t*)(p.ws + OFF_U2)), p.in[12], ((float*)(p.ws + OFF_KVMOD)), ((float*)(p.ws + OFF_KVMOD)) + D, 2048);
            else norm_phase(hsrc, ((bf16_t*)(p.ws + OFF_U)), p.in[4] + l * D, mv, mv + D, 6144, nullptr, nullptr, nullptr, nullptr, 0);
        }
        GSYNC();
        if (l < 2) {
            pg8::EpiHgrnIn e; e.QVG = ((bf16_t*)(p.ws + OFF_QH)); e.LF = ((float*)(p.ws + OFF_LF)); e.lb = ((float*)(p.ws + OFF_LBV)) + l * D;
            run_gemm(shm, ((bf16_t*)(p.ws + OFF_U)), ((bf16_t*)(p.ws + OFF_WB_A_IN)) + (size_t)l * AIN * D, AIN, D, e);
            GSYNC();
            for (int r = 0; r < REP_REC; ++r) rec_pass<false>(p, l, shm);
            GSYNC();
            for (int r = 0; r < REP_REC; ++r) rec_pass<true>(p, l, shm);
        } else {
            if (l == 2) { pg8::EpiBf16Split e; e.d0 = ((bf16_t*)(p.ws + OFF_KB)); e.scale = 1.0f; run_gemm(shm, ((bf16_t*)(p.ws + OFF_U2)), ((bf16_t*)(p.ws + OFF_WB_KV)), 2048, D, e); }
            { pg8::EpiBf16Split e; e.d0 = ((bf16_t*)(p.ws + OFF_QB)); e.scale = 0.125f; run_gemm(shm, ((bf16_t*)(p.ws + OFF_U)), ((bf16_t*)(p.ws + OFF_WB_Q)) + (size_t)(l - 2) * D * D, D, D, e); }
            GSYNC();
            for (int r = 0; r < REP_ATTN; ++r) attn_phase(p, l - 2, shm);
        }
        GSYNC();
        {
            pg8::EpiResid e; e.src = hsrc; e.dst = p.h; e.gate = mv + 2 * D;
            run_gemm(shm, ((bf16_t*)(p.ws + OFF_U)), (l < 2) ? ((bf16_t*)(p.ws + OFF_WB_A_OUT)) + (size_t)l * D * D : ((bf16_t*)(p.ws + OFF_WB_O)) + (size_t)(l - 2) * D * D, D, D, e);
        }
        GSYNC();
        for (int r = 0; r < REP_NORM; ++r) norm_phase(p.h, ((bf16_t*)(p.ws + OFF_U)), p.in[5] + l * D, mv + 3 * D, mv + 4 * D, 6144, nullptr, nullptr, nullptr, nullptr, 0);
        GSYNC();
        for (int r = 0; r < REP_G3; ++r) { pg8::EpiSwiglu e; e.act = ((bf16_t*)(p.ws + OFF_ACT)); run_gemm(shm, ((bf16_t*)(p.ws + OFF_U)), ((bf16_t*)(p.ws + OFF_WB_FFN_IN)) + (size_t)l * 2 * FFN * D, 2 * FFN, D, e); }
        GSYNC();
        { pg8::EpiResid e; e.src = p.h; e.dst = p.h; e.gate = mv + 5 * D; run_gemm(shm, ((bf16_t*)(p.ws + OFF_ACT)), ((bf16_t*)(p.ws + OFF_WB_FFN_OUT)) + (size_t)l * D * FFN, D, FFN, e); }
        GSYNC();
    }
    final_norm_phase(p.h, p.in[19]);
}

extern "C" void kernel_launch(void* const* d_in, const int* in_sizes, int n_in, void* d_out, int out_size, void* d_ws, size_t ws_size, hipStream_t stream) {
    static int grid_blocks = 0;
    if (!grid_blocks) {
        int dev = 0, cus = 0, per_cu = 0;
        hipGetDevice(&dev);
        hipDeviceGetAttribute(&cus, hipDeviceAttributeMultiprocessorCount, dev);
        hipFuncSetAttribute((const void*)yoco_fwd, hipFuncAttributeMaxDynamicSharedMemorySize, LDS_BYTES);
        hipOccupancyMaxActiveBlocksPerMultiprocessor(&per_cu, (const void*)yoco_fwd, 512, LDS_BYTES);
        if (per_cu < 1) per_cu = 1;
        grid_blocks = cus * per_cu;
        (void)hipGetLastError();
    }
    Params p{};
    for (int i = 0; i < 20; ++i) p.in[i] = (const float*)d_in[i];
    p.h = (float*)d_out; p.ws = (unsigned char*)d_ws;
    if (ws_size < WS_END || n_in != 20) { fprintf(stderr, "kernel_launch: workspace too small (%zu < %zu) or unexpected inputs\n", ws_size, (size_t)WS_END); return; }
    void* args[] = {&p};
    hipError_t e = hipLaunchCooperativeKernel((const void*)yoco_fwd, dim3(grid_blocks), dim3(512), args, LDS_BYTES, stream);
    if (e != hipSuccess) fprintf(stderr, "cooperative launch failed: %s (grid %d)\n", hipGetErrorString(e), grid_blocks);
}
```

```cpp
#include <hip/hip_runtime.h>
#include <hip/hip_cooperative_groups.h>
#include <cstdio>
namespace cg = cooperative_groups;

#define LAS __attribute__((address_space(3)))
typedef unsigned short bf16_t;
typedef short bf16x8 __attribute__((ext_vector_type(8)));
typedef float f32x4 __attribute__((ext_vector_type(4)));
typedef unsigned u32x4 __attribute__((ext_vector_type(4)));
typedef unsigned u32x2 __attribute__((ext_vector_type(2)));

constexpr int D = 1024, BATCH = 8, SEQ = 8192, MTOK = BATCH * SEQ, FFN = 2816, AIN = 4096;
constexpr int LDS_BYTES = 144 * 1024;
constexpr int XCD_BAR_WORDS_C = 3456;

__device__ __forceinline__ unsigned cvt_pk_bf16(float lo, float hi) { unsigned r; asm volatile("v_cvt_pk_bf16_f32 %0, %1, %2" : "=v"(r) : "v"(lo), "v"(hi)); return r; }
__device__ __forceinline__ float bf2f(unsigned short h) { return __uint_as_float((unsigned)h << 16); }
__device__ __forceinline__ float bflo(unsigned w) { return __uint_as_float(w << 16); }
__device__ __forceinline__ float bfhi(unsigned w) { return __uint_as_float(w & 0xffff0000u); }
__device__ __forceinline__ float silu_f(float x) { return x * __builtin_amdgcn_rcpf(1.0f + __expf(-x)); }

__device__ __forceinline__ int opaque_tid() { int t = threadIdx.x; asm volatile("" : "+v"(t)); return t; }
struct Params { const float* in[20]; float* h; unsigned char* ws; };
constexpr size_t ACTB = (size_t)MTOK * D * 2;
constexpr size_t OFF_WB_A_IN = 0;
constexpr size_t OFF_WB_A_OUT = OFF_WB_A_IN + (size_t)2 * AIN * D * 2;
constexpr size_t OFF_WB_FFN_IN = OFF_WB_A_OUT + (size_t)2 * D * D * 2;
constexpr size_t OFF_WB_FFN_OUT = OFF_WB_FFN_IN + (size_t)4 * 2 * FFN * D * 2;
constexpr size_t OFF_WB_KV = OFF_WB_FFN_OUT + (size_t)4 * D * FFN * 2;
constexpr size_t OFF_WB_Q = OFF_WB_KV + (size_t)2 * D * D * 2;
constexpr size_t OFF_WB_O = OFF_WB_Q + (size_t)2 * D * D * 2;
constexpr size_t OFF_MODV = OFF_WB_O + (size_t)2 * D * D * 2;
constexpr size_t OFF_KVMOD = OFF_MODV + (size_t)4 * 8 * 6144 * 4;
constexpr size_t OFF_LBV = OFF_KVMOD + (size_t)8 * 2048 * 4;
constexpr size_t OFF_U = OFF_LBV + (size_t)2 * D * 4;
constexpr size_t OFF_R = OFF_U + ACTB;
constexpr size_t OFF_QH = OFF_R, OFF_VH = OFF_R + ACTB, OFF_GH = OFF_R + 2 * ACTB, OFF_LF = OFF_R + 3 * ACTB;
constexpr size_t OFF_ACT = OFF_R;
constexpr size_t OFF_U2 = OFF_R;
constexpr size_t OFF_KB = OFF_R + (size_t)MTOK * FFN * 2, OFF_VB = OFF_KB + ACTB, OFF_QB = OFF_VB + ACTB;
constexpr size_t OFF_SLOC = OFF_R + 5 * ACTB, OFF_DLOG = OFF_SLOC + (size_t)256 * 16384 * 4;
constexpr size_t OFF_BAR = OFF_QB + ACTB;
constexpr size_t WS_END = OFF_BAR + (size_t)XCD_BAR_WORDS_C * 4;


#define XB_TMO      128
#define XB_XCNT(j)  (256  + 64 * (j))
#define XB_XSUB(j)  (1280 + 64 * (j))
#define XB_XGEN(j)  (2304 + 64 * (j))
#define XB_TOP      3328
#define XB_TOPGEN   3392
#define XCD_BAR_WORDS 3456
#define XB_SPIN_CAP (1u << 18)
__device__ __forceinline__ unsigned xb_ld(unsigned* p)              { return __hip_atomic_load(p, __ATOMIC_RELAXED, __HIP_MEMORY_SCOPE_AGENT); }
__device__ __forceinline__ unsigned xb_add(unsigned* p, unsigned v) { return __hip_atomic_fetch_add(p, v, __ATOMIC_RELAXED, __HIP_MEMORY_SCOPE_AGENT); }
__device__ __forceinline__ unsigned xb_xcc_id() { return (unsigned)__builtin_amdgcn_s_getreg((3 << 11) | 20) & 0xFu; }
#define XB_SPIN(cond, bar) do { unsigned _sp = 0; while (cond) { __builtin_amdgcn_s_sleep(1); \
    if ((++_sp & 255u) == 0u) { if (xb_ld(&(bar)[XB_TMO])) break; if (_sp > XB_SPIN_CAP) { atomicAdd(&(bar)[XB_TMO], 1u); break; } } } } while (0)
struct XcdBarrier { unsigned* bar; unsigned x; volatile LAS unsigned* st; };
__device__ __forceinline__ XcdBarrier xcd_barrier_post(unsigned* bar, volatile LAS unsigned* st) {
    XcdBarrier b; b.bar = bar; b.x = xb_xcc_id(); b.st = st;
    if (threadIdx.x == 0) (void)xb_add(&bar[XB_XCNT(b.x)], 1u);
    return b;
}
__device__ __forceinline__ void xcd_barrier_complete(unsigned* bar, unsigned x, unsigned& nloc, unsigned& nx) {
    const unsigned G = gridDim.x * gridDim.y * gridDim.z;
    unsigned sum, cnt, mine, sp = 0u;
    for (;;) {
        sum = 0u; cnt = 0u; mine = 0u;
#pragma unroll
        for (unsigned j = 0; j < 16; ++j) { const unsigned c = xb_ld(&bar[XB_XCNT(j)]); sum += c; cnt += (c > 0u) ? 1u : 0u; mine = (j == x) ? c : mine; }
        if (sum == G) break;
        __builtin_amdgcn_s_sleep(1);
        if ((++sp & 255u) == 0u) { if (xb_ld(&bar[XB_TMO])) break; if (sp > XB_SPIN_CAP) { atomicAdd(&bar[XB_TMO], 1u); break; } }
    }
    nloc = mine > 0u ? mine : 1u; nx = cnt > 0u ? cnt : 1u;
}
__device__ __forceinline__ void xcd_barrier(const XcdBarrier& b) {
    asm volatile("s_waitcnt vmcnt(0)" ::: "memory");
    __syncthreads();
    if (threadIdx.x == 0) {
        unsigned* bar = b.bar;
        __builtin_amdgcn_s_waitcnt(0);
        unsigned nloc = b.st[0], nx = b.st[1];
        if (nloc == 0u) { xcd_barrier_complete(bar, b.x, nloc, nx); b.st[0] = nloc; b.st[1] = nx; }
        const unsigned old = xb_add(&bar[XB_XSUB(b.x)], 1u);
        const unsigned gen = old / nloc;
        if (old + 1u == (gen + 1u) * nloc) {
            __builtin_amdgcn_fence(__ATOMIC_RELEASE, "agent");
            asm volatile("s_waitcnt vmcnt(0)" ::: "memory");
            const unsigned og = xb_add(&bar[XB_TOP], 1u);
            const unsigned tg = og / nx;
            if (og + 1u == (tg + 1u) * nx) xb_add(&bar[XB_TOPGEN], 1u);
            else XB_SPIN(xb_ld(&bar[XB_TOPGEN]) == tg, bar);
            __builtin_amdgcn_fence(__ATOMIC_ACQUIRE, "agent");
            xb_add(&bar[XB_XGEN(b.x)], 1u);
            asm volatile("s_waitcnt vmcnt(0)" ::: "memory");
        } else {
            XB_SPIN(xb_ld(&bar[XB_XGEN(b.x)]) == gen, bar);
            __builtin_amdgcn_fence(__ATOMIC_ACQUIRE, "agent");
            asm volatile("s_waitcnt vmcnt(0)" ::: "memory");
        }
    }
    __syncthreads();
}

namespace pg8 {
constexpr int BM = 256, BK = 64, HALF = 128, HTB = HALF * BK * 2, STAGE_BYTES = 8 * HTB, NXCD = 8, WGM = 8;
__device__ __forceinline__ int lds_byte(int r, int c) { const int st = (r >> 4) * 2 + (c >> 5), rr = r & 15, cc = c & 31, ob = rr * 64 + cc * 2; return st * 1024 + (ob ^ (((ob >> 9) & 1) << 5)); }
__device__ __forceinline__ void stage_rc(int b, int& R, int& C) { const int st = b / 1024, sb = b % 1024, swz = sb ^ (((sb >> 9) & 1) << 5); R = (st >> 1) * 16 + swz / 64; C = (st & 1) * 32 + (swz % 64) / 2; }
__device__ __forceinline__ int perm32(int rho) { const int n = rho >> 4, i = rho & 15; return 8 * (i >> 2) + 4 * n + (i & 3); }
struct Unit { int pm, pn; };
struct Gemm { const bf16_t* A; const bf16_t* Bt; int M, N, K; };
struct StaticOrder {
    int nM, nN, nwg, G, c;
    __device__ void init(int M, int N, int G_, int c_) { nM = M / BM; nN = N / BM; nwg = nM * nN; G = G_; c = c_; }
    __device__ bool next(int i, Unit& u) const {
        const long L = (long)i * G + c; if (L >= nwg) return false;
        int wgid = (int)L; { const int q = nwg / NXCD, r = nwg % NXCD, xcd = wgid % NXCD, off = wgid / NXCD; wgid = (xcd < r ? xcd * (q + 1) : r * (q + 1) + (xcd - r) * q) + off; }
        const int nig = WGM * nN, gid = wgid / nig, fm = gid * WGM, gsz = (nM - fm) < WGM ? (nM - fm) : WGM;
        u.pm = fm + ((wgid % nig) % gsz); u.pn = (wgid % nig) / gsz; return true;
    }
};

template <class Epi>
__device__ __forceinline__ void gemm_phase(LAS unsigned char* lds, const Gemm g, const StaticOrder& S, const Epi& E) {
    const int tid = opaque_tid(), wid = __builtin_amdgcn_readfirstlane(tid >> 6), lane = tid & 63, wr = wid >> 2, wc = wid & 3, fr = lane & 15, fq = lane >> 4;
    const int K = g.K, nt = K / BK;
    unsigned voffA[2], voffB[2];
#pragma unroll
    for (int i = 0; i < 2; ++i) { int R, C; stage_rc(tid * 16 + i * 8192, R, C); const int Rb = Epi::PERM ? ((R & ~31) + perm32(R & 31)) : R;
        voffA[i] = (unsigned)(R * K + C) * 2u; voffB[i] = (unsigned)(Rb * K + C) * 2u; }
    const size_t kstep = (size_t)(BK * 2);
    const size_t hstep = (size_t)HALF * K * 2;
    const size_t tstep = 2 * hstep;
    const unsigned ldsw = (unsigned)wid * 1024u;
    const int aoff = lds_byte(wr * 64 + fr, fq * 8), boff = lds_byte(wc * 32 + fr, fq * 8);
#define PG8_SA(b, h) (((b) * 2 + (h)) * HTB)
#define PG8_SB(b, h) ((4 + (b) * 2 + (h)) * HTB)
#define PG8_STAGE(bufoff, gbase, voff) do { _Pragma("unroll") for (int _i = 0; _i < 2; ++_i) \
        __builtin_amdgcn_global_load_lds((const unsigned*)((const char*)(gbase) + (voff)[_i]), (LAS unsigned*)(lds + (bufoff) + ldsw + _i * 8192), 16, 0, 0); } while (0)
#define PG8_LDA(dst, b, h) do { _Pragma("unroll") for (int m = 0; m < 4; ++m) _Pragma("unroll") for (int k = 0; k < 2; ++k) dst[m][k] = *(const LAS bf16x8*)(lds + PG8_SA(b, h) + aoff + m * 2048 + k * 1024); } while (0)
#define PG8_LDB(dst, b, h) do { _Pragma("unroll") for (int n = 0; n < 2; ++n) _Pragma("unroll") for (int k = 0; k < 2; ++k) dst[n][k] = *(const LAS bf16x8*)(lds + PG8_SB(b, h) + boff + n * 2048 + k * 1024); } while (0)
#define PG8_MMA(ai, bj, At, Bt) do { __builtin_amdgcn_s_setprio(1); _Pragma("unroll") for (int m = 0; m < 4; ++m) _Pragma("unroll") for (int n = 0; n < 2; ++n) _Pragma("unroll") for (int k = 0; k < 2; ++k) \
        acc[ai][bj][m][n] = __builtin_amdgcn_mfma_f32_16x16x32_bf16(Bt[n][k], At[m][k], acc[ai][bj][m][n], 0, 0, 0); __builtin_amdgcn_s_setprio(0); } while (0)
#define PG8_WAIT_V(n) asm volatile("s_waitcnt vmcnt(" #n ")" ::: "memory")
#define PG8_WAIT_L(n) asm volatile("s_waitcnt lgkmcnt(" #n ")" ::: "memory")
#define PG8_BAR __builtin_amdgcn_s_barrier()
#define PG8_SCHED __builtin_amdgcn_sched_barrier(0)
    Unit cur, nxt; int ui = 0;
    if (!S.next(0, cur)) return;
    f32x4 acc[2][2][4][2];
#pragma unroll
    for (int a = 0; a < 2; ++a)
#pragma unroll
        for (int b = 0; b < 2; ++b)
#pragma unroll
            for (int m = 0; m < 4; ++m)
#pragma unroll
                for (int n = 0; n < 2; ++n) acc[a][b][m][n] = (f32x4){0.f, 0.f, 0.f, 0.f};
    bf16x8 At[4][2], B0[2][2], B1[2][2];
    const char* cA = (const char*)g.A + (size_t)cur.pm * tstep; const char* cB = (const char*)g.Bt + (size_t)cur.pn * tstep;
    PG8_STAGE(PG8_SB(0, 0), cB, voffB); PG8_STAGE(PG8_SA(0, 0), cA, voffA); PG8_STAGE(PG8_SB(0, 1), cB + hstep, voffB); PG8_STAGE(PG8_SA(0, 1), cA + hstep, voffA);
    if (wr == 1) PG8_BAR;
    PG8_WAIT_V(4); PG8_BAR;
    PG8_STAGE(PG8_SB(1, 0), cB + kstep, voffB); PG8_STAGE(PG8_SA(1, 0), cA + kstep, voffA); PG8_STAGE(PG8_SB(1, 1), cB + hstep + kstep, voffB);
    PG8_WAIT_V(6); PG8_BAR;
    for (;;) {
        const bool has_next = S.next(ui + 1, nxt);
        const char* nA = has_next ? (const char*)g.A + (size_t)nxt.pm * tstep : cA; const char* nB = has_next ? (const char*)g.Bt + (size_t)nxt.pn * tstep : cB;
        for (int t = 0; t < nt; t += 2) {
            const bool last = (t == nt - 2);
            const char* a1 = cA + (size_t)(t + 1) * kstep;
            const char* a2 = last ? nA : cA + (size_t)(t + 2) * kstep; const char* b2 = last ? nB : cB + (size_t)(t + 2) * kstep;
            const char* a3 = a2 + kstep; const char* b3 = b2 + kstep;
            PG8_LDB(B0, 0, 0); PG8_SCHED; PG8_LDA(At, 0, 0); PG8_STAGE(PG8_SA(1, 1), a1 + hstep, voffA);
            PG8_WAIT_L(8); PG8_BAR; PG8_WAIT_L(0); PG8_MMA(0, 0, At, B0); PG8_BAR; PG8_SCHED;
            PG8_LDB(B1, 0, 1); PG8_STAGE(PG8_SB(0, 0), b2, voffB);
            PG8_BAR; PG8_WAIT_L(0); PG8_MMA(0, 1, At, B1); PG8_BAR;
            PG8_LDA(At, 0, 1); PG8_STAGE(PG8_SA(0, 0), a2, voffA);
            PG8_BAR; PG8_WAIT_L(0); PG8_MMA(1, 0, At, B0); PG8_BAR; PG8_SCHED;
            PG8_STAGE(PG8_SB(0, 1), b2 + hstep, voffB);
            PG8_WAIT_V(6); PG8_BAR; PG8_MMA(1, 1, At, B1); PG8_BAR;
            PG8_LDB(B0, 1, 0); PG8_SCHED; PG8_LDA(At, 1, 0); PG8_STAGE(PG8_SA(0, 1), a2 + hstep, voffA);
            PG8_WAIT_L(8); PG8_BAR; PG8_WAIT_L(0); PG8_MMA(0, 0, At, B0); PG8_BAR; PG8_SCHED;
            PG8_LDB(B1, 1, 1); PG8_STAGE(PG8_SB(1, 0), b3, voffB);
            PG8_BAR; PG8_WAIT_L(0); PG8_MMA(0, 1, At, B1); PG8_BAR;
            PG8_LDA(At, 1, 1); PG8_STAGE(PG8_SA(1, 0), a3, voffA);
            PG8_BAR; PG8_WAIT_L(0); PG8_MMA(1, 0, At, B0); PG8_BAR; PG8_SCHED;
            PG8_STAGE(PG8_SB(1, 1), b3 + hstep, voffB);
            PG8_WAIT_V(6); PG8_BAR; PG8_MMA(1, 1, At, B1); PG8_BAR;
        }
        E(acc, cur, wr, wc, fr, fq);
        if (!has_next) break;
#pragma unroll
        for (int a = 0; a < 2; ++a)
#pragma unroll
            for (int b = 0; b < 2; ++b)
#pragma unroll
                for (int m = 0; m < 4; ++m)
#pragma unroll
                    for (int n = 0; n < 2; ++n) acc[a][b][m][n] = (f32x4){0.f, 0.f, 0.f, 0.f};
        cur = nxt; cA = nA; cB = nB; ++ui;
    }
    PG8_WAIT_V(0);
    if (wr == 0) PG8_BAR;
    PG8_BAR;
#undef PG8_SA
#undef PG8_SB
#undef PG8_STAGE
#undef PG8_LDA
#undef PG8_LDB
#undef PG8_MMA
#undef PG8_WAIT_V
#undef PG8_WAIT_L
#undef PG8_BAR
#undef PG8_SCHED
}

struct EpiHgrnIn {
    static constexpr bool PERM = true;
    bf16_t* QVG; float* LF; const float* lb;
    __device__ __forceinline__ void operator()(const f32x4 (&acc)[2][2][4][2], const Unit& u, int wr, int wc, int fr, int fq) const {
        const int seg = u.pn >> 2, colt = (u.pn & 3) * 256;
        const int row0 = u.pm * BM + wr * 64 + fr, col0 = colt + wc * 32 + 8 * fq;
        if (seg == 1) {
#pragma unroll
            for (int bj = 0; bj < 2; ++bj) {
                const f32x4 l0 = *(const f32x4*)(lb + col0 + bj * HALF), l1 = *(const f32x4*)(lb + col0 + bj * HALF + 4);
#pragma unroll
                for (int ai = 0; ai < 2; ++ai)
#pragma unroll
                    for (int m = 0; m < 4; ++m) {
                        float* rowp = LF + (size_t)(row0 + ai * HALF + m * 16) * D + col0 + bj * HALF;
                        f32x4 o0, o1;
#pragma unroll
                        for (int j = 0; j < 4; ++j) {
                            float z = acc[ai][bj][m][0][j]; float sg = __builtin_amdgcn_rcpf(1.0f + __expf(-z)); float f = l0[j] + (1.0f - l0[j]) * sg; o0[j] = logf(fmaxf(f, 1e-30f));
                            z = acc[ai][bj][m][1][j]; sg = __builtin_amdgcn_rcpf(1.0f + __expf(-z)); f = l1[j] + (1.0f - l1[j]) * sg; o1[j] = logf(fmaxf(f, 1e-30f));
                        }
                        *(f32x4*)rowp = o0; *(f32x4*)(rowp + 4) = o1;
                    }
            }
        } else {
            bf16_t* base = QVG + (size_t)(seg == 0 ? 0 : (seg == 2 ? 1 : 2)) * ((size_t)MTOK * D);
            const bool act = (seg != 2);
#pragma unroll
            for (int ai = 0; ai < 2; ++ai)
#pragma unroll
                for (int m = 0; m < 4; ++m)
#pragma unroll
                    for (int bj = 0; bj < 2; ++bj) {
                        f32x4 v0 = acc[ai][bj][m][0], v1 = acc[ai][bj][m][1];
                        if (act) {
#pragma unroll
                            for (int j = 0; j < 4; ++j) { v0[j] = silu_f(v0[j]); v1[j] = silu_f(v1[j]); }
                        }
                        u32x4 w; w.x = cvt_pk_bf16(v0[0], v0[1]); w.y = cvt_pk_bf16(v0[2], v0[3]); w.z = cvt_pk_bf16(v1[0], v1[1]); w.w = cvt_pk_bf16(v1[2], v1[3]);
                        *(u32x4*)(base + (size_t)(row0 + ai * HALF + m * 16) * D + col0 + bj * HALF) = w;
                    }
        }
    }
};
struct EpiResid {
    static constexpr bool PERM = true;
    const float* src; float* dst; const float* gate;
    __device__ __forceinline__ void operator()(const f32x4 (&acc)[2][2][4][2], const Unit& u, int wr, int wc, int fr, int fq) const {
        const int b = u.pm >> 5;
        const float* gp = gate + (size_t)b * 6144;
        const int row0 = u.pm * BM + wr * 64 + fr, col0 = u.pn * BM + wc * 32 + 8 * fq;
        f32x4 gv[2][2];
#pragma unroll
        for (int bj = 0; bj < 2; ++bj)
#pragma unroll
            for (int n = 0; n < 2; ++n) gv[bj][n] = *(const f32x4*)(gp + col0 + bj * HALF + 4 * n);
#pragma unroll
        for (int ai = 0; ai < 2; ++ai)
#pragma unroll
            for (int m = 0; m < 4; ++m) {
                const size_t ro = (size_t)(row0 + ai * HALF + m * 16) * D + col0;
#pragma unroll
                for (int bj = 0; bj < 2; ++bj)
#pragma unroll
                    for (int n = 0; n < 2; ++n) {
                        const f32x4 s = *(const f32x4*)(src + ro + bj * HALF + 4 * n);
                        *(f32x4*)(dst + ro + bj * HALF + 4 * n) = s + gv[bj][n] * acc[ai][bj][m][n];
                    }
            }
    }
};
struct EpiSwiglu {
    static constexpr bool PERM = true;
    bf16_t* act;
    __device__ __forceinline__ void operator()(const f32x4 (&acc)[2][2][4][2], const Unit& u, int wr, int wc, int fr, int fq) const {
        const int row0 = u.pm * BM + wr * 64 + fr, col0 = u.pn * HALF + wc * 32 + 8 * fq;
#pragma unroll
        for (int ai = 0; ai < 2; ++ai)
#pragma unroll
            for (int m = 0; m < 4; ++m) {
                f32x4 r0, r1;
#pragma unroll
                for (int j = 0; j < 4; ++j) { r0[j] = silu_f(acc[ai][0][m][0][j]) * acc[ai][1][m][0][j]; r1[j] = silu_f(acc[ai][0][m][1][j]) * acc[ai][1][m][1][j]; }
                u32x4 w; w.x = cvt_pk_bf16(r0[0], r0[1]); w.y = cvt_pk_bf16(r0[2], r0[3]); w.z = cvt_pk_bf16(r1[0], r1[1]); w.w = cvt_pk_bf16(r1[2], r1[3]);
                *(u32x4*)(act + (size_t)(row0 + ai * HALF + m * 16) * FFN + col0) = w;
            }
    }
};
struct EpiBf16Split {
    static constexpr bool PERM = true;
    bf16_t* d0; float scale;
    __device__ __forceinline__ void operator()(const f32x4 (&acc)[2][2][4][2], const Unit& u, int wr, int wc, int fr, int fq) const {
        bf16_t* base = d0 + (size_t)(u.pn >> 2) * ((size_t)MTOK * D);
        const int row0 = u.pm * BM + wr * 64 + fr, col0 = (u.pn & 3) * 256 + wc * 32 + 8 * fq;
#pragma unroll
        for (int ai = 0; ai < 2; ++ai)
#pragma unroll
            for (int m = 0; m < 4; ++m)
#pragma unroll
                for (int bj = 0; bj < 2; ++bj) {
                    const f32x4 v0 = acc[ai][bj][m][0] * scale, v1 = acc[ai][bj][m][1] * scale;
                    u32x4 w; w.x = cvt_pk_bf16(v0[0], v0[1]); w.y = cvt_pk_bf16(v0[2], v0[3]); w.z = cvt_pk_bf16(v1[0], v1[1]); w.w = cvt_pk_bf16(v1[2], v1[3]);
                    *(u32x4*)(base + (size_t)(row0 + ai * HALF + m * 16) * D + col0 + bj * HALF) = w;
                }
    }
};
}

template <class Epi>
__device__ __forceinline__ void run_gemm(unsigned char* shm, const bf16_t* A, const bf16_t* Bt, int N, int K, const Epi& E) {
    pg8::Gemm g; g.A = A; g.Bt = Bt; g.M = MTOK; g.N = N; g.K = K;
    pg8::StaticOrder S; S.init(MTOK, N, (int)gridDim.x, (int)blockIdx.x);
    pg8::gemm_phase<Epi>((LAS unsigned char*)shm, g, S, E);
    __syncthreads();
}

__device__ __forceinline__ int ffnmap(int nn) { return nn < FFN ? ((nn >> 7) * 256 + (nn & 127)) : (((nn - FFN) >> 7) * 256 + 128 + ((nn - FFN) & 127)); }

__device__ __forceinline__ void conv_group(const float* src0, bf16_t* dst0, const int K, const int N, const int L, const int mode, unsigned char* shm, const int tid) {
    float* st = (float*)shm;
    const int per = (K / 128) * (N / 64), total = L * per, ntn = N / 64;
    for (int tile = blockIdx.x; tile < total; tile += gridDim.x) {
        const int l = tile / per, tt = tile % per, k0 = (tt / ntn) * 128, n0 = (tt % ntn) * 64;
        const float* src = src0 + (size_t)l * K * N; bf16_t* dst = dst0 + (size_t)l * K * N;
        f32x4 v[4];
#pragma unroll
        for (int it = 0; it < 4; ++it) { const int idx = tid + it * 512, k = idx >> 4, n4 = idx & 15; v[it] = *(const f32x4*)(src + (size_t)(k0 + k) * N + n0 + 4 * n4); }
        __syncthreads();
#pragma unroll
        for (int it = 0; it < 4; ++it) { const int idx = tid + it * 512, k = idx >> 4, n4 = idx & 15;
#pragma unroll
            for (int e = 0; e < 4; ++e) st[k * 65 + 4 * n4 + e] = v[it][e]; }
        __syncthreads();
#pragma unroll
        for (int it = 0; it < 2; ++it) { const int idx = tid + it * 512, n = idx >> 4, kg = idx & 15; const int nn = n0 + n; const int drow = mode ? ffnmap(nn) : nn;
            u32x4 w;
#pragma unroll
            for (int e = 0; e < 4; ++e) w[e] = cvt_pk_bf16(st[(8 * kg + 2 * e) * 65 + n], st[(8 * kg + 2 * e + 1) * 65 + n]);
            *(u32x4*)(dst + (size_t)drow * K + k0 + 8 * kg) = w; }
    }
}

__device__ void prep_phase(const Params& p, unsigned char* shm) {
    const int tid = opaque_tid();
    {
        float* cact = (float*)shm;
        float* red = cact + 8192;
        bool loaded = false;
        const int wv = tid >> 6, lane = tid & 63;
        for (int task = blockIdx.x; task < 416; task += gridDim.x) {
            if (!loaded) {
                for (int i = tid; i < 8192; i += 512) { const int k = i >> 3, b = i & 7; cact[i] = silu_f(p.in[1][b * D + k]); }
                loaded = true;
            }
            __syncthreads();
            const int c0 = task * 64;
            const float* src; const float* bias; float* dst; int stride, dstride;
            if (c0 < 24576) { const int l = c0 / 6144, j = c0 % 6144; src = p.in[2] + (size_t)l * D * 6144 + j; stride = 6144; bias = p.in[3] + l * 6144 + j; dst = ((float*)(p.ws + OFF_MODV)) + (size_t)l * 8 * 6144 + j; dstride = 6144; }
            else { const int j = c0 - 24576; src = p.in[13] + j; stride = 2048; bias = p.in[14] + j; dst = ((float*)(p.ws + OFF_KVMOD)) + j; dstride = 2048; }
            float a[8];
#pragma unroll
            for (int b = 0; b < 8; ++b) a[b] = 0.f;
            const float* sp = src + (size_t)(wv * 128) * stride + lane;
#pragma unroll 8
            for (int k = 0; k < 128; ++k) {
                const float w = sp[(size_t)k * stride];
                const f32x4 c0v = *(const f32x4*)(cact + (wv * 128 + k) * 8), c1v = *(const f32x4*)(cact + (wv * 128 + k) * 8 + 4);
                a[0] += w * c0v[0]; a[1] += w * c0v[1]; a[2] += w * c0v[2]; a[3] += w * c0v[3];
                a[4] += w * c1v[0]; a[5] += w * c1v[1]; a[6] += w * c1v[2]; a[7] += w * c1v[3];
            }
#pragma unroll
            for (int b = 0; b < 8; ++b) red[(wv * 8 + b) * 64 + lane] = a[b];
            __syncthreads();
            {
                const int b = tid >> 6, col = tid & 63;
                float s = bias[col];
#pragma unroll
                for (int w = 0; w < 8; ++w) s += red[(w * 8 + b) * 64 + col];
                dst[(size_t)b * dstride + col] = s;
            }
        }
        __syncthreads();
    }
    for (int i = blockIdx.x * 512 + tid; i < 1024; i += gridDim.x * 512) {
        const float a0 = p.in[10][i], a1 = p.in[10][1024 + i];
        const float mx = fmaxf(a0, a1), e0 = __expf(a0 - mx), e1 = __expf(a1 - mx);
        ((float*)(p.ws + OFF_LBV))[i] = 0.f; ((float*)(p.ws + OFF_LBV))[1024 + i] = e1 / (e0 + e1);
    }
    conv_group(p.in[8], (bf16_t*)(p.ws + OFF_WB_A_IN), D, AIN, 2, 0, shm, tid);
    conv_group(p.in[9], (bf16_t*)(p.ws + OFF_WB_A_OUT), D, D, 2, 0, shm, tid);
    conv_group(p.in[6], (bf16_t*)(p.ws + OFF_WB_FFN_IN), D, 2 * FFN, 4, 1, shm, tid);
    conv_group(p.in[7], (bf16_t*)(p.ws + OFF_WB_FFN_OUT), FFN, D, 4, 0, shm, tid);
    conv_group(p.in[15], (bf16_t*)(p.ws + OFF_WB_KV), D, 2 * D, 1, 0, shm, tid);
    conv_group(p.in[16], (bf16_t*)(p.ws + OFF_WB_Q), D, D, 2, 0, shm, tid);
    conv_group(p.in[17], (bf16_t*)(p.ws + OFF_WB_O), D, D, 2, 0, shm, tid);
    __syncthreads();
}

__device__ void norm_phase(const float* src, bf16_t* U1, const float* gain1, const float* sh1, const float* sc1, int bs1,
                           bf16_t* U2, const float* gain2, const float* sh2, const float* sc2, int bs2) {
    const int tid_ = opaque_tid(); const int lane = tid_ & 63, gw = blockIdx.x * 8 + (tid_ >> 6), nw = gridDim.x * 8;
    for (int row = 2 * gw; row < MTOK; row += 2 * nw) {
        const int b = row >> 13;
        const float* xp = src + (size_t)row * D;
        f32x4 xv[2][4]; float ss[2] = {0.f, 0.f};
#pragma unroll
        for (int r = 0; r < 2; ++r)
#pragma unroll
            for (int i = 0; i < 4; ++i) xv[r][i] = *(const f32x4*)(xp + (size_t)r * D + i * 256 + lane * 4);
#pragma unroll
        for (int r = 0; r < 2; ++r)
#pragma unroll
            for (int i = 0; i < 4; ++i) ss[r] += xv[r][i][0] * xv[r][i][0] + xv[r][i][1] * xv[r][i][1] + xv[r][i][2] * xv[r][i][2] + xv[r][i][3] * xv[r][i][3];
#pragma unroll
        for (int o = 1; o < 64; o <<= 1) { ss[0] += __shfl_xor(ss[0], o); ss[1] += __shfl_xor(ss[1], o); }
        const float rstd0 = rsqrtf(ss[0] * (1.0f / D) + 1e-6f), rstd1 = rsqrtf(ss[1] * (1.0f / D) + 1e-6f);
#pragma unroll
        for (int i = 0; i < 4; ++i) {
            const int k = i * 256 + lane * 4;
            const f32x4 g = *(const f32x4*)(gain1 + k), s = *(const f32x4*)(sc1 + (size_t)b * bs1 + k), t = *(const f32x4*)(sh1 + (size_t)b * bs1 + k);
            f32x4 u0, u1;
#pragma unroll
            for (int j = 0; j < 4; ++j) { const float ga = g[j] * (1.0f + s[j]); u0[j] = (xv[0][i][j] * rstd0) * ga + t[j]; u1[j] = (xv[1][i][j] * rstd1) * ga + t[j]; }
            u32x2 w0, w1; w0.x = cvt_pk_bf16(u0[0], u0[1]); w0.y = cvt_pk_bf16(u0[2], u0[3]); w1.x = cvt_pk_bf16(u1[0], u1[1]); w1.y = cvt_pk_bf16(u1[2], u1[3]);
            *(u32x2*)(U1 + (size_t)row * D + k) = w0; *(u32x2*)(U1 + (size_t)(row + 1) * D + k) = w1;
        }
        if (U2) {
#pragma unroll
            for (int i = 0; i < 4; ++i) {
                const int k = i * 256 + lane * 4;
                const f32x4 g = *(const f32x4*)(gain2 + k), s = *(const f32x4*)(sc2 + (size_t)b * bs2 + k), t = *(const f32x4*)(sh2 + (size_t)b * bs2 + k);
                f32x4 u0, u1;
#pragma unroll
                for (int j = 0; j < 4; ++j) { const float ga = g[j] * (1.0f + s[j]); u0[j] = (xv[0][i][j] * rstd0) * ga + t[j]; u1[j] = (xv[1][i][j] * rstd1) * ga + t[j]; }
                u32x2 w0, w1; w0.x = cvt_pk_bf16(u0[0], u0[1]); w0.y = cvt_pk_bf16(u0[2], u0[3]); w1.x = cvt_pk_bf16(u1[0], u1[1]); w1.y = cvt_pk_bf16(u1[2], u1[3]);
                *(u32x2*)(U2 + (size_t)row * D + k) = w0; *(u32x2*)(U2 + (size_t)(row + 1) * D + k) = w1;
            }
        }
    }
}
__device__ void final_norm_phase(float* h, const float* gain) {
    const int tid_ = opaque_tid(); const int lane = tid_ & 63, gw = blockIdx.x * 8 + (tid_ >> 6), nw = gridDim.x * 8;
    for (int row = gw; row < MTOK; row += nw) {
        float* xp = h + (size_t)row * D;
        f32x4 xv[4]; float ss = 0.f;
#pragma unroll
        for (int i = 0; i < 4; ++i) { xv[i] = *(const f32x4*)(xp + i * 256 + lane * 4); ss += xv[i][0] * xv[i][0] + xv[i][1] * xv[i][1] + xv[i][2] * xv[i][2] + xv[i][3] * xv[i][3]; }
#pragma unroll
        for (int o = 1; o < 64; o <<= 1) ss += __shfl_xor(ss, o);
        const float rstd = rsqrtf(ss * (1.0f / D) + 1e-6f);
#pragma unroll
        for (int i = 0; i < 4; ++i) {
            const int k = i * 256 + lane * 4;
            const f32x4 g = *(const f32x4*)(gain + k);
            f32x4 u;
#pragma unroll
            for (int j = 0; j < 4; ++j) u[j] = xv[i][j] * rstd * g[j];
            *(f32x4*)(xp + k) = u;
        }
    }
}

template <bool OUT>
__device__ void rec_pass(const Params& p, int layer, unsigned char* shm) {
    float* sB = (float*)shm;
    float* sKm = (float*)(shm + 33792);
    bf16_t* sST = (bf16_t*)shm;
    bf16_t* sQb = (bf16_t*)(shm + 67584);
    bf16_t* sA = (bf16_t*)(shm + 84992);
    bf16_t* sKT = (bf16_t*)(shm + 94208);
    bf16_t* sVT = (bf16_t*)(shm + 112640);
    float* sE = (float*)(shm + 131072);
    float* sPart = (float*)(shm + 131584);
    float* sNrm = (float*)(shm + 133632);
    const int tid = opaque_tid(), lane = tid & 63, w = tid >> 6, fr = lane & 15, fq = lane >> 4;
    const int wi = w >> 1, wh = w & 1;
    const int ntask = OUT ? 256 : 192;
    const float* ogain = p.in[11] + layer * 128;
    for (int task = blockIdx.x; task < ntask; task += gridDim.x) {
        int sc, bh; if (OUT) { sc = task & 3; bh = task >> 2; } else { sc = task % 3; bh = task / 3; }
        const int b = bh >> 3, h = bh & 7;
        f32x4 S[8];
#pragma unroll
        for (int db = 0; db < 8; ++db) S[db] = (f32x4){0.f, 0.f, 0.f, 0.f};
        if (OUT) {
            for (int s2 = 0; s2 < sc; ++s2) {
                const float* sl = ((float*)(p.ws + OFF_SLOC)) + (size_t)(bh * 4 + s2) * 16384; const float* dl = ((float*)(p.ws + OFF_DLOG)) + (bh * 4 + s2) * 128;
#pragma unroll
                for (int db = 0; db < 8; ++db) {
                    const f32x4 x = *(const f32x4*)(sl + ((w * 8 + db) * 64 + lane) * 4), dv = *(const f32x4*)(dl + 16 * db + fq * 4);
#pragma unroll
                    for (int j = 0; j < 4; ++j) S[db][j] = S[db][j] * __expf(dv[j]) + x[j];
                }
            }
        }
        float dlacc = 0.f;
        float lfn[16]; u32x4 vn0, vn1;
        {
            const size_t r0 = (size_t)b * SEQ + (size_t)(sc * 32) * 64;
            const float* lp = ((float*)(p.ws + OFF_LF)) + (r0 + 16 * (tid >> 7)) * D + h * 128 + (tid & 127);
#pragma unroll
            for (int e = 0; e < 16; ++e) lfn[e] = lp[(size_t)e * D];
            vn0 = *(const u32x4*)(((bf16_t*)(p.ws + OFF_VH)) + (r0 + (tid & 63)) * D + h * 128 + (tid >> 6) * 8);
            vn1 = *(const u32x4*)(((bf16_t*)(p.ws + OFF_VH)) + (r0 + (tid & 63)) * D + h * 128 + 64 + (tid >> 6) * 8);
        }
        for (int ch = sc * 32; ch < sc * 32 + 32; ++ch) {
            const size_t row0 = (size_t)b * SEQ + (size_t)ch * 64;
            float lfv[16];
#pragma unroll
            for (int e = 0; e < 16; ++e) lfv[e] = lfn[e];
            const u32x4 vr0 = vn0, vr1 = vn1;
            u32x4 qraw[4]; u32x2 graw[4];
            if (OUT) {
#pragma unroll
                for (int ks = 0; ks < 4; ++ks) qraw[ks] = *(const u32x4*)(((bf16_t*)(p.ws + OFF_QH)) + (row0 + 16 * wi + fr) * D + h * 128 + ks * 32 + fq * 8);
#pragma unroll
                for (int vb = 0; vb < 4; ++vb) graw[vb] = *(const u32x2*)(((bf16_t*)(p.ws + OFF_GH)) + (row0 + 16 * wi + fr) * D + h * 128 + 64 * wh + 16 * vb + fq * 4);
            }
            {
                const int d_ = tid & 127, tq = tid >> 7;
                float run = 0.f, kv[16];
#pragma unroll
                for (int e = 0; e < 16; ++e) { kv[e] = 1.0f - __expf(lfv[e]); sKm[(16 * tq + e) * 132 + d_] = kv[e]; run += lfv[e]; lfv[e] = run; }
                sPart[tq * 128 + d_] = run;
                {
                    const int s_ = tid & 63, pc = tid >> 6;
#pragma unroll
                    for (int e = 0; e < 8; ++e) {
                        sVT[(pc * 8 + e) * 72 + s_] = (bf16_t)((e & 1) ? (vr0[e >> 1] >> 16) : (vr0[e >> 1] & 0xffffu));
                        sVT[(64 + pc * 8 + e) * 72 + s_] = (bf16_t)((e & 1) ? (vr1[e >> 1] >> 16) : (vr1[e >> 1] & 0xffffu));
                    }
                }
                __syncthreads();
                const float p0 = sPart[d_], p1 = sPart[128 + d_], p2 = sPart[256 + d_], p3 = sPart[384 + d_];
                const float tot = (p0 + p1) + (p2 + p3);
                const float off = (tq > 0 ? p0 : 0.f) + (tq > 1 ? p1 : 0.f) + (tq > 2 ? p2 : 0.f);
                if (tq == 0) { sE[d_] = __expf(tot); dlacc += tot; }
                u32x4 kw[2];
#pragma unroll
                for (int e = 0; e < 16; e += 2) {
                    const float b0 = lfv[e] + off, b1 = lfv[e + 1] + off;
                    sB[(16 * tq + e) * 132 + d_] = b0; sB[(16 * tq + e + 1) * 132 + d_] = b1;
                    kw[e >> 3][(e >> 1) & 3] = cvt_pk_bf16(kv[e] * __expf(tot - b0), kv[e + 1] * __expf(tot - b1));
                }
                *(u32x4*)(sKT + d_ * 72 + 16 * tq) = kw[0]; *(u32x4*)(sKT + d_ * 72 + 16 * tq + 8) = kw[1];
            }
            __syncthreads();
            if (ch + 1 < sc * 32 + 32) {
                const size_t r1 = row0 + 64;
                const float* lp = ((float*)(p.ws + OFF_LF)) + (r1 + 16 * (tid >> 7)) * D + h * 128 + (tid & 127);
#pragma unroll
                for (int e = 0; e < 16; ++e) lfn[e] = lp[(size_t)e * D];
                vn0 = *(const u32x4*)(((bf16_t*)(p.ws + OFF_VH)) + (r1 + (tid & 63)) * D + h * 128 + (tid >> 6) * 8);
                vn1 = *(const u32x4*)(((bf16_t*)(p.ws + OFF_VH)) + (r1 + (tid & 63)) * D + h * 128 + 64 + (tid >> 6) * 8);
            }
            if (OUT) {
                const int i = wi, hh = wh, t_ = 16 * i + fr;
                bf16x8 qt[4];
#pragma unroll
                for (int ks = 0; ks < 4; ++ks) {
                    const int d0 = ks * 32 + fq * 8;
                    const f32x4 b0 = *(const f32x4*)(sB + t_ * 132 + d0), b1 = *(const f32x4*)(sB + t_ * 132 + d0 + 4);
                    f32x4 r0 = (f32x4){0.f, 0.f, 0.f, 0.f}, r1 = r0;
                    if (i > 0) { r0 = *(const f32x4*)(sB + (16 * i - 1) * 132 + d0); r1 = *(const f32x4*)(sB + (16 * i - 1) * 132 + d0 + 4); }
                    float qv[8], ql[8];
#pragma unroll
                    for (int e = 0; e < 4; ++e) { qv[2 * e] = bflo(qraw[ks][e]); qv[2 * e + 1] = bfhi(qraw[ks][e]); }
#pragma unroll
                    for (int e = 0; e < 4; ++e) { ql[e] = qv[e] * __expf(b0[e] - r0[e]); ql[4 + e] = qv[4 + e] * __expf(b1[e] - r1[e]); }
                    u32x4 pw; pw.x = cvt_pk_bf16(ql[0], ql[1]); pw.y = cvt_pk_bf16(ql[2], ql[3]); pw.z = cvt_pk_bf16(ql[4], ql[5]); pw.w = cvt_pk_bf16(ql[6], ql[7]);
                    qt[ks] = __builtin_bit_cast(bf16x8, pw);
                    if ((ks >> 1) == hh) {
#pragma unroll
                        for (int e = 0; e < 4; ++e) { ql[e] = qv[e] * __expf(b0[e]); ql[4 + e] = qv[4 + e] * __expf(b1[e]); }
                        u32x4 qw; qw.x = cvt_pk_bf16(ql[0], ql[1]); qw.y = cvt_pk_bf16(ql[2], ql[3]); qw.z = cvt_pk_bf16(ql[4], ql[5]); qw.w = cvt_pk_bf16(ql[6], ql[7]);
                        *(u32x4*)(sQb + t_ * 136 + d0) = qw;
                    }
                }
#pragma unroll
                for (int j2 = 0; j2 < 2; ++j2) {
                    const int j = hh + 2 * j2;
                    if (j <= i) {
                        f32x4 acc = (f32x4){0.f, 0.f, 0.f, 0.f};
                        const int s_ = 16 * j + fr;
#pragma unroll
                        for (int ks = 0; ks < 4; ++ks) {
                            const int d0 = ks * 32 + fq * 8;
                            const f32x4 k0 = *(const f32x4*)(sKm + s_ * 132 + d0), k1 = *(const f32x4*)(sKm + s_ * 132 + d0 + 4);
                            const f32x4 b0 = *(const f32x4*)(sB + s_ * 132 + d0), b1 = *(const f32x4*)(sB + s_ * 132 + d0 + 4);
                            f32x4 r0 = (f32x4){0.f, 0.f, 0.f, 0.f}, r1 = r0;
                            if (i > 0) { r0 = *(const f32x4*)(sB + (16 * i - 1) * 132 + d0); r1 = *(const f32x4*)(sB + (16 * i - 1) * 132 + d0 + 4); }
                            float kl[8];
#pragma unroll
                            for (int e = 0; e < 4; ++e) { kl[e] = k0[e] * __expf(fminf(r0[e] - b0[e], 80.f)); kl[4 + e] = k1[e] * __expf(fminf(r1[e] - b1[e], 80.f)); }
                            u32x4 kw; kw.x = cvt_pk_bf16(kl[0], kl[1]); kw.y = cvt_pk_bf16(kl[2], kl[3]); kw.z = cvt_pk_bf16(kl[4], kl[5]); kw.w = cvt_pk_bf16(kl[6], kl[7]);
                            acc = __builtin_amdgcn_mfma_f32_16x16x32_bf16(qt[ks], __builtin_bit_cast(bf16x8, kw), acc, 0, 0, 0);
                        }
#pragma unroll
                        for (int jj = 0; jj < 4; ++jj) {
                            float vv = acc[jj];
                            if (i == j && fr > fq * 4 + jj) vv = 0.f;
                            sA[(16 * i + fq * 4 + jj) * 72 + 16 * j + fr] = (bf16_t)(cvt_pk_bf16(vv, 0.f) & 0xffffu);
                        }
                    } else {
#pragma unroll
                        for (int jj = 0; jj < 4; ++jj) sA[(16 * i + fq * 4 + jj) * 72 + 16 * j + fr] = (bf16_t)0;
                    }
                }
            }
            __syncthreads();
            if (OUT) {
#pragma unroll
                for (int db = 0; db < 8; ++db) { u32x2 sw; sw.x = cvt_pk_bf16(S[db][0], S[db][1]); sw.y = cvt_pk_bf16(S[db][2], S[db][3]); *(u32x2*)(sST + (16 * w + fr) * 136 + 16 * db + fq * 4) = sw; }
                __syncthreads();
            }
            f32x4 o[4];
            if (OUT) {
                const int i = wi;
#pragma unroll
                for (int vb = 0; vb < 4; ++vb) o[vb] = (f32x4){0.f, 0.f, 0.f, 0.f};
#pragma unroll
                for (int kk = 0; kk < 2; ++kk) {
                    if (kk <= (i >> 1)) {
                        const bf16x8 af = *(const bf16x8*)(sA + (16 * i + fr) * 72 + kk * 32 + fq * 8);
#pragma unroll
                        for (int vb = 0; vb < 4; ++vb) { const bf16x8 vf = *(const bf16x8*)(sVT + (64 * wh + 16 * vb + fr) * 72 + kk * 32 + fq * 8); o[vb] = __builtin_amdgcn_mfma_f32_16x16x32_bf16(vf, af, o[vb], 0, 0, 0); }
                    }
                }
#pragma unroll
                for (int ks = 0; ks < 4; ++ks) {
                    const bf16x8 qf = *(const bf16x8*)(sQb + (16 * i + fr) * 136 + ks * 32 + fq * 8);
#pragma unroll
                    for (int vb = 0; vb < 4; ++vb) { const bf16x8 sf = *(const bf16x8*)(sST + (64 * wh + 16 * vb + fr) * 136 + ks * 32 + fq * 8); o[vb] = __builtin_amdgcn_mfma_f32_16x16x32_bf16(sf, qf, o[vb], 0, 0, 0); }
                }
                float ss = 0.f;
#pragma unroll
                for (int vb = 0; vb < 4; ++vb)
#pragma unroll
                    for (int jj = 0; jj < 4; ++jj) ss += o[vb][jj] * o[vb][jj];
                ss += __shfl_xor(ss, 16); ss += __shfl_xor(ss, 32);
                if (fq == 0) sNrm[wh * 64 + 16 * i + fr] = ss;
            }
#pragma unroll
            for (int db = 0; db < 8; ++db) { const f32x4 e4 = *(const f32x4*)(sE + 16 * db + fq * 4); S[db] = S[db] * e4; }
#pragma unroll
            for (int ks = 0; ks < 2; ++ks) {
                const bf16x8 vf = *(const bf16x8*)(sVT + (16 * w + fr) * 72 + ks * 32 + fq * 8);
#pragma unroll
                for (int db = 0; db < 8; ++db) { const bf16x8 kf = *(const bf16x8*)(sKT + (16 * db + fr) * 72 + ks * 32 + fq * 8); S[db] = __builtin_amdgcn_mfma_f32_16x16x32_bf16(kf, vf, S[db], 0, 0, 0); }
            }
            __syncthreads();
            if (OUT) {
                const int i = wi;
                const float tot = sNrm[16 * i + fr] + sNrm[64 + 16 * i + fr];
                const float rstd = rsqrtf(tot * (1.0f / 128.0f) + 1e-6f);
                bf16_t* op = ((bf16_t*)(p.ws + OFF_U)) + (row0 + 16 * i + fr) * D + h * 128 + 64 * wh + fq * 4;
#pragma unroll
                for (int vb = 0; vb < 4; ++vb) {
                    const f32x4 gn = *(const f32x4*)(ogain + 64 * wh + 16 * vb + fq * 4);
                    const float g0 = bflo(graw[vb].x), g1 = bfhi(graw[vb].x), g2 = bflo(graw[vb].y), g3 = bfhi(graw[vb].y);
                    u32x2 ow; ow.x = cvt_pk_bf16(o[vb][0] * rstd * gn[0] * g0, o[vb][1] * rstd * gn[1] * g1); ow.y = cvt_pk_bf16(o[vb][2] * rstd * gn[2] * g2, o[vb][3] * rstd * gn[3] * g3);
                    *(u32x2*)(op + 16 * vb) = ow;
                }
            }
        }
        if (!OUT) {
            float* sl = ((float*)(p.ws + OFF_SLOC)) + (size_t)(bh * 4 + sc) * 16384;
#pragma unroll
            for (int db = 0; db < 8; ++db) *(f32x4*)(sl + ((w * 8 + db) * 64 + lane) * 4) = S[db];
            if (tid < 128) ((float*)(p.ws + OFF_DLOG))[(bh * 4 + sc) * 128 + tid] = dlacc;
        }
    }
    __syncthreads();
}

__device__ void rec_passA(const Params& p, unsigned char* shm) {
    bf16_t* sKT = (bf16_t*)shm;
    bf16_t* sVT = (bf16_t*)(shm + 34816);
    float* sE = (float*)(shm + 69632);
    float* sPart = (float*)(shm + 70144);
    const int tid = opaque_tid(), lane = tid & 63, w = tid >> 6, fr = lane & 15, fq = lane >> 4;
    const int d_ = tid & 127, tq = tid >> 7;
    const float* LFp = (const float*)(p.ws + OFF_LF); const bf16_t* Vp = (const bf16_t*)(p.ws + OFF_VH);
    for (int task = blockIdx.x; task < 192; task += gridDim.x) {
        const int sc = task % 3, bh = task / 3, b = bh >> 3, h = bh & 7;
        f32x4 S[8];
#pragma unroll
        for (int db = 0; db < 8; ++db) S[db] = (f32x4){0.f, 0.f, 0.f, 0.f};
        float dlacc = 0.f;
        const size_t rbase = (size_t)b * SEQ + (size_t)sc * 2048;
        float lfn[32]; u32x4 vn[4];
        {
            const float* lp = LFp + (rbase + 32 * tq) * D + h * 128 + d_;
#pragma unroll
            for (int e = 0; e < 32; ++e) lfn[e] = lp[(size_t)e * D];
#pragma unroll
            for (int i = 0; i < 4; ++i) vn[i] = *(const u32x4*)(Vp + (rbase + d_) * D + h * 128 + (tq + 4 * i) * 8);
        }
        __syncthreads();
        for (int cc = 0; cc < 16; ++cc) {
            const size_t row0 = rbase + (size_t)cc * 128;
            float lf[32]; u32x4 vr[4];
            float run = 0.f;
#pragma unroll
            for (int e = 0; e < 32; ++e) { lf[e] = lfn[e]; run += lf[e]; }
#pragma unroll
            for (int i = 0; i < 4; ++i) vr[i] = vn[i];
            sPart[tq * 128 + d_] = run;
            __syncthreads();
            if (cc + 1 < 16) {
                const float* lp = LFp + (row0 + 128 + 32 * tq) * D + h * 128 + d_;
#pragma unroll
                for (int e = 0; e < 32; ++e) lfn[e] = lp[(size_t)e * D];
#pragma unroll
                for (int i = 0; i < 4; ++i) vn[i] = *(const u32x4*)(Vp + (row0 + 128 + d_) * D + h * 128 + (tq + 4 * i) * 8);
            }
            const float p0 = sPart[d_], p1 = sPart[128 + d_], p2 = sPart[256 + d_], p3 = sPart[384 + d_];
            const float tot = (p0 + p1) + (p2 + p3);
            float bb = (tq > 0 ? p0 : 0.f) + (tq > 1 ? p1 : 0.f) + (tq > 2 ? p2 : 0.f);
            if (tq == 0) { sE[d_] = __expf(tot); dlacc += tot; }
#pragma unroll
            for (int g8 = 0; g8 < 4; ++g8) {
                u32x4 kw;
#pragma unroll
                for (int e = 0; e < 8; e += 2) {
                    const float l0 = lf[8 * g8 + e], l1 = lf[8 * g8 + e + 1];
                    const float b0 = bb + l0, b1 = b0 + l1; bb = b1;
                    kw[e >> 1] = cvt_pk_bf16((1.0f - __expf(l0)) * __expf(tot - b0), (1.0f - __expf(l1)) * __expf(tot - b1));
                }
                *(u32x4*)(sKT + d_ * 136 + 32 * tq + 8 * g8) = kw;
            }
#pragma unroll
            for (int i = 0; i < 4; ++i)
#pragma unroll
                for (int e = 0; e < 8; ++e) sVT[((tq + 4 * i) * 8 + e) * 136 + d_] = (bf16_t)((e & 1) ? (vr[i][e >> 1] >> 16) : (vr[i][e >> 1] & 0xffffu));
            __syncthreads();
#pragma unroll
            for (int db = 0; db < 8; ++db) { const f32x4 e4 = *(const f32x4*)(sE + 16 * db + fq * 4); S[db] = S[db] * e4; }
#pragma unroll
            for (int ks = 0; ks < 4; ++ks) {
                const bf16x8 vf = *(const bf16x8*)(sVT + (16 * w + fr) * 136 + ks * 32 + fq * 8);
#pragma unroll
                for (int db = 0; db < 8; ++db) { const bf16x8 kf = *(const bf16x8*)(sKT + (16 * db + fr) * 136 + ks * 32 + fq * 8); S[db] = __builtin_amdgcn_mfma_f32_16x16x32_bf16(kf, vf, S[db], 0, 0, 0); }
            }
        }
        float* sl = (float*)(p.ws + OFF_SLOC) + (size_t)(bh * 4 + sc) * 16384;
#pragma unroll
        for (int db = 0; db < 8; ++db) *(f32x4*)(sl + ((w * 8 + db) * 64 + lane) * 4) = S[db];
        if (tq == 0) ((float*)(p.ws + OFF_DLOG))[(bh * 4 + sc) * 128 + d_] = dlacc;
    }
    __syncthreads();
}

__device__ void attn_phase(const Params& p, int jl, unsigned char* shm) {
    bf16_t* sK = (bf16_t*)shm;
    bf16_t* sVT = sK + 2 * 9216;
    float* sB = (float*)(sVT + 2 * 8704);
    const int tid = opaque_tid(), lane = tid & 63, w = tid >> 6, fr = lane & 15, fq = lane >> 4;
    const int cq = w >> 1, half = w & 1;
    const float LOG2E = 1.4426950408889634f;
    const int skey = tid >> 3, spiece = tid & 7, vkey = tid & 63, vpiece = tid >> 6;
    const bf16_t* Kg = (const bf16_t*)(p.ws + OFF_KB); const bf16_t* Vg = (const bf16_t*)(p.ws + OFF_VB); const bf16_t* Qg = (const bf16_t*)(p.ws + OFF_QB);
    for (int task = blockIdx.x; task < 4096; task += gridDim.x) {
        const int g = task & 31, h = (task >> 5) & 15, b = task >> 9;
        const int c = 4 * g + cq;
        const int dt0 = (2 * g - 4 > 0) ? 2 * g - 4 : 0, dt1 = 2 * g + 1;
        __syncthreads();
        for (int i = tid; i < 384; i += 512) { int r = i - 64; r = r < 0 ? 0 : (r > 319 ? 319 : r); sB[i] = p.in[18][((size_t)jl * 320 + r) * 16 + h] * LOG2E; }
        bf16x8 qf[2][2];
        {
            const bf16_t* qp = Qg + ((size_t)b * SEQ + c * 64 + half * 32) * D + h * 64;
#pragma unroll
            for (int qb = 0; qb < 2; ++qb)
#pragma unroll
                for (int ks = 0; ks < 2; ++ks) qf[qb][ks] = *(const bf16x8*)(qp + (size_t)(qb * 16 + fr) * D + ks * 32 + fq * 8);
        }
        f32x4 oacc[4][2];
#pragma unroll
        for (int db = 0; db < 4; ++db)
#pragma unroll
            for (int qb = 0; qb < 2; ++qb) oacc[db][qb] = (f32x4){0.f, 0.f, 0.f, 0.f};
        float mrun[2] = {-1e30f, -1e30f}, lrun[2] = {0.f, 0.f};
        u32x4 kreg[2], vreg[2];
        const size_t tokb = (size_t)b * SEQ;
#define ATT_GLOAD(dt_) do { _Pragma("unroll") for (int hf_ = 0; hf_ < 2; ++hf_) { \
            kreg[hf_] = *(const u32x4*)(Kg + (tokb + (size_t)(dt_) * 128 + hf_ * 64 + skey) * D + h * 64 + spiece * 8); \
            vreg[hf_] = *(const u32x4*)(Vg + (tokb + (size_t)(dt_) * 128 + hf_ * 64 + vkey) * D + h * 64 + vpiece * 8); } } while (0)
#define ATT_LSTORE(buf_) do { _Pragma("unroll") for (int hf_ = 0; hf_ < 2; ++hf_) { \
            *(u32x4*)(sK + (buf_) * 9216 + (hf_ * 64 + skey) * 72 + spiece * 8) = kreg[hf_]; \
            bf16_t* vt_ = sVT + (buf_) * 8704 + (vpiece * 8) * 136 + hf_ * 64 + vkey; \
            _Pragma("unroll") for (int e_ = 0; e_ < 8; ++e_) vt_[e_ * 136] = (bf16_t)((e_ & 1) ? (vreg[hf_][e_ >> 1] >> 16) : (vreg[hf_][e_ >> 1] & 0xffffu)); } } while (0)
        ATT_GLOAD(dt0); ATT_LSTORE(0);
        __syncthreads();
        for (int dt = dt0; dt <= dt1; ++dt) {
            const int buf = (dt - dt0) & 1;
            if (dt < dt1) ATT_GLOAD(dt + 1);
            const bool act0 = (2 * dt >= c - 8) && (2 * dt <= c), act1 = (2 * dt + 1 >= c - 8) && (2 * dt + 1 <= c);
            if (act0 || act1) {
                const bf16_t* kb_ = sK + buf * 9216; const bf16_t* vb_ = sVT + buf * 8704;
                f32x4 sacc[2][4][2];
#pragma unroll
                for (int hf = 0; hf < 2; ++hf) {
                    if (hf == 0 ? act0 : act1) {
#pragma unroll
                        for (int kb = 0; kb < 4; ++kb)
#pragma unroll
                            for (int qb = 0; qb < 2; ++qb) sacc[hf][kb][qb] = (f32x4){0.f, 0.f, 0.f, 0.f};
#pragma unroll
                        for (int kb = 0; kb < 4; ++kb)
#pragma unroll
                            for (int ks = 0; ks < 2; ++ks) {
                                const bf16x8 kf = *(const bf16x8*)(kb_ + (hf * 64 + kb * 16 + fr) * 72 + ks * 32 + fq * 8);
#pragma unroll
                                for (int qb = 0; qb < 2; ++qb) sacc[hf][kb][qb] = __builtin_amdgcn_mfma_f32_16x16x32_bf16(kf, qf[qb][ks], sacc[hf][kb][qb], 0, 0, 0);
                            }
                    }
                }
                float mx[2] = {-3e38f, -3e38f};
#pragma unroll
                for (int hf = 0; hf < 2; ++hf) {
                    if (hf == 0 ? act0 : act1) {
                        const int dk = 2 * dt + hf - c;
                        if (dk <= -5) {
                            const float b0 = sB[0];
#pragma unroll
                            for (int kb = 0; kb < 4; ++kb)
#pragma unroll
                                for (int qb = 0; qb < 2; ++qb) sacc[hf][kb][qb] = sacc[hf][kb][qb] * LOG2E + b0;
                        } else {
                            const float* bp = sB + (dk * 64 + fq * 4 - half * 32 - fr + 256 + 64 - 16);
#pragma unroll
                            for (int kb = 0; kb < 4; ++kb)
#pragma unroll
                                for (int qb = 0; qb < 2; ++qb)
#pragma unroll
                                    for (int j = 0; j < 4; ++j) sacc[hf][kb][qb][j] = sacc[hf][kb][qb][j] * LOG2E + bp[kb * 16 + j - qb * 16 + 16];
                        }
#pragma unroll
                        for (int qb = 0; qb < 2; ++qb)
#pragma unroll
                            for (int kb = 0; kb < 4; ++kb)
#pragma unroll
                                for (int j = 0; j < 4; ++j) mx[qb] = fmaxf(mx[qb], sacc[hf][kb][qb][j]);
                    }
                }
                if (__any((mx[0] > mrun[0] + 6.0f) || (mx[1] > mrun[1] + 6.0f))) {
#pragma unroll
                    for (int qb = 0; qb < 2; ++qb) {
                        float m2 = fmaxf(mx[qb], __shfl_xor(mx[qb], 16)); m2 = fmaxf(m2, __shfl_xor(m2, 32));
                        const float mn = fmaxf(mrun[qb], m2), corr = __builtin_amdgcn_exp2f(mrun[qb] - mn);
                        mrun[qb] = mn; lrun[qb] *= corr;
#pragma unroll
                        for (int db = 0; db < 4; ++db) oacc[db][qb] = oacc[db][qb] * corr;
                    }
                }
#pragma unroll
                for (int hf = 0; hf < 2; ++hf) {
                    if (hf == 0 ? act0 : act1) {
                        bf16x8 pf[2][2];
#pragma unroll
                        for (int qb = 0; qb < 2; ++qb) {
                            const float mn = mrun[qb];
                            float ps = 0.f;
#pragma unroll
                            for (int kb = 0; kb < 4; ++kb)
#pragma unroll
                                for (int j = 0; j < 4; ++j) { const float pv = __builtin_amdgcn_exp2f(sacc[hf][kb][qb][j] - mn); sacc[hf][kb][qb][j] = pv; ps += pv; }
                            lrun[qb] += ps;
#pragma unroll
                            for (int kk = 0; kk < 2; ++kk) {
                                u32x4 pw;
                                pw.x = cvt_pk_bf16(sacc[hf][2 * kk][qb][0], sacc[hf][2 * kk][qb][1]); pw.y = cvt_pk_bf16(sacc[hf][2 * kk][qb][2], sacc[hf][2 * kk][qb][3]);
                                pw.z = cvt_pk_bf16(sacc[hf][2 * kk + 1][qb][0], sacc[hf][2 * kk + 1][qb][1]); pw.w = cvt_pk_bf16(sacc[hf][2 * kk + 1][qb][2], sacc[hf][2 * kk + 1][qb][3]);
                                pf[qb][kk] = __builtin_bit_cast(bf16x8, pw);
                            }
                        }
#pragma unroll
                        for (int db = 0; db < 4; ++db)
#pragma unroll
                            for (int kk = 0; kk < 2; ++kk) {
                                const u32x2 lo = *(const u32x2*)(vb_ + (db * 16 + fr) * 136 + hf * 64 + (2 * kk) * 16 + fq * 4);
                                const u32x2 hi = *(const u32x2*)(vb_ + (db * 16 + fr) * 136 + hf * 64 + (2 * kk + 1) * 16 + fq * 4);
                                u32x4 vw; vw.x = lo.x; vw.y = lo.y; vw.z = hi.x; vw.w = hi.y;
                                const bf16x8 vf = __builtin_bit_cast(bf16x8, vw);
#pragma unroll
                                for (int qb = 0; qb < 2; ++qb) oacc[db][qb] = __builtin_amdgcn_mfma_f32_16x16x32_bf16(vf, pf[qb][kk], oacc[db][qb], 0, 0, 0);
                            }
                    }
                }
            }
            if (dt < dt1) ATT_LSTORE(buf ^ 1);
            __syncthreads();
        }
#undef ATT_GLOAD
#undef ATT_LSTORE
#pragma unroll
        for (int qb = 0; qb < 2; ++qb) {
            float lt = lrun[qb]; lt += __shfl_xor(lt, 16); lt += __shfl_xor(lt, 32);
            const float inv = 1.0f / lt;
            bf16_t* op = (bf16_t*)(p.ws + OFF_U) + (tokb + c * 64 + half * 32 + qb * 16 + fr) * D + h * 64 + fq * 4;
#pragma unroll
            for (int db = 0; db < 4; ++db) {
                u32x2 ow; ow.x = cvt_pk_bf16(oacc[db][qb][0] * inv, oacc[db][qb][1] * inv); ow.y = cvt_pk_bf16(oacc[db][qb][2] * inv, oacc[db][qb][3] * inv);
                *(u32x2*)(op + db * 16) = ow;
            }
        }
    }
    __syncthreads();
}

#ifndef REP_ATTN
#define REP_ATTN 1
#endif
#ifndef REP_REC
#define REP_REC 1
#endif
#ifndef REP_NORM
#define REP_NORM 1
#endif
#ifndef REP_SYNC
#define REP_SYNC 1
#endif
#ifndef REP_PREP
#define REP_PREP 1
#endif
#ifndef REP_G3
#define REP_G3 1
#endif
#define GSYNC() do { for (int r_ = 0; r_ < REP_SYNC; ++r_) xcd_barrier(xb); } while (0)
__global__ void __launch_bounds__(512, 2) yoco_fwd(Params p) {
    extern __shared__ __attribute__((aligned(16))) unsigned char shm[];
    cg::grid_group grid = cg::this_grid();
    unsigned* barw = (unsigned*)(p.ws + OFF_BAR);
    for (int i = blockIdx.x * 512 + threadIdx.x; i < XCD_BAR_WORDS; i += gridDim.x * 512) barw[i] = 0u;
    volatile LAS unsigned* xst = (volatile LAS unsigned*)(LAS unsigned char*)(shm + LDS_BYTES - 16);
    if (threadIdx.x == 0) { xst[0] = 0u; xst[1] = 0u; }
    for (int r = 0; r < REP_PREP; ++r) prep_phase(p, shm);
    grid.sync();
    XcdBarrier xb = xcd_barrier_post(barw, xst);
    for (int l = 0; l < 4; ++l) {
        const float* hsrc = (l == 0) ? p.in[0] : p.h;
        const float* mv = ((float*)(p.ws + OFF_MODV)) + (size_t)l * 8 * 6144;
        for (int r = 0; r < REP_NORM; ++r) {
            if (l == 2) norm_phase(hsrc, ((bf16_t*)(p.ws + OFF_U)), p.in[4] + l * D, mv, mv + D, 6144, ((bf16_t*)(p.ws + OFF_U2)), p.in[12], ((float*)(p.ws + OFF_KVMOD)), ((float*)(p.ws + OFF_KVMOD)) + D, 2048);
            else norm_phase(hsrc, ((bf16_t*)(p.ws + OFF_U)), p.in[4] + l * D, mv, mv + D, 6144, nullptr, nullptr, nullptr, nullptr, 0);
        }
        GSYNC();
        if (l < 2) {
            pg8::EpiHgrnIn e; e.QVG = ((bf16_t*)(p.ws + OFF_QH)); e.LF = ((float*)(p.ws + OFF_LF)); e.lb = ((float*)(p.ws + OFF_LBV)) + l * D;
            run_gemm(shm, ((bf16_t*)(p.ws + OFF_U)), ((bf16_t*)(p.ws + OFF_WB_A_IN)) + (size_t)l * AIN * D, AIN, D, e);
            GSYNC();
            for (int r = 0; r < REP_REC; ++r) rec_passA(p, shm);
            GSYNC();
            for (int r = 0; r < REP_REC; ++r) rec_pass<true>(p, l, shm);
        } else {
            if (l == 2) { pg8::EpiBf16Split e; e.d0 = ((bf16_t*)(p.ws + OFF_KB)); e.scale = 1.0f; run_gemm(shm, ((bf16_t*)(p.ws + OFF_U2)), ((bf16_t*)(p.ws + OFF_WB_KV)), 2048, D, e); }
            { pg8::EpiBf16Split e; e.d0 = ((bf16_t*)(p.ws + OFF_QB)); e.scale = 0.125f; run_gemm(shm, ((bf16_t*)(p.ws + OFF_U)), ((bf16_t*)(p.ws + OFF_WB_Q)) + (size_t)(l - 2) * D * D, D, D, e); }
            GSYNC();
            for (int r = 0; r < REP_ATTN; ++r) attn_phase(p, l - 2, shm);
        }
        GSYNC();
        {
            pg8::EpiResid e; e.src = hsrc; e.dst = p.h; e.gate = mv + 2 * D;
            run_gemm(shm, ((bf16_t*)(p.ws + OFF_U)), (l < 2) ? ((bf16_t*)(p.ws + OFF_WB_A_OUT)) + (size_t)l * D * D : ((bf16_t*)(p.ws + OFF_WB_O)) + (size_t)(l - 2) * D * D, D, D, e);
        }
        GSYNC();
        for (int r = 0; r < REP_NORM; ++r) norm_phase(p.h, ((bf16_t*)(p.ws + OFF_U)), p.in[5] + l * D, mv + 3 * D, mv + 4 * D, 6144, nullptr, nullptr, nullptr, nullptr, 0);
        GSYNC();
        for (int r = 0; r < REP_G3; ++r) { pg8::EpiSwiglu e; e.act = ((bf16_t*)(p.ws + OFF_ACT)); run_gemm(shm, ((bf16_t*)(p.ws + OFF_U)), ((bf16_t*)(p.ws + OFF_WB_FFN_IN)) + (size_t)l * 2 * FFN * D, 2 * FFN, D, e); }
        GSYNC();
        { pg8::EpiResid e; e.src = p.h; e.dst = p.h; e.gate = mv + 5 * D; run_gemm(shm, ((bf16_t*)(p.ws + OFF_ACT)), ((bf16_t*)(p.ws + OFF_WB_FFN_OUT)) + (size_t)l * D * FFN, D, FFN, e); }
        GSYNC();
    }
    final_norm_phase(p.h, p.in[19]);
}

extern "C" void kernel_launch(void* const* d_in, const int* in_sizes, int n_in, void* d_out, int out_size, void* d_ws, size_t ws_size, hipStream_t stream) {
    static int grid_blocks = 0;
    if (!grid_blocks) {
        int dev = 0, cus = 0, per_cu = 0;
        hipGetDevice(&dev);
        hipDeviceGetAttribute(&cus, hipDeviceAttributeMultiprocessorCount, dev);
        hipFuncSetAttribute((const void*)yoco_fwd, hipFuncAttributeMaxDynamicSharedMemorySize, LDS_BYTES);
        hipOccupancyMaxActiveBlocksPerMultiprocessor(&per_cu, (const void*)yoco_fwd, 512, LDS_BYTES);
        if (per_cu < 1) per_cu = 1;
        grid_blocks = cus * per_cu;
        (void)hipGetLastError();
    }
    Params p{};
    for (int i = 0; i < 20; ++i) p.in[i] = (const float*)d_in[i];
    p.h = (float*)d_out; p.ws = (unsigned char*)d_ws;
    if (ws_size < WS_END || n_in != 20) { fprintf(stderr, "kernel_launch: workspace too small (%zu < %zu) or unexpected inputs\n", ws_size, (size_t)WS_END); return; }
    void* args[] = {&p};
    hipError_t e = hipLaunchCooperativeKernel((const void*)yoco_fwd, dim3(grid_blocks), dim3(512), args, LDS_BYTES, stream);
    if (e != hipSuccess) fprintf(stderr, "cooperative launch failed: %s (grid %d)\n", hipGetErrorString(e), grid_blocks);
}
```

```cpp
#include <hip/hip_runtime.h>
#include <hip/hip_cooperative_groups.h>
#include <cstdio>
namespace cg = cooperative_groups;

#define LAS __attribute__((address_space(3)))
typedef unsigned short bf16_t;
typedef short bf16x8 __attribute__((ext_vector_type(8)));
typedef float f32x4 __attribute__((ext_vector_type(4)));
typedef unsigned u32x4 __attribute__((ext_vector_type(4)));
typedef unsigned u32x2 __attribute__((ext_vector_type(2)));
typedef float f32x2 __attribute__((ext_vector_type(2)));

constexpr int D = 1024, BATCH = 8, SEQ = 8192, MTOK = BATCH * SEQ, FFN = 2816, AIN = 4096;
constexpr int LDS_BYTES = 144 * 1024;
constexpr int XCD_BAR_WORDS_C = 3456;

__device__ __forceinline__ unsigned cvt_pk_bf16(float lo, float hi) { unsigned r; asm volatile("v_cvt_pk_bf16_f32 %0, %1, %2" : "=v"(r) : "v"(lo), "v"(hi)); return r; }
__device__ __forceinline__ float bf2f(unsigned short h) { return __uint_as_float((unsigned)h << 16); }
__device__ __forceinline__ float bflo(unsigned w) { return __uint_as_float(w << 16); }
__device__ __forceinline__ float bfhi(unsigned w) { return __uint_as_float(w & 0xffff0000u); }
__device__ __forceinline__ float silu_f(float x) { return x * __builtin_amdgcn_rcpf(1.0f + __expf(-x)); }

__device__ __forceinline__ int opaque_tid() { int t = threadIdx.x; asm volatile("" : "+v"(t)); return t; }
struct Params { const float* in[20]; float* h; unsigned char* ws; };
constexpr size_t ACTB = (size_t)MTOK * D * 2;
constexpr size_t OFF_WB_A_IN = 0;
constexpr size_t OFF_WB_A_OUT = OFF_WB_A_IN + (size_t)2 * AIN * D * 2;
constexpr size_t OFF_WB_FFN_IN = OFF_WB_A_OUT + (size_t)2 * D * D * 2;
constexpr size_t OFF_WB_FFN_OUT = OFF_WB_FFN_IN + (size_t)4 * 2 * FFN * D * 2;
constexpr size_t OFF_WB_KV = OFF_WB_FFN_OUT + (size_t)4 * D * FFN * 2;
constexpr size_t OFF_WB_Q = OFF_WB_KV + (size_t)2 * D * D * 2;
constexpr size_t OFF_WB_O = OFF_WB_Q + (size_t)2 * D * D * 2;
constexpr size_t OFF_MODV = OFF_WB_O + (size_t)2 * D * D * 2;
constexpr size_t OFF_KVMOD = OFF_MODV + (size_t)4 * 8 * 6144 * 4;
constexpr size_t OFF_LBV = OFF_KVMOD + (size_t)8 * 2048 * 4;
constexpr size_t OFF_U = OFF_LBV + (size_t)2 * D * 4;
constexpr size_t OFF_R = OFF_U + ACTB;
constexpr size_t OFF_QH = OFF_R, OFF_VH = OFF_R + ACTB, OFF_GH = OFF_R + 2 * ACTB, OFF_LF = OFF_R + 3 * ACTB;
constexpr size_t OFF_ACT = OFF_R;
constexpr size_t OFF_U2 = OFF_R;
constexpr size_t OFF_KB = OFF_R + (size_t)MTOK * FFN * 2, OFF_VB = OFF_KB + ACTB, OFF_QB = OFF_VB + ACTB;
constexpr size_t OFF_SLOC = OFF_R + 5 * ACTB, OFF_DLOG = OFF_SLOC + (size_t)256 * 16384 * 4;
constexpr size_t OFF_BAR = OFF_QB + ACTB;
constexpr size_t WS_END = OFF_BAR + (size_t)XCD_BAR_WORDS_C * 4;


#define XB_TMO      128
#define XB_XCNT(j)  (256  + 64 * (j))
#define XB_XSUB(j)  (1280 + 64 * (j))
#define XB_XGEN(j)  (2304 + 64 * (j))
#define XB_TOP      3328
#define XB_TOPGEN   3392
#define XCD_BAR_WORDS 3456
#define XB_SPIN_CAP (1u << 18)
__device__ __forceinline__ unsigned xb_ld(unsigned* p)              { return __hip_atomic_load(p, __ATOMIC_RELAXED, __HIP_MEMORY_SCOPE_AGENT); }
__device__ __forceinline__ unsigned xb_add(unsigned* p, unsigned v) { return __hip_atomic_fetch_add(p, v, __ATOMIC_RELAXED, __HIP_MEMORY_SCOPE_AGENT); }
__device__ __forceinline__ unsigned xb_xcc_id() { return (unsigned)__builtin_amdgcn_s_getreg((3 << 11) | 20) & 0xFu; }
#define XB_SPIN(cond, bar) do { unsigned _sp = 0; while (cond) { __builtin_amdgcn_s_sleep(1); \
    if ((++_sp & 255u) == 0u) { if (xb_ld(&(bar)[XB_TMO])) break; if (_sp > XB_SPIN_CAP) { atomicAdd(&(bar)[XB_TMO], 1u); break; } } } } while (0)
struct XcdBarrier { unsigned* bar; unsigned x; volatile LAS unsigned* st; };
__device__ __forceinline__ XcdBarrier xcd_barrier_post(unsigned* bar, volatile LAS unsigned* st) {
    XcdBarrier b; b.bar = bar; b.x = xb_xcc_id(); b.st = st;
    if (threadIdx.x == 0) (void)xb_add(&bar[XB_XCNT(b.x)], 1u);
    return b;
}
__device__ __forceinline__ void xcd_barrier_complete(unsigned* bar, unsigned x, unsigned& nloc, unsigned& nx) {
    const unsigned G = gridDim.x * gridDim.y * gridDim.z;
    unsigned sum, cnt, mine, sp = 0u;
    for (;;) {
        sum = 0u; cnt = 0u; mine = 0u;
#pragma unroll
        for (unsigned j = 0; j < 16; ++j) { const unsigned c = xb_ld(&bar[XB_XCNT(j)]); sum += c; cnt += (c > 0u) ? 1u : 0u; mine = (j == x) ? c : mine; }
        if (sum == G) break;
        __builtin_amdgcn_s_sleep(1);
        if ((++sp & 255u) == 0u) { if (xb_ld(&bar[XB_TMO])) break; if (sp > XB_SPIN_CAP) { atomicAdd(&bar[XB_TMO], 1u); break; } }
    }
    nloc = mine > 0u ? mine : 1u; nx = cnt > 0u ? cnt : 1u;
}
__device__ __forceinline__ void xcd_barrier(const XcdBarrier& b) {
    asm volatile("s_waitcnt vmcnt(0)" ::: "memory");
    __syncthreads();
    if (threadIdx.x == 0) {
        unsigned* bar = b.bar;
        __builtin_amdgcn_s_waitcnt(0);
        unsigned nloc = b.st[0], nx = b.st[1];
        if (nloc == 0u) { xcd_barrier_complete(bar, b.x, nloc, nx); b.st[0] = nloc; b.st[1] = nx; }
        const unsigned old = xb_add(&bar[XB_XSUB(b.x)], 1u);
        const unsigned gen = old / nloc;
        if (old + 1u == (gen + 1u) * nloc) {
            __builtin_amdgcn_fence(__ATOMIC_RELEASE, "agent");
            asm volatile("s_waitcnt vmcnt(0)" ::: "memory");
            const unsigned og = xb_add(&bar[XB_TOP], 1u);
            const unsigned tg = og / nx;
            if (og + 1u == (tg + 1u) * nx) xb_add(&bar[XB_TOPGEN], 1u);
            else XB_SPIN(xb_ld(&bar[XB_TOPGEN]) == tg, bar);
            __builtin_amdgcn_fence(__ATOMIC_ACQUIRE, "agent");
            xb_add(&bar[XB_XGEN(b.x)], 1u);
            asm volatile("s_waitcnt vmcnt(0)" ::: "memory");
        } else {
            XB_SPIN(xb_ld(&bar[XB_XGEN(b.x)]) == gen, bar);
            __builtin_amdgcn_fence(__ATOMIC_ACQUIRE, "agent");
            asm volatile("s_waitcnt vmcnt(0)" ::: "memory");
        }
    }
    __syncthreads();
}

namespace pg8 {
constexpr int BM = 256, BK = 64, HALF = 128, HTB = HALF * BK * 2, STAGE_BYTES = 8 * HTB, NXCD = 8, WGM = 8;
__device__ __forceinline__ int lds_byte(int r, int c) { const int st = (r >> 4) * 2 + (c >> 5), rr = r & 15, cc = c & 31, ob = rr * 64 + cc * 2; return st * 1024 + (ob ^ (((ob >> 9) & 1) << 5)); }
__device__ __forceinline__ void stage_rc(int b, int& R, int& C) { const int st = b / 1024, sb = b % 1024, swz = sb ^ (((sb >> 9) & 1) << 5); R = (st >> 1) * 16 + swz / 64; C = (st & 1) * 32 + (swz % 64) / 2; }
__device__ __forceinline__ int perm32(int rho) { const int n = rho >> 4, i = rho & 15; return 8 * (i >> 2) + 4 * n + (i & 3); }
struct Unit { int pm, pn; };
struct Gemm { const bf16_t* A; const bf16_t* Bt; int M, N, K; };
struct StaticOrder {
    int nM, nN, nwg, G, c;
    __device__ void init(int M, int N, int G_, int c_) { nM = M / BM; nN = N / BM; nwg = nM * nN; G = G_; c = c_; }
    __device__ bool next(int i, Unit& u) const {
        const long L = (long)i * G + c; if (L >= nwg) return false;
        int wgid = (int)L; { const int q = nwg / NXCD, r = nwg % NXCD, xcd = wgid % NXCD, off = wgid / NXCD; wgid = (xcd < r ? xcd * (q + 1) : r * (q + 1) + (xcd - r) * q) + off; }
        const int nig = WGM * nN, gid = wgid / nig, fm = gid * WGM, gsz = (nM - fm) < WGM ? (nM - fm) : WGM;
        u.pm = fm + ((wgid % nig) % gsz); u.pn = (wgid % nig) / gsz; return true;
    }
};

template <class Epi>
__device__ __forceinline__ void gemm_phase(LAS unsigned char* lds, const Gemm g, const StaticOrder& S, const Epi& E) {
    const int tid = opaque_tid(), wid = __builtin_amdgcn_readfirstlane(tid >> 6), lane = tid & 63, wr = wid >> 2, wc = wid & 3, fr = lane & 15, fq = lane >> 4;
    const int K = g.K, nt = K / BK;
    unsigned voffA[2], voffB[2];
#pragma unroll
    for (int i = 0; i < 2; ++i) { int R, C; stage_rc(tid * 16 + i * 8192, R, C); const int Rb = Epi::PERM ? ((R & ~31) + perm32(R & 31)) : R;
        voffA[i] = (unsigned)(R * K + C) * 2u; voffB[i] = (unsigned)(Rb * K + C) * 2u; }
    const size_t kstep = (size_t)(BK * 2);
    const size_t hstep = (size_t)HALF * K * 2;
    const size_t tstep = 2 * hstep;
    const unsigned ldsw = (unsigned)wid * 1024u;
    const int aoff = lds_byte(wr * 64 + fr, fq * 8), boff = lds_byte(wc * 32 + fr, fq * 8);
#define PG8_SA(b, h) (((b) * 2 + (h)) * HTB)
#define PG8_SB(b, h) ((4 + (b) * 2 + (h)) * HTB)
#define PG8_STAGE(bufoff, gbase, voff) do { _Pragma("unroll") for (int _i = 0; _i < 2; ++_i) \
        __builtin_amdgcn_global_load_lds((const unsigned*)((const char*)(gbase) + (voff)[_i]), (LAS unsigned*)(lds + (bufoff) + ldsw + _i * 8192), 16, 0, 0); } while (0)
#define PG8_LDA(dst, b, h) do { _Pragma("unroll") for (int m = 0; m < 4; ++m) _Pragma("unroll") for (int k = 0; k < 2; ++k) dst[m][k] = *(const LAS bf16x8*)(lds + PG8_SA(b, h) + aoff + m * 2048 + k * 1024); } while (0)
#define PG8_LDB(dst, b, h) do { _Pragma("unroll") for (int n = 0; n < 2; ++n) _Pragma("unroll") for (int k = 0; k < 2; ++k) dst[n][k] = *(const LAS bf16x8*)(lds + PG8_SB(b, h) + boff + n * 2048 + k * 1024); } while (0)
#define PG8_MMA(ai, bj, At, Bt) do { __builtin_amdgcn_s_setprio(1); _Pragma("unroll") for (int m = 0; m < 4; ++m) _Pragma("unroll") for (int n = 0; n < 2; ++n) _Pragma("unroll") for (int k = 0; k < 2; ++k) \
        acc[ai][bj][m][n] = __builtin_amdgcn_mfma_f32_16x16x32_bf16(Bt[n][k], At[m][k], acc[ai][bj][m][n], 0, 0, 0); __builtin_amdgcn_s_setprio(0); } while (0)
#define PG8_WAIT_V(n) asm volatile("s_waitcnt vmcnt(" #n ")" ::: "memory")
#define PG8_WAIT_L(n) asm volatile("s_waitcnt lgkmcnt(" #n ")" ::: "memory")
#define PG8_BAR __builtin_amdgcn_s_barrier()
#define PG8_SCHED __builtin_amdgcn_sched_barrier(0)
    Unit cur, nxt; int ui = 0;
    if (!S.next(0, cur)) return;
    f32x4 acc[2][2][4][2];
#pragma unroll
    for (int a = 0; a < 2; ++a)
#pragma unroll
        for (int b = 0; b < 2; ++b)
#pragma unroll
            for (int m = 0; m < 4; ++m)
#pragma unroll
                for (int n = 0; n < 2; ++n) acc[a][b][m][n] = (f32x4){0.f, 0.f, 0.f, 0.f};
    bf16x8 At[4][2], B0[2][2], B1[2][2];
    const char* cA = (const char*)g.A + (size_t)cur.pm * tstep; const char* cB = (const char*)g.Bt + (size_t)cur.pn * tstep;
    PG8_STAGE(PG8_SB(0, 0), cB, voffB); PG8_STAGE(PG8_SA(0, 0), cA, voffA); PG8_STAGE(PG8_SB(0, 1), cB + hstep, voffB); PG8_STAGE(PG8_SA(0, 1), cA + hstep, voffA);
    if (wr == 1) PG8_BAR;
    PG8_WAIT_V(4); PG8_BAR;
    PG8_STAGE(PG8_SB(1, 0), cB + kstep, voffB); PG8_STAGE(PG8_SA(1, 0), cA + kstep, voffA); PG8_STAGE(PG8_SB(1, 1), cB + hstep + kstep, voffB);
    PG8_WAIT_V(6); PG8_BAR;
    for (;;) {
        const bool has_next = S.next(ui + 1, nxt);
        const char* nA = has_next ? (const char*)g.A + (size_t)nxt.pm * tstep : cA; const char* nB = has_next ? (const char*)g.Bt + (size_t)nxt.pn * tstep : cB;
        for (int t = 0; t < nt; t += 2) {
            const bool last = (t == nt - 2);
            const char* a1 = cA + (size_t)(t + 1) * kstep;
            const char* a2 = last ? nA : cA + (size_t)(t + 2) * kstep; const char* b2 = last ? nB : cB + (size_t)(t + 2) * kstep;
            const char* a3 = a2 + kstep; const char* b3 = b2 + kstep;
            PG8_LDB(B0, 0, 0); PG8_SCHED; PG8_LDA(At, 0, 0); PG8_STAGE(PG8_SA(1, 1), a1 + hstep, voffA);
            PG8_WAIT_L(8); PG8_BAR; PG8_WAIT_L(0); PG8_MMA(0, 0, At, B0); PG8_BAR; PG8_SCHED;
            PG8_LDB(B1, 0, 1); PG8_STAGE(PG8_SB(0, 0), b2, voffB);
            PG8_BAR; PG8_WAIT_L(0); PG8_MMA(0, 1, At, B1); PG8_BAR;
            PG8_LDA(At, 0, 1); PG8_STAGE(PG8_SA(0, 0), a2, voffA);
            PG8_BAR; PG8_WAIT_L(0); PG8_MMA(1, 0, At, B0); PG8_BAR; PG8_SCHED;
            PG8_STAGE(PG8_SB(0, 1), b2 + hstep, voffB);
            PG8_WAIT_V(6); PG8_BAR; PG8_MMA(1, 1, At, B1); PG8_BAR;
            PG8_LDB(B0, 1, 0); PG8_SCHED; PG8_LDA(At, 1, 0); PG8_STAGE(PG8_SA(0, 1), a2 + hstep, voffA);
            PG8_WAIT_L(8); PG8_BAR; PG8_WAIT_L(0); PG8_MMA(0, 0, At, B0); PG8_BAR; PG8_SCHED;
            PG8_LDB(B1, 1, 1); PG8_STAGE(PG8_SB(1, 0), b3, voffB);
            PG8_BAR; PG8_WAIT_L(0); PG8_MMA(0, 1, At, B1); PG8_BAR;
            PG8_LDA(At, 1, 1); PG8_STAGE(PG8_SA(1, 0), a3, voffA);
            PG8_BAR; PG8_WAIT_L(0); PG8_MMA(1, 0, At, B0); PG8_BAR; PG8_SCHED;
            PG8_STAGE(PG8_SB(1, 1), b3 + hstep, voffB);
            PG8_WAIT_V(6); PG8_BAR; PG8_MMA(1, 1, At, B1); PG8_BAR;
        }
        E(acc, cur, wr, wc, fr, fq);
        if (!has_next) break;
#pragma unroll
        for (int a = 0; a < 2; ++a)
#pragma unroll
            for (int b = 0; b < 2; ++b)
#pragma unroll
                for (int m = 0; m < 4; ++m)
#pragma unroll
                    for (int n = 0; n < 2; ++n) acc[a][b][m][n] = (f32x4){0.f, 0.f, 0.f, 0.f};
        cur = nxt; cA = nA; cB = nB; ++ui;
    }
    PG8_WAIT_V(0);
    if (wr == 0) PG8_BAR;
    PG8_BAR;
#undef PG8_SA
#undef PG8_SB
#undef PG8_STAGE
#undef PG8_LDA
#undef PG8_LDB
#undef PG8_MMA
#undef PG8_WAIT_V
#undef PG8_WAIT_L
#undef PG8_BAR
#undef PG8_SCHED
}

struct EpiHgrnIn {
    static constexpr bool PERM = true;
    bf16_t* QVG; bf16_t* LF; const float* lb;
    __device__ __forceinline__ void operator()(const f32x4 (&acc)[2][2][4][2], const Unit& u, int wr, int wc, int fr, int fq) const {
        const int seg = u.pn >> 2, colt = (u.pn & 3) * 256;
        const int row0 = u.pm * BM + wr * 64 + fr, col0 = colt + wc * 32 + 8 * fq;
        if (seg == 1) {
#pragma unroll
            for (int bj = 0; bj < 2; ++bj) {
                const f32x4 l0 = *(const f32x4*)(lb + col0 + bj * HALF), l1 = *(const f32x4*)(lb + col0 + bj * HALF + 4);
#pragma unroll
                for (int ai = 0; ai < 2; ++ai)
#pragma unroll
                    for (int m = 0; m < 4; ++m) {
                        bf16_t* rowp = LF + (size_t)(row0 + ai * HALF + m * 16) * D + col0 + bj * HALF;
                        f32x4 o0, o1;
#pragma unroll
                        for (int j = 0; j < 4; ++j) {
                            float z = acc[ai][bj][m][0][j]; float sg = __builtin_amdgcn_rcpf(1.0f + __expf(-z)); float f = l0[j] + (1.0f - l0[j]) * sg; o0[j] = logf(fmaxf(f, 1e-30f));
                            z = acc[ai][bj][m][1][j]; sg = __builtin_amdgcn_rcpf(1.0f + __expf(-z)); f = l1[j] + (1.0f - l1[j]) * sg; o1[j] = logf(fmaxf(f, 1e-30f));
                        }
                        u32x4 lw; lw.x = cvt_pk_bf16(o0[0], o0[1]); lw.y = cvt_pk_bf16(o0[2], o0[3]); lw.z = cvt_pk_bf16(o1[0], o1[1]); lw.w = cvt_pk_bf16(o1[2], o1[3]);
                        *(u32x4*)rowp = lw;
                    }
            }
        } else {
            bf16_t* base = QVG + (size_t)(seg == 0 ? 0 : (seg == 2 ? 1 : 2)) * ((size_t)MTOK * D);
            const bool act = (seg != 2);
#pragma unroll
            for (int ai = 0; ai < 2; ++ai)
#pragma unroll
                for (int m = 0; m < 4; ++m)
#pragma unroll
                    for (int bj = 0; bj < 2; ++bj) {
                        f32x4 v0 = acc[ai][bj][m][0], v1 = acc[ai][bj][m][1];
                        if (act) {
#pragma unroll
                            for (int j = 0; j < 4; ++j) { v0[j] = silu_f(v0[j]); v1[j] = silu_f(v1[j]); }
                        }
                        u32x4 w; w.x = cvt_pk_bf16(v0[0], v0[1]); w.y = cvt_pk_bf16(v0[2], v0[3]); w.z = cvt_pk_bf16(v1[0], v1[1]); w.w = cvt_pk_bf16(v1[2], v1[3]);
                        *(u32x4*)(base + (size_t)(row0 + ai * HALF + m * 16) * D + col0 + bj * HALF) = w;
                    }
        }
    }
};
struct EpiResid {
    static constexpr bool PERM = true;
    const float* src; float* dst; const float* gate;
    __device__ __forceinline__ void operator()(const f32x4 (&acc)[2][2][4][2], const Unit& u, int wr, int wc, int fr, int fq) const {
        const int b = u.pm >> 5;
        const float* gp = gate + (size_t)b * 6144;
        const int row0 = u.pm * BM + wr * 64 + fr, col0 = u.pn * BM + wc * 32 + 8 * fq;
        f32x4 gv[2][2];
#pragma unroll
        for (int bj = 0; bj < 2; ++bj)
#pragma unroll
            for (int n = 0; n < 2; ++n) gv[bj][n] = *(const f32x4*)(gp + col0 + bj * HALF + 4 * n);
#pragma unroll
        for (int ai = 0; ai < 2; ++ai)
#pragma unroll
            for (int m = 0; m < 4; ++m) {
                const size_t ro = (size_t)(row0 + ai * HALF + m * 16) * D + col0;
#pragma unroll
                for (int bj = 0; bj < 2; ++bj)
#pragma unroll
                    for (int n = 0; n < 2; ++n) {
                        const f32x4 s = *(const f32x4*)(src + ro + bj * HALF + 4 * n);
                        *(f32x4*)(dst + ro + bj * HALF + 4 * n) = s + gv[bj][n] * acc[ai][bj][m][n];
                    }
            }
    }
};
struct EpiSwiglu {
    static constexpr bool PERM = true;
    bf16_t* act;
    __device__ __forceinline__ void operator()(const f32x4 (&acc)[2][2][4][2], const Unit& u, int wr, int wc, int fr, int fq) const {
        const int row0 = u.pm * BM + wr * 64 + fr, col0 = u.pn * HALF + wc * 32 + 8 * fq;
#pragma unroll
        for (int ai = 0; ai < 2; ++ai)
#pragma unroll
            for (int m = 0; m < 4; ++m) {
                f32x4 r0, r1;
#pragma unroll
                for (int j = 0; j < 4; ++j) { r0[j] = silu_f(acc[ai][0][m][0][j]) * acc[ai][1][m][0][j]; r1[j] = silu_f(acc[ai][0][m][1][j]) * acc[ai][1][m][1][j]; }
                u32x4 w; w.x = cvt_pk_bf16(r0[0], r0[1]); w.y = cvt_pk_bf16(r0[2], r0[3]); w.z = cvt_pk_bf16(r1[0], r1[1]); w.w = cvt_pk_bf16(r1[2], r1[3]);
                *(u32x4*)(act + (size_t)(row0 + ai * HALF + m * 16) * FFN + col0) = w;
            }
    }
};
struct EpiBf16Split {
    static constexpr bool PERM = true;
    bf16_t* d0; float scale;
    __device__ __forceinline__ void operator()(const f32x4 (&acc)[2][2][4][2], const Unit& u, int wr, int wc, int fr, int fq) const {
        bf16_t* base = d0 + (size_t)(u.pn >> 2) * ((size_t)MTOK * D);
        const int row0 = u.pm * BM + wr * 64 + fr, col0 = (u.pn & 3) * 256 + wc * 32 + 8 * fq;
#pragma unroll
        for (int ai = 0; ai < 2; ++ai)
#pragma unroll
            for (int m = 0; m < 4; ++m)
#pragma unroll
                for (int bj = 0; bj < 2; ++bj) {
                    const f32x4 v0 = acc[ai][bj][m][0] * scale, v1 = acc[ai][bj][m][1] * scale;
                    u32x4 w; w.x = cvt_pk_bf16(v0[0], v0[1]); w.y = cvt_pk_bf16(v0[2], v0[3]); w.z = cvt_pk_bf16(v1[0], v1[1]); w.w = cvt_pk_bf16(v1[2], v1[3]);
                    *(u32x4*)(base + (size_t)(row0 + ai * HALF + m * 16) * D + col0 + bj * HALF) = w;
                }
    }
};
}

template <class Epi>
__device__ __forceinline__ void run_gemm(unsigned char* shm, const bf16_t* A, const bf16_t* Bt, int N, int K, const Epi& E) {
    pg8::Gemm g; g.A = A; g.Bt = Bt; g.M = MTOK; g.N = N; g.K = K;
    pg8::StaticOrder S; S.init(MTOK, N, (int)gridDim.x, (int)blockIdx.x);
    pg8::gemm_phase<Epi>((LAS unsigned char*)shm, g, S, E);
    __syncthreads();
}

__device__ __forceinline__ int ffnmap(int nn) { return nn < FFN ? ((nn >> 7) * 256 + (nn & 127)) : (((nn - FFN) >> 7) * 256 + 128 + ((nn - FFN) & 127)); }

__device__ __forceinline__ void conv_group(const float* src0, bf16_t* dst0, const int K, const int N, const int L, const int mode, unsigned char* shm, const int tid) {
    float* st = (float*)shm;
    const int per = (K / 128) * (N / 64), total = L * per, ntn = N / 64;
    for (int tile = blockIdx.x; tile < total; tile += gridDim.x) {
        const int l = tile / per, tt = tile % per, k0 = (tt / ntn) * 128, n0 = (tt % ntn) * 64;
        const float* src = src0 + (size_t)l * K * N; bf16_t* dst = dst0 + (size_t)l * K * N;
        f32x4 v[4];
#pragma unroll
        for (int it = 0; it < 4; ++it) { const int idx = tid + it * 512, k = idx >> 4, n4 = idx & 15; v[it] = *(const f32x4*)(src + (size_t)(k0 + k) * N + n0 + 4 * n4); }
        __syncthreads();
#pragma unroll
        for (int it = 0; it < 4; ++it) { const int idx = tid + it * 512, k = idx >> 4, n4 = idx & 15;
#pragma unroll
            for (int e = 0; e < 4; ++e) st[k * 65 + 4 * n4 + e] = v[it][e]; }
        __syncthreads();
#pragma unroll
        for (int it = 0; it < 2; ++it) { const int idx = tid + it * 512, n = idx >> 4, kg = idx & 15; const int nn = n0 + n; const int drow = mode ? ffnmap(nn) : nn;
            u32x4 w;
#pragma unroll
            for (int e = 0; e < 4; ++e) w[e] = cvt_pk_bf16(st[(8 * kg + 2 * e) * 65 + n], st[(8 * kg + 2 * e + 1) * 65 + n]);
            *(u32x4*)(dst + (size_t)drow * K + k0 + 8 * kg) = w; }
    }
}

__device__ void prep_phase(const Params& p, unsigned char* shm) {
    const int tid = opaque_tid();
    {
        float* cact = (float*)shm;
        float* red = cact + 8192;
        bool loaded = false;
        const int wv = tid >> 6, lane = tid & 63;
        for (int task = blockIdx.x; task < 416; task += gridDim.x) {
            if (!loaded) {
                for (int i = tid; i < 8192; i += 512) { const int k = i >> 3, b = i & 7; cact[i] = silu_f(p.in[1][b * D + k]); }
                loaded = true;
            }
            __syncthreads();
            const int c0 = task * 64;
            const float* src; const float* bias; float* dst; int stride, dstride;
            if (c0 < 24576) { const int l = c0 / 6144, j = c0 % 6144; src = p.in[2] + (size_t)l * D * 6144 + j; stride = 6144; bias = p.in[3] + l * 6144 + j; dst = ((float*)(p.ws + OFF_MODV)) + (size_t)l * 8 * 6144 + j; dstride = 6144; }
            else { const int j = c0 - 24576; src = p.in[13] + j; stride = 2048; bias = p.in[14] + j; dst = ((float*)(p.ws + OFF_KVMOD)) + j; dstride = 2048; }
            float a[8];
#pragma unroll
            for (int b = 0; b < 8; ++b) a[b] = 0.f;
            const float* sp = src + (size_t)(wv * 128) * stride + lane;
#pragma unroll 8
            for (int k = 0; k < 128; ++k) {
                const float w = sp[(size_t)k * stride];
                const f32x4 c0v = *(const f32x4*)(cact + (wv * 128 + k) * 8), c1v = *(const f32x4*)(cact + (wv * 128 + k) * 8 + 4);
                a[0] += w * c0v[0]; a[1] += w * c0v[1]; a[2] += w * c0v[2]; a[3] += w * c0v[3];
                a[4] += w * c1v[0]; a[5] += w * c1v[1]; a[6] += w * c1v[2]; a[7] += w * c1v[3];
            }
#pragma unroll
            for (int b = 0; b < 8; ++b) red[(wv * 8 + b) * 64 + lane] = a[b];
            __syncthreads();
            {
                const int b = tid >> 6, col = tid & 63;
                float s = bias[col];
#pragma unroll
                for (int w = 0; w < 8; ++w) s += red[(w * 8 + b) * 64 + col];
                dst[(size_t)b * dstride + col] = s;
            }
        }
        __syncthreads();
    }
    for (int i = blockIdx.x * 512 + tid; i < 1024; i += gridDim.x * 512) {
        const float a0 = p.in[10][i], a1 = p.in[10][1024 + i];
        const float mx = fmaxf(a0, a1), e0 = __expf(a0 - mx), e1 = __expf(a1 - mx);
        ((float*)(p.ws + OFF_LBV))[i] = 0.f; ((float*)(p.ws + OFF_LBV))[1024 + i] = e1 / (e0 + e1);
    }
    conv_group(p.in[8], (bf16_t*)(p.ws + OFF_WB_A_IN), D, AIN, 2, 0, shm, tid);
    conv_group(p.in[9], (bf16_t*)(p.ws + OFF_WB_A_OUT), D, D, 2, 0, shm, tid);
    conv_group(p.in[6], (bf16_t*)(p.ws + OFF_WB_FFN_IN), D, 2 * FFN, 4, 1, shm, tid);
    conv_group(p.in[7], (bf16_t*)(p.ws + OFF_WB_FFN_OUT), FFN, D, 4, 0, shm, tid);
    conv_group(p.in[15], (bf16_t*)(p.ws + OFF_WB_KV), D, 2 * D, 1, 0, shm, tid);
    conv_group(p.in[16], (bf16_t*)(p.ws + OFF_WB_Q), D, D, 2, 0, shm, tid);
    conv_group(p.in[17], (bf16_t*)(p.ws + OFF_WB_O), D, D, 2, 0, shm, tid);
    __syncthreads();
}

__device__ void norm_phase(const float* src, bf16_t* U1, const float* gain1, const float* sh1, const float* sc1, int bs1,
                           bf16_t* U2, const float* gain2, const float* sh2, const float* sc2, int bs2) {
    const int tid_ = opaque_tid(); const int lane = tid_ & 63, gw = blockIdx.x * 8 + (tid_ >> 6), nw = gridDim.x * 8;
    for (int row = 2 * gw; row < MTOK; row += 2 * nw) {
        const int b = row >> 13;
        const float* xp = src + (size_t)row * D;
        f32x4 xv[2][4]; float ss[2] = {0.f, 0.f};
#pragma unroll
        for (int r = 0; r < 2; ++r)
#pragma unroll
            for (int i = 0; i < 4; ++i) xv[r][i] = *(const f32x4*)(xp + (size_t)r * D + i * 256 + lane * 4);
#pragma unroll
        for (int r = 0; r < 2; ++r)
#pragma unroll
            for (int i = 0; i < 4; ++i) ss[r] += xv[r][i][0] * xv[r][i][0] + xv[r][i][1] * xv[r][i][1] + xv[r][i][2] * xv[r][i][2] + xv[r][i][3] * xv[r][i][3];
#pragma unroll
        for (int o = 1; o < 64; o <<= 1) { ss[0] += __shfl_xor(ss[0], o); ss[1] += __shfl_xor(ss[1], o); }
        const float rstd0 = rsqrtf(ss[0] * (1.0f / D) + 1e-6f), rstd1 = rsqrtf(ss[1] * (1.0f / D) + 1e-6f);
#pragma unroll
        for (int i = 0; i < 4; ++i) {
            const int k = i * 256 + lane * 4;
            const f32x4 g = *(const f32x4*)(gain1 + k), s = *(const f32x4*)(sc1 + (size_t)b * bs1 + k), t = *(const f32x4*)(sh1 + (size_t)b * bs1 + k);
            f32x4 u0, u1;
#pragma unroll
            for (int j = 0; j < 4; ++j) { const float ga = g[j] * (1.0f + s[j]); u0[j] = (xv[0][i][j] * rstd0) * ga + t[j]; u1[j] = (xv[1][i][j] * rstd1) * ga + t[j]; }
            u32x2 w0, w1; w0.x = cvt_pk_bf16(u0[0], u0[1]); w0.y = cvt_pk_bf16(u0[2], u0[3]); w1.x = cvt_pk_bf16(u1[0], u1[1]); w1.y = cvt_pk_bf16(u1[2], u1[3]);
            *(u32x2*)(U1 + (size_t)row * D + k) = w0; *(u32x2*)(U1 + (size_t)(row + 1) * D + k) = w1;
        }
        if (U2) {
#pragma unroll
            for (int i = 0; i < 4; ++i) {
                const int k = i * 256 + lane * 4;
                const f32x4 g = *(const f32x4*)(gain2 + k), s = *(const f32x4*)(sc2 + (size_t)b * bs2 + k), t = *(const f32x4*)(sh2 + (size_t)b * bs2 + k);
                f32x4 u0, u1;
#pragma unroll
                for (int j = 0; j < 4; ++j) { const float ga = g[j] * (1.0f + s[j]); u0[j] = (xv[0][i][j] * rstd0) * ga + t[j]; u1[j] = (xv[1][i][j] * rstd1) * ga + t[j]; }
                u32x2 w0, w1; w0.x = cvt_pk_bf16(u0[0], u0[1]); w0.y = cvt_pk_bf16(u0[2], u0[3]); w1.x = cvt_pk_bf16(u1[0], u1[1]); w1.y = cvt_pk_bf16(u1[2], u1[3]);
                *(u32x2*)(U2 + (size_t)row * D + k) = w0; *(u32x2*)(U2 + (size_t)(row + 1) * D + k) = w1;
            }
        }
    }
}
__device__ void final_norm_phase(float* h, const float* gain) {
    const int tid_ = opaque_tid(); const int lane = tid_ & 63, gw = blockIdx.x * 8 + (tid_ >> 6), nw = gridDim.x * 8;
    for (int row = gw; row < MTOK; row += nw) {
        float* xp = h + (size_t)row * D;
        f32x4 xv[4]; float ss = 0.f;
#pragma unroll
        for (int i = 0; i < 4; ++i) { xv[i] = *(const f32x4*)(xp + i * 256 + lane * 4); ss += xv[i][0] * xv[i][0] + xv[i][1] * xv[i][1] + xv[i][2] * xv[i][2] + xv[i][3] * xv[i][3]; }
#pragma unroll
        for (int o = 1; o < 64; o <<= 1) ss += __shfl_xor(ss, o);
        const float rstd = rsqrtf(ss * (1.0f / D) + 1e-6f);
#pragma unroll
        for (int i = 0; i < 4; ++i) {
            const int k = i * 256 + lane * 4;
            const f32x4 g = *(const f32x4*)(gain + k);
            f32x4 u;
#pragma unroll
            for (int j = 0; j < 4; ++j) u[j] = xv[i][j] * rstd * g[j];
            *(f32x4*)(xp + k) = u;
        }
    }
}

template <bool OUT>
__device__ void rec_pass(const Params& p, int layer, unsigned char* shm) {
    float* sB = (float*)shm;
    float* sKm = (float*)(shm + 33792);
    bf16_t* sST = (bf16_t*)shm;
    bf16_t* sQb = (bf16_t*)(shm + 67584);
    bf16_t* sA = (bf16_t*)(shm + 84992);
    bf16_t* sKT = (bf16_t*)(shm + 94208);
    bf16_t* sVT = (bf16_t*)(shm + 112640);
    float* sE = (float*)(shm + 131072);
    float* sPart = (float*)(shm + 131584);
    float* sNrm = (float*)(shm + 135680);
    const int tid = opaque_tid(), lane = tid & 63, w = tid >> 6, fr = lane & 15, fq = lane >> 4;
    const int wi = w >> 1, wh = w & 1;
    const int ntask = OUT ? 256 : 192;
    const float* ogain = p.in[11] + layer * 128;
    for (int task = blockIdx.x; task < ntask; task += gridDim.x) {
        int sc, bh; if (OUT) { sc = task & 3; bh = task >> 2; } else { sc = task % 3; bh = task / 3; }
        const int b = bh >> 3, h = bh & 7;
        f32x4 S[8];
#pragma unroll
        for (int db = 0; db < 8; ++db) S[db] = (f32x4){0.f, 0.f, 0.f, 0.f};
        if (OUT) {
            for (int s2 = 0; s2 < sc; ++s2) {
                const float* sl = ((float*)(p.ws + OFF_SLOC)) + (size_t)(bh * 4 + s2) * 16384; const float* dl = ((float*)(p.ws + OFF_DLOG)) + (bh * 4 + s2) * 128;
#pragma unroll
                for (int db = 0; db < 8; ++db) {
                    const f32x4 x = *(const f32x4*)(sl + ((w * 8 + db) * 64 + lane) * 4), dv = *(const f32x4*)(dl + 16 * db + fq * 4);
#pragma unroll
                    for (int j = 0; j < 4; ++j) S[db][j] = S[db][j] * __expf(dv[j]) + x[j];
                }
            }
        }
        float dlacc = 0.f;
        unsigned lfn[8]; u32x4 vn0, vn1;
        const bf16_t* LFb = (const bf16_t*)(p.ws + OFF_LF);
        const int d2 = (tid & 63) * 2, tq = tid >> 6;
        {
            const size_t r0 = (size_t)b * SEQ + (size_t)(sc * 32) * 64;
            const bf16_t* lp = LFb + (r0 + 8 * tq) * D + h * 128 + d2;
#pragma unroll
            for (int e = 0; e < 8; ++e) lfn[e] = *(const unsigned*)(lp + (size_t)e * D);
            vn0 = *(const u32x4*)(((bf16_t*)(p.ws + OFF_VH)) + (r0 + (tid & 63)) * D + h * 128 + (tid >> 6) * 8);
            vn1 = *(const u32x4*)(((bf16_t*)(p.ws + OFF_VH)) + (r0 + (tid & 63)) * D + h * 128 + 64 + (tid >> 6) * 8);
        }
        for (int ch = sc * 32; ch < sc * 32 + 32; ++ch) {
            const size_t row0 = (size_t)b * SEQ + (size_t)ch * 64;
            float la[8], lb2[8];
#pragma unroll
            for (int e = 0; e < 8; ++e) { la[e] = bflo(lfn[e]); lb2[e] = bfhi(lfn[e]); }
            const u32x4 vr0 = vn0, vr1 = vn1;
            u32x4 qraw[4]; u32x2 graw[4];
            if (OUT) {
#pragma unroll
                for (int ks = 0; ks < 4; ++ks) qraw[ks] = *(const u32x4*)(((bf16_t*)(p.ws + OFF_QH)) + (row0 + 16 * wi + fr) * D + h * 128 + ks * 32 + fq * 8);
#pragma unroll
                for (int vb = 0; vb < 4; ++vb) graw[vb] = *(const u32x2*)(((bf16_t*)(p.ws + OFF_GH)) + (row0 + 16 * wi + fr) * D + h * 128 + 64 * wh + 16 * vb + fq * 4);
            }
            {
                float ra = 0.f, rb = 0.f, ka[8], kb2[8];
#pragma unroll
                for (int e = 0; e < 8; ++e) {
                    ka[e] = 1.0f - __expf(la[e]); kb2[e] = 1.0f - __expf(lb2[e]);
                    *(f32x2*)(sKm + (8 * tq + e) * 132 + d2) = (f32x2){ka[e], kb2[e]};
                    ra += la[e]; la[e] = ra; rb += lb2[e]; lb2[e] = rb;
                }
                *(f32x2*)(sPart + tq * 128 + d2) = (f32x2){ra, rb};
                {
                    const int s_ = tid & 63, pc = tid >> 6;
#pragma unroll
                    for (int e = 0; e < 8; ++e) {
                        sVT[(pc * 8 + e) * 72 + s_] = (bf16_t)((e & 1) ? (vr0[e >> 1] >> 16) : (vr0[e >> 1] & 0xffffu));
                        sVT[(64 + pc * 8 + e) * 72 + s_] = (bf16_t)((e & 1) ? (vr1[e >> 1] >> 16) : (vr1[e >> 1] & 0xffffu));
                    }
                }
                __syncthreads();
                float offa = 0.f, offb = 0.f, tota = 0.f, totb = 0.f;
#pragma unroll
                for (int q = 0; q < 8; ++q) { const f32x2 pq = *(const f32x2*)(sPart + q * 128 + d2); tota += pq[0]; totb += pq[1]; if (q < tq) { offa += pq[0]; offb += pq[1]; } }
                if (tq == 0) { *(f32x2*)(sE + d2) = (f32x2){__expf(tota), __expf(totb)}; }
                u32x4 kwa, kwb;
#pragma unroll
                for (int e = 0; e < 8; e += 2) {
                    const float a0 = la[e] + offa, a1 = la[e + 1] + offa, b0 = lb2[e] + offb, b1 = lb2[e + 1] + offb;
                    *(f32x2*)(sB + (8 * tq + e) * 132 + d2) = (f32x2){a0, b0}; *(f32x2*)(sB + (8 * tq + e + 1) * 132 + d2) = (f32x2){a1, b1};
                    kwa[e >> 1] = cvt_pk_bf16(ka[e] * __expf(tota - a0), ka[e + 1] * __expf(tota - a1));
                    kwb[e >> 1] = cvt_pk_bf16(kb2[e] * __expf(totb - b0), kb2[e + 1] * __expf(totb - b1));
                }
                *(u32x4*)(sKT + d2 * 72 + 8 * tq) = kwa; *(u32x4*)(sKT + (d2 + 1) * 72 + 8 * tq) = kwb;
            }
            __syncthreads();
            if (ch + 1 < sc * 32 + 32) {
                const size_t r1 = row0 + 64;
                const bf16_t* lp = LFb + (r1 + 8 * tq) * D + h * 128 + d2;
#pragma unroll
                for (int e = 0; e < 8; ++e) lfn[e] = *(const unsigned*)(lp + (size_t)e * D);
                vn0 = *(const u32x4*)(((bf16_t*)(p.ws + OFF_VH)) + (r1 + (tid & 63)) * D + h * 128 + (tid >> 6) * 8);
                vn1 = *(const u32x4*)(((bf16_t*)(p.ws + OFF_VH)) + (r1 + (tid & 63)) * D + h * 128 + 64 + (tid >> 6) * 8);
            }
            if (OUT) {
                const int i = wi, hh = wh, t_ = 16 * i + fr;
                bf16x8 qt[4];
#pragma unroll
                for (int ks = 0; ks < 4; ++ks) {
                    const int d0 = ks * 32 + fq * 8;
                    const f32x4 b0 = *(const f32x4*)(sB + t_ * 132 + d0), b1 = *(const f32x4*)(sB + t_ * 132 + d0 + 4);
                    f32x4 r0 = (f32x4){0.f, 0.f, 0.f, 0.f}, r1 = r0;
                    if (i > 0) { r0 = *(const f32x4*)(sB + (16 * i - 1) * 132 + d0); r1 = *(const f32x4*)(sB + (16 * i - 1) * 132 + d0 + 4); }
                    float qv[8], ql[8];
#pragma unroll
                    for (int e = 0; e < 4; ++e) { qv[2 * e] = bflo(qraw[ks][e]); qv[2 * e + 1] = bfhi(qraw[ks][e]); }
#pragma unroll
                    for (int e = 0; e < 4; ++e) { ql[e] = qv[e] * __expf(b0[e] - r0[e]); ql[4 + e] = qv[4 + e] * __expf(b1[e] - r1[e]); }
                    u32x4 pw; pw.x = cvt_pk_bf16(ql[0], ql[1]); pw.y = cvt_pk_bf16(ql[2], ql[3]); pw.z = cvt_pk_bf16(ql[4], ql[5]); pw.w = cvt_pk_bf16(ql[6], ql[7]);
                    qt[ks] = __builtin_bit_cast(bf16x8, pw);
                    if ((ks >> 1) == hh) {
#pragma unroll
                        for (int e = 0; e < 4; ++e) { ql[e] = qv[e] * __expf(b0[e]); ql[4 + e] = qv[4 + e] * __expf(b1[e]); }
                        u32x4 qw; qw.x = cvt_pk_bf16(ql[0], ql[1]); qw.y = cvt_pk_bf16(ql[2], ql[3]); qw.z = cvt_pk_bf16(ql[4], ql[5]); qw.w = cvt_pk_bf16(ql[6], ql[7]);
                        *(u32x4*)(sQb + t_ * 136 + d0) = qw;
                    }
                }
#pragma unroll
                for (int j2 = 0; j2 < 2; ++j2) {
                    const int j = hh + 2 * j2;
                    if (j <= i) {
                        f32x4 acc = (f32x4){0.f, 0.f, 0.f, 0.f};
                        const int s_ = 16 * j + fr;
#pragma unroll
                        for (int ks = 0; ks < 4; ++ks) {
                            const int d0 = ks * 32 + fq * 8;
                            const f32x4 k0 = *(const f32x4*)(sKm + s_ * 132 + d0), k1 = *(const f32x4*)(sKm + s_ * 132 + d0 + 4);
                            const f32x4 b0 = *(const f32x4*)(sB + s_ * 132 + d0), b1 = *(const f32x4*)(sB + s_ * 132 + d0 + 4);
                            f32x4 r0 = (f32x4){0.f, 0.f, 0.f, 0.f}, r1 = r0;
                            if (i > 0) { r0 = *(const f32x4*)(sB + (16 * i - 1) * 132 + d0); r1 = *(const f32x4*)(sB + (16 * i - 1) * 132 + d0 + 4); }
                            float kl[8];
#pragma unroll
                            for (int e = 0; e < 4; ++e) { kl[e] = k0[e] * __expf(fminf(r0[e] - b0[e], 80.f)); kl[4 + e] = k1[e] * __expf(fminf(r1[e] - b1[e], 80.f)); }
                            u32x4 kw; kw.x = cvt_pk_bf16(kl[0], kl[1]); kw.y = cvt_pk_bf16(kl[2], kl[3]); kw.z = cvt_pk_bf16(kl[4], kl[5]); kw.w = cvt_pk_bf16(kl[6], kl[7]);
                            acc = __builtin_amdgcn_mfma_f32_16x16x32_bf16(qt[ks], __builtin_bit_cast(bf16x8, kw), acc, 0, 0, 0);
                        }
#pragma unroll
                        for (int jj = 0; jj < 4; ++jj) {
                            float vv = acc[jj];
                            if (i == j && fr > fq * 4 + jj) vv = 0.f;
                            sA[(16 * i + fq * 4 + jj) * 72 + 16 * j + fr] = (bf16_t)(cvt_pk_bf16(vv, 0.f) & 0xffffu);
                        }
                    } else {
#pragma unroll
                        for (int jj = 0; jj < 4; ++jj) sA[(16 * i + fq * 4 + jj) * 72 + 16 * j + fr] = (bf16_t)0;
                    }
                }
            }
            __syncthreads();
            if (OUT) {
#pragma unroll
                for (int db = 0; db < 8; ++db) { u32x2 sw; sw.x = cvt_pk_bf16(S[db][0], S[db][1]); sw.y = cvt_pk_bf16(S[db][2], S[db][3]); *(u32x2*)(sST + (16 * w + fr) * 136 + 16 * db + fq * 4) = sw; }
                __syncthreads();
            }
            f32x4 o[4];
            if (OUT) {
                const int i = wi;
#pragma unroll
                for (int vb = 0; vb < 4; ++vb) o[vb] = (f32x4){0.f, 0.f, 0.f, 0.f};
#pragma unroll
                for (int kk = 0; kk < 2; ++kk) {
                    if (kk <= (i >> 1)) {
                        const bf16x8 af = *(const bf16x8*)(sA + (16 * i + fr) * 72 + kk * 32 + fq * 8);
#pragma unroll
                        for (int vb = 0; vb < 4; ++vb) { const bf16x8 vf = *(const bf16x8*)(sVT + (64 * wh + 16 * vb + fr) * 72 + kk * 32 + fq * 8); o[vb] = __builtin_amdgcn_mfma_f32_16x16x32_bf16(vf, af, o[vb], 0, 0, 0); }
                    }
                }
#pragma unroll
                for (int ks = 0; ks < 4; ++ks) {
                    const bf16x8 qf = *(const bf16x8*)(sQb + (16 * i + fr) * 136 + ks * 32 + fq * 8);
#pragma unroll
                    for (int vb = 0; vb < 4; ++vb) { const bf16x8 sf = *(const bf16x8*)(sST + (64 * wh + 16 * vb + fr) * 136 + ks * 32 + fq * 8); o[vb] = __builtin_amdgcn_mfma_f32_16x16x32_bf16(sf, qf, o[vb], 0, 0, 0); }
                }
                float ss = 0.f;
#pragma unroll
                for (int vb = 0; vb < 4; ++vb)
#pragma unroll
                    for (int jj = 0; jj < 4; ++jj) ss += o[vb][jj] * o[vb][jj];
                ss += __shfl_xor(ss, 16); ss += __shfl_xor(ss, 32);
                if (fq == 0) sNrm[wh * 64 + 16 * i + fr] = ss;
            }
#pragma unroll
            for (int db = 0; db < 8; ++db) { const f32x4 e4 = *(const f32x4*)(sE + 16 * db + fq * 4); S[db] = S[db] * e4; }
#pragma unroll
            for (int ks = 0; ks < 2; ++ks) {
                const bf16x8 vf = *(const bf16x8*)(sVT + (16 * w + fr) * 72 + ks * 32 + fq * 8);
#pragma unroll
                for (int db = 0; db < 8; ++db) { const bf16x8 kf = *(const bf16x8*)(sKT + (16 * db + fr) * 72 + ks * 32 + fq * 8); S[db] = __builtin_amdgcn_mfma_f32_16x16x32_bf16(kf, vf, S[db], 0, 0, 0); }
            }
            __syncthreads();
            if (OUT) {
                const int i = wi;
                const float tot = sNrm[16 * i + fr] + sNrm[64 + 16 * i + fr];
                const float rstd = rsqrtf(tot * (1.0f / 128.0f) + 1e-6f);
                bf16_t* op = ((bf16_t*)(p.ws + OFF_U)) + (row0 + 16 * i + fr) * D + h * 128 + 64 * wh + fq * 4;
#pragma unroll
                for (int vb = 0; vb < 4; ++vb) {
                    const f32x4 gn = *(const f32x4*)(ogain + 64 * wh + 16 * vb + fq * 4);
                    const float g0 = bflo(graw[vb].x), g1 = bfhi(graw[vb].x), g2 = bflo(graw[vb].y), g3 = bfhi(graw[vb].y);
                    u32x2 ow; ow.x = cvt_pk_bf16(o[vb][0] * rstd * gn[0] * g0, o[vb][1] * rstd * gn[1] * g1); ow.y = cvt_pk_bf16(o[vb][2] * rstd * gn[2] * g2, o[vb][3] * rstd * gn[3] * g3);
                    *(u32x2*)(op + 16 * vb) = ow;
                }
            }
        }
        if (!OUT) {
            float* sl = ((float*)(p.ws + OFF_SLOC)) + (size_t)(bh * 4 + sc) * 16384;
#pragma unroll
            for (int db = 0; db < 8; ++db) *(f32x4*)(sl + ((w * 8 + db) * 64 + lane) * 4) = S[db];
            if (tid < 128) ((float*)(p.ws + OFF_DLOG))[(bh * 4 + sc) * 128 + tid] = dlacc;
        }
    }
    __syncthreads();
}

__device__ void rec_passA(const Params& p, unsigned char* shm) {
    bf16_t* sKT = (bf16_t*)shm;
    bf16_t* sVT = (bf16_t*)(shm + 34816);
    float* sE = (float*)(shm + 69632);
    float* sPart = (float*)(shm + 70144);
    const int tid = opaque_tid(), lane = tid & 63, w = tid >> 6, fr = lane & 15, fq = lane >> 4;
    const int d2 = (tid & 63) * 2, tq = tid >> 6;
    const int vs = tid & 127, vq = tid >> 7;
    const bf16_t* LFb = (const bf16_t*)(p.ws + OFF_LF); const bf16_t* Vp = (const bf16_t*)(p.ws + OFF_VH);
    for (int task = blockIdx.x; task < 192; task += gridDim.x) {
        const int sc = task % 3, bh = task / 3, b = bh >> 3, h = bh & 7;
        f32x4 S[8];
#pragma unroll
        for (int db = 0; db < 8; ++db) S[db] = (f32x4){0.f, 0.f, 0.f, 0.f};
        float dla = 0.f, dlb = 0.f;
        const size_t rbase = (size_t)b * SEQ + (size_t)sc * 2048;
        unsigned lfn[16]; u32x4 vn[4];
        {
            const bf16_t* lp = LFb + (rbase + 16 * tq) * D + h * 128 + d2;
#pragma unroll
            for (int e = 0; e < 16; ++e) lfn[e] = *(const unsigned*)(lp + (size_t)e * D);
#pragma unroll
            for (int i = 0; i < 4; ++i) vn[i] = *(const u32x4*)(Vp + (rbase + vs) * D + h * 128 + (vq + 4 * i) * 8);
        }
        __syncthreads();
        for (int cc = 0; cc < 16; ++cc) {
            const size_t row0 = rbase + (size_t)cc * 128;
            unsigned lf[16]; u32x4 vr[4];
            float ra = 0.f, rb = 0.f;
#pragma unroll
            for (int e = 0; e < 16; ++e) { lf[e] = lfn[e]; ra += bflo(lf[e]); rb += bfhi(lf[e]); }
#pragma unroll
            for (int i = 0; i < 4; ++i) vr[i] = vn[i];
            *(f32x2*)(sPart + tq * 128 + d2) = (f32x2){ra, rb};
            __syncthreads();
            if (cc + 1 < 16) {
                const bf16_t* lp = LFb + (row0 + 128 + 16 * tq) * D + h * 128 + d2;
#pragma unroll
                for (int e = 0; e < 16; ++e) lfn[e] = *(const unsigned*)(lp + (size_t)e * D);
#pragma unroll
                for (int i = 0; i < 4; ++i) vn[i] = *(const u32x4*)(Vp + (row0 + 128 + vs) * D + h * 128 + (vq + 4 * i) * 8);
            }
            float ba = 0.f, bb = 0.f, tota = 0.f, totb = 0.f;
#pragma unroll
            for (int q = 0; q < 8; ++q) { const f32x2 pq = *(const f32x2*)(sPart + q * 128 + d2); tota += pq[0]; totb += pq[1]; if (q < tq) { ba += pq[0]; bb += pq[1]; } }
            if (tq == 0) { *(f32x2*)(sE + d2) = (f32x2){__expf(tota), __expf(totb)}; dla += tota; dlb += totb; }
#pragma unroll
            for (int g8 = 0; g8 < 2; ++g8) {
                u32x4 kwa, kwb;
#pragma unroll
                for (int e = 0; e < 8; e += 2) {
                    const float la0 = bflo(lf[8 * g8 + e]), lb0 = bfhi(lf[8 * g8 + e]), la1 = bflo(lf[8 * g8 + e + 1]), lb1 = bfhi(lf[8 * g8 + e + 1]);
                    const float a0 = ba + la0, a1 = a0 + la1; ba = a1;
                    const float b0 = bb + lb0, b1 = b0 + lb1; bb = b1;
                    kwa[e >> 1] = cvt_pk_bf16((1.0f - __expf(la0)) * __expf(tota - a0), (1.0f - __expf(la1)) * __expf(tota - a1));
                    kwb[e >> 1] = cvt_pk_bf16((1.0f - __expf(lb0)) * __expf(totb - b0), (1.0f - __expf(lb1)) * __expf(totb - b1));
                }
                *(u32x4*)(sKT + d2 * 136 + 16 * tq + 8 * g8) = kwa; *(u32x4*)(sKT + (d2 + 1) * 136 + 16 * tq + 8 * g8) = kwb;
            }
#pragma unroll
            for (int i = 0; i < 4; ++i)
#pragma unroll
                for (int e = 0; e < 8; ++e) sVT[((vq + 4 * i) * 8 + e) * 136 + vs] = (bf16_t)((e & 1) ? (vr[i][e >> 1] >> 16) : (vr[i][e >> 1] & 0xffffu));
            __syncthreads();
#pragma unroll
            for (int db = 0; db < 8; ++db) { const f32x4 e4 = *(const f32x4*)(sE + 16 * db + fq * 4); S[db] = S[db] * e4; }
#pragma unroll
            for (int ks = 0; ks < 4; ++ks) {
                const bf16x8 vf = *(const bf16x8*)(sVT + (16 * w + fr) * 136 + ks * 32 + fq * 8);
#pragma unroll
                for (int db = 0; db < 8; ++db) { const bf16x8 kf = *(const bf16x8*)(sKT + (16 * db + fr) * 136 + ks * 32 + fq * 8); S[db] = __builtin_amdgcn_mfma_f32_16x16x32_bf16(kf, vf, S[db], 0, 0, 0); }
            }
        }
        float* sl = (float*)(p.ws + OFF_SLOC) + (size_t)(bh * 4 + sc) * 16384;
#pragma unroll
        for (int db = 0; db < 8; ++db) *(f32x4*)(sl + ((w * 8 + db) * 64 + lane) * 4) = S[db];
        if (tq == 0) *(f32x2*)((float*)(p.ws + OFF_DLOG) + (bh * 4 + sc) * 128 + d2) = (f32x2){dla, dlb};
    }
    __syncthreads();
}

__device__ void attn_phase(const Params& p, int jl, unsigned char* shm) {
    bf16_t* sK = (bf16_t*)shm;
    bf16_t* sVT = sK + 2 * 9216;
    float* sB = (float*)(sVT + 2 * 8704);
    const int tid = opaque_tid(), lane = tid & 63, w = tid >> 6, fr = lane & 15, fq = lane >> 4;
    const int cq = w >> 1, half = w & 1;
    const float LOG2E = 1.4426950408889634f;
    const int skey = tid >> 3, spiece = tid & 7, vkey = tid & 63, vpiece = tid >> 6;
    const bf16_t* Kg = (const bf16_t*)(p.ws + OFF_KB); const bf16_t* Vg = (const bf16_t*)(p.ws + OFF_VB); const bf16_t* Qg = (const bf16_t*)(p.ws + OFF_QB);
    for (int task = blockIdx.x; task < 4096; task += gridDim.x) {
        const int g = task & 31, h = (task >> 5) & 15, b = task >> 9;
        const int c = 4 * g + cq;
        const int dt0 = (2 * g - 4 > 0) ? 2 * g - 4 : 0, dt1 = 2 * g + 1;
        __syncthreads();
        for (int i = tid; i < 384; i += 512) { int r = i - 64; r = r < 0 ? 0 : (r > 319 ? 319 : r); sB[i] = p.in[18][((size_t)jl * 320 + r) * 16 + h] * LOG2E; }
        bf16x8 qf[2][2];
        {
            const bf16_t* qp = Qg + ((size_t)b * SEQ + c * 64 + half * 32) * D + h * 64;
#pragma unroll
            for (int qb = 0; qb < 2; ++qb)
#pragma unroll
                for (int ks = 0; ks < 2; ++ks) qf[qb][ks] = *(const bf16x8*)(qp + (size_t)(qb * 16 + fr) * D + ks * 32 + fq * 8);
        }
        f32x4 oacc[4][2];
#pragma unroll
        for (int db = 0; db < 4; ++db)
#pragma unroll
            for (int qb = 0; qb < 2; ++qb) oacc[db][qb] = (f32x4){0.f, 0.f, 0.f, 0.f};
        float mrun[2] = {-1e30f, -1e30f}, lrun[2] = {0.f, 0.f};
        u32x4 kreg[2], vreg[2];
        const size_t tokb = (size_t)b * SEQ;
#define ATT_GLOAD(dt_) do { _Pragma("unroll") for (int hf_ = 0; hf_ < 2; ++hf_) { \
            kreg[hf_] = *(const u32x4*)(Kg + (tokb + (size_t)(dt_) * 128 + hf_ * 64 + skey) * D + h * 64 + spiece * 8); \
            vreg[hf_] = *(const u32x4*)(Vg + (tokb + (size_t)(dt_) * 128 + hf_ * 64 + vkey) * D + h * 64 + vpiece * 8); } } while (0)
#define ATT_LSTORE(buf_) do { _Pragma("unroll") for (int hf_ = 0; hf_ < 2; ++hf_) { \
            *(u32x4*)(sK + (buf_) * 9216 + (hf_ * 64 + skey) * 72 + spiece * 8) = kreg[hf_]; \
            bf16_t* vt_ = sVT + (buf_) * 8704 + (vpiece * 8) * 136 + hf_ * 64 + vkey; \
            _Pragma("unroll") for (int e_ = 0; e_ < 8; ++e_) vt_[e_ * 136] = (bf16_t)((e_ & 1) ? (vreg[hf_][e_ >> 1] >> 16) : (vreg[hf_][e_ >> 1] & 0xffffu)); } } while (0)
        ATT_GLOAD(dt0); ATT_LSTORE(0);
        __syncthreads();
        for (int dt = dt0; dt <= dt1; ++dt) {
            const int buf = (dt - dt0) & 1;
            if (dt < dt1) ATT_GLOAD(dt + 1);
            const bool act0 = (2 * dt >= c - 8) && (2 * dt <= c), act1 = (2 * dt + 1 >= c - 8) && (2 * dt + 1 <= c);
            if (act0 || act1) {
                const bf16_t* kb_ = sK + buf * 9216; const bf16_t* vb_ = sVT + buf * 8704;
                f32x4 sacc[2][4][2];
#pragma unroll
                for (int hf = 0; hf < 2; ++hf) {
                    if (hf == 0 ? act0 : act1) {
#pragma unroll
                        for (int kb = 0; kb < 4; ++kb)
#pragma unroll
                            for (int qb = 0; qb < 2; ++qb) sacc[hf][kb][qb] = (f32x4){0.f, 0.f, 0.f, 0.f};
#pragma unroll
                        for (int kb = 0; kb < 4; ++kb)
#pragma unroll
                            for (int ks = 0; ks < 2; ++ks) {
                                const bf16x8 kf = *(const bf16x8*)(kb_ + (hf * 64 + kb * 16 + fr) * 72 + ks * 32 + fq * 8);
#pragma unroll
                                for (int qb = 0; qb < 2; ++qb) sacc[hf][kb][qb] = __builtin_amdgcn_mfma_f32_16x16x32_bf16(kf, qf[qb][ks], sacc[hf][kb][qb], 0, 0, 0);
                            }
                    }
                }
                float mx[2] = {-3e38f, -3e38f};
#pragma unroll
                for (int hf = 0; hf < 2; ++hf) {
                    if (hf == 0 ? act0 : act1) {
                        const int dk = 2 * dt + hf - c;
                        if (dk <= -5) {
                            const float b0 = sB[0];
#pragma unroll
                            for (int kb = 0; kb < 4; ++kb)
#pragma unroll
                                for (int qb = 0; qb < 2; ++qb) sacc[hf][kb][qb] = sacc[hf][kb][qb] * LOG2E + b0;
                        } else {
                            const float* bp = sB + (dk * 64 + fq * 4 - half * 32 - fr + 256 + 64 - 16);
#pragma unroll
                            for (int kb = 0; kb < 4; ++kb)
#pragma unroll
                                for (int qb = 0; qb < 2; ++qb)
#pragma unroll
                                    for (int j = 0; j < 4; ++j) sacc[hf][kb][qb][j] = sacc[hf][kb][qb][j] * LOG2E + bp[kb * 16 + j - qb * 16 + 16];
                        }
#pragma unroll
                        for (int qb = 0; qb < 2; ++qb)
#pragma unroll
                            for (int kb = 0; kb < 4; ++kb)
#pragma unroll
                                for (int j = 0; j < 4; ++j) mx[qb] = fmaxf(mx[qb], sacc[hf][kb][qb][j]);
                    }
                }
                if (__any((mx[0] > mrun[0] + 6.0f) || (mx[1] > mrun[1] + 6.0f))) {
#pragma unroll
                    for (int qb = 0; qb < 2; ++qb) {
                        float m2 = fmaxf(mx[qb], __shfl_xor(mx[qb], 16)); m2 = fmaxf(m2, __shfl_xor(m2, 32));
                        const float mn = fmaxf(mrun[qb], m2), corr = __builtin_amdgcn_exp2f(mrun[qb] - mn);
                        mrun[qb] = mn; lrun[qb] *= corr;
#pragma unroll
                        for (int db = 0; db < 4; ++db) oacc[db][qb] = oacc[db][qb] * corr;
                    }
                }
#pragma unroll
                for (int hf = 0; hf < 2; ++hf) {
                    if (hf == 0 ? act0 : act1) {
                        bf16x8 pf[2][2];
#pragma unroll
                        for (int qb = 0; qb < 2; ++qb) {
                            const float mn = mrun[qb];
                            float ps = 0.f;
#pragma unroll
                            for (int kb = 0; kb < 4; ++kb)
#pragma unroll
                                for (int j = 0; j < 4; ++j) { const float pv = __builtin_amdgcn_exp2f(sacc[hf][kb][qb][j] - mn); sacc[hf][kb][qb][j] = pv; ps += pv; }
                            lrun[qb] += ps;
#pragma unroll
                            for (int kk = 0; kk < 2; ++kk) {
                                u32x4 pw;
                                pw.x = cvt_pk_bf16(sacc[hf][2 * kk][qb][0], sacc[hf][2 * kk][qb][1]); pw.y = cvt_pk_bf16(sacc[hf][2 * kk][qb][2], sacc[hf][2 * kk][qb][3]);
                                pw.z = cvt_pk_bf16(sacc[hf][2 * kk + 1][qb][0], sacc[hf][2 * kk + 1][qb][1]); pw.w = cvt_pk_bf16(sacc[hf][2 * kk + 1][qb][2], sacc[hf][2 * kk + 1][qb][3]);
                                pf[qb][kk] = __builtin_bit_cast(bf16x8, pw);
                            }
                        }
#pragma unroll
                        for (int db = 0; db < 4; ++db)
#pragma unroll
                            for (int kk = 0; kk < 2; ++kk) {
                                const u32x2 lo = *(const u32x2*)(vb_ + (db * 16 + fr) * 136 + hf * 64 + (2 * kk) * 16 + fq * 4);
                                const u32x2 hi = *(const u32x2*)(vb_ + (db * 16 + fr) * 136 + hf * 64 + (2 * kk + 1) * 16 + fq * 4);
                                u32x4 vw; vw.x = lo.x; vw.y = lo.y; vw.z = hi.x; vw.w = hi.y;
                                const bf16x8 vf = __builtin_bit_cast(bf16x8, vw);
#pragma unroll
                                for (int qb = 0; qb < 2; ++qb) oacc[db][qb] = __builtin_amdgcn_mfma_f32_16x16x32_bf16(vf, pf[qb][kk], oacc[db][qb], 0, 0, 0);
                            }
                    }
                }
            }
            if (dt < dt1) ATT_LSTORE(buf ^ 1);
            __syncthreads();
        }
#undef ATT_GLOAD
#undef ATT_LSTORE
#pragma unroll
        for (int qb = 0; qb < 2; ++qb) {
            float lt = lrun[qb]; lt += __shfl_xor(lt, 16); lt += __shfl_xor(lt, 32);
            const float inv = 1.0f / lt;
            bf16_t* op = (bf16_t*)(p.ws + OFF_U) + (tokb + c * 64 + half * 32 + qb * 16 + fr) * D + h * 64 + fq * 4;
#pragma unroll
            for (int db = 0; db < 4; ++db) {
                u32x2 ow; ow.x = cvt_pk_bf16(oacc[db][qb][0] * inv, oacc[db][qb][1] * inv); ow.y = cvt_pk_bf16(oacc[db][qb][2] * inv, oacc[db][qb][3] * inv);
                *(u32x2*)(op + db * 16) = ow;
            }
        }
    }
    __syncthreads();
}

#ifndef REP_ATTN
#define REP_ATTN 1
#endif
#ifndef REP_REC
#define REP_REC 1
#endif
#ifndef REP_NORM
#define REP_NORM 1
#endif
#ifndef REP_SYNC
#define REP_SYNC 1
#endif
#ifndef REP_PREP
#define REP_PREP 1
#endif
#ifndef REP_G3
#define REP_G3 1
#endif
#define GSYNC() do { for (int r_ = 0; r_ < REP_SYNC; ++r_) xcd_barrier(xb); } while (0)
__global__ void __launch_bounds__(512, 2) yoco_fwd(Params p) {
    extern __shared__ __attribute__((aligned(16))) unsigned char shm[];
    cg::grid_group grid = cg::this_grid();
    unsigned* barw = (unsigned*)(p.ws + OFF_BAR);
    for (int i = blockIdx.x * 512 + threadIdx.x; i < XCD_BAR_WORDS; i += gridDim.x * 512) barw[i] = 0u;
    volatile LAS unsigned* xst = (volatile LAS unsigned*)(LAS unsigned char*)(shm + LDS_BYTES - 16);
    if (threadIdx.x == 0) { xst[0] = 0u; xst[1] = 0u; }
    for (int r = 0; r < REP_PREP; ++r) prep_phase(p, shm);
    grid.sync();
    XcdBarrier xb = xcd_barrier_post(barw, xst);
    for (int l = 0; l < 4; ++l) {
        const float* hsrc = (l == 0) ? p.in[0] : p.h;
        const float* mv = ((float*)(p.ws + OFF_MODV)) + (size_t)l * 8 * 6144;
        for (int r = 0; r < REP_NORM; ++r) {
            if (l == 2) norm_phase(hsrc, ((bf16_t*)(p.ws + OFF_U)), p.in[4] + l * D, mv, mv + D, 6144, ((bf16_t*)(p.ws + OFF_U2)), p.in[12], ((float*)(p.ws + OFF_KVMOD)), ((float*)(p.ws + OFF_KVMOD)) + D, 2048);
            else norm_phase(hsrc, ((bf16_t*)(p.ws + OFF_U)), p.in[4] + l * D, mv, mv + D, 6144, nullptr, nullptr, nullptr, nullptr, 0);
        }
        GSYNC();
        if (l < 2) {
            pg8::EpiHgrnIn e; e.QVG = ((bf16_t*)(p.ws + OFF_QH)); e.LF = (bf16_t*)(p.ws + OFF_LF); e.lb = ((float*)(p.ws + OFF_LBV)) + l * D;
            run_gemm(shm, ((bf16_t*)(p.ws + OFF_U)), ((bf16_t*)(p.ws + OFF_WB_A_IN)) + (size_t)l * AIN * D, AIN, D, e);
            GSYNC();
            for (int r = 0; r < REP_REC; ++r) rec_passA(p, shm);
            GSYNC();
            for (int r = 0; r < REP_REC; ++r) rec_pass<true>(p, l, shm);
        } else {
            if (l == 2) { pg8::EpiBf16Split e; e.d0 = ((bf16_t*)(p.ws + OFF_KB)); e.scale = 1.0f; run_gemm(shm, ((bf16_t*)(p.ws + OFF_U2)), ((bf16_t*)(p.ws + OFF_WB_KV)), 2048, D, e); }
            { pg8::EpiBf16Split e; e.d0 = ((bf16_t*)(p.ws + OFF_QB)); e.scale = 0.125f; run_gemm(shm, ((bf16_t*)(p.ws + OFF_U)), ((bf16_t*)(p.ws + OFF_WB_Q)) + (size_t)(l - 2) * D * D, D, D, e); }
            GSYNC();
            for (int r = 0; r < REP_ATTN; ++r) attn_phase(p, l - 2, shm);
        }
        GSYNC();
        {
            pg8::EpiResid e; e.src = hsrc; e.dst = p.h; e.gate = mv + 2 * D;
            run_gemm(shm, ((bf16_t*)(p.ws + OFF_U)), (l < 2) ? ((bf16_t*)(p.ws + OFF_WB_A_OUT)) + (size_t)l * D * D : ((bf16_t*)(p.ws + OFF_WB_O)) + (size_t)(l - 2) * D * D, D, D, e);
        }
        GSYNC();
        for (int r = 0; r < REP_NORM; ++r) norm_phase(p.h, ((bf16_t*)(p.ws + OFF_U)), p.in[5] + l * D, mv + 3 * D, mv + 4 * D, 6144, nullptr, nullptr, nullptr, nullptr, 0);
        GSYNC();
        for (int r = 0; r < REP_G3; ++r) { pg8::EpiSwiglu e; e.act = ((bf16_t*)(p.ws + OFF_ACT)); run_gemm(shm, ((bf16_t*)(p.ws + OFF_U)), ((bf16_t*)(p.ws + OFF_WB_FFN_IN)) + (size_t)l * 2 * FFN * D, 2 * FFN, D, e); }
        GSYNC();
        { pg8::EpiResid e; e.src = p.h; e.dst = p.h; e.gate = mv + 5 * D; run_gemm(shm, ((bf16_t*)(p.ws + OFF_ACT)), ((bf16_t*)(p.ws + OFF_WB_FFN_OUT)) + (size_t)l * D * FFN, D, FFN, e); }
        GSYNC();
    }
    final_norm_phase(p.h, p.in[19]);
}

extern "C" void kernel_launch(void* const* d_in, const int* in_sizes, int n_in, void* d_out, int out_size, void* d_ws, size_t ws_size, hipStream_t stream) {
    static int grid_blocks = 0;
    if (!grid_blocks) {
        int dev = 0, cus = 0, per_cu = 0;
        hipGetDevice(&dev);
        hipDeviceGetAttribute(&cus, hipDeviceAttributeMultiprocessorCount, dev);
        hipFuncSetAttribute((const void*)yoco_fwd, hipFuncAttributeMaxDynamicSharedMemorySize, LDS_BYTES);
        hipOccupancyMaxActiveBlocksPerMultiprocessor(&per_cu, (const void*)yoco_fwd, 512, LDS_BYTES);
        if (per_cu < 1) per_cu = 1;
        grid_blocks = cus * per_cu;
        (void)hipGetLastError();
    }
    Params p{};
    for (int i = 0; i < 20; ++i) p.in[i] = (const float*)d_in[i];
    p.h = (float*)d_out; p.ws = (unsigned char*)d_ws;
    if (ws_size < WS_END || n_in != 20) { fprintf(stderr, "kernel_launch: workspace too small (%zu < %zu) or unexpected inputs\n", ws_size, (size_t)WS_END); return; }
    void* args[] = {&p};
    hipError_t e = hipLaunchCooperativeKernel((const void*)yoco_fwd, dim3(grid_blocks), dim3(512), args, LDS_BYTES, stream);
    if (e != hipSuccess) fprintf(stderr, "cooperative launch failed: %s (grid %d)\n", hipGetErrorString(e), grid_blocks);
}
```

```cpp
#include <hip/hip_runtime.h>
#include <hip/hip_cooperative_groups.h>
#include <cstdio>
namespace cg = cooperative_groups;

#define LAS __attribute__((address_space(3)))
typedef unsigned short bf16_t;
typedef short bf16x8 __attribute__((ext_vector_type(8)));
typedef float f32x4 __attribute__((ext_vector_type(4)));
typedef unsigned u32x4 __attribute__((ext_vector_type(4)));
typedef unsigned u32x2 __attribute__((ext_vector_type(2)));
typedef float f32x2 __attribute__((ext_vector_type(2)));

constexpr int D = 1024, BATCH = 8, SEQ = 8192, MTOK = BATCH * SEQ, FFN = 2816, AIN = 4096;
constexpr int LDS_BYTES = 144 * 1024;
constexpr int XCD_BAR_WORDS_C = 3456;

__device__ __forceinline__ unsigned cvt_pk_bf16(float lo, float hi) { unsigned r; asm volatile("v_cvt_pk_bf16_f32 %0, %1, %2" : "=v"(r) : "v"(lo), "v"(hi)); return r; }
__device__ __forceinline__ float bf2f(unsigned short h) { return __uint_as_float((unsigned)h << 16); }
__device__ __forceinline__ float bflo(unsigned w) { return __uint_as_float(w << 16); }
__device__ __forceinline__ float bfhi(unsigned w) { return __uint_as_float(w & 0xffff0000u); }
__device__ __forceinline__ float silu_f(float x) { return x * __builtin_amdgcn_rcpf(1.0f + __expf(-x)); }

constexpr int WAVE_TAB_OFF = LDS_BYTES - 16 - 256;
__device__ __forceinline__ unsigned hw_wave_slot() { return (unsigned)__builtin_amdgcn_s_getreg(((6 - 1) << 11) | 4); }
__device__ __forceinline__ int opaque_tid() {
    extern __shared__ __attribute__((aligned(16))) unsigned char shm_tid_[];
    const int wv = __builtin_amdgcn_readfirstlane(*(volatile LAS int*)(LAS unsigned char*)(shm_tid_ + WAVE_TAB_OFF + 4 * hw_wave_slot()));
    int lane_;
    asm volatile("v_mbcnt_lo_u32_b32 %0, -1, 0\n\tv_mbcnt_hi_u32_b32 %0, -1, %0" : "=&v"(lane_));
    int t = wv * 64 + lane_;
    asm volatile("" : "+v"(t)); return t;
}
struct Params { const float* in[20]; float* h; unsigned char* ws; };
constexpr size_t ACTB = (size_t)MTOK * D * 2;
constexpr size_t OFF_WB_A_IN = 0;
constexpr size_t OFF_WB_A_OUT = OFF_WB_A_IN + (size_t)2 * AIN * D * 2;
constexpr size_t OFF_WB_FFN_IN = OFF_WB_A_OUT + (size_t)2 * D * D * 2;
constexpr size_t OFF_WB_FFN_OUT = OFF_WB_FFN_IN + (size_t)4 * 2 * FFN * D * 2;
constexpr size_t OFF_WB_KV = OFF_WB_FFN_OUT + (size_t)4 * D * FFN * 2;
constexpr size_t OFF_WB_Q = OFF_WB_KV + (size_t)2 * D * D * 2;
constexpr size_t OFF_WB_O = OFF_WB_Q + (size_t)2 * D * D * 2;
constexpr size_t OFF_MODV = OFF_WB_O + (size_t)2 * D * D * 2;
constexpr size_t OFF_KVMOD = OFF_MODV + (size_t)4 * 8 * 6144 * 4;
constexpr size_t OFF_LBV = OFF_KVMOD + (size_t)8 * 2048 * 4;
constexpr size_t OFF_U = OFF_LBV + (size_t)2 * D * 4;
constexpr size_t OFF_R = OFF_U + ACTB;
constexpr size_t OFF_QH = OFF_R, OFF_VH = OFF_R + ACTB, OFF_GH = OFF_R + 2 * ACTB, OFF_LF = OFF_R + 3 * ACTB;
constexpr size_t OFF_ACT = OFF_R;
constexpr size_t OFF_UF_A = OFF_R + 4 * ACTB;
constexpr size_t OFF_KB = OFF_R + (size_t)MTOK * FFN * 2, OFF_VB = OFF_KB + ACTB, OFF_QB = OFF_VB + ACTB;
constexpr size_t OFF_SLOC = OFF_R + 5 * ACTB, OFF_DLOG = OFF_SLOC + (size_t)256 * 16384 * 4;
constexpr size_t OFF_BAR = OFF_QB + ACTB;
constexpr size_t OFF_ROWSS = OFF_BAR + (size_t)16384;
constexpr size_t WS_END = OFF_ROWSS + (size_t)8 * MTOK * 8;


#define XB_TMO      128
#define XB_XCNT(j)  (256  + 64 * (j))
#define XB_XSUB(j)  (1280 + 64 * (j))
#define XB_XGEN(j)  (2304 + 64 * (j))
#define XB_TOP      3328
#define XB_TOPGEN   3392
#define XCD_BAR_WORDS 3456
#define XB_SPIN_CAP (1u << 18)
__device__ __forceinline__ unsigned xb_ld(unsigned* p)              { return __hip_atomic_load(p, __ATOMIC_RELAXED, __HIP_MEMORY_SCOPE_AGENT); }
__device__ __forceinline__ unsigned xb_add(unsigned* p, unsigned v) { return __hip_atomic_fetch_add(p, v, __ATOMIC_RELAXED, __HIP_MEMORY_SCOPE_AGENT); }
__device__ __forceinline__ unsigned xb_xcc_id() { return (unsigned)__builtin_amdgcn_s_getreg((3 << 11) | 20) & 0xFu; }
#define XB_SPIN(cond, bar) do { unsigned _sp = 0; while (cond) { __builtin_amdgcn_s_sleep(1); \
    if ((++_sp & 255u) == 0u) { if (xb_ld(&(bar)[XB_TMO])) break; if (_sp > XB_SPIN_CAP) { atomicAdd(&(bar)[XB_TMO], 1u); break; } } } } while (0)
struct XcdBarrier { unsigned* bar; unsigned x; volatile LAS unsigned* st; };
__device__ __forceinline__ XcdBarrier xcd_barrier_post(unsigned* bar, volatile LAS unsigned* st) {
    XcdBarrier b; b.bar = bar; b.x = xb_xcc_id(); b.st = st;
    if (opaque_tid() == 0) (void)xb_add(&bar[XB_XCNT(b.x)], 1u);
    return b;
}
__device__ __forceinline__ void xcd_barrier_complete(unsigned* bar, unsigned x, unsigned& nloc, unsigned& nx) {
    const unsigned G = gridDim.x * gridDim.y * gridDim.z;
    unsigned sum, cnt, mine, sp = 0u;
    for (;;) {
        sum = 0u; cnt = 0u; mine = 0u;
#pragma unroll
        for (unsigned j = 0; j < 16; ++j) { const unsigned c = xb_ld(&bar[XB_XCNT(j)]); sum += c; cnt += (c > 0u) ? 1u : 0u; mine = (j == x) ? c : mine; }
        if (sum == G) break;
        __builtin_amdgcn_s_sleep(1);
        if ((++sp & 255u) == 0u) { if (xb_ld(&bar[XB_TMO])) break; if (sp > XB_SPIN_CAP) { atomicAdd(&bar[XB_TMO], 1u); break; } }
    }
    nloc = mine > 0u ? mine : 1u; nx = cnt > 0u ? cnt : 1u;
}
__device__ __forceinline__ void xcd_barrier(const XcdBarrier& b) {
    asm volatile("s_waitcnt vmcnt(0)" ::: "memory");
    __syncthreads();
    if (opaque_tid() == 0) {
        unsigned* bar = b.bar;
        __builtin_amdgcn_s_waitcnt(0);
        unsigned nloc = b.st[0], nx = b.st[1];
        if (nloc == 0u) { xcd_barrier_complete(bar, b.x, nloc, nx); b.st[0] = nloc; b.st[1] = nx; }
        const unsigned old = xb_add(&bar[XB_XSUB(b.x)], 1u);
        const unsigned gen = old / nloc;
        if (old + 1u == (gen + 1u) * nloc) {
            __builtin_amdgcn_fence(__ATOMIC_RELEASE, "agent");
            asm volatile("s_waitcnt vmcnt(0)" ::: "memory");
            const unsigned og = xb_add(&bar[XB_TOP], 1u);
            const unsigned tg = og / nx;
            if (og + 1u == (tg + 1u) * nx) xb_add(&bar[XB_TOPGEN], 1u);
            else XB_SPIN(xb_ld(&bar[XB_TOPGEN]) == tg, bar);
            __builtin_amdgcn_fence(__ATOMIC_ACQUIRE, "agent");
            xb_add(&bar[XB_XGEN(b.x)], 1u);
            asm volatile("s_waitcnt vmcnt(0)" ::: "memory");
        } else {
            XB_SPIN(xb_ld(&bar[XB_XGEN(b.x)]) == gen, bar);
            __builtin_amdgcn_fence(__ATOMIC_ACQUIRE, "agent");
            asm volatile("s_waitcnt vmcnt(0)" ::: "memory");
        }
    }
    __syncthreads();
}

namespace pg8 {
constexpr int BM = 256, BK = 64, HALF = 128, HTB = HALF * BK * 2, STAGE_BYTES = 8 * HTB, NXCD = 8, WGM = 8;
__device__ __forceinline__ int lds_byte(int r, int c) { const int st = (r >> 4) * 2 + (c >> 5), rr = r & 15, cc = c & 31, ob = rr * 64 + cc * 2; return st * 1024 + (ob ^ (((ob >> 9) & 1) << 5)); }
__device__ __forceinline__ void stage_rc(int b, int& R, int& C) { const int st = b / 1024, sb = b % 1024, swz = sb ^ (((sb >> 9) & 1) << 5); R = (st >> 1) * 16 + swz / 64; C = (st & 1) * 32 + (swz % 64) / 2; }
__device__ __forceinline__ int perm32(int rho) { const int n = rho >> 4, i = rho & 15; return 8 * (i >> 2) + 4 * n + (i & 3); }
struct Unit { int pm, pn; };
struct Gemm { const bf16_t* A; const bf16_t* Bt; int M, N, K; };
struct StaticOrder {
    int nM, nN, nwg, G, c;
    __device__ void init(int M, int N, int G_, int c_) { nM = M / BM; nN = N / BM; nwg = nM * nN; G = G_; c = c_; }
    __device__ bool next(int i, Unit& u) const {
        const long L = (long)i * G + c; if (L >= nwg) return false;
        int wgid = (int)L; { const int q = nwg / NXCD, r = nwg % NXCD, xcd = wgid % NXCD, off = wgid / NXCD; wgid = (xcd < r ? xcd * (q + 1) : r * (q + 1) + (xcd - r) * q) + off; }
        const int nig = WGM * nN, gid = wgid / nig, fm = gid * WGM, gsz = (nM - fm) < WGM ? (nM - fm) : WGM;
        u.pm = fm + ((wgid % nig) % gsz); u.pn = (wgid % nig) / gsz; return true;
    }
};

template <class Epi>
__device__ __forceinline__ void gemm_phase(LAS unsigned char* lds, const Gemm g, const StaticOrder& S, const Epi& E) {
    const int tid = opaque_tid(), wid = __builtin_amdgcn_readfirstlane(tid >> 6), lane = tid & 63, wr = wid >> 2, wc = wid & 3, fr = lane & 15, fq = lane >> 4;
    const int K = g.K, nt = K / BK;
    unsigned voffA[2], voffB[2];
#pragma unroll
    for (int i = 0; i < 2; ++i) { int R, C; stage_rc(tid * 16 + i * 8192, R, C); const int Rb = Epi::PERM ? ((R & ~31) + perm32(R & 31)) : R;
        voffA[i] = (unsigned)(R * K + C) * 2u; voffB[i] = (unsigned)(Rb * K + C) * 2u; }
    const size_t kstep = (size_t)(BK * 2);
    const size_t hstep = (size_t)HALF * K * 2;
    const size_t tstep = 2 * hstep;
    const unsigned ldsw = (unsigned)wid * 1024u;
    const int aoff = lds_byte(wr * 64 + fr, fq * 8), boff = lds_byte(wc * 32 + fr, fq * 8);
#define PG8_SA(b, h) (((b) * 2 + (h)) * HTB)
#define PG8_SB(b, h) ((4 + (b) * 2 + (h)) * HTB)
#define PG8_STAGE(bufoff, gbase, voff) do { _Pragma("unroll") for (int _i = 0; _i < 2; ++_i) \
        __builtin_amdgcn_global_load_lds((const unsigned*)((const char*)(gbase) + (voff)[_i]), (LAS unsigned*)(lds + (bufoff) + ldsw + _i * 8192), 16, 0, 0); } while (0)
#define PG8_LDA(dst, b, h) do { _Pragma("unroll") for (int m = 0; m < 4; ++m) _Pragma("unroll") for (int k = 0; k < 2; ++k) dst[m][k] = *(const LAS bf16x8*)(lds + PG8_SA(b, h) + aoff + m * 2048 + k * 1024); } while (0)
#define PG8_LDB(dst, b, h) do { _Pragma("unroll") for (int n = 0; n < 2; ++n) _Pragma("unroll") for (int k = 0; k < 2; ++k) dst[n][k] = *(const LAS bf16x8*)(lds + PG8_SB(b, h) + boff + n * 2048 + k * 1024); } while (0)
#define PG8_MMA(ai, bj, At, Bt) do { __builtin_amdgcn_s_setprio(1); _Pragma("unroll") for (int m = 0; m < 4; ++m) _Pragma("unroll") for (int n = 0; n < 2; ++n) _Pragma("unroll") for (int k = 0; k < 2; ++k) \
        acc[ai][bj][m][n] = __builtin_amdgcn_mfma_f32_16x16x32_bf16(Bt[n][k], At[m][k], acc[ai][bj][m][n], 0, 0, 0); __builtin_amdgcn_s_setprio(0); } while (0)
#define PG8_WAIT_V(n) asm volatile("s_waitcnt vmcnt(" #n ")" ::: "memory")
#define PG8_WAIT_L(n) asm volatile("s_waitcnt lgkmcnt(" #n ")" ::: "memory")
#define PG8_BAR __builtin_amdgcn_s_barrier()
#define PG8_SCHED __builtin_amdgcn_sched_barrier(0)
    Unit cur, nxt; int ui = 0;
    if (!S.next(0, cur)) return;
    f32x4 acc[2][2][4][2];
#pragma unroll
    for (int a = 0; a < 2; ++a)
#pragma unroll
        for (int b = 0; b < 2; ++b)
#pragma unroll
            for (int m = 0; m < 4; ++m)
#pragma unroll
                for (int n = 0; n < 2; ++n) acc[a][b][m][n] = (f32x4){0.f, 0.f, 0.f, 0.f};
    bf16x8 At[4][2], B0[2][2], B1[2][2];
    const char* cA = (const char*)g.A + (size_t)cur.pm * tstep; const char* cB = (const char*)g.Bt + (size_t)cur.pn * tstep;
    PG8_STAGE(PG8_SB(0, 0), cB, voffB); PG8_STAGE(PG8_SA(0, 0), cA, voffA); PG8_STAGE(PG8_SB(0, 1), cB + hstep, voffB); PG8_STAGE(PG8_SA(0, 1), cA + hstep, voffA);
    if (wr == 1) PG8_BAR;
    PG8_WAIT_V(4); PG8_BAR;
    PG8_STAGE(PG8_SB(1, 0), cB + kstep, voffB); PG8_STAGE(PG8_SA(1, 0), cA + kstep, voffA); PG8_STAGE(PG8_SB(1, 1), cB + hstep + kstep, voffB);
    PG8_WAIT_V(6); PG8_BAR;
    for (;;) {
        const bool has_next = S.next(ui + 1, nxt);
        const char* nA = has_next ? (const char*)g.A + (size_t)nxt.pm * tstep : cA; const char* nB = has_next ? (const char*)g.Bt + (size_t)nxt.pn * tstep : cB;
        for (int t = 0; t < nt; t += 2) {
            const bool last = (t == nt - 2);
            const char* a1 = cA + (size_t)(t + 1) * kstep;
            const char* a2 = last ? nA : cA + (size_t)(t + 2) * kstep; const char* b2 = last ? nB : cB + (size_t)(t + 2) * kstep;
            const char* a3 = a2 + kstep; const char* b3 = b2 + kstep;
            PG8_LDB(B0, 0, 0); PG8_SCHED; PG8_LDA(At, 0, 0); PG8_STAGE(PG8_SA(1, 1), a1 + hstep, voffA);
            PG8_WAIT_L(8); PG8_BAR; PG8_WAIT_L(0); PG8_MMA(0, 0, At, B0); PG8_BAR; PG8_SCHED;
            PG8_LDB(B1, 0, 1); PG8_STAGE(PG8_SB(0, 0), b2, voffB);
            PG8_BAR; PG8_WAIT_L(0); PG8_MMA(0, 1, At, B1); PG8_BAR;
            PG8_LDA(At, 0, 1); PG8_STAGE(PG8_SA(0, 0), a2, voffA);
            PG8_BAR; PG8_WAIT_L(0); PG8_MMA(1, 0, At, B0); PG8_BAR; PG8_SCHED;
            PG8_STAGE(PG8_SB(0, 1), b2 + hstep, voffB);
            PG8_WAIT_V(6); PG8_BAR; PG8_MMA(1, 1, At, B1); PG8_BAR;
            PG8_LDB(B0, 1, 0); PG8_SCHED; PG8_LDA(At, 1, 0); PG8_STAGE(PG8_SA(0, 1), a2 + hstep, voffA);
            PG8_WAIT_L(8); PG8_BAR; PG8_WAIT_L(0); PG8_MMA(0, 0, At, B0); PG8_BAR; PG8_SCHED;
            PG8_LDB(B1, 1, 1); PG8_STAGE(PG8_SB(1, 0), b3, voffB);
            PG8_BAR; PG8_WAIT_L(0); PG8_MMA(0, 1, At, B1); PG8_BAR;
            PG8_LDA(At, 1, 1); PG8_STAGE(PG8_SA(1, 0), a3, voffA);
            PG8_BAR; PG8_WAIT_L(0); PG8_MMA(1, 0, At, B0); PG8_BAR; PG8_SCHED;
            PG8_STAGE(PG8_SB(1, 1), b3 + hstep, voffB);
            PG8_WAIT_V(6); PG8_BAR; PG8_MMA(1, 1, At, B1); PG8_BAR;
        }
        E(acc, cur, wr, wc, fr, fq);
        if (!has_next) break;
#pragma unroll
        for (int a = 0; a < 2; ++a)
#pragma unroll
            for (int b = 0; b < 2; ++b)
#pragma unroll
                for (int m = 0; m < 4; ++m)
#pragma unroll
                    for (int n = 0; n < 2; ++n) acc[a][b][m][n] = (f32x4){0.f, 0.f, 0.f, 0.f};
        cur = nxt; cA = nA; cB = nB; ++ui;
    }
    PG8_WAIT_V(0);
    if (wr == 0) PG8_BAR;
    PG8_BAR;
#undef PG8_SA
#undef PG8_SB
#undef PG8_STAGE
#undef PG8_LDA
#undef PG8_LDB
#undef PG8_MMA
#undef PG8_WAIT_V
#undef PG8_WAIT_L
#undef PG8_BAR
#undef PG8_SCHED
}

struct EpiHgrnIn {
    static constexpr bool PERM = true;
    bf16_t* QVG; bf16_t* LF; const float* lb;
    __device__ __forceinline__ void operator()(const f32x4 (&acc)[2][2][4][2], const Unit& u, int wr, int wc, int fr, int fq) const {
        const int seg = u.pn >> 2, colt = (u.pn & 3) * 256;
        const int row0 = u.pm * BM + wr * 64 + fr, col0 = colt + wc * 32 + 8 * fq;
        if (seg == 1) {
#pragma unroll
            for (int bj = 0; bj < 2; ++bj) {
                const f32x4 l0 = *(const f32x4*)(lb + col0 + bj * HALF), l1 = *(const f32x4*)(lb + col0 + bj * HALF + 4);
#pragma unroll
                for (int ai = 0; ai < 2; ++ai)
#pragma unroll
                    for (int m = 0; m < 4; ++m) {
                        bf16_t* rowp = LF + (size_t)(row0 + ai * HALF + m * 16) * D + col0 + bj * HALF;
                        f32x4 o0, o1;
#pragma unroll
                        for (int j = 0; j < 4; ++j) {
                            float z = acc[ai][bj][m][0][j]; float sg = __builtin_amdgcn_rcpf(1.0f + __expf(-z)); float f = l0[j] + (1.0f - l0[j]) * sg; o0[j] = logf(fmaxf(f, 1e-30f));
                            z = acc[ai][bj][m][1][j]; sg = __builtin_amdgcn_rcpf(1.0f + __expf(-z)); f = l1[j] + (1.0f - l1[j]) * sg; o1[j] = logf(fmaxf(f, 1e-30f));
                        }
                        u32x4 lw; lw.x = cvt_pk_bf16(o0[0], o0[1]); lw.y = cvt_pk_bf16(o0[2], o0[3]); lw.z = cvt_pk_bf16(o1[0], o1[1]); lw.w = cvt_pk_bf16(o1[2], o1[3]);
                        *(u32x4*)rowp = lw;
                    }
            }
        } else {
            bf16_t* base = QVG + (size_t)(seg == 0 ? 0 : (seg == 2 ? 1 : 2)) * ((size_t)MTOK * D);
            const bool act = (seg != 2);
#pragma unroll
            for (int ai = 0; ai < 2; ++ai)
#pragma unroll
                for (int m = 0; m < 4; ++m)
#pragma unroll
                    for (int bj = 0; bj < 2; ++bj) {
                        f32x4 v0 = acc[ai][bj][m][0], v1 = acc[ai][bj][m][1];
                        if (act) {
#pragma unroll
                            for (int j = 0; j < 4; ++j) { v0[j] = silu_f(v0[j]); v1[j] = silu_f(v1[j]); }
                        }
                        u32x4 w; w.x = cvt_pk_bf16(v0[0], v0[1]); w.y = cvt_pk_bf16(v0[2], v0[3]); w.z = cvt_pk_bf16(v1[0], v1[1]); w.w = cvt_pk_bf16(v1[2], v1[3]);
                        *(u32x4*)(base + (size_t)(row0 + ai * HALF + m * 16) * D + col0 + bj * HALF) = w;
                    }
        }
    }
};
struct EpiResid {
    static constexpr bool PERM = true;
    const float* const* in; unsigned char* ws; float* hbuf; int l, which;
    __device__ __forceinline__ void emit(const f32x4 (&v)[2][2][4][2], const float (&rs)[2][4], bf16_t* U, const float* gain, const float* sh, const float* sc, int bs, int b, int row0, int col0) const {
#pragma unroll
        for (int bj = 0; bj < 2; ++bj) {
            const int c = col0 + bj * HALF;
            f32x4 a0, a1, t0, t1;
            { const f32x4 g0 = *(const f32x4*)(gain + c), s0 = *(const f32x4*)(sc + (size_t)b * bs + c); a0 = g0 * (s0 + 1.0f); t0 = *(const f32x4*)(sh + (size_t)b * bs + c); }
            { const f32x4 g1 = *(const f32x4*)(gain + c + 4), s1 = *(const f32x4*)(sc + (size_t)b * bs + c + 4); a1 = g1 * (s1 + 1.0f); t1 = *(const f32x4*)(sh + (size_t)b * bs + c + 4); }
#pragma unroll
            for (int ai = 0; ai < 2; ++ai)
#pragma unroll
                for (int m = 0; m < 4; ++m) {
                    const f32x4 u0 = (v[ai][bj][m][0] * rs[ai][m]) * a0 + t0, u1 = (v[ai][bj][m][1] * rs[ai][m]) * a1 + t1;
                    u32x4 w; w.x = cvt_pk_bf16(u0[0], u0[1]); w.y = cvt_pk_bf16(u0[2], u0[3]); w.z = cvt_pk_bf16(u1[0], u1[1]); w.w = cvt_pk_bf16(u1[2], u1[3]);
                    *(u32x4*)(U + (size_t)(row0 + ai * HALF + m * 16) * D + c) = w;
                }
            __builtin_amdgcn_sched_barrier(0);
        }
    }
    __device__ __forceinline__ void operator()(f32x4 (&acc)[2][2][4][2], const Unit& u, int wr, int wc, int fr, int fq) const {
        __builtin_amdgcn_sched_barrier(0);
        const int b = u.pm >> 5;
        const float* mv = (const float*)(ws + OFF_MODV) + (size_t)l * 8 * 6144;
        const float* src = (l == 0 && which == 0) ? in[0] : hbuf; float* dst = hbuf;
        const int mode = (l == 3 && which == 1) ? 1 : 0;
        unsigned long long* rowacc = (unsigned long long*)(ws + OFF_ROWSS) + (size_t)(2 * l + which) * MTOK;
        const float* gp = mv + (which ? 5 : 2) * D + (size_t)b * 6144;
        const int row0 = u.pm * BM + wr * 64 + fr, col0 = u.pn * BM + wc * 32 + 8 * fq;
        {
            f32x4 gv[2][2];
#pragma unroll
            for (int bj = 0; bj < 2; ++bj)
#pragma unroll
                for (int n = 0; n < 2; ++n) gv[bj][n] = *(const f32x4*)(gp + col0 + bj * HALF + 4 * n);
#pragma unroll
            for (int ai = 0; ai < 2; ++ai)
#pragma unroll
                for (int m = 0; m < 4; ++m) {
                    const size_t ro = (size_t)(row0 + ai * HALF + m * 16) * D + col0;
                    float pt = 0.f;
#pragma unroll
                    for (int bj = 0; bj < 2; ++bj)
#pragma unroll
                        for (int n = 0; n < 2; ++n) {
                            const f32x4 v = *(const f32x4*)(src + ro + bj * HALF + 4 * n) + gv[bj][n] * acc[ai][bj][m][n];
                            acc[ai][bj][m][n] = v;
                            if (mode == 0) *(f32x4*)(dst + ro + bj * HALF + 4 * n) = v;
                            pt += (v[0] * v[0] + v[1] * v[1]) + (v[2] * v[2] + v[3] * v[3]);
                        }
                    pt += __shfl_xor(pt, 16); pt += __shfl_xor(pt, 32);
                    if (fq == 0) (void)__hip_atomic_fetch_add(rowacc + row0 + ai * HALF + m * 16, (1ull << 48) + (unsigned long long)(pt * 65536.0f + 0.5f), __ATOMIC_RELAXED, __HIP_MEMORY_SCOPE_AGENT);
                    __builtin_amdgcn_sched_barrier(0);
                }
        }
        float rs[2][4];
        {
            unsigned spins = 0;
            for (;;) {
                bool done = true;
#pragma unroll
                for (int ai = 0; ai < 2; ++ai)
#pragma unroll
                    for (int m = 0; m < 4; ++m) {
                        const unsigned long long q = __hip_atomic_load(rowacc + row0 + ai * HALF + m * 16, __ATOMIC_RELAXED, __HIP_MEMORY_SCOPE_AGENT);
                        done = done && ((q >> 48) >= 16ull);
                        rs[ai][m] = rsqrtf((float)(q & 0xffffffffffffull) * (1.0f / 65536.0f) * (1.0f / D) + 1e-6f);
                    }
                if (__all(done) || ++spins > (1u << 16)) break;
                __builtin_amdgcn_s_sleep(2);
            }
        }
        asm volatile("" ::: "memory");
        __builtin_amdgcn_sched_barrier(0);
        if (mode == 1) {
            const float* gain1 = in[19];
#pragma unroll
            for (int bj = 0; bj < 2; ++bj) {
                const f32x4 g0 = *(const f32x4*)(gain1 + col0 + bj * HALF), g1 = *(const f32x4*)(gain1 + col0 + bj * HALF + 4);
#pragma unroll
                for (int ai = 0; ai < 2; ++ai)
#pragma unroll
                    for (int m = 0; m < 4; ++m) {
                        float* op = dst + (size_t)(row0 + ai * HALF + m * 16) * D + col0 + bj * HALF;
                        *(f32x4*)op = (acc[ai][bj][m][0] * rs[ai][m]) * g0; *(f32x4*)(op + 4) = (acc[ai][bj][m][1] * rs[ai][m]) * g1;
                    }
            }
        } else {
            if (which == 0) emit(acc, rs, (l < 2) ? (bf16_t*)(ws + OFF_UF_A) : (bf16_t*)(ws + OFF_QB), in[5] + l * D, mv + 3 * D, mv + 4 * D, 6144, b, row0, col0);
            else {
                const float* mvn = mv + (size_t)8 * 6144;
                emit(acc, rs, (bf16_t*)(ws + OFF_U), in[4] + (l + 1) * D, mvn, mvn + D, 6144, b, row0, col0);
                if (l == 1) { const float* kvm = (const float*)(ws + OFF_KVMOD); emit(acc, rs, (bf16_t*)(ws + OFF_QB), in[12], kvm, kvm + D, 2048, b, row0, col0); }
            }
        }
    }
};
struct EpiSwiglu {
    static constexpr bool PERM = true;
    bf16_t* act;
    __device__ __forceinline__ void operator()(const f32x4 (&acc)[2][2][4][2], const Unit& u, int wr, int wc, int fr, int fq) const {
        const int row0 = u.pm * BM + wr * 64 + fr, col0 = u.pn * HALF + wc * 32 + 8 * fq;
#pragma unroll
        for (int ai = 0; ai < 2; ++ai)
#pragma unroll
            for (int m = 0; m < 4; ++m) {
                f32x4 r0, r1;
#pragma unroll
                for (int j = 0; j < 4; ++j) { r0[j] = silu_f(acc[ai][0][m][0][j]) * acc[ai][1][m][0][j]; r1[j] = silu_f(acc[ai][0][m][1][j]) * acc[ai][1][m][1][j]; }
                u32x4 w; w.x = cvt_pk_bf16(r0[0], r0[1]); w.y = cvt_pk_bf16(r0[2], r0[3]); w.z = cvt_pk_bf16(r1[0], r1[1]); w.w = cvt_pk_bf16(r1[2], r1[3]);
                *(u32x4*)(act + (size_t)(row0 + ai * HALF + m * 16) * FFN + col0) = w;
            }
    }
};
struct EpiBf16Split {
    static constexpr bool PERM = true;
    bf16_t* d0; float scale;
    __device__ __forceinline__ void operator()(const f32x4 (&acc)[2][2][4][2], const Unit& u, int wr, int wc, int fr, int fq) const {
        bf16_t* base = d0 + (size_t)(u.pn >> 2) * ((size_t)MTOK * D);
        const int row0 = u.pm * BM + wr * 64 + fr, col0 = (u.pn & 3) * 256 + wc * 32 + 8 * fq;
#pragma unroll
        for (int ai = 0; ai < 2; ++ai)
#pragma unroll
            for (int m = 0; m < 4; ++m)
#pragma unroll
                for (int bj = 0; bj < 2; ++bj) {
                    const f32x4 v0 = acc[ai][bj][m][0] * scale, v1 = acc[ai][bj][m][1] * scale;
                    u32x4 w; w.x = cvt_pk_bf16(v0[0], v0[1]); w.y = cvt_pk_bf16(v0[2], v0[3]); w.z = cvt_pk_bf16(v1[0], v1[1]); w.w = cvt_pk_bf16(v1[2], v1[3]);
                    *(u32x4*)(base + (size_t)(row0 + ai * HALF + m * 16) * D + col0 + bj * HALF) = w;
                }
    }
};
}

template <class Epi>
__device__ __forceinline__ void run_gemm(unsigned char* shm, const bf16_t* A, const bf16_t* Bt, int N, int K, const Epi& E) {
    pg8::Gemm g; g.A = A; g.Bt = Bt; g.M = MTOK; g.N = N; g.K = K;
    pg8::StaticOrder S; S.init(MTOK, N, (int)gridDim.x, (int)blockIdx.x);
    pg8::gemm_phase<Epi>((LAS unsigned char*)shm, g, S, E);
    __syncthreads();
}

__device__ __forceinline__ int ffnmap(int nn) { return nn < FFN ? ((nn >> 7) * 256 + (nn & 127)) : (((nn - FFN) >> 7) * 256 + 128 + ((nn - FFN) & 127)); }

__device__ __forceinline__ void conv_group(const float* src0, bf16_t* dst0, const int K, const int N, const int L, const int mode, unsigned char* shm, const int tid) {
    float* st = (float*)shm;
    const int per = (K / 128) * (N / 64), total = L * per, ntn = N / 64;
    for (int tile = blockIdx.x; tile < total; tile += gridDim.x) {
        const int l = tile / per, tt = tile % per, k0 = (tt / ntn) * 128, n0 = (tt % ntn) * 64;
        const float* src = src0 + (size_t)l * K * N; bf16_t* dst = dst0 + (size_t)l * K * N;
        f32x4 v[4];
#pragma unroll
        for (int it = 0; it < 4; ++it) { const int idx = tid + it * 512, k = idx >> 4, n4 = idx & 15; v[it] = *(const f32x4*)(src + (size_t)(k0 + k) * N + n0 + 4 * n4); }
        __syncthreads();
#pragma unroll
        for (int it = 0; it < 4; ++it) { const int idx = tid + it * 512, k = idx >> 4, n4 = idx & 15;
#pragma unroll
            for (int e = 0; e < 4; ++e) st[k * 65 + 4 * n4 + e] = v[it][e]; }
        __syncthreads();
#pragma unroll
        for (int it = 0; it < 2; ++it) { const int idx = tid + it * 512, n = idx >> 4, kg = idx & 15; const int nn = n0 + n; const int drow = mode ? ffnmap(nn) : nn;
            u32x4 w;
#pragma unroll
            for (int e = 0; e < 4; ++e) w[e] = cvt_pk_bf16(st[(8 * kg + 2 * e) * 65 + n], st[(8 * kg + 2 * e + 1) * 65 + n]);
            *(u32x4*)(dst + (size_t)drow * K + k0 + 8 * kg) = w; }
    }
}

__device__ void prep_phase(const Params& p, unsigned char* shm) {
    const int tid = opaque_tid();
    {
        float* cact = (float*)shm;
        float* red = cact + 8192;
        bool loaded = false;
        const int wv = tid >> 6, lane = tid & 63;
        for (int task = blockIdx.x; task < 416; task += gridDim.x) {
            if (!loaded) {
                for (int i = tid; i < 8192; i += 512) { const int k = i >> 3, b = i & 7; cact[i] = silu_f(p.in[1][b * D + k]); }
                loaded = true;
            }
            __syncthreads();
            const int c0 = task * 64;
            const float* src; const float* bias; float* dst; int stride, dstride;
            if (c0 < 24576) { const int l = c0 / 6144, j = c0 % 6144; src = p.in[2] + (size_t)l * D * 6144 + j; stride = 6144; bias = p.in[3] + l * 6144 + j; dst = ((float*)(p.ws + OFF_MODV)) + (size_t)l * 8 * 6144 + j; dstride = 6144; }
            else { const int j = c0 - 24576; src = p.in[13] + j; stride = 2048; bias = p.in[14] + j; dst = ((float*)(p.ws + OFF_KVMOD)) + j; dstride = 2048; }
            float a[8];
#pragma unroll
            for (int b = 0; b < 8; ++b) a[b] = 0.f;
            const float* sp = src + (size_t)(wv * 128) * stride + lane;
#pragma unroll 8
            for (int k = 0; k < 128; ++k) {
                const float w = sp[(size_t)k * stride];
                const f32x4 c0v = *(const f32x4*)(cact + (wv * 128 + k) * 8), c1v = *(const f32x4*)(cact + (wv * 128 + k) * 8 + 4);
                a[0] += w * c0v[0]; a[1] += w * c0v[1]; a[2] += w * c0v[2]; a[3] += w * c0v[3];
                a[4] += w * c1v[0]; a[5] += w * c1v[1]; a[6] += w * c1v[2]; a[7] += w * c1v[3];
            }
#pragma unroll
            for (int b = 0; b < 8; ++b) red[(wv * 8 + b) * 64 + lane] = a[b];
            __syncthreads();
            {
                const int b = tid >> 6, col = tid & 63;
                float s = bias[col];
#pragma unroll
                for (int w = 0; w < 8; ++w) s += red[(w * 8 + b) * 64 + col];
                dst[(size_t)b * dstride + col] = s;
            }
        }
        __syncthreads();
    }
    for (int i = blockIdx.x * 512 + tid; i < 1024; i += gridDim.x * 512) {
        const float a0 = p.in[10][i], a1 = p.in[10][1024 + i];
        const float mx = fmaxf(a0, a1), e0 = __expf(a0 - mx), e1 = __expf(a1 - mx);
        ((float*)(p.ws + OFF_LBV))[i] = 0.f; ((float*)(p.ws + OFF_LBV))[1024 + i] = e1 / (e0 + e1);
    }
    conv_group(p.in[8], (bf16_t*)(p.ws + OFF_WB_A_IN), D, AIN, 2, 0, shm, tid);
    conv_group(p.in[9], (bf16_t*)(p.ws + OFF_WB_A_OUT), D, D, 2, 0, shm, tid);
    conv_group(p.in[6], (bf16_t*)(p.ws + OFF_WB_FFN_IN), D, 2 * FFN, 4, 1, shm, tid);
    conv_group(p.in[7], (bf16_t*)(p.ws + OFF_WB_FFN_OUT), FFN, D, 4, 0, shm, tid);
    conv_group(p.in[15], (bf16_t*)(p.ws + OFF_WB_KV), D, 2 * D, 1, 0, shm, tid);
    conv_group(p.in[16], (bf16_t*)(p.ws + OFF_WB_Q), D, D, 2, 0, shm, tid);
    conv_group(p.in[17], (bf16_t*)(p.ws + OFF_WB_O), D, D, 2, 0, shm, tid);
    __syncthreads();
}

__device__ void norm_phase(const float* src, bf16_t* U1, const float* gain1, const float* sh1, const float* sc1, int bs1,
                           bf16_t* U2, const float* gain2, const float* sh2, const float* sc2, int bs2) {
    const int tid_ = opaque_tid(); const int lane = tid_ & 63, gw = blockIdx.x * 8 + (tid_ >> 6), nw = gridDim.x * 8;
    for (int row = 2 * gw; row < MTOK; row += 2 * nw) {
        const int b = row >> 13;
        const float* xp = src + (size_t)row * D;
        f32x4 xv[2][4]; float ss[2] = {0.f, 0.f};
#pragma unroll
        for (int r = 0; r < 2; ++r)
#pragma unroll
            for (int i = 0; i < 4; ++i) xv[r][i] = *(const f32x4*)(xp + (size_t)r * D + i * 256 + lane * 4);
#pragma unroll
        for (int r = 0; r < 2; ++r)
#pragma unroll
            for (int i = 0; i < 4; ++i) ss[r] += xv[r][i][0] * xv[r][i][0] + xv[r][i][1] * xv[r][i][1] + xv[r][i][2] * xv[r][i][2] + xv[r][i][3] * xv[r][i][3];
#pragma unroll
        for (int o = 1; o < 64; o <<= 1) { ss[0] += __shfl_xor(ss[0], o); ss[1] += __shfl_xor(ss[1], o); }
        const float rstd0 = rsqrtf(ss[0] * (1.0f / D) + 1e-6f), rstd1 = rsqrtf(ss[1] * (1.0f / D) + 1e-6f);
#pragma unroll
        for (int i = 0; i < 4; ++i) {
            const int k = i * 256 + lane * 4;
            const f32x4 g = *(const f32x4*)(gain1 + k), s = *(const f32x4*)(sc1 + (size_t)b * bs1 + k), t = *(const f32x4*)(sh1 + (size_t)b * bs1 + k);
            f32x4 u0, u1;
#pragma unroll
            for (int j = 0; j < 4; ++j) { const float ga = g[j] * (1.0f + s[j]); u0[j] = (xv[0][i][j] * rstd0) * ga + t[j]; u1[j] = (xv[1][i][j] * rstd1) * ga + t[j]; }
            u32x2 w0, w1; w0.x = cvt_pk_bf16(u0[0], u0[1]); w0.y = cvt_pk_bf16(u0[2], u0[3]); w1.x = cvt_pk_bf16(u1[0], u1[1]); w1.y = cvt_pk_bf16(u1[2], u1[3]);
            *(u32x2*)(U1 + (size_t)row * D + k) = w0; *(u32x2*)(U1 + (size_t)(row + 1) * D + k) = w1;
        }
        if (U2) {
#pragma unroll
            for (int i = 0; i < 4; ++i) {
                const int k = i * 256 + lane * 4;
                const f32x4 g = *(const f32x4*)(gain2 + k), s = *(const f32x4*)(sc2 + (size_t)b * bs2 + k), t = *(const f32x4*)(sh2 + (size_t)b * bs2 + k);
                f32x4 u0, u1;
#pragma unroll
                for (int j = 0; j < 4; ++j) { const float ga = g[j] * (1.0f + s[j]); u0[j] = (xv[0][i][j] * rstd0) * ga + t[j]; u1[j] = (xv[1][i][j] * rstd1) * ga + t[j]; }
                u32x2 w0, w1; w0.x = cvt_pk_bf16(u0[0], u0[1]); w0.y = cvt_pk_bf16(u0[2], u0[3]); w1.x = cvt_pk_bf16(u1[0], u1[1]); w1.y = cvt_pk_bf16(u1[2], u1[3]);
                *(u32x2*)(U2 + (size_t)row * D + k) = w0; *(u32x2*)(U2 + (size_t)(row + 1) * D + k) = w1;
            }
        }
    }
}
__device__ void final_norm_phase(float* h, const float* gain) {
    const int tid_ = opaque_tid(); const int lane = tid_ & 63, gw = blockIdx.x * 8 + (tid_ >> 6), nw = gridDim.x * 8;
    for (int row = gw; row < MTOK; row += nw) {
        float* xp = h + (size_t)row * D;
        f32x4 xv[4]; float ss = 0.f;
#pragma unroll
        for (int i = 0; i < 4; ++i) { xv[i] = *(const f32x4*)(xp + i * 256 + lane * 4); ss += xv[i][0] * xv[i][0] + xv[i][1] * xv[i][1] + xv[i][2] * xv[i][2] + xv[i][3] * xv[i][3]; }
#pragma unroll
        for (int o = 1; o < 64; o <<= 1) ss += __shfl_xor(ss, o);
        const float rstd = rsqrtf(ss * (1.0f / D) + 1e-6f);
#pragma unroll
        for (int i = 0; i < 4; ++i) {
            const int k = i * 256 + lane * 4;
            const f32x4 g = *(const f32x4*)(gain + k);
            f32x4 u;
#pragma unroll
            for (int j = 0; j < 4; ++j) u[j] = xv[i][j] * rstd * g[j];
            *(f32x4*)(xp + k) = u;
        }
    }
}

template <bool OUT>
__device__ void rec_pass(const Params& p, int layer, unsigned char* shm) {
    float* sB = (float*)shm;
    float* sKm = (float*)(shm + 33792);
    bf16_t* sST = (bf16_t*)shm;
    bf16_t* sQb = (bf16_t*)(shm + 67584);
    bf16_t* sA = (bf16_t*)(shm + 84992);
    bf16_t* sKT = (bf16_t*)(shm + 94208);
    bf16_t* sVT = (bf16_t*)(shm + 112640);
    float* sE = (float*)(shm + 131072);
    float* sPart = (float*)(shm + 131584);
    float* sNrm = (float*)(shm + 135680);
    const int tid = opaque_tid(), lane = tid & 63, w = tid >> 6, fr = lane & 15, fq = lane >> 4;
    const int wi = w >> 1, wh = w & 1;
    const int ntask = OUT ? 256 : 192;
    const float* ogain = p.in[11] + layer * 128;
    for (int task = blockIdx.x; task < ntask; task += gridDim.x) {
        int sc, bh; if (OUT) { sc = task & 3; bh = task >> 2; } else { sc = task % 3; bh = task / 3; }
        const int b = bh >> 3, h = bh & 7;
        f32x4 S[8];
#pragma unroll
        for (int db = 0; db < 8; ++db) S[db] = (f32x4){0.f, 0.f, 0.f, 0.f};
        if (OUT) {
            for (int s2 = 0; s2 < sc; ++s2) {
                const float* sl = ((float*)(p.ws + OFF_SLOC)) + (size_t)(bh * 4 + s2) * 16384; const float* dl = ((float*)(p.ws + OFF_DLOG)) + (bh * 4 + s2) * 128;
#pragma unroll
                for (int db = 0; db < 8; ++db) {
                    const f32x4 x = *(const f32x4*)(sl + ((w * 8 + db) * 64 + lane) * 4), dv = *(const f32x4*)(dl + 16 * db + fq * 4);
#pragma unroll
                    for (int j = 0; j < 4; ++j) S[db][j] = S[db][j] * __expf(dv[j]) + x[j];
                }
            }
        }
        float dlacc = 0.f;
        unsigned lfn[8]; u32x4 vn0, vn1;
        const bf16_t* LFb = (const bf16_t*)(p.ws + OFF_LF);
        const int d2 = (tid & 63) * 2, tq = tid >> 6;
        {
            const size_t r0 = (size_t)b * SEQ + (size_t)(sc * 32) * 64;
            const bf16_t* lp = LFb + (r0 + 8 * tq) * D + h * 128 + d2;
#pragma unroll
            for (int e = 0; e < 8; ++e) lfn[e] = *(const unsigned*)(lp + (size_t)e * D);
            vn0 = *(const u32x4*)(((bf16_t*)(p.ws + OFF_VH)) + (r0 + (tid & 63)) * D + h * 128 + (tid >> 6) * 8);
            vn1 = *(const u32x4*)(((bf16_t*)(p.ws + OFF_VH)) + (r0 + (tid & 63)) * D + h * 128 + 64 + (tid >> 6) * 8);
        }
        for (int ch = sc * 32; ch < sc * 32 + 32; ++ch) {
            const size_t row0 = (size_t)b * SEQ + (size_t)ch * 64;
            float la[8], lb2[8];
#pragma unroll
            for (int e = 0; e < 8; ++e) { la[e] = bflo(lfn[e]); lb2[e] = bfhi(lfn[e]); }
            const u32x4 vr0 = vn0, vr1 = vn1;
            u32x4 qraw[4]; u32x2 graw[4];
            if (OUT) {
#pragma unroll
                for (int ks = 0; ks < 4; ++ks) qraw[ks] = *(const u32x4*)(((bf16_t*)(p.ws + OFF_QH)) + (row0 + 16 * wi + fr) * D + h * 128 + ks * 32 + fq * 8);
#pragma unroll
                for (int vb = 0; vb < 4; ++vb) graw[vb] = *(const u32x2*)(((bf16_t*)(p.ws + OFF_GH)) + (row0 + 16 * wi + fr) * D + h * 128 + 64 * wh + 16 * vb + fq * 4);
            }
            {
                float ra = 0.f, rb = 0.f, ka[8], kb2[8];
#pragma unroll
                for (int e = 0; e < 8; ++e) {
                    ka[e] = 1.0f - __expf(la[e]); kb2[e] = 1.0f - __expf(lb2[e]);
                    *(f32x2*)(sKm + (8 * tq + e) * 132 + d2) = (f32x2){ka[e], kb2[e]};
                    ra += la[e]; la[e] = ra; rb += lb2[e]; lb2[e] = rb;
                }
                *(f32x2*)(sPart + tq * 128 + d2) = (f32x2){ra, rb};
                {
                    const int s_ = tid & 63, pc = tid >> 6;
#pragma unroll
                    for (int e = 0; e < 8; ++e) {
                        sVT[(pc * 8 + e) * 72 + s_] = (bf16_t)((e & 1) ? (vr0[e >> 1] >> 16) : (vr0[e >> 1] & 0xffffu));
                        sVT[(64 + pc * 8 + e) * 72 + s_] = (bf16_t)((e & 1) ? (vr1[e >> 1] >> 16) : (vr1[e >> 1] & 0xffffu));
                    }
                }
                __syncthreads();
                float offa = 0.f, offb = 0.f, tota = 0.f, totb = 0.f;
#pragma unroll
                for (int q = 0; q < 8; ++q) { const f32x2 pq = *(const f32x2*)(sPart + q * 128 + d2); tota += pq[0]; totb += pq[1]; if (q < tq) { offa += pq[0]; offb += pq[1]; } }
                if (tq == 0) { *(f32x2*)(sE + d2) = (f32x2){__expf(tota), __expf(totb)}; }
                u32x4 kwa, kwb;
#pragma unroll
                for (int e = 0; e < 8; e += 2) {
                    const float a0 = la[e] + offa, a1 = la[e + 1] + offa, b0 = lb2[e] + offb, b1 = lb2[e + 1] + offb;
                    *(f32x2*)(sB + (8 * tq + e) * 132 + d2) = (f32x2){a0, b0}; *(f32x2*)(sB + (8 * tq + e + 1) * 132 + d2) = (f32x2){a1, b1};
                    kwa[e >> 1] = cvt_pk_bf16(ka[e] * __expf(tota - a0), ka[e + 1] * __expf(tota - a1));
                    kwb[e >> 1] = cvt_pk_bf16(kb2[e] * __expf(totb - b0), kb2[e + 1] * __expf(totb - b1));
                }
                *(u32x4*)(sKT + d2 * 72 + 8 * tq) = kwa; *(u32x4*)(sKT + (d2 + 1) * 72 + 8 * tq) = kwb;
            }
            __syncthreads();
            if (ch + 1 < sc * 32 + 32) {
                const size_t r1 = row0 + 64;
                const bf16_t* lp = LFb + (r1 + 8 * tq) * D + h * 128 + d2;
#pragma unroll
                for (int e = 0; e < 8; ++e) lfn[e] = *(const unsigned*)(lp + (size_t)e * D);
                vn0 = *(const u32x4*)(((bf16_t*)(p.ws + OFF_VH)) + (r1 + (tid & 63)) * D + h * 128 + (tid >> 6) * 8);
                vn1 = *(const u32x4*)(((bf16_t*)(p.ws + OFF_VH)) + (r1 + (tid & 63)) * D + h * 128 + 64 + (tid >> 6) * 8);
            }
            if (OUT) {
                const int i = wi, hh = wh, t_ = 16 * i + fr;
                bf16x8 qt[4];
#pragma unroll
                for (int ks = 0; ks < 4; ++ks) {
                    const int d0 = ks * 32 + fq * 8;
                    const f32x4 b0 = *(const f32x4*)(sB + t_ * 132 + d0), b1 = *(const f32x4*)(sB + t_ * 132 + d0 + 4);
                    f32x4 r0 = (f32x4){0.f, 0.f, 0.f, 0.f}, r1 = r0;
                    if (i > 0) { r0 = *(const f32x4*)(sB + (16 * i - 1) * 132 + d0); r1 = *(const f32x4*)(sB + (16 * i - 1) * 132 + d0 + 4); }
                    float qv[8], ql[8];
#pragma unroll
                    for (int e = 0; e < 4; ++e) { qv[2 * e] = bflo(qraw[ks][e]); qv[2 * e + 1] = bfhi(qraw[ks][e]); }
#pragma unroll
                    for (int e = 0; e < 4; ++e) { ql[e] = qv[e] * __expf(b0[e] - r0[e]); ql[4 + e] = qv[4 + e] * __expf(b1[e] - r1[e]); }
                    u32x4 pw; pw.x = cvt_pk_bf16(ql[0], ql[1]); pw.y = cvt_pk_bf16(ql[2], ql[3]); pw.z = cvt_pk_bf16(ql[4], ql[5]); pw.w = cvt_pk_bf16(ql[6], ql[7]);
                    qt[ks] = __builtin_bit_cast(bf16x8, pw);
                    if ((ks >> 1) == hh) {
#pragma unroll
                        for (int e = 0; e < 4; ++e) { ql[e] = qv[e] * __expf(b0[e]); ql[4 + e] = qv[4 + e] * __expf(b1[e]); }
                        u32x4 qw; qw.x = cvt_pk_bf16(ql[0], ql[1]); qw.y = cvt_pk_bf16(ql[2], ql[3]); qw.z = cvt_pk_bf16(ql[4], ql[5]); qw.w = cvt_pk_bf16(ql[6], ql[7]);
                        *(u32x4*)(sQb + t_ * 136 + d0) = qw;
                    }
                }
#pragma unroll
                for (int j2 = 0; j2 < 2; ++j2) {
                    const int j = hh + 2 * j2;
                    if (j <= i) {
                        f32x4 acc = (f32x4){0.f, 0.f, 0.f, 0.f};
                        const int s_ = 16 * j + fr;
#pragma unroll
                        for (int ks = 0; ks < 4; ++ks) {
                            const int d0 = ks * 32 + fq * 8;
                            const f32x4 k0 = *(const f32x4*)(sKm + s_ * 132 + d0), k1 = *(const f32x4*)(sKm + s_ * 132 + d0 + 4);
                            const f32x4 b0 = *(const f32x4*)(sB + s_ * 132 + d0), b1 = *(const f32x4*)(sB + s_ * 132 + d0 + 4);
                            f32x4 r0 = (f32x4){0.f, 0.f, 0.f, 0.f}, r1 = r0;
                            if (i > 0) { r0 = *(const f32x4*)(sB + (16 * i - 1) * 132 + d0); r1 = *(const f32x4*)(sB + (16 * i - 1) * 132 + d0 + 4); }
                            float kl[8];
#pragma unroll
                            for (int e = 0; e < 4; ++e) { kl[e] = k0[e] * __expf(fminf(r0[e] - b0[e], 80.f)); kl[4 + e] = k1[e] * __expf(fminf(r1[e] - b1[e], 80.f)); }
                            u32x4 kw; kw.x = cvt_pk_bf16(kl[0], kl[1]); kw.y = cvt_pk_bf16(kl[2], kl[3]); kw.z = cvt_pk_bf16(kl[4], kl[5]); kw.w = cvt_pk_bf16(kl[6], kl[7]);
                            acc = __builtin_amdgcn_mfma_f32_16x16x32_bf16(qt[ks], __builtin_bit_cast(bf16x8, kw), acc, 0, 0, 0);
                        }
#pragma unroll
                        for (int jj = 0; jj < 4; ++jj) {
                            float vv = acc[jj];
                            if (i == j && fr > fq * 4 + jj) vv = 0.f;
                            sA[(16 * i + fq * 4 + jj) * 72 + 16 * j + fr] = (bf16_t)(cvt_pk_bf16(vv, 0.f) & 0xffffu);
                        }
                    } else {
#pragma unroll
                        for (int jj = 0; jj < 4; ++jj) sA[(16 * i + fq * 4 + jj) * 72 + 16 * j + fr] = (bf16_t)0;
                    }
                }
            }
            __syncthreads();
            if (OUT) {
#pragma unroll
                for (int db = 0; db < 8; ++db) { u32x2 sw; sw.x = cvt_pk_bf16(S[db][0], S[db][1]); sw.y = cvt_pk_bf16(S[db][2], S[db][3]); *(u32x2*)(sST + (16 * w + fr) * 136 + 16 * db + fq * 4) = sw; }
                __syncthreads();
            }
            f32x4 o[4];
            if (OUT) {
                const int i = wi;
#pragma unroll
                for (int vb = 0; vb < 4; ++vb) o[vb] = (f32x4){0.f, 0.f, 0.f, 0.f};
#pragma unroll
                for (int kk = 0; kk < 2; ++kk) {
                    if (kk <= (i >> 1)) {
                        const bf16x8 af = *(const bf16x8*)(sA + (16 * i + fr) * 72 + kk * 32 + fq * 8);
#pragma unroll
                        for (int vb = 0; vb < 4; ++vb) { const bf16x8 vf = *(const bf16x8*)(sVT + (64 * wh + 16 * vb + fr) * 72 + kk * 32 + fq * 8); o[vb] = __builtin_amdgcn_mfma_f32_16x16x32_bf16(vf, af, o[vb], 0, 0, 0); }
                    }
                }
#pragma unroll
                for (int ks = 0; ks < 4; ++ks) {
                    const bf16x8 qf = *(const bf16x8*)(sQb + (16 * i + fr) * 136 + ks * 32 + fq * 8);
#pragma unroll
                    for (int vb = 0; vb < 4; ++vb) { const bf16x8 sf = *(const bf16x8*)(sST + (64 * wh + 16 * vb + fr) * 136 + ks * 32 + fq * 8); o[vb] = __builtin_amdgcn_mfma_f32_16x16x32_bf16(sf, qf, o[vb], 0, 0, 0); }
                }
                float ss = 0.f;
#pragma unroll
                for (int vb = 0; vb < 4; ++vb)
#pragma unroll
                    for (int jj = 0; jj < 4; ++jj) ss += o[vb][jj] * o[vb][jj];
                ss += __shfl_xor(ss, 16); ss += __shfl_xor(ss, 32);
                if (fq == 0) sNrm[wh * 64 + 16 * i + fr] = ss;
            }
#pragma unroll
            for (int db = 0; db < 8; ++db) { const f32x4 e4 = *(const f32x4*)(sE + 16 * db + fq * 4); S[db] = S[db] * e4; }
#pragma unroll
            for (int ks = 0; ks < 2; ++ks) {
                const bf16x8 vf = *(const bf16x8*)(sVT + (16 * w + fr) * 72 + ks * 32 + fq * 8);
#pragma unroll
                for (int db = 0; db < 8; ++db) { const bf16x8 kf = *(const bf16x8*)(sKT + (16 * db + fr) * 72 + ks * 32 + fq * 8); S[db] = __builtin_amdgcn_mfma_f32_16x16x32_bf16(kf, vf, S[db], 0, 0, 0); }
            }
            __syncthreads();
            if (OUT) {
                const int i = wi;
                const float tot = sNrm[16 * i + fr] + sNrm[64 + 16 * i + fr];
                const float rstd = rsqrtf(tot * (1.0f / 128.0f) + 1e-6f);
                bf16_t* op = ((bf16_t*)(p.ws + OFF_U)) + (row0 + 16 * i + fr) * D + h * 128 + 64 * wh + fq * 4;
#pragma unroll
                for (int vb = 0; vb < 4; ++vb) {
                    const f32x4 gn = *(const f32x4*)(ogain + 64 * wh + 16 * vb + fq * 4);
                    const float g0 = bflo(graw[vb].x), g1 = bfhi(graw[vb].x), g2 = bflo(graw[vb].y), g3 = bfhi(graw[vb].y);
                    u32x2 ow; ow.x = cvt_pk_bf16(o[vb][0] * rstd * gn[0] * g0, o[vb][1] * rstd * gn[1] * g1); ow.y = cvt_pk_bf16(o[vb][2] * rstd * gn[2] * g2, o[vb][3] * rstd * gn[3] * g3);
                    *(u32x2*)(op + 16 * vb) = ow;
                }
            }
        }
        if (!OUT) {
            float* sl = ((float*)(p.ws + OFF_SLOC)) + (size_t)(bh * 4 + sc) * 16384;
#pragma unroll
            for (int db = 0; db < 8; ++db) *(f32x4*)(sl + ((w * 8 + db) * 64 + lane) * 4) = S[db];
            if (tid < 128) ((float*)(p.ws + OFF_DLOG))[(bh * 4 + sc) * 128 + tid] = dlacc;
        }
    }
    __syncthreads();
}

__device__ void rec_passA(const Params& p, unsigned char* shm) {
    bf16_t* sKT = (bf16_t*)shm;
    bf16_t* sVT = (bf16_t*)(shm + 34816);
    float* sE = (float*)(shm + 69632);
    float* sPart = (float*)(shm + 70144);
    const int tid = opaque_tid(), lane = tid & 63, w = tid >> 6, fr = lane & 15, fq = lane >> 4;
    const int d2 = (tid & 63) * 2, tq = tid >> 6;
    const int vs = tid & 127, vq = tid >> 7;
    const bf16_t* LFb = (const bf16_t*)(p.ws + OFF_LF); const bf16_t* Vp = (const bf16_t*)(p.ws + OFF_VH);
    for (int task = blockIdx.x; task < 192; task += gridDim.x) {
        const int sc = task % 3, bh = task / 3, b = bh >> 3, h = bh & 7;
        f32x4 S[8];
#pragma unroll
        for (int db = 0; db < 8; ++db) S[db] = (f32x4){0.f, 0.f, 0.f, 0.f};
        float dla = 0.f, dlb = 0.f;
        const size_t rbase = (size_t)b * SEQ + (size_t)sc * 2048;
        unsigned lfn[16]; u32x4 vn[4];
        {
            const bf16_t* lp = LFb + (rbase + 16 * tq) * D + h * 128 + d2;
#pragma unroll
            for (int e = 0; e < 16; ++e) lfn[e] = *(const unsigned*)(lp + (size_t)e * D);
#pragma unroll
            for (int i = 0; i < 4; ++i) vn[i] = *(const u32x4*)(Vp + (rbase + vs) * D + h * 128 + (vq + 4 * i) * 8);
        }
        __syncthreads();
        for (int cc = 0; cc < 16; ++cc) {
            const size_t row0 = rbase + (size_t)cc * 128;
            unsigned lf[16]; u32x4 vr[4];
            float ra = 0.f, rb = 0.f;
#pragma unroll
            for (int e = 0; e < 16; ++e) { lf[e] = lfn[e]; ra += bflo(lf[e]); rb += bfhi(lf[e]); }
#pragma unroll
            for (int i = 0; i < 4; ++i) vr[i] = vn[i];
            *(f32x2*)(sPart + tq * 128 + d2) = (f32x2){ra, rb};
            __syncthreads();
            if (cc + 1 < 16) {
                const bf16_t* lp = LFb + (row0 + 128 + 16 * tq) * D + h * 128 + d2;
#pragma unroll
                for (int e = 0; e < 16; ++e) lfn[e] = *(const unsigned*)(lp + (size_t)e * D);
#pragma unroll
                for (int i = 0; i < 4; ++i) vn[i] = *(const u32x4*)(Vp + (row0 + 128 + vs) * D + h * 128 + (vq + 4 * i) * 8);
            }
            float ba = 0.f, bb = 0.f, tota = 0.f, totb = 0.f;
#pragma unroll
            for (int q = 0; q < 8; ++q) { const f32x2 pq = *(const f32x2*)(sPart + q * 128 + d2); tota += pq[0]; totb += pq[1]; if (q < tq) { ba += pq[0]; bb += pq[1]; } }
            if (tq == 0) { *(f32x2*)(sE + d2) = (f32x2){__expf(tota), __expf(totb)}; dla += tota; dlb += totb; }
#pragma unroll
            for (int g8 = 0; g8 < 2; ++g8) {
                u32x4 kwa, kwb;
#pragma unroll
                for (int e = 0; e < 8; e += 2) {
                    const float la0 = bflo(lf[8 * g8 + e]), lb0 = bfhi(lf[8 * g8 + e]), la1 = bflo(lf[8 * g8 + e + 1]), lb1 = bfhi(lf[8 * g8 + e + 1]);
                    const float a0 = ba + la0, a1 = a0 + la1; ba = a1;
                    const float b0 = bb + lb0, b1 = b0 + lb1; bb = b1;
                    kwa[e >> 1] = cvt_pk_bf16((1.0f - __expf(la0)) * __expf(tota - a0), (1.0f - __expf(la1)) * __expf(tota - a1));
                    kwb[e >> 1] = cvt_pk_bf16((1.0f - __expf(lb0)) * __expf(totb - b0), (1.0f - __expf(lb1)) * __expf(totb - b1));
                }
                *(u32x4*)(sKT + d2 * 136 + 16 * tq + 8 * g8) = kwa; *(u32x4*)(sKT + (d2 + 1) * 136 + 16 * tq + 8 * g8) = kwb;
            }
#pragma unroll
            for (int i = 0; i < 4; ++i)
#pragma unroll
                for (int e = 0; e < 8; ++e) sVT[((vq + 4 * i) * 8 + e) * 136 + vs] = (bf16_t)((e & 1) ? (vr[i][e >> 1] >> 16) : (vr[i][e >> 1] & 0xffffu));
            __syncthreads();
#pragma unroll
            for (int db = 0; db < 8; ++db) { const f32x4 e4 = *(const f32x4*)(sE + 16 * db + fq * 4); S[db] = S[db] * e4; }
#pragma unroll
            for (int ks = 0; ks < 4; ++ks) {
                const bf16x8 vf = *(const bf16x8*)(sVT + (16 * w + fr) * 136 + ks * 32 + fq * 8);
#pragma unroll
                for (int db = 0; db < 8; ++db) { const bf16x8 kf = *(const bf16x8*)(sKT + (16 * db + fr) * 136 + ks * 32 + fq * 8); S[db] = __builtin_amdgcn_mfma_f32_16x16x32_bf16(kf, vf, S[db], 0, 0, 0); }
            }
        }
        float* sl = (float*)(p.ws + OFF_SLOC) + (size_t)(bh * 4 + sc) * 16384;
#pragma unroll
        for (int db = 0; db < 8; ++db) *(f32x4*)(sl + ((w * 8 + db) * 64 + lane) * 4) = S[db];
        if (tq == 0) *(f32x2*)((float*)(p.ws + OFF_DLOG) + (bh * 4 + sc) * 128 + d2) = (f32x2){dla, dlb};
    }
    __syncthreads();
}

__device__ void attn_phase(const Params& p, int jl, unsigned char* shm) {
    bf16_t* sK = (bf16_t*)shm;
    bf16_t* sVT = sK + 2 * 9216;
    float* sB = (float*)(sVT + 2 * 8704);
    const int tid = opaque_tid(), lane = tid & 63, w = tid >> 6, fr = lane & 15, fq = lane >> 4;
    const int cq = w >> 1, half = w & 1;
    const float LOG2E = 1.4426950408889634f;
    const int skey = tid >> 3, spiece = tid & 7, vkey = tid & 63, vpiece = tid >> 6;
    const bf16_t* Kg = (const bf16_t*)(p.ws + OFF_KB); const bf16_t* Vg = (const bf16_t*)(p.ws + OFF_VB); const bf16_t* Qg = (const bf16_t*)(p.ws + OFF_QB);
    for (int task = blockIdx.x; task < 4096; task += gridDim.x) {
        const int g = task & 31, h = (task >> 5) & 15, b = task >> 9;
        const int c = 4 * g + cq;
        const int dt0 = (2 * g - 4 > 0) ? 2 * g - 4 : 0, dt1 = 2 * g + 1;
        __syncthreads();
        for (int i = tid; i < 384; i += 512) { int r = i - 64; r = r < 0 ? 0 : (r > 319 ? 319 : r); sB[i] = p.in[18][((size_t)jl * 320 + r) * 16 + h] * LOG2E; }
        bf16x8 qf[2][2];
        {
            const bf16_t* qp = Qg + ((size_t)b * SEQ + c * 64 + half * 32) * D + h * 64;
#pragma unroll
            for (int qb = 0; qb < 2; ++qb)
#pragma unroll
                for (int ks = 0; ks < 2; ++ks) qf[qb][ks] = *(const bf16x8*)(qp + (size_t)(qb * 16 + fr) * D + ks * 32 + fq * 8);
        }
        f32x4 oacc[4][2];
#pragma unroll
        for (int db = 0; db < 4; ++db)
#pragma unroll
            for (int qb = 0; qb < 2; ++qb) oacc[db][qb] = (f32x4){0.f, 0.f, 0.f, 0.f};
        float mrun[2] = {-1e30f, -1e30f}, lrun[2] = {0.f, 0.f};
        u32x4 kreg[2], vreg[2];
        const size_t tokb = (size_t)b * SEQ;
#define ATT_GLOAD(dt_) do { _Pragma("unroll") for (int hf_ = 0; hf_ < 2; ++hf_) { \
            kreg[hf_] = *(const u32x4*)(Kg + (tokb + (size_t)(dt_) * 128 + hf_ * 64 + skey) * D + h * 64 + spiece * 8); \
            vreg[hf_] = *(const u32x4*)(Vg + (tokb + (size_t)(dt_) * 128 + hf_ * 64 + vkey) * D + h * 64 + vpiece * 8); } } while (0)
#define ATT_LSTORE(buf_) do { _Pragma("unroll") for (int hf_ = 0; hf_ < 2; ++hf_) { \
            *(u32x4*)(sK + (buf_) * 9216 + (hf_ * 64 + skey) * 72 + spiece * 8) = kreg[hf_]; \
            bf16_t* vt_ = sVT + (buf_) * 8704 + (vpiece * 8) * 136 + hf_ * 64 + vkey; \
            _Pragma("unroll") for (int e_ = 0; e_ < 8; ++e_) vt_[e_ * 136] = (bf16_t)((e_ & 1) ? (vreg[hf_][e_ >> 1] >> 16) : (vreg[hf_][e_ >> 1] & 0xffffu)); } } while (0)
        ATT_GLOAD(dt0); ATT_LSTORE(0);
        __syncthreads();
        for (int dt = dt0; dt <= dt1; ++dt) {
            const int buf = (dt - dt0) & 1;
            if (dt < dt1) ATT_GLOAD(dt + 1);
            const bool act0 = (2 * dt >= c - 8) && (2 * dt <= c), act1 = (2 * dt + 1 >= c - 8) && (2 * dt + 1 <= c);
            if (act0 || act1) {
                const bf16_t* kb_ = sK + buf * 9216; const bf16_t* vb_ = sVT + buf * 8704;
                f32x4 sacc[2][4][2];
#pragma unroll
                for (int hf = 0; hf < 2; ++hf) {
                    if (hf == 0 ? act0 : act1) {
#pragma unroll
                        for (int kb = 0; kb < 4; ++kb)
#pragma unroll
                            for (int qb = 0; qb < 2; ++qb) sacc[hf][kb][qb] = (f32x4){0.f, 0.f, 0.f, 0.f};
#pragma unroll
                        for (int kb = 0; kb < 4; ++kb)
#pragma unroll
                            for (int ks = 0; ks < 2; ++ks) {
                                const bf16x8 kf = *(const bf16x8*)(kb_ + (hf * 64 + kb * 16 + fr) * 72 + ks * 32 + fq * 8);
#pragma unroll
                                for (int qb = 0; qb < 2; ++qb) sacc[hf][kb][qb] = __builtin_amdgcn_mfma_f32_16x16x32_bf16(kf, qf[qb][ks], sacc[hf][kb][qb], 0, 0, 0);
                            }
                    }
                }
                float mx[2] = {-3e38f, -3e38f};
#pragma unroll
                for (int hf = 0; hf < 2; ++hf) {
                    if (hf == 0 ? act0 : act1) {
                        const int dk = 2 * dt + hf - c;
                        if (dk <= -5) {
                            const float b0 = sB[0];
#pragma unroll
                            for (int kb = 0; kb < 4; ++kb)
#pragma unroll
                                for (int qb = 0; qb < 2; ++qb) sacc[hf][kb][qb] = sacc[hf][kb][qb] * LOG2E + b0;
                        } else {
                            const float* bp = sB + (dk * 64 + fq * 4 - half * 32 - fr + 256 + 64 - 16);
#pragma unroll
                            for (int kb = 0; kb < 4; ++kb)
#pragma unroll
                                for (int qb = 0; qb < 2; ++qb)
#pragma unroll
                                    for (int j = 0; j < 4; ++j) sacc[hf][kb][qb][j] = sacc[hf][kb][qb][j] * LOG2E + bp[kb * 16 + j - qb * 16 + 16];
                        }
#pragma unroll
                        for (int qb = 0; qb < 2; ++qb)
#pragma unroll
                            for (int kb = 0; kb < 4; ++kb)
#pragma unroll
                                for (int j = 0; j < 4; ++j) mx[qb] = fmaxf(mx[qb], sacc[hf][kb][qb][j]);
                    }
                }
                if (__any((mx[0] > mrun[0] + 6.0f) || (mx[1] > mrun[1] + 6.0f))) {
#pragma unroll
                    for (int qb = 0; qb < 2; ++qb) {
                        float m2 = fmaxf(mx[qb], __shfl_xor(mx[qb], 16)); m2 = fmaxf(m2, __shfl_xor(m2, 32));
                        const float mn = fmaxf(mrun[qb], m2), corr = __builtin_amdgcn_exp2f(mrun[qb] - mn);
                        mrun[qb] = mn; lrun[qb] *= corr;
#pragma unroll
                        for (int db = 0; db < 4; ++db) oacc[db][qb] = oacc[db][qb] * corr;
                    }
                }
#pragma unroll
                for (int hf = 0; hf < 2; ++hf) {
                    if (hf == 0 ? act0 : act1) {
                        bf16x8 pf[2][2];
#pragma unroll
                        for (int qb = 0; qb < 2; ++qb) {
                            const float mn = mrun[qb];
                            float ps = 0.f;
#pragma unroll
                            for (int kb = 0; kb < 4; ++kb)
#pragma unroll
                                for (int j = 0; j < 4; ++j) { const float pv = __builtin_amdgcn_exp2f(sacc[hf][kb][qb][j] - mn); sacc[hf][kb][qb][j] = pv; ps += pv; }
                            lrun[qb] += ps;
#pragma unroll
                            for (int kk = 0; kk < 2; ++kk) {
                                u32x4 pw;
                                pw.x = cvt_pk_bf16(sacc[hf][2 * kk][qb][0], sacc[hf][2 * kk][qb][1]); pw.y = cvt_pk_bf16(sacc[hf][2 * kk][qb][2], sacc[hf][2 * kk][qb][3]);
                                pw.z = cvt_pk_bf16(sacc[hf][2 * kk + 1][qb][0], sacc[hf][2 * kk + 1][qb][1]); pw.w = cvt_pk_bf16(sacc[hf][2 * kk + 1][qb][2], sacc[hf][2 * kk + 1][qb][3]);
                                pf[qb][kk] = __builtin_bit_cast(bf16x8, pw);
                            }
                        }
#pragma unroll
                        for (int db = 0; db < 4; ++db)
#pragma unroll
                            for (int kk = 0; kk < 2; ++kk) {
                                const u32x2 lo = *(const u32x2*)(vb_ + (db * 16 + fr) * 136 + hf * 64 + (2 * kk) * 16 + fq * 4);
                                const u32x2 hi = *(const u32x2*)(vb_ + (db * 16 + fr) * 136 + hf * 64 + (2 * kk + 1) * 16 + fq * 4);
                                u32x4 vw; vw.x = lo.x; vw.y = lo.y; vw.z = hi.x; vw.w = hi.y;
                                const bf16x8 vf = __builtin_bit_cast(bf16x8, vw);
#pragma unroll
                                for (int qb = 0; qb < 2; ++qb) oacc[db][qb] = __builtin_amdgcn_mfma_f32_16x16x32_bf16(vf, pf[qb][kk], oacc[db][qb], 0, 0, 0);
                            }
                    }
                }
            }
            if (dt < dt1) ATT_LSTORE(buf ^ 1);
            __syncthreads();
        }
#undef ATT_GLOAD
#undef ATT_LSTORE
#pragma unroll
        for (int qb = 0; qb < 2; ++qb) {
            float lt = lrun[qb]; lt += __shfl_xor(lt, 16); lt += __shfl_xor(lt, 32);
            const float inv = 1.0f / lt;
            bf16_t* op = (bf16_t*)(p.ws + OFF_U) + (tokb + c * 64 + half * 32 + qb * 16 + fr) * D + h * 64 + fq * 4;
#pragma unroll
            for (int db = 0; db < 4; ++db) {
                u32x2 ow; ow.x = cvt_pk_bf16(oacc[db][qb][0] * inv, oacc[db][qb][1] * inv); ow.y = cvt_pk_bf16(oacc[db][qb][2] * inv, oacc[db][qb][3] * inv);
                *(u32x2*)(op + db * 16) = ow;
            }
        }
    }
    __syncthreads();
}

#ifndef REP_ATTN
#define REP_ATTN 1
#endif
#ifndef REP_REC
#define REP_REC 1
#endif
#ifndef REP_NORM
#define REP_NORM 1
#endif
#ifndef REP_SYNC
#define REP_SYNC 1
#endif
#ifndef REP_PREP
#define REP_PREP 1
#endif
#ifndef REP_G3
#define REP_G3 1
#endif
#define GSYNC() do { for (int r_ = 0; r_ < REP_SYNC; ++r_) xcd_barrier(xb); } while (0)
__global__ void __launch_bounds__(512, 2) yoco_fwd(Params p) {
    extern __shared__ __attribute__((aligned(16))) unsigned char shm[];
    cg::grid_group grid = cg::this_grid();
    {
        const int t0 = threadIdx.x;
        if ((t0 & 63) == 0) *(volatile LAS int*)(LAS unsigned char*)(shm + WAVE_TAB_OFF + 4 * hw_wave_slot()) = t0 >> 6;
        __syncthreads();
    }
    const int tid0 = opaque_tid();
    unsigned* barw = (unsigned*)(p.ws + OFF_BAR);
    for (int i = blockIdx.x * 512 + tid0; i < XCD_BAR_WORDS; i += gridDim.x * 512) barw[i] = 0u;
    {
        u32x4* z = (u32x4*)(p.ws + OFF_ROWSS); const int nz = (int)((8 * (size_t)MTOK * 8) / 16);
        for (int i = blockIdx.x * 512 + tid0; i < nz; i += gridDim.x * 512) z[i] = (u32x4){0u, 0u, 0u, 0u};
    }
    volatile LAS unsigned* xst = (volatile LAS unsigned*)(LAS unsigned char*)(shm + LDS_BYTES - 16);
    if (tid0 == 0) { xst[0] = 0u; xst[1] = 0u; }
    for (int r = 0; r < REP_PREP; ++r) prep_phase(p, shm);
    grid.sync();
    XcdBarrier xb = xcd_barrier_post(barw, xst);
    {
        const float* mv = (const float*)(p.ws + OFF_MODV);
        for (int r = 0; r < REP_NORM; ++r) norm_phase(p.in[0], (bf16_t*)(p.ws + OFF_U), p.in[4], mv, mv + D, 6144, nullptr, nullptr, nullptr, nullptr, 0);
    }
    GSYNC();
    for (int l = 0; l < 4; ++l) {
        const float* hsrc = (l == 0) ? p.in[0] : p.h;
        const float* mv = (const float*)(p.ws + OFF_MODV) + (size_t)l * 8 * 6144;
        bf16_t* UF = (l < 2) ? (bf16_t*)(p.ws + OFF_UF_A) : (bf16_t*)(p.ws + OFF_QB);
        if (l < 2) {
            pg8::EpiHgrnIn e; e.QVG = (bf16_t*)(p.ws + OFF_QH); e.LF = (bf16_t*)(p.ws + OFF_LF); e.lb = (const float*)(p.ws + OFF_LBV) + l * D;
            run_gemm(shm, (const bf16_t*)(p.ws + OFF_U), (const bf16_t*)(p.ws + OFF_WB_A_IN) + (size_t)l * AIN * D, AIN, D, e);
            GSYNC();
            for (int r = 0; r < REP_REC; ++r) rec_passA(p, shm);
            GSYNC();
            for (int r = 0; r < REP_REC; ++r) rec_pass<true>(p, l, shm);
        } else {
            if (l == 2) { pg8::EpiBf16Split e; e.d0 = (bf16_t*)(p.ws + OFF_KB); e.scale = 1.0f;
                run_gemm(shm, (const bf16_t*)(p.ws + OFF_QB), (const bf16_t*)(p.ws + OFF_WB_KV), 2048, D, e);
                GSYNC(); }
            { pg8::EpiBf16Split e; e.d0 = (bf16_t*)(p.ws + OFF_QB); e.scale = 0.125f; run_gemm(shm, (const bf16_t*)(p.ws + OFF_U), (const bf16_t*)(p.ws + OFF_WB_Q) + (size_t)(l - 2) * D * D, D, D, e); }
            GSYNC();
            for (int r = 0; r < REP_ATTN; ++r) attn_phase(p, l - 2, shm);
        }
        GSYNC();
        {
            pg8::EpiResid e; e.in = p.in; e.ws = p.ws; e.hbuf = p.h; e.l = l; e.which = 0;
            run_gemm(shm, (const bf16_t*)(p.ws + OFF_U), (l < 2) ? (const bf16_t*)(p.ws + OFF_WB_A_OUT) + (size_t)l * D * D : (const bf16_t*)(p.ws + OFF_WB_O) + (size_t)(l - 2) * D * D, D, D, e);
        }
        GSYNC();
        for (int r = 0; r < REP_G3; ++r) { pg8::EpiSwiglu e; e.act = (bf16_t*)(p.ws + OFF_ACT); run_gemm(shm, UF, (const bf16_t*)(p.ws + OFF_WB_FFN_IN) + (size_t)l * 2 * FFN * D, 2 * FFN, D, e); }
        GSYNC();
        {
            pg8::EpiResid e; e.in = p.in; e.ws = p.ws; e.hbuf = p.h; e.l = l; e.which = 1;
            run_gemm(shm, (const bf16_t*)(p.ws + OFF_ACT), (const bf16_t*)(p.ws + OFF_WB_FFN_OUT) + (size_t)l * D * FFN, D, FFN, e);
        }
        if (l < 3) GSYNC();
    }
}

extern "C" void kernel_launch(void* const* d_in, const int* in_sizes, int n_in, void* d_out, int out_size, void* d_ws, size_t ws_size, hipStream_t stream) {
    static int grid_blocks = 0;
    if (!grid_blocks) {
        int dev = 0, cus = 0, per_cu = 0;
        hipGetDevice(&dev);
        hipDeviceGetAttribute(&cus, hipDeviceAttributeMultiprocessorCount, dev);
        hipFuncSetAttribute((const void*)yoco_fwd, hipFuncAttributeMaxDynamicSharedMemorySize, LDS_BYTES);
        hipOccupancyMaxActiveBlocksPerMultiprocessor(&per_cu, (const void*)yoco_fwd, 512, LDS_BYTES);
        if (per_cu < 1) per_cu = 1;
        grid_blocks = cus * per_cu;
        (void)hipGetLastError();
    }
    Params p{};
    for (int i = 0; i < 20; ++i) p.in[i] = (const float*)d_in[i];
    p.h = (float*)d_out; p.ws = (unsigned char*)d_ws;
    if (ws_size < WS_END || n_in != 20) { fprintf(stderr, "kernel_launch: workspace too small (%zu < %zu) or unexpected inputs\n", ws_size, (size_t)WS_END); return; }
    void* args[] = {&p};
    hipError_t e = hipLaunchCooperativeKernel((const void*)yoco_fwd, dim3(grid_blocks), dim3(512), args, LDS_BYTES, stream);
    if (e != hipSuccess) fprintf(stderr, "cooperative launch failed: %s (grid %d)\n", hipGetErrorString(e), grid_blocks);
}
```

```cpp
#include <hip/hip_runtime.h>
#include <hip/hip_cooperative_groups.h>
#include <cstdio>
namespace cg = cooperative_groups;

#define LAS __attribute__((address_space(3)))
typedef unsigned short bf16_t;
typedef short bf16x8 __attribute__((ext_vector_type(8)));
typedef float f32x4 __attribute__((ext_vector_type(4)));
typedef unsigned u32x4 __attribute__((ext_vector_type(4)));
typedef unsigned u32x2 __attribute__((ext_vector_type(2)));
typedef float f32x2 __attribute__((ext_vector_type(2)));

constexpr int D = 1024, BATCH = 8, SEQ = 8192, MTOK = BATCH * SEQ, FFN = 2816, AIN = 4096;
constexpr int LDS_BYTES = 144 * 1024;
constexpr int XCD_BAR_WORDS_C = 3456;

__device__ __forceinline__ unsigned cvt_pk_bf16(float lo, float hi) { unsigned r; asm volatile("v_cvt_pk_bf16_f32 %0, %1, %2" : "=v"(r) : "v"(lo), "v"(hi)); return r; }
__device__ __forceinline__ float bf2f(unsigned short h) { return __uint_as_float((unsigned)h << 16); }
__device__ __forceinline__ float bflo(unsigned w) { return __uint_as_float(w << 16); }
__device__ __forceinline__ float bfhi(unsigned w) { return __uint_as_float(w & 0xffff0000u); }
__device__ __forceinline__ float silu_f(float x) { return x * __builtin_amdgcn_rcpf(1.0f + __expf(-x)); }

constexpr int WAVE_TAB_OFF = LDS_BYTES - 16 - 256;
__device__ __forceinline__ unsigned hw_wave_slot() { return (unsigned)__builtin_amdgcn_s_getreg(((6 - 1) << 11) | 4); }
__device__ __forceinline__ int opaque_tid() {
    extern __shared__ __attribute__((aligned(16))) unsigned char shm_tid_[];
    const int wv = __builtin_amdgcn_readfirstlane(*(volatile LAS int*)(LAS unsigned char*)(shm_tid_ + WAVE_TAB_OFF + 4 * hw_wave_slot()));
    int lane_;
    asm volatile("v_mbcnt_lo_u32_b32 %0, -1, 0\n\tv_mbcnt_hi_u32_b32 %0, -1, %0" : "=&v"(lane_));
    int t = wv * 64 + lane_;
    asm volatile("" : "+v"(t)); return t;
}
struct Params { const float* in[20]; float* h; unsigned char* ws; };
constexpr size_t ACTB = (size_t)MTOK * D * 2;
constexpr size_t OFF_WB_A_IN = 0;
constexpr size_t OFF_WB_A_OUT = OFF_WB_A_IN + (size_t)2 * AIN * D * 2;
constexpr size_t OFF_WB_FFN_IN = OFF_WB_A_OUT + (size_t)2 * D * D * 2;
constexpr size_t OFF_WB_FFN_OUT = OFF_WB_FFN_IN + (size_t)4 * 2 * FFN * D * 2;
constexpr size_t OFF_WB_KV = OFF_WB_FFN_OUT + (size_t)4 * D * FFN * 2;
constexpr size_t OFF_WB_Q = OFF_WB_KV + (size_t)2 * D * D * 2;
constexpr size_t OFF_WB_O = OFF_WB_Q + (size_t)2 * D * D * 2;
constexpr size_t OFF_MODV = OFF_WB_O + (size_t)2 * D * D * 2;
constexpr size_t OFF_KVMOD = OFF_MODV + (size_t)4 * 8 * 6144 * 4;
constexpr size_t OFF_LBV = OFF_KVMOD + (size_t)8 * 2048 * 4;
constexpr size_t OFF_U = OFF_LBV + (size_t)2 * D * 4;
constexpr size_t OFF_R = OFF_U + ACTB;
constexpr size_t OFF_QH = OFF_R, OFF_VH = OFF_R + ACTB, OFF_GH = OFF_R + 2 * ACTB, OFF_LF = OFF_R + 3 * ACTB;
constexpr size_t OFF_ACT = OFF_R;
constexpr size_t OFF_UF_A = OFF_R + 4 * ACTB;
constexpr size_t OFF_KB = OFF_R + (size_t)MTOK * FFN * 2, OFF_VB = OFF_KB + ACTB, OFF_QB = OFF_VB + ACTB;
constexpr size_t OFF_SLOC = OFF_R + 5 * ACTB, OFF_DLOG = OFF_SLOC + (size_t)256 * 16384 * 4;
constexpr size_t OFF_BAR = OFF_QB + ACTB;
constexpr size_t OFF_ROWSS = OFF_BAR + (size_t)16384;
constexpr size_t WS_END = OFF_ROWSS + (size_t)8 * MTOK * 8;


#define XB_TMO      128
#define XB_XCNT(j)  (256  + 64 * (j))
#define XB_XSUB(j)  (1280 + 64 * (j))
#define XB_XGEN(j)  (2304 + 64 * (j))
#define XB_TOP      3328
#define XB_TOPGEN   3392
#define XCD_BAR_WORDS 3456
#define XB_SPIN_CAP (1u << 18)
__device__ __forceinline__ unsigned xb_ld(unsigned* p)              { return __hip_atomic_load(p, __ATOMIC_RELAXED, __HIP_MEMORY_SCOPE_AGENT); }
__device__ __forceinline__ unsigned xb_add(unsigned* p, unsigned v) { return __hip_atomic_fetch_add(p, v, __ATOMIC_RELAXED, __HIP_MEMORY_SCOPE_AGENT); }
__device__ __forceinline__ unsigned xb_xcc_id() { return (unsigned)__builtin_amdgcn_s_getreg((3 << 11) | 20) & 0xFu; }
#define XB_SPIN(cond, bar) do { unsigned _sp = 0; while (cond) { __builtin_amdgcn_s_sleep(1); \
    if ((++_sp & 255u) == 0u) { if (xb_ld(&(bar)[XB_TMO])) break; if (_sp > XB_SPIN_CAP) { atomicAdd(&(bar)[XB_TMO], 1u); break; } } } } while (0)
struct XcdBarrier { unsigned* bar; unsigned x; volatile LAS unsigned* st; };
__device__ __forceinline__ XcdBarrier xcd_barrier_post(unsigned* bar, volatile LAS unsigned* st) {
    XcdBarrier b; b.bar = bar; b.x = xb_xcc_id(); b.st = st;
    if (opaque_tid() == 0) (void)xb_add(&bar[XB_XCNT(b.x)], 1u);
    return b;
}
__device__ __forceinline__ void xcd_barrier_complete(unsigned* bar, unsigned x, unsigned& nloc, unsigned& nx) {
    const unsigned G = gridDim.x * gridDim.y * gridDim.z;
    unsigned sum, cnt, mine, sp = 0u;
    for (;;) {
        sum = 0u; cnt = 0u; mine = 0u;
#pragma unroll
        for (unsigned j = 0; j < 16; ++j) { const unsigned c = xb_ld(&bar[XB_XCNT(j)]); sum += c; cnt += (c > 0u) ? 1u : 0u; mine = (j == x) ? c : mine; }
        if (sum == G) break;
        __builtin_amdgcn_s_sleep(1);
        if ((++sp & 255u) == 0u) { if (xb_ld(&bar[XB_TMO])) break; if (sp > XB_SPIN_CAP) { atomicAdd(&bar[XB_TMO], 1u); break; } }
    }
    nloc = mine > 0u ? mine : 1u; nx = cnt > 0u ? cnt : 1u;
}
__device__ __forceinline__ void xcd_barrier(const XcdBarrier& b) {
    asm volatile("s_waitcnt vmcnt(0)" ::: "memory");
    __syncthreads();
    if (opaque_tid() == 0) {
        unsigned* bar = b.bar;
        __builtin_amdgcn_s_waitcnt(0);
        unsigned nloc = b.st[0], nx = b.st[1];
        if (nloc == 0u) { xcd_barrier_complete(bar, b.x, nloc, nx); b.st[0] = nloc; b.st[1] = nx; }
        const unsigned old = xb_add(&bar[XB_XSUB(b.x)], 1u);
        const unsigned gen = old / nloc;
        if (old + 1u == (gen + 1u) * nloc) {
            __builtin_amdgcn_fence(__ATOMIC_RELEASE, "agent");
            asm volatile("s_waitcnt vmcnt(0)" ::: "memory");
            const unsigned og = xb_add(&bar[XB_TOP], 1u);
            const unsigned tg = og / nx;
            if (og + 1u == (tg + 1u) * nx) xb_add(&bar[XB_TOPGEN], 1u);
            else XB_SPIN(xb_ld(&bar[XB_TOPGEN]) == tg, bar);
            __builtin_amdgcn_fence(__ATOMIC_ACQUIRE, "agent");
            xb_add(&bar[XB_XGEN(b.x)], 1u);
            asm volatile("s_waitcnt vmcnt(0)" ::: "memory");
        } else {
            XB_SPIN(xb_ld(&bar[XB_XGEN(b.x)]) == gen, bar);
            __builtin_amdgcn_fence(__ATOMIC_ACQUIRE, "agent");
            asm volatile("s_waitcnt vmcnt(0)" ::: "memory");
        }
    }
    __syncthreads();
}

namespace pg8 {
constexpr int BM = 256, BK = 64, HALF = 128, HTB = HALF * BK * 2, STAGE_BYTES = 8 * HTB, NXCD = 8, WGM = 8;
__device__ __forceinline__ int lds_byte(int r, int c) { const int st = (r >> 4) * 2 + (c >> 5), rr = r & 15, cc = c & 31, ob = rr * 64 + cc * 2; return st * 1024 + (ob ^ (((ob >> 9) & 1) << 5)); }
__device__ __forceinline__ void stage_rc(int b, int& R, int& C) { const int st = b / 1024, sb = b % 1024, swz = sb ^ (((sb >> 9) & 1) << 5); R = (st >> 1) * 16 + swz / 64; C = (st & 1) * 32 + (swz % 64) / 2; }
__device__ __forceinline__ int perm32(int rho) { const int n = rho >> 4, i = rho & 15; return 8 * (i >> 2) + 4 * n + (i & 3); }
struct Unit { int pm, pn; };
struct Gemm { const bf16_t* A; const bf16_t* Bt; int M, N, K; };
struct StaticOrder {
    int nM, nN, nwg, G, c;
    __device__ void init(int M, int N, int G_, int c_) { nM = M / BM; nN = N / BM; nwg = nM * nN; G = G_; c = c_; }
    __device__ bool next(int i, Unit& u) const {
        const long L = (long)i * G + c; if (L >= nwg) return false;
        int wgid = (int)L; { const int q = nwg / NXCD, r = nwg % NXCD, xcd = wgid % NXCD, off = wgid / NXCD; wgid = (xcd < r ? xcd * (q + 1) : r * (q + 1) + (xcd - r) * q) + off; }
        const int nig = WGM * nN, gid = wgid / nig, fm = gid * WGM, gsz = (nM - fm) < WGM ? (nM - fm) : WGM;
        u.pm = fm + ((wgid % nig) % gsz); u.pn = (wgid % nig) / gsz; return true;
    }
};

template <class Epi>
__device__ __forceinline__ void gemm_phase(LAS unsigned char* lds, const Gemm g, const StaticOrder& S, const Epi& E) {
    const int tid = opaque_tid(), wid = __builtin_amdgcn_readfirstlane(tid >> 6), lane = tid & 63, wr = wid >> 2, wc = wid & 3, fr = lane & 15, fq = lane >> 4;
    const int K = g.K, nt = K / BK;
    unsigned voffA[2], voffB[2];
#pragma unroll
    for (int i = 0; i < 2; ++i) { int R, C; stage_rc(tid * 16 + i * 8192, R, C); const int Rb = Epi::PERM ? ((R & ~31) + perm32(R & 31)) : R;
        voffA[i] = (unsigned)(R * K + C) * 2u; voffB[i] = (unsigned)(Rb * K + C) * 2u; }
    const size_t kstep = (size_t)(BK * 2);
    const size_t hstep = (size_t)HALF * K * 2;
    const size_t tstep = 2 * hstep;
    const unsigned ldsw = (unsigned)wid * 1024u;
    const int aoff = lds_byte(wr * 64 + fr, fq * 8), boff = lds_byte(wc * 32 + fr, fq * 8);
#define PG8_SA(b, h) (((b) * 2 + (h)) * HTB)
#define PG8_SB(b, h) ((4 + (b) * 2 + (h)) * HTB)
#define PG8_STAGE(bufoff, gbase, voff) do { _Pragma("unroll") for (int _i = 0; _i < 2; ++_i) \
        __builtin_amdgcn_global_load_lds((const unsigned*)((const char*)(gbase) + (voff)[_i]), (LAS unsigned*)(lds + (bufoff) + ldsw + _i * 8192), 16, 0, 0); } while (0)
#define PG8_LDA(dst, b, h) do { _Pragma("unroll") for (int m = 0; m < 4; ++m) _Pragma("unroll") for (int k = 0; k < 2; ++k) dst[m][k] = *(const LAS bf16x8*)(lds + PG8_SA(b, h) + aoff + m * 2048 + k * 1024); } while (0)
#define PG8_LDB(dst, b, h) do { _Pragma("unroll") for (int n = 0; n < 2; ++n) _Pragma("unroll") for (int k = 0; k < 2; ++k) dst[n][k] = *(const LAS bf16x8*)(lds + PG8_SB(b, h) + boff + n * 2048 + k * 1024); } while (0)
#define PG8_MMA(ai, bj, At, Bt) do { __builtin_amdgcn_s_setprio(1); _Pragma("unroll") for (int m = 0; m < 4; ++m) _Pragma("unroll") for (int n = 0; n < 2; ++n) _Pragma("unroll") for (int k = 0; k < 2; ++k) \
        acc[ai][bj][m][n] = __builtin_amdgcn_mfma_f32_16x16x32_bf16(Bt[n][k], At[m][k], acc[ai][bj][m][n], 0, 0, 0); __builtin_amdgcn_s_setprio(0); } while (0)
#define PG8_WAIT_V(n) asm volatile("s_waitcnt vmcnt(" #n ")" ::: "memory")
#define PG8_WAIT_L(n) asm volatile("s_waitcnt lgkmcnt(" #n ")" ::: "memory")
#define PG8_BAR __builtin_amdgcn_s_barrier()
#define PG8_SCHED __builtin_amdgcn_sched_barrier(0)
    Unit cur, nxt; int ui = 0;
    if (!S.next(0, cur)) return;
    f32x4 acc[2][2][4][2];
#pragma unroll
    for (int a = 0; a < 2; ++a)
#pragma unroll
        for (int b = 0; b < 2; ++b)
#pragma unroll
            for (int m = 0; m < 4; ++m)
#pragma unroll
                for (int n = 0; n < 2; ++n) acc[a][b][m][n] = (f32x4){0.f, 0.f, 0.f, 0.f};
    bf16x8 At[4][2], B0[2][2], B1[2][2];
    const char* cA = (const char*)g.A + (size_t)cur.pm * tstep; const char* cB = (const char*)g.Bt + (size_t)cur.pn * tstep;
    PG8_STAGE(PG8_SB(0, 0), cB, voffB); PG8_STAGE(PG8_SA(0, 0), cA, voffA); PG8_STAGE(PG8_SB(0, 1), cB + hstep, voffB); PG8_STAGE(PG8_SA(0, 1), cA + hstep, voffA);
    if (wr == 1) PG8_BAR;
    PG8_WAIT_V(4); PG8_BAR;
    PG8_STAGE(PG8_SB(1, 0), cB + kstep, voffB); PG8_STAGE(PG8_SA(1, 0), cA + kstep, voffA); PG8_STAGE(PG8_SB(1, 1), cB + hstep + kstep, voffB);
    PG8_WAIT_V(6); PG8_BAR;
    for (;;) {
        const bool has_next = S.next(ui + 1, nxt);
        const char* nA = has_next ? (const char*)g.A + (size_t)nxt.pm * tstep : cA; const char* nB = has_next ? (const char*)g.Bt + (size_t)nxt.pn * tstep : cB;
        for (int t = 0; t < nt; t += 2) {
            const bool last = (t == nt - 2);
            const char* a1 = cA + (size_t)(t + 1) * kstep;
            const char* a2 = last ? nA : cA + (size_t)(t + 2) * kstep; const char* b2 = last ? nB : cB + (size_t)(t + 2) * kstep;
            const char* a3 = a2 + kstep; const char* b3 = b2 + kstep;
            PG8_LDB(B0, 0, 0); PG8_SCHED; PG8_LDA(At, 0, 0); PG8_STAGE(PG8_SA(1, 1), a1 + hstep, voffA);
            PG8_WAIT_L(8); PG8_BAR; PG8_WAIT_L(0); PG8_MMA(0, 0, At, B0); PG8_BAR; PG8_SCHED;
            PG8_LDB(B1, 0, 1); PG8_STAGE(PG8_SB(0, 0), b2, voffB);
            PG8_BAR; PG8_WAIT_L(0); PG8_MMA(0, 1, At, B1); PG8_BAR;
            PG8_LDA(At, 0, 1); PG8_STAGE(PG8_SA(0, 0), a2, voffA);
            PG8_BAR; PG8_WAIT_L(0); PG8_MMA(1, 0, At, B0); PG8_BAR; PG8_SCHED;
            PG8_STAGE(PG8_SB(0, 1), b2 + hstep, voffB);
            PG8_WAIT_V(6); PG8_BAR; PG8_MMA(1, 1, At, B1); PG8_BAR;
            PG8_LDB(B0, 1, 0); PG8_SCHED; PG8_LDA(At, 1, 0); PG8_STAGE(PG8_SA(0, 1), a2 + hstep, voffA);
            PG8_WAIT_L(8); PG8_BAR; PG8_WAIT_L(0); PG8_MMA(0, 0, At, B0); PG8_BAR; PG8_SCHED;
            PG8_LDB(B1, 1, 1); PG8_STAGE(PG8_SB(1, 0), b3, voffB);
            PG8_BAR; PG8_WAIT_L(0); PG8_MMA(0, 1, At, B1); PG8_BAR;
            PG8_LDA(At, 1, 1); PG8_STAGE(PG8_SA(1, 0), a3, voffA);
            PG8_BAR; PG8_WAIT_L(0); PG8_MMA(1, 0, At, B0); PG8_BAR; PG8_SCHED;
            PG8_STAGE(PG8_SB(1, 1), b3 + hstep, voffB);
            PG8_WAIT_V(6); PG8_BAR; PG8_MMA(1, 1, At, B1); PG8_BAR;
        }
        E(acc, cur, wr, wc, fr, fq);
        if (!has_next) break;
#pragma unroll
        for (int a = 0; a < 2; ++a)
#pragma unroll
            for (int b = 0; b < 2; ++b)
#pragma unroll
                for (int m = 0; m < 4; ++m)
#pragma unroll
                    for (int n = 0; n < 2; ++n) acc[a][b][m][n] = (f32x4){0.f, 0.f, 0.f, 0.f};
        cur = nxt; cA = nA; cB = nB; ++ui;
    }
    PG8_WAIT_V(0);
    if (wr == 0) PG8_BAR;
    PG8_BAR;
#undef PG8_SA
#undef PG8_SB
#undef PG8_STAGE
#undef PG8_LDA
#undef PG8_LDB
#undef PG8_MMA
#undef PG8_WAIT_V
#undef PG8_WAIT_L
#undef PG8_BAR
#undef PG8_SCHED
}

struct EpiHgrnIn {
    static constexpr bool PERM = true;
    bf16_t* QVG; bf16_t* LF; const float* lb;
    __device__ __forceinline__ void operator()(const f32x4 (&acc)[2][2][4][2], const Unit& u, int wr, int wc, int fr, int fq) const {
        const int seg = u.pn >> 2, colt = (u.pn & 3) * 256;
        const int row0 = u.pm * BM + wr * 64 + fr, col0 = colt + wc * 32 + 8 * fq;
        if (seg == 1) {
#pragma unroll
            for (int bj = 0; bj < 2; ++bj) {
                const f32x4 l0 = *(const f32x4*)(lb + col0 + bj * HALF), l1 = *(const f32x4*)(lb + col0 + bj * HALF + 4);
#pragma unroll
                for (int ai = 0; ai < 2; ++ai)
#pragma unroll
                    for (int m = 0; m < 4; ++m) {
                        bf16_t* rowp = LF + (size_t)(row0 + ai * HALF + m * 16) * D + col0 + bj * HALF;
                        f32x4 o0, o1;
#pragma unroll
                        for (int j = 0; j < 4; ++j) {
                            float z = acc[ai][bj][m][0][j]; float sg = __builtin_amdgcn_rcpf(1.0f + __expf(-z)); float f = l0[j] + (1.0f - l0[j]) * sg; o0[j] = logf(fmaxf(f, 1e-30f));
                            z = acc[ai][bj][m][1][j]; sg = __builtin_amdgcn_rcpf(1.0f + __expf(-z)); f = l1[j] + (1.0f - l1[j]) * sg; o1[j] = logf(fmaxf(f, 1e-30f));
                        }
                        u32x4 lw; lw.x = cvt_pk_bf16(o0[0], o0[1]); lw.y = cvt_pk_bf16(o0[2], o0[3]); lw.z = cvt_pk_bf16(o1[0], o1[1]); lw.w = cvt_pk_bf16(o1[2], o1[3]);
                        *(u32x4*)rowp = lw;
                    }
            }
        } else {
            bf16_t* base = QVG + (size_t)(seg == 0 ? 0 : (seg == 2 ? 1 : 2)) * ((size_t)MTOK * D);
            const bool act = (seg != 2);
#pragma unroll
            for (int ai = 0; ai < 2; ++ai)
#pragma unroll
                for (int m = 0; m < 4; ++m)
#pragma unroll
                    for (int bj = 0; bj < 2; ++bj) {
                        f32x4 v0 = acc[ai][bj][m][0], v1 = acc[ai][bj][m][1];
                        if (act) {
#pragma unroll
                            for (int j = 0; j < 4; ++j) { v0[j] = silu_f(v0[j]); v1[j] = silu_f(v1[j]); }
                        }
                        u32x4 w; w.x = cvt_pk_bf16(v0[0], v0[1]); w.y = cvt_pk_bf16(v0[2], v0[3]); w.z = cvt_pk_bf16(v1[0], v1[1]); w.w = cvt_pk_bf16(v1[2], v1[3]);
                        *(u32x4*)(base + (size_t)(row0 + ai * HALF + m * 16) * D + col0 + bj * HALF) = w;
                    }
        }
    }
};
struct EpiResid {
    static constexpr bool PERM = true;
    const float* const* in; unsigned char* ws; float* hbuf; int l, which;
    __device__ __forceinline__ void emit(const f32x4 (&v)[2][2][4][2], const float (&rs)[2][4], bf16_t* U, const float* gain, const float* sh, const float* sc, int bs, int b, int row0, int col0) const {
#pragma unroll
        for (int bj = 0; bj < 2; ++bj) {
            const int c = col0 + bj * HALF;
            f32x4 a0, a1, t0, t1;
            { const f32x4 g0 = *(const f32x4*)(gain + c), s0 = *(const f32x4*)(sc + (size_t)b * bs + c); a0 = g0 * (s0 + 1.0f); t0 = *(const f32x4*)(sh + (size_t)b * bs + c); }
            { const f32x4 g1 = *(const f32x4*)(gain + c + 4), s1 = *(const f32x4*)(sc + (size_t)b * bs + c + 4); a1 = g1 * (s1 + 1.0f); t1 = *(const f32x4*)(sh + (size_t)b * bs + c + 4); }
#pragma unroll
            for (int ai = 0; ai < 2; ++ai)
#pragma unroll
                for (int m = 0; m < 4; ++m) {
                    const f32x4 u0 = (v[ai][bj][m][0] * rs[ai][m]) * a0 + t0, u1 = (v[ai][bj][m][1] * rs[ai][m]) * a1 + t1;
                    u32x4 w; w.x = cvt_pk_bf16(u0[0], u0[1]); w.y = cvt_pk_bf16(u0[2], u0[3]); w.z = cvt_pk_bf16(u1[0], u1[1]); w.w = cvt_pk_bf16(u1[2], u1[3]);
                    *(u32x4*)(U + (size_t)(row0 + ai * HALF + m * 16) * D + c) = w;
                }
            __builtin_amdgcn_sched_barrier(0);
        }
    }
    __device__ __forceinline__ void operator()(f32x4 (&acc)[2][2][4][2], const Unit& u, int wr, int wc, int fr, int fq) const {
        __builtin_amdgcn_sched_barrier(0);
        const int b = u.pm >> 5;
        const float* mv = (const float*)(ws + OFF_MODV) + (size_t)l * 8 * 6144;
        const float* src = (l == 0 && which == 0) ? in[0] : hbuf; float* dst = hbuf;
        const int mode = (l == 3 && which == 1) ? 1 : 0;
        unsigned long long* rowacc = (unsigned long long*)(ws + OFF_ROWSS) + (size_t)(2 * l + which) * MTOK;
        const float* gp = mv + (which ? 5 : 2) * D + (size_t)b * 6144;
        const int row0 = u.pm * BM + wr * 64 + fr, col0 = u.pn * BM + wc * 32 + 8 * fq;
        {
            f32x4 gv[2][2];
#pragma unroll
            for (int bj = 0; bj < 2; ++bj)
#pragma unroll
                for (int n = 0; n < 2; ++n) gv[bj][n] = *(const f32x4*)(gp + col0 + bj * HALF + 4 * n);
#pragma unroll
            for (int ai = 0; ai < 2; ++ai)
#pragma unroll
                for (int m = 0; m < 4; ++m) {
                    const size_t ro = (size_t)(row0 + ai * HALF + m * 16) * D + col0;
                    float pt = 0.f;
#pragma unroll
                    for (int bj = 0; bj < 2; ++bj)
#pragma unroll
                        for (int n = 0; n < 2; ++n) {
                            const f32x4 v = *(const f32x4*)(src + ro + bj * HALF + 4 * n) + gv[bj][n] * acc[ai][bj][m][n];
                            acc[ai][bj][m][n] = v;
                            if (mode == 0) *(f32x4*)(dst + ro + bj * HALF + 4 * n) = v;
                            pt += (v[0] * v[0] + v[1] * v[1]) + (v[2] * v[2] + v[3] * v[3]);
                        }
                    pt += __shfl_xor(pt, 16); pt += __shfl_xor(pt, 32);
                    if (fq == 0) (void)__hip_atomic_fetch_add(rowacc + row0 + ai * HALF + m * 16, (1ull << 48) + (unsigned long long)(pt * 65536.0f + 0.5f), __ATOMIC_RELAXED, __HIP_MEMORY_SCOPE_AGENT);
                    __builtin_amdgcn_sched_barrier(0);
                }
        }
        float rs[2][4];
        {
            unsigned spins = 0;
            for (;;) {
                bool done = true;
#pragma unroll
                for (int ai = 0; ai < 2; ++ai)
#pragma unroll
                    for (int m = 0; m < 4; ++m) {
                        const unsigned long long q = __hip_atomic_load(rowacc + row0 + ai * HALF + m * 16, __ATOMIC_RELAXED, __HIP_MEMORY_SCOPE_AGENT);
                        done = done && ((q >> 48) >= 16ull);
                        rs[ai][m] = rsqrtf((float)(q & 0xffffffffffffull) * (1.0f / 65536.0f) * (1.0f / D) + 1e-6f);
                    }
                if (__all(done) || ++spins > (1u << 16)) break;
                __builtin_amdgcn_s_sleep(2);
            }
        }
        asm volatile("" ::: "memory");
        __builtin_amdgcn_sched_barrier(0);
        if (mode == 1) {
            const float* gain1 = in[19];
#pragma unroll
            for (int bj = 0; bj < 2; ++bj) {
                const f32x4 g0 = *(const f32x4*)(gain1 + col0 + bj * HALF), g1 = *(const f32x4*)(gain1 + col0 + bj * HALF + 4);
#pragma unroll
                for (int ai = 0; ai < 2; ++ai)
#pragma unroll
                    for (int m = 0; m < 4; ++m) {
                        float* op = dst + (size_t)(row0 + ai * HALF + m * 16) * D + col0 + bj * HALF;
                        *(f32x4*)op = (acc[ai][bj][m][0] * rs[ai][m]) * g0; *(f32x4*)(op + 4) = (acc[ai][bj][m][1] * rs[ai][m]) * g1;
                    }
            }
        } else {
            if (which == 0) emit(acc, rs, (l < 2) ? (bf16_t*)(ws + OFF_UF_A) : (bf16_t*)(ws + OFF_QB), in[5] + l * D, mv + 3 * D, mv + 4 * D, 6144, b, row0, col0);
            else {
                const float* mvn = mv + (size_t)8 * 6144;
                emit(acc, rs, (bf16_t*)(ws + OFF_U), in[4] + (l + 1) * D, mvn, mvn + D, 6144, b, row0, col0);
                if (l == 1) { const float* kvm = (const float*)(ws + OFF_KVMOD); emit(acc, rs, (bf16_t*)(ws + OFF_QB), in[12], kvm, kvm + D, 2048, b, row0, col0); }
            }
        }
    }
};
struct EpiSwiglu {
    static constexpr bool PERM = true;
    bf16_t* act;
    __device__ __forceinline__ void operator()(const f32x4 (&acc)[2][2][4][2], const Unit& u, int wr, int wc, int fr, int fq) const {
        const int row0 = u.pm * BM + wr * 64 + fr, col0 = u.pn * HALF + wc * 32 + 8 * fq;
#pragma unroll
        for (int ai = 0; ai < 2; ++ai)
#pragma unroll
            for (int m = 0; m < 4; ++m) {
                f32x4 r0, r1;
#pragma unroll
                for (int j = 0; j < 4; ++j) { r0[j] = silu_f(acc[ai][0][m][0][j]) * acc[ai][1][m][0][j]; r1[j] = silu_f(acc[ai][0][m][1][j]) * acc[ai][1][m][1][j]; }
                u32x4 w; w.x = cvt_pk_bf16(r0[0], r0[1]); w.y = cvt_pk_bf16(r0[2], r0[3]); w.z = cvt_pk_bf16(r1[0], r1[1]); w.w = cvt_pk_bf16(r1[2], r1[3]);
                *(u32x4*)(act + (size_t)(row0 + ai * HALF + m * 16) * FFN + col0) = w;
            }
    }
};
struct EpiBf16Split {
    static constexpr bool PERM = true;
    bf16_t* d0; float scale;
    __device__ __forceinline__ void operator()(const f32x4 (&acc)[2][2][4][2], const Unit& u, int wr, int wc, int fr, int fq) const {
        bf16_t* base = d0 + (size_t)(u.pn >> 2) * ((size_t)MTOK * D);
        const int row0 = u.pm * BM + wr * 64 + fr, col0 = (u.pn & 3) * 256 + wc * 32 + 8 * fq;
#pragma unroll
        for (int ai = 0; ai < 2; ++ai)
#pragma unroll
            for (int m = 0; m < 4; ++m)
#pragma unroll
                for (int bj = 0; bj < 2; ++bj) {
                    const f32x4 v0 = acc[ai][bj][m][0] * scale, v1 = acc[ai][bj][m][1] * scale;
                    u32x4 w; w.x = cvt_pk_bf16(v0[0], v0[1]); w.y = cvt_pk_bf16(v0[2], v0[3]); w.z = cvt_pk_bf16(v1[0], v1[1]); w.w = cvt_pk_bf16(v1[2], v1[3]);
                    *(u32x4*)(base + (size_t)(row0 + ai * HALF + m * 16) * D + col0 + bj * HALF) = w;
                }
    }
};
}

template <class Epi>
__device__ __forceinline__ void run_gemm(unsigned char* shm, const bf16_t* A, const bf16_t* Bt, int N, int K, const Epi& E) {
    pg8::Gemm g; g.A = A; g.Bt = Bt; g.M = MTOK; g.N = N; g.K = K;
    pg8::StaticOrder S; S.init(MTOK, N, (int)gridDim.x, (int)blockIdx.x);
    pg8::gemm_phase<Epi>((LAS unsigned char*)shm, g, S, E);
    __syncthreads();
}

__device__ __forceinline__ int ffnmap(int nn) { return nn < FFN ? ((nn >> 7) * 256 + (nn & 127)) : (((nn - FFN) >> 7) * 256 + 128 + ((nn - FFN) & 127)); }

__device__ __forceinline__ void conv_group(const float* src0, bf16_t* dst0, const int K, const int N, const int L, const int mode, unsigned char* shm, const int tid) {
    float* st = (float*)shm;
    const int per = (K / 128) * (N / 64), total = L * per, ntn = N / 64;
    for (int tile = blockIdx.x; tile < total; tile += gridDim.x) {
        const int l = tile / per, tt = tile % per, k0 = (tt / ntn) * 128, n0 = (tt % ntn) * 64;
        const float* src = src0 + (size_t)l * K * N; bf16_t* dst = dst0 + (size_t)l * K * N;
        f32x4 v[4];
#pragma unroll
        for (int it = 0; it < 4; ++it) { const int idx = tid + it * 512, k = idx >> 4, n4 = idx & 15; v[it] = *(const f32x4*)(src + (size_t)(k0 + k) * N + n0 + 4 * n4); }
        __syncthreads();
#pragma unroll
        for (int it = 0; it < 4; ++it) { const int idx = tid + it * 512, k = idx >> 4, n4 = idx & 15;
#pragma unroll
            for (int e = 0; e < 4; ++e) st[k * 65 + 4 * n4 + e] = v[it][e]; }
        __syncthreads();
#pragma unroll
        for (int it = 0; it < 2; ++it) { const int idx = tid + it * 512, n = idx >> 4, kg = idx & 15; const int nn = n0 + n; const int drow = mode ? ffnmap(nn) : nn;
            u32x4 w;
#pragma unroll
            for (int e = 0; e < 4; ++e) w[e] = cvt_pk_bf16(st[(8 * kg + 2 * e) * 65 + n], st[(8 * kg + 2 * e + 1) * 65 + n]);
            *(u32x4*)(dst + (size_t)drow * K + k0 + 8 * kg) = w; }
    }
}

__device__ void prep_phase(const Params& p, unsigned char* shm) {
    const int tid = opaque_tid();
    {
        float* cact = (float*)shm;
        float* red = cact + 8192;
        bool loaded = false;
        const int wv = tid >> 6, lane = tid & 63;
        for (int task = blockIdx.x; task < 416; task += gridDim.x) {
            if (!loaded) {
                for (int i = tid; i < 8192; i += 512) { const int k = i >> 3, b = i & 7; cact[i] = silu_f(p.in[1][b * D + k]); }
                loaded = true;
            }
            __syncthreads();
            const int c0 = task * 64;
            const float* src; const float* bias; float* dst; int stride, dstride;
            if (c0 < 24576) { const int l = c0 / 6144, j = c0 % 6144; src = p.in[2] + (size_t)l * D * 6144 + j; stride = 6144; bias = p.in[3] + l * 6144 + j; dst = ((float*)(p.ws + OFF_MODV)) + (size_t)l * 8 * 6144 + j; dstride = 6144; }
            else { const int j = c0 - 24576; src = p.in[13] + j; stride = 2048; bias = p.in[14] + j; dst = ((float*)(p.ws + OFF_KVMOD)) + j; dstride = 2048; }
            float a[8];
#pragma unroll
            for (int b = 0; b < 8; ++b) a[b] = 0.f;
            const float* sp = src + (size_t)(wv * 128) * stride + lane;
#pragma unroll 8
            for (int k = 0; k < 128; ++k) {
                const float w = sp[(size_t)k * stride];
                const f32x4 c0v = *(const f32x4*)(cact + (wv * 128 + k) * 8), c1v = *(const f32x4*)(cact + (wv * 128 + k) * 8 + 4);
                a[0] += w * c0v[0]; a[1] += w * c0v[1]; a[2] += w * c0v[2]; a[3] += w * c0v[3];
                a[4] += w * c1v[0]; a[5] += w * c1v[1]; a[6] += w * c1v[2]; a[7] += w * c1v[3];
            }
#pragma unroll
            for (int b = 0; b < 8; ++b) red[(wv * 8 + b) * 64 + lane] = a[b];
            __syncthreads();
            {
                const int b = tid >> 6, col = tid & 63;
                float s = bias[col];
#pragma unroll
                for (int w = 0; w < 8; ++w) s += red[(w * 8 + b) * 64 + col];
                dst[(size_t)b * dstride + col] = s;
            }
        }
        __syncthreads();
    }
    for (int i = blockIdx.x * 512 + tid; i < 1024; i += gridDim.x * 512) {
        const float a0 = p.in[10][i], a1 = p.in[10][1024 + i];
        const float mx = fmaxf(a0, a1), e0 = __expf(a0 - mx), e1 = __expf(a1 - mx);
        ((float*)(p.ws + OFF_LBV))[i] = 0.f; ((float*)(p.ws + OFF_LBV))[1024 + i] = e1 / (e0 + e1);
    }
    conv_group(p.in[8], (bf16_t*)(p.ws + OFF_WB_A_IN), D, AIN, 2, 0, shm, tid);
    conv_group(p.in[9], (bf16_t*)(p.ws + OFF_WB_A_OUT), D, D, 2, 0, shm, tid);
    conv_group(p.in[6], (bf16_t*)(p.ws + OFF_WB_FFN_IN), D, 2 * FFN, 4, 1, shm, tid);
    conv_group(p.in[7], (bf16_t*)(p.ws + OFF_WB_FFN_OUT), FFN, D, 4, 0, shm, tid);
    conv_group(p.in[15], (bf16_t*)(p.ws + OFF_WB_KV), D, 2 * D, 1, 0, shm, tid);
    conv_group(p.in[16], (bf16_t*)(p.ws + OFF_WB_Q), D, D, 2, 0, shm, tid);
    conv_group(p.in[17], (bf16_t*)(p.ws + OFF_WB_O), D, D, 2, 0, shm, tid);
    __syncthreads();
}

__device__ void norm_phase(const float* src, bf16_t* U1, const float* gain1, const float* sh1, const float* sc1, int bs1,
                           bf16_t* U2, const float* gain2, const float* sh2, const float* sc2, int bs2) {
    const int tid_ = opaque_tid(); const int lane = tid_ & 63, gw = blockIdx.x * 8 + (tid_ >> 6), nw = gridDim.x * 8;
    for (int row = 2 * gw; row < MTOK; row += 2 * nw) {
        const int b = row >> 13;
        const float* xp = src + (size_t)row * D;
        f32x4 xv[2][4]; float ss[2] = {0.f, 0.f};
#pragma unroll
        for (int r = 0; r < 2; ++r)
#pragma unroll
            for (int i = 0; i < 4; ++i) xv[r][i] = *(const f32x4*)(xp + (size_t)r * D + i * 256 + lane * 4);
#pragma unroll
        for (int r = 0; r < 2; ++r)
#pragma unroll
            for (int i = 0; i < 4; ++i) ss[r] += xv[r][i][0] * xv[r][i][0] + xv[r][i][1] * xv[r][i][1] + xv[r][i][2] * xv[r][i][2] + xv[r][i][3] * xv[r][i][3];
#pragma unroll
        for (int o = 1; o < 64; o <<= 1) { ss[0] += __shfl_xor(ss[0], o); ss[1] += __shfl_xor(ss[1], o); }
        const float rstd0 = rsqrtf(ss[0] * (1.0f / D) + 1e-6f), rstd1 = rsqrtf(ss[1] * (1.0f / D) + 1e-6f);
#pragma unroll
        for (int i = 0; i < 4; ++i) {
            const int k = i * 256 + lane * 4;
            const f32x4 g = *(const f32x4*)(gain1 + k), s = *(const f32x4*)(sc1 + (size_t)b * bs1 + k), t = *(const f32x4*)(sh1 + (size_t)b * bs1 + k);
            f32x4 u0, u1;
#pragma unroll
            for (int j = 0; j < 4; ++j) { const float ga = g[j] * (1.0f + s[j]); u0[j] = (xv[0][i][j] * rstd0) * ga + t[j]; u1[j] = (xv[1][i][j] * rstd1) * ga + t[j]; }
            u32x2 w0, w1; w0.x = cvt_pk_bf16(u0[0], u0[1]); w0.y = cvt_pk_bf16(u0[2], u0[3]); w1.x = cvt_pk_bf16(u1[0], u1[1]); w1.y = cvt_pk_bf16(u1[2], u1[3]);
            *(u32x2*)(U1 + (size_t)row * D + k) = w0; *(u32x2*)(U1 + (size_t)(row + 1) * D + k) = w1;
        }
        if (U2) {
#pragma unroll
            for (int i = 0; i < 4; ++i) {
                const int k = i * 256 + lane * 4;
                const f32x4 g = *(const f32x4*)(gain2 + k), s = *(const f32x4*)(sc2 + (size_t)b * bs2 + k), t = *(const f32x4*)(sh2 + (size_t)b * bs2 + k);
                f32x4 u0, u1;
#pragma unroll
                for (int j = 0; j < 4; ++j) { const float ga = g[j] * (1.0f + s[j]); u0[j] = (xv[0][i][j] * rstd0) * ga + t[j]; u1[j] = (xv[1][i][j] * rstd1) * ga + t[j]; }
                u32x2 w0, w1; w0.x = cvt_pk_bf16(u0[0], u0[1]); w0.y = cvt_pk_bf16(u0[2], u0[3]); w1.x = cvt_pk_bf16(u1[0], u1[1]); w1.y = cvt_pk_bf16(u1[2], u1[3]);
                *(u32x2*)(U2 + (size_t)row * D + k) = w0; *(u32x2*)(U2 + (size_t)(row + 1) * D + k) = w1;
            }
        }
    }
}
__device__ void final_norm_phase(float* h, const float* gain) {
    const int tid_ = opaque_tid(); const int lane = tid_ & 63, gw = blockIdx.x * 8 + (tid_ >> 6), nw = gridDim.x * 8;
    for (int row = gw; row < MTOK; row += nw) {
        float* xp = h + (size_t)row * D;
        f32x4 xv[4]; float ss = 0.f;
#pragma unroll
        for (int i = 0; i < 4; ++i) { xv[i] = *(const f32x4*)(xp + i * 256 + lane * 4); ss += xv[i][0] * xv[i][0] + xv[i][1] * xv[i][1] + xv[i][2] * xv[i][2] + xv[i][3] * xv[i][3]; }
#pragma unroll
        for (int o = 1; o < 64; o <<= 1) ss += __shfl_xor(ss, o);
        const float rstd = rsqrtf(ss * (1.0f / D) + 1e-6f);
#pragma unroll
        for (int i = 0; i < 4; ++i) {
            const int k = i * 256 + lane * 4;
            const f32x4 g = *(const f32x4*)(gain + k);
            f32x4 u;
#pragma unroll
            for (int j = 0; j < 4; ++j) u[j] = xv[i][j] * rstd * g[j];
            *(f32x4*)(xp + k) = u;
        }
    }
}

template <bool OUT>
__device__ void rec_pass(const Params& p, int layer, unsigned char* shm) {
    float* sB = (float*)shm;
    float* sKm = (float*)(shm + 33792);
    bf16_t* sST = (bf16_t*)shm;
    bf16_t* sQb = (bf16_t*)(shm + 67584);
    bf16_t* sA = (bf16_t*)(shm + 84992);
    bf16_t* sKT = (bf16_t*)(shm + 94208);
    bf16_t* sVT = (bf16_t*)(shm + 112640);
    float* sE = (float*)(shm + 131072);
    float* sPart = (float*)(shm + 131584);
    float* sNrm = (float*)(shm + 135680);
    const int tid = opaque_tid(), lane = tid & 63, w = tid >> 6, fr = lane & 15, fq = lane >> 4;
    const int wi = w >> 1, wh = w & 1;
    const int ntask = OUT ? 256 : 192;
    const float* ogain = p.in[11] + layer * 128;
    for (int task = blockIdx.x; task < ntask; task += gridDim.x) {
        int sc, bh; if (OUT) { sc = task & 3; bh = task >> 2; } else { sc = task % 3; bh = task / 3; }
        const int b = bh >> 3, h = bh & 7;
        f32x4 S[8];
#pragma unroll
        for (int db = 0; db < 8; ++db) S[db] = (f32x4){0.f, 0.f, 0.f, 0.f};
        if (OUT) {
            for (int s2 = 0; s2 < sc; ++s2) {
                const float* sl = ((float*)(p.ws + OFF_SLOC)) + (size_t)(bh * 4 + s2) * 16384; const float* dl = ((float*)(p.ws + OFF_DLOG)) + (bh * 4 + s2) * 128;
#pragma unroll
                for (int db = 0; db < 8; ++db) {
                    const f32x4 x = *(const f32x4*)(sl + ((w * 8 + db) * 64 + lane) * 4), dv = *(const f32x4*)(dl + 16 * db + fq * 4);
#pragma unroll
                    for (int j = 0; j < 4; ++j) S[db][j] = S[db][j] * __expf(dv[j]) + x[j];
                }
            }
        }
        float dlacc = 0.f;
        unsigned lfn[8]; u32x4 vn0, vn1;
        const bf16_t* LFb = (const bf16_t*)(p.ws + OFF_LF);
        const int d2 = (tid & 63) * 2, tq = tid >> 6;
        {
            const size_t r0 = (size_t)b * SEQ + (size_t)(sc * 32) * 64;
            const bf16_t* lp = LFb + (r0 + 8 * tq) * D + h * 128 + d2;
#pragma unroll
            for (int e = 0; e < 8; ++e) lfn[e] = *(const unsigned*)(lp + (size_t)e * D);
            vn0 = *(const u32x4*)(((bf16_t*)(p.ws + OFF_VH)) + (r0 + (tid & 63)) * D + h * 128 + (tid >> 6) * 8);
            vn1 = *(const u32x4*)(((bf16_t*)(p.ws + OFF_VH)) + (r0 + (tid & 63)) * D + h * 128 + 64 + (tid >> 6) * 8);
        }
        for (int ch = sc * 32; ch < sc * 32 + 32; ++ch) {
            const size_t row0 = (size_t)b * SEQ + (size_t)ch * 64;
            float la[8], lb2[8];
#pragma unroll
            for (int e = 0; e < 8; ++e) { la[e] = bflo(lfn[e]); lb2[e] = bfhi(lfn[e]); }
            const u32x4 vr0 = vn0, vr1 = vn1;
            u32x4 qraw[4]; u32x2 graw[4];
            if (OUT) {
#pragma unroll
                for (int ks = 0; ks < 4; ++ks) qraw[ks] = *(const u32x4*)(((bf16_t*)(p.ws + OFF_QH)) + (row0 + 16 * wi + fr) * D + h * 128 + ks * 32 + fq * 8);
#pragma unroll
                for (int vb = 0; vb < 4; ++vb) graw[vb] = *(const u32x2*)(((bf16_t*)(p.ws + OFF_GH)) + (row0 + 16 * wi + fr) * D + h * 128 + 64 * wh + 16 * vb + fq * 4);
            }
            {
                float ra = 0.f, rb = 0.f, ka[8], kb2[8];
#pragma unroll
                for (int e = 0; e < 8; ++e) {
                    ka[e] = 1.0f - __expf(la[e]); kb2[e] = 1.0f - __expf(lb2[e]);
                    *(f32x2*)(sKm + (8 * tq + e) * 132 + d2) = (f32x2){ka[e], kb2[e]};
                    ra += la[e]; la[e] = ra; rb += lb2[e]; lb2[e] = rb;
                }
                *(f32x2*)(sPart + tq * 128 + d2) = (f32x2){ra, rb};
                {
                    const int s_ = tid & 63, pc = tid >> 6;
#pragma unroll
                    for (int e = 0; e < 8; ++e) {
                        sVT[(pc * 8 + e) * 72 + s_] = (bf16_t)((e & 1) ? (vr0[e >> 1] >> 16) : (vr0[e >> 1] & 0xffffu));
                        sVT[(64 + pc * 8 + e) * 72 + s_] = (bf16_t)((e & 1) ? (vr1[e >> 1] >> 16) : (vr1[e >> 1] & 0xffffu));
                    }
                }
                __syncthreads();
                float offa = 0.f, offb = 0.f, tota = 0.f, totb = 0.f;
#pragma unroll
                for (int q = 0; q < 8; ++q) { const f32x2 pq = *(const f32x2*)(sPart + q * 128 + d2); tota += pq[0]; totb += pq[1]; if (q < tq) { offa += pq[0]; offb += pq[1]; } }
                if (tq == 0) { *(f32x2*)(sE + d2) = (f32x2){__expf(tota), __expf(totb)}; }
                u32x4 kwa, kwb;
#pragma unroll
                for (int e = 0; e < 8; e += 2) {
                    const float a0 = la[e] + offa, a1 = la[e + 1] + offa, b0 = lb2[e] + offb, b1 = lb2[e + 1] + offb;
                    *(f32x2*)(sB + (8 * tq + e) * 132 + d2) = (f32x2){a0, b0}; *(f32x2*)(sB + (8 * tq + e + 1) * 132 + d2) = (f32x2){a1, b1};
                    kwa[e >> 1] = cvt_pk_bf16(ka[e] * __expf(tota - a0), ka[e + 1] * __expf(tota - a1));
                    kwb[e >> 1] = cvt_pk_bf16(kb2[e] * __expf(totb - b0), kb2[e + 1] * __expf(totb - b1));
                }
                *(u32x4*)(sKT + d2 * 72 + 8 * tq) = kwa; *(u32x4*)(sKT + (d2 + 1) * 72 + 8 * tq) = kwb;
            }
            __syncthreads();
            if (ch + 1 < sc * 32 + 32) {
                const size_t r1 = row0 + 64;
                const bf16_t* lp = LFb + (r1 + 8 * tq) * D + h * 128 + d2;
#pragma unroll
                for (int e = 0; e < 8; ++e) lfn[e] = *(const unsigned*)(lp + (size_t)e * D);
                vn0 = *(const u32x4*)(((bf16_t*)(p.ws + OFF_VH)) + (r1 + (tid & 63)) * D + h * 128 + (tid >> 6) * 8);
                vn1 = *(const u32x4*)(((bf16_t*)(p.ws + OFF_VH)) + (r1 + (tid & 63)) * D + h * 128 + 64 + (tid >> 6) * 8);
            }
            if (OUT) {
                const int i = wi, hh = wh, t_ = 16 * i + fr;
                bf16x8 qt[4];
#pragma unroll
                for (int ks = 0; ks < 4; ++ks) {
                    const int d0 = ks * 32 + fq * 8;
                    const f32x4 b0 = *(const f32x4*)(sB + t_ * 132 + d0), b1 = *(const f32x4*)(sB + t_ * 132 + d0 + 4);
                    f32x4 r0 = (f32x4){0.f, 0.f, 0.f, 0.f}, r1 = r0;
                    if (i > 0) { r0 = *(const f32x4*)(sB + (16 * i - 1) * 132 + d0); r1 = *(const f32x4*)(sB + (16 * i - 1) * 132 + d0 + 4); }
                    float qv[8], ql[8];
#pragma unroll
                    for (int e = 0; e < 4; ++e) { qv[2 * e] = bflo(qraw[ks][e]); qv[2 * e + 1] = bfhi(qraw[ks][e]); }
#pragma unroll
                    for (int e = 0; e < 4; ++e) { ql[e] = qv[e] * __expf(b0[e] - r0[e]); ql[4 + e] = qv[4 + e] * __expf(b1[e] - r1[e]); }
                    u32x4 pw; pw.x = cvt_pk_bf16(ql[0], ql[1]); pw.y = cvt_pk_bf16(ql[2], ql[3]); pw.z = cvt_pk_bf16(ql[4], ql[5]); pw.w = cvt_pk_bf16(ql[6], ql[7]);
                    qt[ks] = __builtin_bit_cast(bf16x8, pw);
                    if ((ks >> 1) == hh) {
#pragma unroll
                        for (int e = 0; e < 4; ++e) { ql[e] = qv[e] * __expf(b0[e]); ql[4 + e] = qv[4 + e] * __expf(b1[e]); }
                        u32x4 qw; qw.x = cvt_pk_bf16(ql[0], ql[1]); qw.y = cvt_pk_bf16(ql[2], ql[3]); qw.z = cvt_pk_bf16(ql[4], ql[5]); qw.w = cvt_pk_bf16(ql[6], ql[7]);
                        *(u32x4*)(sQb + t_ * 136 + d0) = qw;
                    }
                }
#pragma unroll
                for (int j2 = 0; j2 < 2; ++j2) {
                    const int j = hh + 2 * j2;
                    if (j <= i) {
                        f32x4 acc = (f32x4){0.f, 0.f, 0.f, 0.f};
                        const int s_ = 16 * j + fr;
#pragma unroll
                        for (int ks = 0; ks < 4; ++ks) {
                            const int d0 = ks * 32 + fq * 8;
                            const f32x4 k0 = *(const f32x4*)(sKm + s_ * 132 + d0), k1 = *(const f32x4*)(sKm + s_ * 132 + d0 + 4);
                            const f32x4 b0 = *(const f32x4*)(sB + s_ * 132 + d0), b1 = *(const f32x4*)(sB + s_ * 132 + d0 + 4);
                            f32x4 r0 = (f32x4){0.f, 0.f, 0.f, 0.f}, r1 = r0;
                            if (i > 0) { r0 = *(const f32x4*)(sB + (16 * i - 1) * 132 + d0); r1 = *(const f32x4*)(sB + (16 * i - 1) * 132 + d0 + 4); }
                            float kl[8];
#pragma unroll
                            for (int e = 0; e < 4; ++e) { kl[e] = k0[e] * __expf(fminf(r0[e] - b0[e], 80.f)); kl[4 + e] = k1[e] * __expf(fminf(r1[e] - b1[e], 80.f)); }
                            u32x4 kw; kw.x = cvt_pk_bf16(kl[0], kl[1]); kw.y = cvt_pk_bf16(kl[2], kl[3]); kw.z = cvt_pk_bf16(kl[4], kl[5]); kw.w = cvt_pk_bf16(kl[6], kl[7]);
                            acc = __builtin_amdgcn_mfma_f32_16x16x32_bf16(qt[ks], __builtin_bit_cast(bf16x8, kw), acc, 0, 0, 0);
                        }
#pragma unroll
                        for (int jj = 0; jj < 4; ++jj) {
                            float vv = acc[jj];
                            if (i == j && fr > fq * 4 + jj) vv = 0.f;
                            sA[(16 * i + fq * 4 + jj) * 72 + 16 * j + fr] = (bf16_t)(cvt_pk_bf16(vv, 0.f) & 0xffffu);
                        }
                    } else {
#pragma unroll
                        for (int jj = 0; jj < 4; ++jj) sA[(16 * i + fq * 4 + jj) * 72 + 16 * j + fr] = (bf16_t)0;
                    }
                }
            }
            __syncthreads();
            if (OUT) {
#pragma unroll
                for (int db = 0; db < 8; ++db) { u32x2 sw; sw.x = cvt_pk_bf16(S[db][0], S[db][1]); sw.y = cvt_pk_bf16(S[db][2], S[db][3]); *(u32x2*)(sST + (16 * w + fr) * 136 + 16 * db + fq * 4) = sw; }
                __syncthreads();
            }
            f32x4 o[4];
            if (OUT) {
                const int i = wi;
#pragma unroll
                for (int vb = 0; vb < 4; ++vb) o[vb] = (f32x4){0.f, 0.f, 0.f, 0.f};
#pragma unroll
                for (int kk = 0; kk < 2; ++kk) {
                    if (kk <= (i >> 1)) {
                        const bf16x8 af = *(const bf16x8*)(sA + (16 * i + fr) * 72 + kk * 32 + fq * 8);
#pragma unroll
                        for (int vb = 0; vb < 4; ++vb) { const bf16x8 vf = *(const bf16x8*)(sVT + (64 * wh + 16 * vb + fr) * 72 + kk * 32 + fq * 8); o[vb] = __builtin_amdgcn_mfma_f32_16x16x32_bf16(vf, af, o[vb], 0, 0, 0); }
                    }
                }
#pragma unroll
                for (int ks = 0; ks < 4; ++ks) {
                    const bf16x8 qf = *(const bf16x8*)(sQb + (16 * i + fr) * 136 + ks * 32 + fq * 8);
#pragma unroll
                    for (int vb = 0; vb < 4; ++vb) { const bf16x8 sf = *(const bf16x8*)(sST + (64 * wh + 16 * vb + fr) * 136 + ks * 32 + fq * 8); o[vb] = __builtin_amdgcn_mfma_f32_16x16x32_bf16(sf, qf, o[vb], 0, 0, 0); }
                }
                float ss = 0.f;
#pragma unroll
                for (int vb = 0; vb < 4; ++vb)
#pragma unroll
                    for (int jj = 0; jj < 4; ++jj) ss += o[vb][jj] * o[vb][jj];
                ss += __shfl_xor(ss, 16); ss += __shfl_xor(ss, 32);
                if (fq == 0) sNrm[wh * 64 + 16 * i + fr] = ss;
            }
#pragma unroll
            for (int db = 0; db < 8; ++db) { const f32x4 e4 = *(const f32x4*)(sE + 16 * db + fq * 4); S[db] = S[db] * e4; }
#pragma unroll
            for (int ks = 0; ks < 2; ++ks) {
                const bf16x8 vf = *(const bf16x8*)(sVT + (16 * w + fr) * 72 + ks * 32 + fq * 8);
#pragma unroll
                for (int db = 0; db < 8; ++db) { const bf16x8 kf = *(const bf16x8*)(sKT + (16 * db + fr) * 72 + ks * 32 + fq * 8); S[db] = __builtin_amdgcn_mfma_f32_16x16x32_bf16(kf, vf, S[db], 0, 0, 0); }
            }
            __syncthreads();
            if (OUT) {
                const int i = wi;
                const float tot = sNrm[16 * i + fr] + sNrm[64 + 16 * i + fr];
                const float rstd = rsqrtf(tot * (1.0f / 128.0f) + 1e-6f);
                bf16_t* op = ((bf16_t*)(p.ws + OFF_U)) + (row0 + 16 * i + fr) * D + h * 128 + 64 * wh + fq * 4;
#pragma unroll
                for (int vb = 0; vb < 4; ++vb) {
                    const f32x4 gn = *(const f32x4*)(ogain + 64 * wh + 16 * vb + fq * 4);
                    const float g0 = bflo(graw[vb].x), g1 = bfhi(graw[vb].x), g2 = bflo(graw[vb].y), g3 = bfhi(graw[vb].y);
                    u32x2 ow; ow.x = cvt_pk_bf16(o[vb][0] * rstd * gn[0] * g0, o[vb][1] * rstd * gn[1] * g1); ow.y = cvt_pk_bf16(o[vb][2] * rstd * gn[2] * g2, o[vb][3] * rstd * gn[3] * g3);
                    *(u32x2*)(op + 16 * vb) = ow;
                }
            }
        }
        if (!OUT) {
            float* sl = ((float*)(p.ws + OFF_SLOC)) + (size_t)(bh * 4 + sc) * 16384;
#pragma unroll
            for (int db = 0; db < 8; ++db) *(f32x4*)(sl + ((w * 8 + db) * 64 + lane) * 4) = S[db];
            if (tid < 128) ((float*)(p.ws + OFF_DLOG))[(bh * 4 + sc) * 128 + tid] = dlacc;
        }
    }
    __syncthreads();
}

__device__ void rec_passA(const Params& p, unsigned char* shm) {
    bf16_t* sKT = (bf16_t*)shm;
    bf16_t* sVT = (bf16_t*)(shm + 34816);
    float* sE = (float*)(shm + 69632);
    float* sPart = (float*)(shm + 70144);
    const int tid = opaque_tid(), lane = tid & 63, w = tid >> 6, fr = lane & 15, fq = lane >> 4;
    const int d2 = (tid & 63) * 2, tq = tid >> 6;
    const int vs = tid & 127, vq = tid >> 7;
    const bf16_t* LFb = (const bf16_t*)(p.ws + OFF_LF); const bf16_t* Vp = (const bf16_t*)(p.ws + OFF_VH);
    for (int task = blockIdx.x; task < 192; task += gridDim.x) {
        const int sc = task % 3, bh = task / 3, b = bh >> 3, h = bh & 7;
        f32x4 S[8];
#pragma unroll
        for (int db = 0; db < 8; ++db) S[db] = (f32x4){0.f, 0.f, 0.f, 0.f};
        float dla = 0.f, dlb = 0.f;
        const size_t rbase = (size_t)b * SEQ + (size_t)sc * 2048;
        unsigned lfn[16]; u32x4 vn[4];
        {
            const bf16_t* lp = LFb + (rbase + 16 * tq) * D + h * 128 + d2;
#pragma unroll
            for (int e = 0; e < 16; ++e) lfn[e] = *(const unsigned*)(lp + (size_t)e * D);
#pragma unroll
            for (int i = 0; i < 4; ++i) vn[i] = *(const u32x4*)(Vp + (rbase + vs) * D + h * 128 + (vq + 4 * i) * 8);
        }
        __syncthreads();
        for (int cc = 0; cc < 16; ++cc) {
            const size_t row0 = rbase + (size_t)cc * 128;
            unsigned lf[16]; u32x4 vr[4];
            float ra = 0.f, rb = 0.f;
#pragma unroll
            for (int e = 0; e < 16; ++e) { lf[e] = lfn[e]; ra += bflo(lf[e]); rb += bfhi(lf[e]); }
#pragma unroll
            for (int i = 0; i < 4; ++i) vr[i] = vn[i];
            *(f32x2*)(sPart + tq * 128 + d2) = (f32x2){ra, rb};
            __syncthreads();
            if (cc + 1 < 16) {
                const bf16_t* lp = LFb + (row0 + 128 + 16 * tq) * D + h * 128 + d2;
#pragma unroll
                for (int e = 0; e < 16; ++e) lfn[e] = *(const unsigned*)(lp + (size_t)e * D);
#pragma unroll
                for (int i = 0; i < 4; ++i) vn[i] = *(const u32x4*)(Vp + (row0 + 128 + vs) * D + h * 128 + (vq + 4 * i) * 8);
            }
            float ba = 0.f, bb = 0.f, tota = 0.f, totb = 0.f;
#pragma unroll
            for (int q = 0; q < 8; ++q) { const f32x2 pq = *(const f32x2*)(sPart + q * 128 + d2); tota += pq[0]; totb += pq[1]; if (q < tq) { ba += pq[0]; bb += pq[1]; } }
            if (tq == 0) { *(f32x2*)(sE + d2) = (f32x2){__expf(tota), __expf(totb)}; dla += tota; dlb += totb; }
#pragma unroll
            for (int g8 = 0; g8 < 2; ++g8) {
                u32x4 kwa, kwb;
#pragma unroll
                for (int e = 0; e < 8; e += 2) {
                    const float la0 = bflo(lf[8 * g8 + e]), lb0 = bfhi(lf[8 * g8 + e]), la1 = bflo(lf[8 * g8 + e + 1]), lb1 = bfhi(lf[8 * g8 + e + 1]);
                    const float a0 = ba + la0, a1 = a0 + la1; ba = a1;
                    const float b0 = bb + lb0, b1 = b0 + lb1; bb = b1;
                    kwa[e >> 1] = cvt_pk_bf16((1.0f - __expf(la0)) * __expf(tota - a0), (1.0f - __expf(la1)) * __expf(tota - a1));
                    kwb[e >> 1] = cvt_pk_bf16((1.0f - __expf(lb0)) * __expf(totb - b0), (1.0f - __expf(lb1)) * __expf(totb - b1));
                }
                *(u32x4*)(sKT + d2 * 136 + 16 * tq + 8 * g8) = kwa; *(u32x4*)(sKT + (d2 + 1) * 136 + 16 * tq + 8 * g8) = kwb;
            }
#pragma unroll
            for (int i = 0; i < 4; ++i)
#pragma unroll
                for (int e = 0; e < 8; ++e) sVT[((vq + 4 * i) * 8 + e) * 136 + vs] = (bf16_t)((e & 1) ? (vr[i][e >> 1] >> 16) : (vr[i][e >> 1] & 0xffffu));
            __syncthreads();
#pragma unroll
            for (int db = 0; db < 8; ++db) { const f32x4 e4 = *(const f32x4*)(sE + 16 * db + fq * 4); S[db] = S[db] * e4; }
#pragma unroll
            for (int ks = 0; ks < 4; ++ks) {
                const bf16x8 vf = *(const bf16x8*)(sVT + (16 * w + fr) * 136 + ks * 32 + fq * 8);
#pragma unroll
                for (int db = 0; db < 8; ++db) { const bf16x8 kf = *(const bf16x8*)(sKT + (16 * db + fr) * 136 + ks * 32 + fq * 8); S[db] = __builtin_amdgcn_mfma_f32_16x16x32_bf16(kf, vf, S[db], 0, 0, 0); }
            }
        }
        float* sl = (float*)(p.ws + OFF_SLOC) + (size_t)(bh * 4 + sc) * 16384;
#pragma unroll
        for (int db = 0; db < 8; ++db) *(f32x4*)(sl + ((w * 8 + db) * 64 + lane) * 4) = S[db];
        if (tq == 0) *(f32x2*)((float*)(p.ws + OFF_DLOG) + (bh * 4 + sc) * 128 + d2) = (f32x2){dla, dlb};
    }
    __syncthreads();
}

__device__ void attn_phase(const Params& p, int jl, unsigned char* shm) {
    bf16_t* sK = (bf16_t*)shm;
    bf16_t* sVT = sK + 2 * 9216;
    float* sB = (float*)(sVT + 2 * 8704);
    const int tid = opaque_tid(), lane = tid & 63, w = tid >> 6, fr = lane & 15, fq = lane >> 4;
    const int cq = w >> 1, half = w & 1;
    const float LOG2E = 1.4426950408889634f;
    const int skey = tid >> 3, spiece = tid & 7, vkey = tid & 63, vpiece = tid >> 6;
    const bf16_t* Kg = (const bf16_t*)(p.ws + OFF_KB); const bf16_t* Vg = (const bf16_t*)(p.ws + OFF_VB); const bf16_t* Qg = (const bf16_t*)(p.ws + OFF_QB);
    for (int task = blockIdx.x; task < 4096; task += gridDim.x) {
        const int g = task & 31, h = (task >> 5) & 15, b = task >> 9;
        const int c = 4 * g + cq;
        const int dt0 = (2 * g - 4 > 0) ? 2 * g - 4 : 0, dt1 = 2 * g + 1;
        __syncthreads();
        for (int i = tid; i < 384; i += 512) { int r = i - 64; r = r < 0 ? 0 : (r > 319 ? 319 : r); sB[i] = p.in[18][((size_t)jl * 320 + r) * 16 + h] * LOG2E; }
        bf16x8 qf[2][2];
        {
            const bf16_t* qp = Qg + ((size_t)b * SEQ + c * 64 + half * 32) * D + h * 64;
#pragma unroll
            for (int qb = 0; qb < 2; ++qb)
#pragma unroll
                for (int ks = 0; ks < 2; ++ks) qf[qb][ks] = *(const bf16x8*)(qp + (size_t)(qb * 16 + fr) * D + ks * 32 + fq * 8);
        }
        f32x4 oacc[4][2];
#pragma unroll
        for (int db = 0; db < 4; ++db)
#pragma unroll
            for (int qb = 0; qb < 2; ++qb) oacc[db][qb] = (f32x4){0.f, 0.f, 0.f, 0.f};
        float mrun[2] = {0.f, 0.f}, lrun[2] = {0.f, 0.f};
        bool first = true;
        u32x4 kreg[2], vreg[2];
        const size_t tokb = (size_t)b * SEQ;
#define ATT_GLOAD(dt_) do { _Pragma("unroll") for (int hf_ = 0; hf_ < 2; ++hf_) { \
            kreg[hf_] = *(const u32x4*)(Kg + (tokb + (size_t)(dt_) * 128 + hf_ * 64 + skey) * D + h * 64 + spiece * 8); \
            vreg[hf_] = *(const u32x4*)(Vg + (tokb + (size_t)(dt_) * 128 + hf_ * 64 + vkey) * D + h * 64 + vpiece * 8); } } while (0)
#define ATT_LSTORE(buf_) do { _Pragma("unroll") for (int hf_ = 0; hf_ < 2; ++hf_) { \
            *(u32x4*)(sK + (buf_) * 9216 + (hf_ * 64 + skey) * 72 + spiece * 8) = kreg[hf_]; \
            bf16_t* vt_ = sVT + (buf_) * 8704 + (vpiece * 8) * 136 + hf_ * 64 + vkey; \
            _Pragma("unroll") for (int e_ = 0; e_ < 8; ++e_) vt_[e_ * 136] = (bf16_t)((e_ & 1) ? (vreg[hf_][e_ >> 1] >> 16) : (vreg[hf_][e_ >> 1] & 0xffffu)); } } while (0)
        ATT_GLOAD(dt0); ATT_LSTORE(0);
        __syncthreads();
        for (int dt = dt0; dt <= dt1; ++dt) {
            const int buf = (dt - dt0) & 1;
            if (dt < dt1) ATT_GLOAD(dt + 1);
            const bool act0 = (2 * dt >= c - 8) && (2 * dt <= c), act1 = (2 * dt + 1 >= c - 8) && (2 * dt + 1 <= c);
            if (act0 || act1) {
                const bf16_t* kb_ = sK + buf * 9216; const bf16_t* vb_ = sVT + buf * 8704;
                f32x4 sacc[2][4][2];
                const float b0 = sB[0];
#pragma unroll
                for (int hf = 0; hf < 2; ++hf) {
                    if (hf == 0 ? act0 : act1) {
                        const float cb = (2 * dt + hf - c <= -5) ? b0 : 0.f;
#pragma unroll
                        for (int kb = 0; kb < 4; ++kb)
#pragma unroll
                            for (int qb = 0; qb < 2; ++qb) { const float iv = cb - mrun[qb]; sacc[hf][kb][qb] = (f32x4){iv, iv, iv, iv}; }
#pragma unroll
                        for (int kb = 0; kb < 4; ++kb)
#pragma unroll
                            for (int ks = 0; ks < 2; ++ks) {
                                const bf16x8 kf = *(const bf16x8*)(kb_ + (hf * 64 + kb * 16 + fr) * 72 + ks * 32 + fq * 8);
#pragma unroll
                                for (int qb = 0; qb < 2; ++qb) sacc[hf][kb][qb] = __builtin_amdgcn_mfma_f32_16x16x32_bf16(kf, qf[qb][ks], sacc[hf][kb][qb], 0, 0, 0);
                            }
                    }
                }
                float mx[2] = {-3e38f, -3e38f};
#pragma unroll
                for (int hf = 0; hf < 2; ++hf) {
                    if (hf == 0 ? act0 : act1) {
                        const int dk = 2 * dt + hf - c;
                        if (dk > -5) {
                            const float* bp = sB + (dk * 64 + fq * 4 - half * 32 - fr + 256 + 64 - 16);
#pragma unroll
                            for (int kb = 0; kb < 4; ++kb)
#pragma unroll
                                for (int qb = 0; qb < 2; ++qb)
#pragma unroll
                                    for (int j = 0; j < 4; ++j) sacc[hf][kb][qb][j] += bp[kb * 16 + j - qb * 16 + 16];
                        }
#pragma unroll
                        for (int qb = 0; qb < 2; ++qb)
#pragma unroll
                            for (int kb = 0; kb < 4; ++kb)
#pragma unroll
                                for (int j = 0; j < 4; ++j) mx[qb] = fmaxf(mx[qb], sacc[hf][kb][qb][j]);
                    }
                }
                if (first || __any((mx[0] > 6.0f) || (mx[1] > 6.0f))) {
#pragma unroll
                    for (int qb = 0; qb < 2; ++qb) {
                        float m2 = fmaxf(mx[qb], __shfl_xor(mx[qb], 16)); m2 = fmaxf(m2, __shfl_xor(m2, 32));
                        const float delta = first ? m2 : fmaxf(m2, 0.f), corr = first ? 1.0f : __builtin_amdgcn_exp2f(-delta);
                        mrun[qb] += delta; lrun[qb] *= corr;
#pragma unroll
                        for (int db = 0; db < 4; ++db) oacc[db][qb] = oacc[db][qb] * corr;
#pragma unroll
                        for (int hf = 0; hf < 2; ++hf)
#pragma unroll
                            for (int kb = 0; kb < 4; ++kb) sacc[hf][kb][qb] = sacc[hf][kb][qb] - delta;
                    }
                    first = false;
                }
#pragma unroll
                for (int hf = 0; hf < 2; ++hf) {
                    if (hf == 0 ? act0 : act1) {
                        bf16x8 pf[2][2];
#pragma unroll
                        for (int qb = 0; qb < 2; ++qb) {
                            float ps = 0.f;
#pragma unroll
                            for (int kb = 0; kb < 4; ++kb)
#pragma unroll
                                for (int j = 0; j < 4; ++j) { const float pv = __builtin_amdgcn_exp2f(sacc[hf][kb][qb][j]); sacc[hf][kb][qb][j] = pv; ps += pv; }
                            lrun[qb] += ps;
#pragma unroll
                            for (int kk = 0; kk < 2; ++kk) {
                                u32x4 pw;
                                pw.x = cvt_pk_bf16(sacc[hf][2 * kk][qb][0], sacc[hf][2 * kk][qb][1]); pw.y = cvt_pk_bf16(sacc[hf][2 * kk][qb][2], sacc[hf][2 * kk][qb][3]);
                                pw.z = cvt_pk_bf16(sacc[hf][2 * kk + 1][qb][0], sacc[hf][2 * kk + 1][qb][1]); pw.w = cvt_pk_bf16(sacc[hf][2 * kk + 1][qb][2], sacc[hf][2 * kk + 1][qb][3]);
                                pf[qb][kk] = __builtin_bit_cast(bf16x8, pw);
                            }
                        }
#pragma unroll
                        for (int db = 0; db < 4; ++db)
#pragma unroll
                            for (int kk = 0; kk < 2; ++kk) {
                                const u32x2 lo = *(const u32x2*)(vb_ + (db * 16 + fr) * 136 + hf * 64 + (2 * kk) * 16 + fq * 4);
                                const u32x2 hi = *(const u32x2*)(vb_ + (db * 16 + fr) * 136 + hf * 64 + (2 * kk + 1) * 16 + fq * 4);
                                u32x4 vw; vw.x = lo.x; vw.y = lo.y; vw.z = hi.x; vw.w = hi.y;
                                const bf16x8 vf = __builtin_bit_cast(bf16x8, vw);
#pragma unroll
                                for (int qb = 0; qb < 2; ++qb) oacc[db][qb] = __builtin_amdgcn_mfma_f32_16x16x32_bf16(vf, pf[qb][kk], oacc[db][qb], 0, 0, 0);
                            }
                    }
                }
            }
            if (dt < dt1) ATT_LSTORE(buf ^ 1);
            __syncthreads();
        }
#undef ATT_GLOAD
#undef ATT_LSTORE
#pragma unroll
        for (int qb = 0; qb < 2; ++qb) {
            float lt = lrun[qb]; lt += __shfl_xor(lt, 16); lt += __shfl_xor(lt, 32);
            const float inv = 1.0f / lt;
            bf16_t* op = (bf16_t*)(p.ws + OFF_U) + (tokb + c * 64 + half * 32 + qb * 16 + fr) * D + h * 64 + fq * 4;
#pragma unroll
            for (int db = 0; db < 4; ++db) {
                u32x2 ow; ow.x = cvt_pk_bf16(oacc[db][qb][0] * inv, oacc[db][qb][1] * inv); ow.y = cvt_pk_bf16(oacc[db][qb][2] * inv, oacc[db][qb][3] * inv);
                *(u32x2*)(op + db * 16) = ow;
            }
        }
    }
    __syncthreads();
}

#ifndef REP_ATTN
#define REP_ATTN 1
#endif
#ifndef REP_REC
#define REP_REC 1
#endif
#ifndef REP_NORM
#define REP_NORM 1
#endif
#ifndef REP_SYNC
#define REP_SYNC 1
#endif
#ifndef REP_PREP
#define REP_PREP 1
#endif
#ifndef REP_G3
#define REP_G3 1
#endif
#define GSYNC() do { for (int r_ = 0; r_ < REP_SYNC; ++r_) xcd_barrier(xb); } while (0)
__global__ void __launch_bounds__(512, 2) yoco_fwd(Params p) {
    extern __shared__ __attribute__((aligned(16))) unsigned char shm[];
    cg::grid_group grid = cg::this_grid();
    {
        const int t0 = threadIdx.x;
        if ((t0 & 63) == 0) *(volatile LAS int*)(LAS unsigned char*)(shm + WAVE_TAB_OFF + 4 * hw_wave_slot()) = t0 >> 6;
        __syncthreads();
    }
    const int tid0 = opaque_tid();
    unsigned* barw = (unsigned*)(p.ws + OFF_BAR);
    for (int i = blockIdx.x * 512 + tid0; i < XCD_BAR_WORDS; i += gridDim.x * 512) barw[i] = 0u;
    {
        u32x4* z = (u32x4*)(p.ws + OFF_ROWSS); const int nz = (int)((8 * (size_t)MTOK * 8) / 16);
        for (int i = blockIdx.x * 512 + tid0; i < nz; i += gridDim.x * 512) z[i] = (u32x4){0u, 0u, 0u, 0u};
    }
    volatile LAS unsigned* xst = (volatile LAS unsigned*)(LAS unsigned char*)(shm + LDS_BYTES - 16);
    if (tid0 == 0) { xst[0] = 0u; xst[1] = 0u; }
    for (int r = 0; r < REP_PREP; ++r) prep_phase(p, shm);
    grid.sync();
    XcdBarrier xb = xcd_barrier_post(barw, xst);
    {
        const float* mv = (const float*)(p.ws + OFF_MODV);
        for (int r = 0; r < REP_NORM; ++r) norm_phase(p.in[0], (bf16_t*)(p.ws + OFF_U), p.in[4], mv, mv + D, 6144, nullptr, nullptr, nullptr, nullptr, 0);
    }
    GSYNC();
    for (int l = 0; l < 4; ++l) {
        const float* hsrc = (l == 0) ? p.in[0] : p.h;
        const float* mv = (const float*)(p.ws + OFF_MODV) + (size_t)l * 8 * 6144;
        bf16_t* UF = (l < 2) ? (bf16_t*)(p.ws + OFF_UF_A) : (bf16_t*)(p.ws + OFF_QB);
        if (l < 2) {
            pg8::EpiHgrnIn e; e.QVG = (bf16_t*)(p.ws + OFF_QH); e.LF = (bf16_t*)(p.ws + OFF_LF); e.lb = (const float*)(p.ws + OFF_LBV) + l * D;
            run_gemm(shm, (const bf16_t*)(p.ws + OFF_U), (const bf16_t*)(p.ws + OFF_WB_A_IN) + (size_t)l * AIN * D, AIN, D, e);
            GSYNC();
            for (int r = 0; r < REP_REC; ++r) rec_passA(p, shm);
            GSYNC();
            for (int r = 0; r < REP_REC; ++r) rec_pass<true>(p, l, shm);
        } else {
            if (l == 2) { pg8::EpiBf16Split e; e.d0 = (bf16_t*)(p.ws + OFF_KB); e.scale = 1.0f;
                run_gemm(shm, (const bf16_t*)(p.ws + OFF_QB), (const bf16_t*)(p.ws + OFF_WB_KV), 2048, D, e);
                GSYNC(); }
            { pg8::EpiBf16Split e; e.d0 = (bf16_t*)(p.ws + OFF_QB); e.scale = 0.125f * 1.4426950408889634f;   run_gemm(shm, (const bf16_t*)(p.ws + OFF_U), (const bf16_t*)(p.ws + OFF_WB_Q) + (size_t)(l - 2) * D * D, D, D, e); }
            GSYNC();
            for (int r = 0; r < REP_ATTN; ++r) attn_phase(p, l - 2, shm);
        }
        GSYNC();
        {
            pg8::EpiResid e; e.in = p.in; e.ws = p.ws; e.hbuf = p.h; e.l = l; e.which = 0;
            run_gemm(shm, (const bf16_t*)(p.ws + OFF_U), (l < 2) ? (const bf16_t*)(p.ws + OFF_WB_A_OUT) + (size_t)l * D * D : (const bf16_t*)(p.ws + OFF_WB_O) + (size_t)(l - 2) * D * D, D, D, e);
        }
        GSYNC();
        for (int r = 0; r < REP_G3; ++r) { pg8::EpiSwiglu e; e.act = (bf16_t*)(p.ws + OFF_ACT); run_gemm(shm, UF, (const bf16_t*)(p.ws + OFF_WB_FFN_IN) + (size_t)l * 2 * FFN * D, 2 * FFN, D, e); }
        GSYNC();
        {
            pg8::EpiResid e; e.in = p.in; e.ws = p.ws; e.hbuf = p.h; e.l = l; e.which = 1;
            run_gemm(shm, (const bf16_t*)(p.ws + OFF_ACT), (const bf16_t*)(p.ws + OFF_WB_FFN_OUT) + (size_t)l * D * FFN, D, FFN, e);
        }
        if (l < 3) GSYNC();
    }
}

extern "C" void kernel_launch(void* const* d_in, const int* in_sizes, int n_in, void* d_out, int out_size, void* d_ws, size_t ws_size, hipStream_t stream) {
    static int grid_blocks = 0;
    if (!grid_blocks) {
        int dev = 0, cus = 0, per_cu = 0;
        hipGetDevice(&dev);
        hipDeviceGetAttribute(&cus, hipDeviceAttributeMultiprocessorCount, dev);
        hipFuncSetAttribute((const void*)yoco_fwd, hipFuncAttributeMaxDynamicSharedMemorySize, LDS_BYTES);
        hipOccupancyMaxActiveBlocksPerMultiprocessor(&per_cu, (const void*)yoco_fwd, 512, LDS_BYTES);
        if (per_cu < 1) per_cu = 1;
        grid_blocks = cus * per_cu;
        (void)hipGetLastError();
    }
    Params p{};
    for (int i = 0; i < 20; ++i) p.in[i] = (const float*)d_in[i];
    p.h = (float*)d_out; p.ws = (unsigned char*)d_ws;
    if (ws_size < WS_END || n_in != 20) { fprintf(stderr, "kernel_launch: workspace too small (%zu < %zu) or unexpected inputs\n", ws_size, (size_t)WS_END); return; }
    void* args[] = {&p};
    hipError_t e = hipLaunchCooperativeKernel((const void*)yoco_fwd, dim3(grid_blocks), dim3(512), args, LDS_BYTES, stream);
    if (e != hipSuccess) fprintf(stderr, "cooperative launch failed: %s (grid %d)\n", hipGetErrorString(e), grid_blocks);
}
```

```cpp
#include <hip/hip_runtime.h>
#include <hip/hip_cooperative_groups.h>
#include <cstdio>
namespace cg = cooperative_groups;

#define LAS __attribute__((address_space(3)))
typedef unsigned short bf16_t;
typedef short bf16x8 __attribute__((ext_vector_type(8)));
typedef float f32x4 __attribute__((ext_vector_type(4)));
typedef unsigned u32x4 __attribute__((ext_vector_type(4)));
typedef unsigned u32x2 __attribute__((ext_vector_type(2)));
typedef float f32x2 __attribute__((ext_vector_type(2)));

constexpr int D = 1024, BATCH = 8, SEQ = 8192, MTOK = BATCH * SEQ, FFN = 2816, AIN = 4096;
constexpr int LDS_BYTES = 144 * 1024;
constexpr int XCD_BAR_WORDS_C = 3456;

__device__ __forceinline__ unsigned cvt_pk_bf16(float lo, float hi) { unsigned r; asm volatile("v_cvt_pk_bf16_f32 %0, %1, %2" : "=v"(r) : "v"(lo), "v"(hi)); return r; }
__device__ __forceinline__ float bf2f(unsigned short h) { return __uint_as_float((unsigned)h << 16); }
__device__ __forceinline__ float bflo(unsigned w) { return __uint_as_float(w << 16); }
__device__ __forceinline__ float bfhi(unsigned w) { return __uint_as_float(w & 0xffff0000u); }
__device__ __forceinline__ float silu_f(float x) { return x * __builtin_amdgcn_rcpf(1.0f + __expf(-x)); }

constexpr int WAVE_TAB_OFF = LDS_BYTES - 16 - 256;
__device__ __forceinline__ unsigned hw_wave_slot() { return (unsigned)__builtin_amdgcn_s_getreg(((6 - 1) << 11) | 4); }
__device__ __forceinline__ int opaque_tid() {
    extern __shared__ __attribute__((aligned(16))) unsigned char shm_tid_[];
    const int wv = __builtin_amdgcn_readfirstlane(*(volatile LAS int*)(LAS unsigned char*)(shm_tid_ + WAVE_TAB_OFF + 4 * hw_wave_slot()));
    int lane_;
    asm volatile("v_mbcnt_lo_u32_b32 %0, -1, 0\n\tv_mbcnt_hi_u32_b32 %0, -1, %0" : "=&v"(lane_));
    int t = wv * 64 + lane_;
    asm volatile("" : "+v"(t)); return t;
}
struct Params { const float* in[20]; float* h; unsigned char* ws; };
constexpr size_t ACTB = (size_t)MTOK * D * 2;
constexpr size_t OFF_WB_A_IN = 0;
constexpr size_t OFF_WB_A_OUT = OFF_WB_A_IN + (size_t)2 * AIN * D * 2;
constexpr size_t OFF_WB_FFN_IN = OFF_WB_A_OUT + (size_t)2 * D * D * 2;
constexpr size_t OFF_WB_FFN_OUT = OFF_WB_FFN_IN + (size_t)4 * 2 * FFN * D * 2;
constexpr size_t OFF_WB_KV = OFF_WB_FFN_OUT + (size_t)4 * D * FFN * 2;
constexpr size_t OFF_WB_Q = OFF_WB_KV + (size_t)2 * D * D * 2;
constexpr size_t OFF_WB_O = OFF_WB_Q + (size_t)2 * D * D * 2;
constexpr size_t OFF_MODV = OFF_WB_O + (size_t)2 * D * D * 2;
constexpr size_t OFF_KVMOD = OFF_MODV + (size_t)4 * 8 * 6144 * 4;
constexpr size_t OFF_LBV = OFF_KVMOD + (size_t)8 * 2048 * 4;
constexpr size_t OFF_U = OFF_LBV + (size_t)2 * D * 4;
constexpr size_t OFF_R = OFF_U + ACTB;
constexpr size_t OFF_QH = OFF_R, OFF_VH = OFF_R + ACTB, OFF_GH = OFF_R + 2 * ACTB, OFF_LF = OFF_R + 3 * ACTB;
constexpr size_t OFF_ACT = OFF_R;
constexpr size_t OFF_UF_A = OFF_R + 4 * ACTB;
constexpr size_t OFF_KB = OFF_R + (size_t)MTOK * FFN * 2, OFF_VB = OFF_KB + ACTB, OFF_QB = OFF_VB + ACTB;
constexpr size_t OFF_SLOC = OFF_R + 5 * ACTB, OFF_DLOG = OFF_SLOC + (size_t)256 * 16384 * 4;
constexpr size_t OFF_BAR = OFF_QB + ACTB;
constexpr size_t OFF_ROWSS = OFF_BAR + (size_t)16384;
constexpr size_t WS_END = OFF_ROWSS + (size_t)8 * MTOK * 8;


#define XB_TMO      128
#define XB_XCNT(j)  (256  + 64 * (j))
#define XB_XSUB(j)  (1280 + 64 * (j))
#define XB_XGEN(j)  (2304 + 64 * (j))
#define XB_TOP      3328
#define XB_TOPGEN   3392
#define XCD_BAR_WORDS 3456
#define XB_SPIN_CAP (1u << 18)
__device__ __forceinline__ unsigned xb_ld(unsigned* p)              { return __hip_atomic_load(p, __ATOMIC_RELAXED, __HIP_MEMORY_SCOPE_AGENT); }
__device__ __forceinline__ unsigned xb_add(unsigned* p, unsigned v) { return __hip_atomic_fetch_add(p, v, __ATOMIC_RELAXED, __HIP_MEMORY_SCOPE_AGENT); }
__device__ __forceinline__ unsigned xb_xcc_id() { return (unsigned)__builtin_amdgcn_s_getreg((3 << 11) | 20) & 0xFu; }
#define XB_SPIN(cond, bar) do { unsigned _sp = 0; while (cond) { __builtin_amdgcn_s_sleep(1); \
    if ((++_sp & 255u) == 0u) { if (xb_ld(&(bar)[XB_TMO])) break; if (_sp > XB_SPIN_CAP) { atomicAdd(&(bar)[XB_TMO], 1u); break; } } } } while (0)
struct XcdBarrier { unsigned* bar; unsigned x; volatile LAS unsigned* st; };
__device__ __forceinline__ XcdBarrier xcd_barrier_post(unsigned* bar, volatile LAS unsigned* st) {
    XcdBarrier b; b.bar = bar; b.x = xb_xcc_id(); b.st = st;
    if (opaque_tid() == 0) (void)xb_add(&bar[XB_XCNT(b.x)], 1u);
    return b;
}
__device__ __forceinline__ void xcd_barrier_complete(unsigned* bar, unsigned x, unsigned& nloc, unsigned& nx) {
    const unsigned G = gridDim.x * gridDim.y * gridDim.z;
    unsigned sum, cnt, mine, sp = 0u;
    for (;;) {
        sum = 0u; cnt = 0u; mine = 0u;
#pragma unroll
        for (unsigned j = 0; j < 16; ++j) { const unsigned c = xb_ld(&bar[XB_XCNT(j)]); sum += c; cnt += (c > 0u) ? 1u : 0u; mine = (j == x) ? c : mine; }
        if (sum == G) break;
        __builtin_amdgcn_s_sleep(1);
        if ((++sp & 255u) == 0u) { if (xb_ld(&bar[XB_TMO])) break; if (sp > XB_SPIN_CAP) { atomicAdd(&bar[XB_TMO], 1u); break; } }
    }
    nloc = mine > 0u ? mine : 1u; nx = cnt > 0u ? cnt : 1u;
}
__device__ __forceinline__ void xcd_barrier(const XcdBarrier& b) {
    asm volatile("s_waitcnt vmcnt(0)" ::: "memory");
    __syncthreads();
    if (opaque_tid() == 0) {
        unsigned* bar = b.bar;
        __builtin_amdgcn_s_waitcnt(0);
        unsigned nloc = b.st[0], nx = b.st[1];
        if (nloc == 0u) { xcd_barrier_complete(bar, b.x, nloc, nx); b.st[0] = nloc; b.st[1] = nx; }
        const unsigned old = xb_add(&bar[XB_XSUB(b.x)], 1u);
        const unsigned gen = old / nloc;
        if (old + 1u == (gen + 1u) * nloc) {
            __builtin_amdgcn_fence(__ATOMIC_RELEASE, "agent");
            asm volatile("s_waitcnt vmcnt(0)" ::: "memory");
            const unsigned og = xb_add(&bar[XB_TOP], 1u);
            const unsigned tg = og / nx;
            if (og + 1u == (tg + 1u) * nx) xb_add(&bar[XB_TOPGEN], 1u);
            else XB_SPIN(xb_ld(&bar[XB_TOPGEN]) == tg, bar);
            __builtin_amdgcn_fence(__ATOMIC_ACQUIRE, "agent");
            xb_add(&bar[XB_XGEN(b.x)], 1u);
            asm volatile("s_waitcnt vmcnt(0)" ::: "memory");
        } else {
            XB_SPIN(xb_ld(&bar[XB_XGEN(b.x)]) == gen, bar);
            __builtin_amdgcn_fence(__ATOMIC_ACQUIRE, "agent");
            asm volatile("s_waitcnt vmcnt(0)" ::: "memory");
        }
    }
    __syncthreads();
}

namespace pg8 {
constexpr int BM = 256, BK = 64, HALF = 128, HTB = HALF * BK * 2, STAGE_BYTES = 8 * HTB, NXCD = 8, WGM = 8;
__device__ __forceinline__ int lds_byte(int r, int c) { const int st = (r >> 4) * 2 + (c >> 5), rr = r & 15, cc = c & 31, ob = rr * 64 + cc * 2; return st * 1024 + (ob ^ (((ob >> 9) & 1) << 5)); }
__device__ __forceinline__ void stage_rc(int b, int& R, int& C) { const int st = b / 1024, sb = b % 1024, swz = sb ^ (((sb >> 9) & 1) << 5); R = (st >> 1) * 16 + swz / 64; C = (st & 1) * 32 + (swz % 64) / 2; }
__device__ __forceinline__ int perm32(int rho) { const int n = rho >> 4, i = rho & 15; return 8 * (i >> 2) + 4 * n + (i & 3); }
struct Unit { int pm, pn; };
struct Gemm { const bf16_t* A; const bf16_t* Bt; int M, N, K; };
struct StaticOrder {
    int nM, nN, nwg, G, c;
    __device__ void init(int M, int N, int G_, int c_) { nM = M / BM; nN = N / BM; nwg = nM * nN; G = G_; c = c_; }
    __device__ bool next(int i, Unit& u) const {
        const long L = (long)i * G + c; if (L >= nwg) return false;
        int wgid = (int)L; { const int q = nwg / NXCD, r = nwg % NXCD, xcd = wgid % NXCD, off = wgid / NXCD; wgid = (xcd < r ? xcd * (q + 1) : r * (q + 1) + (xcd - r) * q) + off; }
        const int nig = WGM * nN, gid = wgid / nig, fm = gid * WGM, gsz = (nM - fm) < WGM ? (nM - fm) : WGM;
        u.pm = fm + ((wgid % nig) % gsz); u.pn = (wgid % nig) / gsz; return true;
    }
};

template <class Epi>
__device__ __forceinline__ void gemm_phase(LAS unsigned char* lds, const Gemm g, const StaticOrder& S, const Epi& E) {
    const int tid = opaque_tid(), wid = __builtin_amdgcn_readfirstlane(tid >> 6), lane = tid & 63, wr = wid >> 2, wc = wid & 3, fr = lane & 15, fq = lane >> 4;
    const int K = g.K, nt = K / BK;
    unsigned voffA[2], voffB[2];
#pragma unroll
    for (int i = 0; i < 2; ++i) { int R, C; stage_rc(tid * 16 + i * 8192, R, C); const int Rb = Epi::PERM ? ((R & ~31) + perm32(R & 31)) : R;
        voffA[i] = (unsigned)(R * K + C) * 2u; voffB[i] = (unsigned)(Rb * K + C) * 2u; }
    const size_t kstep = (size_t)(BK * 2);
    const size_t hstep = (size_t)HALF * K * 2;
    const size_t tstep = 2 * hstep;
    const unsigned ldsw = (unsigned)wid * 1024u;
    const int aoff = lds_byte(wr * 64 + fr, fq * 8), boff = lds_byte(wc * 32 + fr, fq * 8);
#define PG8_SA(b, h) (((b) * 2 + (h)) * HTB)
#define PG8_SB(b, h) ((4 + (b) * 2 + (h)) * HTB)
#define PG8_STAGE(bufoff, gbase, voff) do { _Pragma("unroll") for (int _i = 0; _i < 2; ++_i) \
        __builtin_amdgcn_global_load_lds((const unsigned*)((const char*)(gbase) + (voff)[_i]), (LAS unsigned*)(lds + (bufoff) + ldsw + _i * 8192), 16, 0, 0); } while (0)
#define PG8_LDA(dst, b, h) do { _Pragma("unroll") for (int m = 0; m < 4; ++m) _Pragma("unroll") for (int k = 0; k < 2; ++k) dst[m][k] = *(const LAS bf16x8*)(lds + PG8_SA(b, h) + aoff + m * 2048 + k * 1024); } while (0)
#define PG8_LDB(dst, b, h) do { _Pragma("unroll") for (int n = 0; n < 2; ++n) _Pragma("unroll") for (int k = 0; k < 2; ++k) dst[n][k] = *(const LAS bf16x8*)(lds + PG8_SB(b, h) + boff + n * 2048 + k * 1024); } while (0)
#define PG8_MMA(ai, bj, At, Bt) do { __builtin_amdgcn_s_setprio(1); _Pragma("unroll") for (int m = 0; m < 4; ++m) _Pragma("unroll") for (int n = 0; n < 2; ++n) _Pragma("unroll") for (int k = 0; k < 2; ++k) \
        acc[ai][bj][m][n] = __builtin_amdgcn_mfma_f32_16x16x32_bf16(Bt[n][k], At[m][k], acc[ai][bj][m][n], 0, 0, 0); __builtin_amdgcn_s_setprio(0); } while (0)
#define PG8_WAIT_V(n) asm volatile("s_waitcnt vmcnt(" #n ")" ::: "memory")
#define PG8_WAIT_L(n) asm volatile("s_waitcnt lgkmcnt(" #n ")" ::: "memory")
#define PG8_BAR __builtin_amdgcn_s_barrier()
#define PG8_SCHED __builtin_amdgcn_sched_barrier(0)
    Unit cur, nxt; int ui = 0;
    if (!S.next(0, cur)) return;
    f32x4 acc[2][2][4][2];
#pragma unroll
    for (int a = 0; a < 2; ++a)
#pragma unroll
        for (int b = 0; b < 2; ++b)
#pragma unroll
            for (int m = 0; m < 4; ++m)
#pragma unroll
                for (int n = 0; n < 2; ++n) acc[a][b][m][n] = (f32x4){0.f, 0.f, 0.f, 0.f};
    bf16x8 At[4][2], B0[2][2], B1[2][2];
    const char* cA = (const char*)g.A + (size_t)cur.pm * tstep; const char* cB = (const char*)g.Bt + (size_t)cur.pn * tstep;
    PG8_STAGE(PG8_SB(0, 0), cB, voffB); PG8_STAGE(PG8_SA(0, 0), cA, voffA); PG8_STAGE(PG8_SB(0, 1), cB + hstep, voffB); PG8_STAGE(PG8_SA(0, 1), cA + hstep, voffA);
    if (wr == 1) PG8_BAR;
    PG8_WAIT_V(4); PG8_BAR;
    PG8_STAGE(PG8_SB(1, 0), cB + kstep, voffB); PG8_STAGE(PG8_SA(1, 0), cA + kstep, voffA); PG8_STAGE(PG8_SB(1, 1), cB + hstep + kstep, voffB);
    PG8_WAIT_V(6); PG8_BAR;
    for (;;) {
        const bool has_next = S.next(ui + 1, nxt);
        const char* nA = has_next ? (const char*)g.A + (size_t)nxt.pm * tstep : cA; const char* nB = has_next ? (const char*)g.Bt + (size_t)nxt.pn * tstep : cB;
        for (int t = 0; t < nt; t += 2) {
            const bool last = (t == nt - 2);
            const char* a1 = cA + (size_t)(t + 1) * kstep;
            const char* a2 = last ? nA : cA + (size_t)(t + 2) * kstep; const char* b2 = last ? nB : cB + (size_t)(t + 2) * kstep;
            const char* a3 = a2 + kstep; const char* b3 = b2 + kstep;
            PG8_LDB(B0, 0, 0); PG8_SCHED; PG8_LDA(At, 0, 0); PG8_STAGE(PG8_SA(1, 1), a1 + hstep, voffA);
            PG8_WAIT_L(8); PG8_BAR; PG8_WAIT_L(0); PG8_MMA(0, 0, At, B0); PG8_BAR; PG8_SCHED;
            PG8_LDB(B1, 0, 1); PG8_STAGE(PG8_SB(0, 0), b2, voffB);
            PG8_BAR; PG8_WAIT_L(0); PG8_MMA(0, 1, At, B1); PG8_BAR;
            PG8_LDA(At, 0, 1); PG8_STAGE(PG8_SA(0, 0), a2, voffA);
            PG8_BAR; PG8_WAIT_L(0); PG8_MMA(1, 0, At, B0); PG8_BAR; PG8_SCHED;
            PG8_STAGE(PG8_SB(0, 1), b2 + hstep, voffB);
            PG8_WAIT_V(6); PG8_BAR; PG8_MMA(1, 1, At, B1); PG8_BAR;
            PG8_LDB(B0, 1, 0); PG8_SCHED; PG8_LDA(At, 1, 0); PG8_STAGE(PG8_SA(0, 1), a2 + hstep, voffA);
            PG8_WAIT_L(8); PG8_BAR; PG8_WAIT_L(0); PG8_MMA(0, 0, At, B0); PG8_BAR; PG8_SCHED;
            PG8_LDB(B1, 1, 1); PG8_STAGE(PG8_SB(1, 0), b3, voffB);
            PG8_BAR; PG8_WAIT_L(0); PG8_MMA(0, 1, At, B1); PG8_BAR;
            PG8_LDA(At, 1, 1); PG8_STAGE(PG8_SA(1, 0), a3, voffA);
            PG8_BAR; PG8_WAIT_L(0); PG8_MMA(1, 0, At, B0); PG8_BAR; PG8_SCHED;
            PG8_STAGE(PG8_SB(1, 1), b3 + hstep, voffB);
            PG8_WAIT_V(6); PG8_BAR; PG8_MMA(1, 1, At, B1); PG8_BAR;
        }
        E(acc, cur, wr, wc, fr, fq);
        if (!has_next) break;
#pragma unroll
        for (int a = 0; a < 2; ++a)
#pragma unroll
            for (int b = 0; b < 2; ++b)
#pragma unroll
                for (int m = 0; m < 4; ++m)
#pragma unroll
                    for (int n = 0; n < 2; ++n) acc[a][b][m][n] = (f32x4){0.f, 0.f, 0.f, 0.f};
        cur = nxt; cA = nA; cB = nB; ++ui;
    }
    PG8_WAIT_V(0);
    if (wr == 0) PG8_BAR;
    PG8_BAR;
#undef PG8_SA
#undef PG8_SB
#undef PG8_STAGE
#undef PG8_LDA
#undef PG8_LDB
#undef PG8_MMA
#undef PG8_WAIT_V
#undef PG8_WAIT_L
#undef PG8_BAR
#undef PG8_SCHED
}

struct EpiHgrnIn {
    static constexpr bool PERM = true;
    bf16_t* QVG; bf16_t* LF; const float* lb;
    __device__ __forceinline__ void operator()(const f32x4 (&acc)[2][2][4][2], const Unit& u, int wr, int wc, int fr, int fq) const {
        const int seg = u.pn >> 2, colt = (u.pn & 3) * 256;
        const int row0 = u.pm * BM + wr * 64 + fr, col0 = colt + wc * 32 + 8 * fq;
        const size_t hm0 = (size_t)(u.pm >> 5) * SEQ * 896 + (size_t)(2 * (u.pn & 3)) * SEQ * 128 + wc * 32 + 8 * fq;
        if (seg == 1) {
#pragma unroll
            for (int bj = 0; bj < 2; ++bj) {
                const f32x4 l0 = *(const f32x4*)(lb + col0 + bj * HALF), l1 = *(const f32x4*)(lb + col0 + bj * HALF + 4);
#pragma unroll
                for (int ai = 0; ai < 2; ++ai)
#pragma unroll
                    for (int m = 0; m < 4; ++m) {
                        bf16_t* rowp = LF + (size_t)(row0 + ai * HALF + m * 16) * 128 + hm0 + (size_t)bj * SEQ * 128;
                        f32x4 o0, o1;
#pragma unroll
                        for (int j = 0; j < 4; ++j) {
                            float z = acc[ai][bj][m][0][j]; float sg = __builtin_amdgcn_rcpf(1.0f + __expf(-z)); float f = l0[j] + (1.0f - l0[j]) * sg; o0[j] = logf(fmaxf(f, 1e-30f));
                            z = acc[ai][bj][m][1][j]; sg = __builtin_amdgcn_rcpf(1.0f + __expf(-z)); f = l1[j] + (1.0f - l1[j]) * sg; o1[j] = logf(fmaxf(f, 1e-30f));
                        }
                        u32x4 lw; lw.x = cvt_pk_bf16(o0[0], o0[1]); lw.y = cvt_pk_bf16(o0[2], o0[3]); lw.z = cvt_pk_bf16(o1[0], o1[1]); lw.w = cvt_pk_bf16(o1[2], o1[3]);
                        *(u32x4*)rowp = lw;
                    }
            }
        } else {
            bf16_t* base = QVG + (size_t)(seg == 0 ? 0 : (seg == 2 ? 1 : 2)) * ((size_t)MTOK * D);
            const bool act = (seg != 2);
#pragma unroll
            for (int ai = 0; ai < 2; ++ai)
#pragma unroll
                for (int m = 0; m < 4; ++m)
#pragma unroll
                    for (int bj = 0; bj < 2; ++bj) {
                        f32x4 v0 = acc[ai][bj][m][0], v1 = acc[ai][bj][m][1];
                        if (act) {
#pragma unroll
                            for (int j = 0; j < 4; ++j) { v0[j] = silu_f(v0[j]); v1[j] = silu_f(v1[j]); }
                        }
                        u32x4 w; w.x = cvt_pk_bf16(v0[0], v0[1]); w.y = cvt_pk_bf16(v0[2], v0[3]); w.z = cvt_pk_bf16(v1[0], v1[1]); w.w = cvt_pk_bf16(v1[2], v1[3]);
                        *(u32x4*)(base + (size_t)(row0 + ai * HALF + m * 16) * 128 + hm0 + (size_t)bj * SEQ * 128) = w;
                    }
        }
    }
};
struct EpiResid {
    static constexpr bool PERM = true;
    const float* const* in; unsigned char* ws; float* hbuf; int l, which;
    __device__ __forceinline__ void emit(const f32x4 (&v)[2][2][4][2], const float (&rs)[2][4], bf16_t* U, const float* gain, const float* sh, const float* sc, int bs, int b, int row0, int col0) const {
#pragma unroll
        for (int bj = 0; bj < 2; ++bj) {
            const int c = col0 + bj * HALF;
            f32x4 a0, a1, t0, t1;
            { const f32x4 g0 = *(const f32x4*)(gain + c), s0 = *(const f32x4*)(sc + (size_t)b * bs + c); a0 = g0 * (s0 + 1.0f); t0 = *(const f32x4*)(sh + (size_t)b * bs + c); }
            { const f32x4 g1 = *(const f32x4*)(gain + c + 4), s1 = *(const f32x4*)(sc + (size_t)b * bs + c + 4); a1 = g1 * (s1 + 1.0f); t1 = *(const f32x4*)(sh + (size_t)b * bs + c + 4); }
#pragma unroll
            for (int ai = 0; ai < 2; ++ai)
#pragma unroll
                for (int m = 0; m < 4; ++m) {
                    const f32x4 u0 = (v[ai][bj][m][0] * rs[ai][m]) * a0 + t0, u1 = (v[ai][bj][m][1] * rs[ai][m]) * a1 + t1;
                    u32x4 w; w.x = cvt_pk_bf16(u0[0], u0[1]); w.y = cvt_pk_bf16(u0[2], u0[3]); w.z = cvt_pk_bf16(u1[0], u1[1]); w.w = cvt_pk_bf16(u1[2], u1[3]);
                    *(u32x4*)(U + (size_t)(row0 + ai * HALF + m * 16) * D + c) = w;
                }
            __builtin_amdgcn_sched_barrier(0);
        }
    }
    __device__ __forceinline__ void operator()(f32x4 (&acc)[2][2][4][2], const Unit& u, int wr, int wc, int fr, int fq) const {
        __builtin_amdgcn_sched_barrier(0);
        const int b = u.pm >> 5;
        const float* mv = (const float*)(ws + OFF_MODV) + (size_t)l * 8 * 6144;
        const float* src = (l == 0 && which == 0) ? in[0] : hbuf; float* dst = hbuf;
        const int mode = (l == 3 && which == 1) ? 1 : 0;
        unsigned long long* rowacc = (unsigned long long*)(ws + OFF_ROWSS) + (size_t)(2 * l + which) * MTOK;
        const float* gp = mv + (which ? 5 : 2) * D + (size_t)b * 6144;
        const int row0 = u.pm * BM + wr * 64 + fr, col0 = u.pn * BM + wc * 32 + 8 * fq;
        {
            f32x4 gv[2][2];
#pragma unroll
            for (int bj = 0; bj < 2; ++bj)
#pragma unroll
                for (int n = 0; n < 2; ++n) gv[bj][n] = *(const f32x4*)(gp + col0 + bj * HALF + 4 * n);
#pragma unroll
            for (int ai = 0; ai < 2; ++ai)
#pragma unroll
                for (int m = 0; m < 4; ++m) {
                    const size_t ro = (size_t)(row0 + ai * HALF + m * 16) * D + col0;
                    float pt = 0.f;
#pragma unroll
                    for (int bj = 0; bj < 2; ++bj)
#pragma unroll
                        for (int n = 0; n < 2; ++n) {
                            const f32x4 v = *(const f32x4*)(src + ro + bj * HALF + 4 * n) + gv[bj][n] * acc[ai][bj][m][n];
                            acc[ai][bj][m][n] = v;
                            if (mode == 0) *(f32x4*)(dst + ro + bj * HALF + 4 * n) = v;
                            pt += (v[0] * v[0] + v[1] * v[1]) + (v[2] * v[2] + v[3] * v[3]);
                        }
                    pt += __shfl_xor(pt, 16); pt += __shfl_xor(pt, 32);
                    if (fq == 0) (void)__hip_atomic_fetch_add(rowacc + row0 + ai * HALF + m * 16, (1ull << 48) + (unsigned long long)(pt * 65536.0f + 0.5f), __ATOMIC_RELAXED, __HIP_MEMORY_SCOPE_AGENT);
                    __builtin_amdgcn_sched_barrier(0);
                }
        }
        float rs[2][4];
        {
            unsigned spins = 0;
            for (;;) {
                bool done = true;
#pragma unroll
                for (int ai = 0; ai < 2; ++ai)
#pragma unroll
                    for (int m = 0; m < 4; ++m) {
                        const unsigned long long q = __hip_atomic_load(rowacc + row0 + ai * HALF + m * 16, __ATOMIC_RELAXED, __HIP_MEMORY_SCOPE_AGENT);
                        done = done && ((q >> 48) >= 16ull);
                        rs[ai][m] = rsqrtf((float)(q & 0xffffffffffffull) * (1.0f / 65536.0f) * (1.0f / D) + 1e-6f);
                    }
                if (__all(done) || ++spins > (1u << 16)) break;
                __builtin_amdgcn_s_sleep(2);
            }
        }
        asm volatile("" ::: "memory");
        __builtin_amdgcn_sched_barrier(0);
        if (mode == 1) {
            const float* gain1 = in[19];
#pragma unroll
            for (int bj = 0; bj < 2; ++bj) {
                const f32x4 g0 = *(const f32x4*)(gain1 + col0 + bj * HALF), g1 = *(const f32x4*)(gain1 + col0 + bj * HALF + 4);
#pragma unroll
                for (int ai = 0; ai < 2; ++ai)
#pragma unroll
                    for (int m = 0; m < 4; ++m) {
                        float* op = dst + (size_t)(row0 + ai * HALF + m * 16) * D + col0 + bj * HALF;
                        *(f32x4*)op = (acc[ai][bj][m][0] * rs[ai][m]) * g0; *(f32x4*)(op + 4) = (acc[ai][bj][m][1] * rs[ai][m]) * g1;
                    }
            }
        } else {
            if (which == 0) emit(acc, rs, (l < 2) ? (bf16_t*)(ws + OFF_UF_A) : (bf16_t*)(ws + OFF_QB), in[5] + l * D, mv + 3 * D, mv + 4 * D, 6144, b, row0, col0);
            else {
                const float* mvn = mv + (size_t)8 * 6144;
                emit(acc, rs, (bf16_t*)(ws + OFF_U), in[4] + (l + 1) * D, mvn, mvn + D, 6144, b, row0, col0);
                if (l == 1) { const float* kvm = (const float*)(ws + OFF_KVMOD); emit(acc, rs, (bf16_t*)(ws + OFF_QB), in[12], kvm, kvm + D, 2048, b, row0, col0); }
            }
        }
    }
};
struct EpiSwiglu {
    static constexpr bool PERM = true;
    bf16_t* act;
    __device__ __forceinline__ void operator()(const f32x4 (&acc)[2][2][4][2], const Unit& u, int wr, int wc, int fr, int fq) const {
        const int row0 = u.pm * BM + wr * 64 + fr, col0 = u.pn * HALF + wc * 32 + 8 * fq;
#pragma unroll
        for (int ai = 0; ai < 2; ++ai)
#pragma unroll
            for (int m = 0; m < 4; ++m) {
                f32x4 r0, r1;
#pragma unroll
                for (int j = 0; j < 4; ++j) { r0[j] = silu_f(acc[ai][0][m][0][j]) * acc[ai][1][m][0][j]; r1[j] = silu_f(acc[ai][0][m][1][j]) * acc[ai][1][m][1][j]; }
                u32x4 w; w.x = cvt_pk_bf16(r0[0], r0[1]); w.y = cvt_pk_bf16(r0[2], r0[3]); w.z = cvt_pk_bf16(r1[0], r1[1]); w.w = cvt_pk_bf16(r1[2], r1[3]);
                *(u32x4*)(act + (size_t)(row0 + ai * HALF + m * 16) * FFN + col0) = w;
            }
    }
};
struct EpiBf16Split {
    static constexpr bool PERM = true;
    bf16_t* d0; float scale; int hm;
    __device__ __forceinline__ void operator()(const f32x4 (&acc)[2][2][4][2], const Unit& u, int wr, int wc, int fr, int fq) const {
        bf16_t* base = d0 + (size_t)(u.pn >> 2) * ((size_t)MTOK * D);
        const int row0 = u.pm * BM + wr * 64 + fr, col0 = (u.pn & 3) * 256 + wc * 32 + 8 * fq;
#pragma unroll
        for (int ai = 0; ai < 2; ++ai)
#pragma unroll
            for (int m = 0; m < 4; ++m)
#pragma unroll
                for (int bj = 0; bj < 2; ++bj) {
                    const f32x4 v0 = acc[ai][bj][m][0] * scale, v1 = acc[ai][bj][m][1] * scale;
                    u32x4 w; w.x = cvt_pk_bf16(v0[0], v0[1]); w.y = cvt_pk_bf16(v0[2], v0[3]); w.z = cvt_pk_bf16(v1[0], v1[1]); w.w = cvt_pk_bf16(v1[2], v1[3]);
                    const int row = row0 + ai * HALF + m * 16;
                    if (hm) *(u32x4*)(base + (size_t)row * 64 + (size_t)(u.pm >> 5) * SEQ * 960 + (size_t)((col0 + bj * HALF) >> 6) * SEQ * 64 + ((col0 + bj * HALF) & 63)) = w;
                    else *(u32x4*)(base + (size_t)row * D + col0 + bj * HALF) = w;
                }
    }
};
}

template <class Epi>
__device__ __forceinline__ void run_gemm(unsigned char* shm, const bf16_t* A, const bf16_t* Bt, int N, int K, const Epi& E) {
    pg8::Gemm g; g.A = A; g.Bt = Bt; g.M = MTOK; g.N = N; g.K = K;
    pg8::StaticOrder S; S.init(MTOK, N, (int)gridDim.x, (int)blockIdx.x);
    pg8::gemm_phase<Epi>((LAS unsigned char*)shm, g, S, E);
    __syncthreads();
}

__device__ __forceinline__ int ffnmap(int nn) { return nn < FFN ? ((nn >> 7) * 256 + (nn & 127)) : (((nn - FFN) >> 7) * 256 + 128 + ((nn - FFN) & 127)); }

__device__ __forceinline__ void conv_group(const float* src0, bf16_t* dst0, const int K, const int N, const int L, const int mode, unsigned char* shm, const int tid) {
    float* st = (float*)shm;
    const int per = (K / 128) * (N / 64), total = L * per, ntn = N / 64;
    for (int tile = blockIdx.x; tile < total; tile += gridDim.x) {
        const int l = tile / per, tt = tile % per, k0 = (tt / ntn) * 128, n0 = (tt % ntn) * 64;
        const float* src = src0 + (size_t)l * K * N; bf16_t* dst = dst0 + (size_t)l * K * N;
        f32x4 v[4];
#pragma unroll
        for (int it = 0; it < 4; ++it) { const int idx = tid + it * 512, k = idx >> 4, n4 = idx & 15; v[it] = *(const f32x4*)(src + (size_t)(k0 + k) * N + n0 + 4 * n4); }
        __syncthreads();
#pragma unroll
        for (int it = 0; it < 4; ++it) { const int idx = tid + it * 512, k = idx >> 4, n4 = idx & 15;
#pragma unroll
            for (int e = 0; e < 4; ++e) st[k * 65 + 4 * n4 + e] = v[it][e]; }
        __syncthreads();
#pragma unroll
        for (int it = 0; it < 2; ++it) { const int idx = tid + it * 512, n = idx >> 4, kg = idx & 15; const int nn = n0 + n; const int drow = mode ? ffnmap(nn) : nn;
            u32x4 w;
#pragma unroll
            for (int e = 0; e < 4; ++e) w[e] = cvt_pk_bf16(st[(8 * kg + 2 * e) * 65 + n], st[(8 * kg + 2 * e + 1) * 65 + n]);
            *(u32x4*)(dst + (size_t)drow * K + k0 + 8 * kg) = w; }
    }
}

__device__ void prep_phase(const Params& p, unsigned char* shm) {
    const int tid = opaque_tid();
    {
        float* cact = (float*)shm;
        float* red = cact + 8192;
        bool loaded = false;
        const int wv = tid >> 6, lane = tid & 63;
        for (int task = blockIdx.x; task < 416; task += gridDim.x) {
            if (!loaded) {
                for (int i = tid; i < 8192; i += 512) { const int k = i >> 3, b = i & 7; cact[i] = silu_f(p.in[1][b * D + k]); }
                loaded = true;
            }
            __syncthreads();
            const int c0 = task * 64;
            const float* src; const float* bias; float* dst; int stride, dstride;
            if (c0 < 24576) { const int l = c0 / 6144, j = c0 % 6144; src = p.in[2] + (size_t)l * D * 6144 + j; stride = 6144; bias = p.in[3] + l * 6144 + j; dst = ((float*)(p.ws + OFF_MODV)) + (size_t)l * 8 * 6144 + j; dstride = 6144; }
            else { const int j = c0 - 24576; src = p.in[13] + j; stride = 2048; bias = p.in[14] + j; dst = ((float*)(p.ws + OFF_KVMOD)) + j; dstride = 2048; }
            float a[8];
#pragma unroll
            for (int b = 0; b < 8; ++b) a[b] = 0.f;
            const float* sp = src + (size_t)(wv * 128) * stride + lane;
#pragma unroll 8
            for (int k = 0; k < 128; ++k) {
                const float w = sp[(size_t)k * stride];
                const f32x4 c0v = *(const f32x4*)(cact + (wv * 128 + k) * 8), c1v = *(const f32x4*)(cact + (wv * 128 + k) * 8 + 4);
                a[0] += w * c0v[0]; a[1] += w * c0v[1]; a[2] += w * c0v[2]; a[3] += w * c0v[3];
                a[4] += w * c1v[0]; a[5] += w * c1v[1]; a[6] += w * c1v[2]; a[7] += w * c1v[3];
            }
#pragma unroll
            for (int b = 0; b < 8; ++b) red[(wv * 8 + b) * 64 + lane] = a[b];
            __syncthreads();
            {
                const int b = tid >> 6, col = tid & 63;
                float s = bias[col];
#pragma unroll
                for (int w = 0; w < 8; ++w) s += red[(w * 8 + b) * 64 + col];
                dst[(size_t)b * dstride + col] = s;
            }
        }
        __syncthreads();
    }
    for (int i = blockIdx.x * 512 + tid; i < 1024; i += gridDim.x * 512) {
        const float a0 = p.in[10][i], a1 = p.in[10][1024 + i];
        const float mx = fmaxf(a0, a1), e0 = __expf(a0 - mx), e1 = __expf(a1 - mx);
        ((float*)(p.ws + OFF_LBV))[i] = 0.f; ((float*)(p.ws + OFF_LBV))[1024 + i] = e1 / (e0 + e1);
    }
    conv_group(p.in[8], (bf16_t*)(p.ws + OFF_WB_A_IN), D, AIN, 2, 0, shm, tid);
    conv_group(p.in[9], (bf16_t*)(p.ws + OFF_WB_A_OUT), D, D, 2, 0, shm, tid);
    conv_group(p.in[6], (bf16_t*)(p.ws + OFF_WB_FFN_IN), D, 2 * FFN, 4, 1, shm, tid);
    conv_group(p.in[7], (bf16_t*)(p.ws + OFF_WB_FFN_OUT), FFN, D, 4, 0, shm, tid);
    conv_group(p.in[15], (bf16_t*)(p.ws + OFF_WB_KV), D, 2 * D, 1, 0, shm, tid);
    conv_group(p.in[16], (bf16_t*)(p.ws + OFF_WB_Q), D, D, 2, 0, shm, tid);
    conv_group(p.in[17], (bf16_t*)(p.ws + OFF_WB_O), D, D, 2, 0, shm, tid);
    __syncthreads();
}

__device__ void norm_phase(const float* src, bf16_t* U1, const float* gain1, const float* sh1, const float* sc1, int bs1,
                           bf16_t* U2, const float* gain2, const float* sh2, const float* sc2, int bs2) {
    const int tid_ = opaque_tid(); const int lane = tid_ & 63, gw = blockIdx.x * 8 + (tid_ >> 6), nw = gridDim.x * 8;
    for (int row = 2 * gw; row < MTOK; row += 2 * nw) {
        const int b = row >> 13;
        const float* xp = src + (size_t)row * D;
        f32x4 xv[2][4]; float ss[2] = {0.f, 0.f};
#pragma unroll
        for (int r = 0; r < 2; ++r)
#pragma unroll
            for (int i = 0; i < 4; ++i) xv[r][i] = *(const f32x4*)(xp + (size_t)r * D + i * 256 + lane * 4);
#pragma unroll
        for (int r = 0; r < 2; ++r)
#pragma unroll
            for (int i = 0; i < 4; ++i) ss[r] += xv[r][i][0] * xv[r][i][0] + xv[r][i][1] * xv[r][i][1] + xv[r][i][2] * xv[r][i][2] + xv[r][i][3] * xv[r][i][3];
#pragma unroll
        for (int o = 1; o < 64; o <<= 1) { ss[0] += __shfl_xor(ss[0], o); ss[1] += __shfl_xor(ss[1], o); }
        const float rstd0 = rsqrtf(ss[0] * (1.0f / D) + 1e-6f), rstd1 = rsqrtf(ss[1] * (1.0f / D) + 1e-6f);
#pragma unroll
        for (int i = 0; i < 4; ++i) {
            const int k = i * 256 + lane * 4;
            const f32x4 g = *(const f32x4*)(gain1 + k), s = *(const f32x4*)(sc1 + (size_t)b * bs1 + k), t = *(const f32x4*)(sh1 + (size_t)b * bs1 + k);
            f32x4 u0, u1;
#pragma unroll
            for (int j = 0; j < 4; ++j) { const float ga = g[j] * (1.0f + s[j]); u0[j] = (xv[0][i][j] * rstd0) * ga + t[j]; u1[j] = (xv[1][i][j] * rstd1) * ga + t[j]; }
            u32x2 w0, w1; w0.x = cvt_pk_bf16(u0[0], u0[1]); w0.y = cvt_pk_bf16(u0[2], u0[3]); w1.x = cvt_pk_bf16(u1[0], u1[1]); w1.y = cvt_pk_bf16(u1[2], u1[3]);
            *(u32x2*)(U1 + (size_t)row * D + k) = w0; *(u32x2*)(U1 + (size_t)(row + 1) * D + k) = w1;
        }
        if (U2) {
#pragma unroll
            for (int i = 0; i < 4; ++i) {
                const int k = i * 256 + lane * 4;
                const f32x4 g = *(const f32x4*)(gain2 + k), s = *(const f32x4*)(sc2 + (size_t)b * bs2 + k), t = *(const f32x4*)(sh2 + (size_t)b * bs2 + k);
                f32x4 u0, u1;
#pragma unroll
                for (int j = 0; j < 4; ++j) { const float ga = g[j] * (1.0f + s[j]); u0[j] = (xv[0][i][j] * rstd0) * ga + t[j]; u1[j] = (xv[1][i][j] * rstd1) * ga + t[j]; }
                u32x2 w0, w1; w0.x = cvt_pk_bf16(u0[0], u0[1]); w0.y = cvt_pk_bf16(u0[2], u0[3]); w1.x = cvt_pk_bf16(u1[0], u1[1]); w1.y = cvt_pk_bf16(u1[2], u1[3]);
                *(u32x2*)(U2 + (size_t)row * D + k) = w0; *(u32x2*)(U2 + (size_t)(row + 1) * D + k) = w1;
            }
        }
    }
}
__device__ void final_norm_phase(float* h, const float* gain) {
    const int tid_ = opaque_tid(); const int lane = tid_ & 63, gw = blockIdx.x * 8 + (tid_ >> 6), nw = gridDim.x * 8;
    for (int row = gw; row < MTOK; row += nw) {
        float* xp = h + (size_t)row * D;
        f32x4 xv[4]; float ss = 0.f;
#pragma unroll
        for (int i = 0; i < 4; ++i) { xv[i] = *(const f32x4*)(xp + i * 256 + lane * 4); ss += xv[i][0] * xv[i][0] + xv[i][1] * xv[i][1] + xv[i][2] * xv[i][2] + xv[i][3] * xv[i][3]; }
#pragma unroll
        for (int o = 1; o < 64; o <<= 1) ss += __shfl_xor(ss, o);
        const float rstd = rsqrtf(ss * (1.0f / D) + 1e-6f);
#pragma unroll
        for (int i = 0; i < 4; ++i) {
            const int k = i * 256 + lane * 4;
            const f32x4 g = *(const f32x4*)(gain + k);
            f32x4 u;
#pragma unroll
            for (int j = 0; j < 4; ++j) u[j] = xv[i][j] * rstd * g[j];
            *(f32x4*)(xp + k) = u;
        }
    }
}

template <bool OUT>
__device__ void rec_pass(const Params& p, int layer, unsigned char* shm) {
    float* sB = (float*)shm;
    float* sKm = (float*)(shm + 33792);
    bf16_t* sST = (bf16_t*)shm;
    bf16_t* sQb = (bf16_t*)(shm + 67584);
    bf16_t* sA = (bf16_t*)(shm + 84992);
    bf16_t* sKT = (bf16_t*)(shm + 94208);
    bf16_t* sVT = (bf16_t*)(shm + 112640);
    float* sE = (float*)(shm + 131072);
    float* sPart = (float*)(shm + 131584);
    float* sNrm = (float*)(shm + 135680);
    const int tid = opaque_tid(), lane = tid & 63, w = tid >> 6, fr = lane & 15, fq = lane >> 4;
    const int wi = w >> 1, wh = w & 1;
    const int ntask = OUT ? 256 : 192;
    const float* ogain = p.in[11] + layer * 128;
    for (int task = blockIdx.x; task < ntask; task += gridDim.x) {
        int sc, bh; if (OUT) { sc = task & 3; bh = task >> 2; } else { sc = task % 3; bh = task / 3; }
        const int b = bh >> 3, h = bh & 7;
        const size_t hoff = (size_t)b * SEQ * 896 + (size_t)h * SEQ * 128;
        f32x4 S[8];
#pragma unroll
        for (int db = 0; db < 8; ++db) S[db] = (f32x4){0.f, 0.f, 0.f, 0.f};
        if (OUT) {
            for (int s2 = 0; s2 < sc; ++s2) {
                const float* sl = ((float*)(p.ws + OFF_SLOC)) + (size_t)(bh * 4 + s2) * 16384; const float* dl = ((float*)(p.ws + OFF_DLOG)) + (bh * 4 + s2) * 128;
#pragma unroll
                for (int db = 0; db < 8; ++db) {
                    const f32x4 x = *(const f32x4*)(sl + ((w * 8 + db) * 64 + lane) * 4), dv = *(const f32x4*)(dl + 16 * db + fq * 4);
#pragma unroll
                    for (int j = 0; j < 4; ++j) S[db][j] = S[db][j] * __expf(dv[j]) + x[j];
                }
            }
        }
        float dlacc = 0.f;
        unsigned lfn[8]; u32x4 vn0, vn1;
        const bf16_t* LFb = (const bf16_t*)(p.ws + OFF_LF);
        const int d2 = (tid & 63) * 2, tq = tid >> 6;
        {
            const size_t r0 = (size_t)b * SEQ + (size_t)(sc * 32) * 64;
            const bf16_t* lp = LFb + (r0 + 8 * tq) * 128 + hoff + d2;
#pragma unroll
            for (int e = 0; e < 8; ++e) lfn[e] = *(const unsigned*)(lp + (size_t)e * 128);
            vn0 = *(const u32x4*)(((bf16_t*)(p.ws + OFF_VH)) + (r0 + (tid & 63)) * 128 + hoff + (tid >> 6) * 8);
            vn1 = *(const u32x4*)(((bf16_t*)(p.ws + OFF_VH)) + (r0 + (tid & 63)) * 128 + hoff + 64 + (tid >> 6) * 8);
        }
        for (int ch = sc * 32; ch < sc * 32 + 32; ++ch) {
            const size_t row0 = (size_t)b * SEQ + (size_t)ch * 64;
            float la[8], lb2[8];
#pragma unroll
            for (int e = 0; e < 8; ++e) { la[e] = bflo(lfn[e]); lb2[e] = bfhi(lfn[e]); }
            const u32x4 vr0 = vn0, vr1 = vn1;
            u32x4 qraw[4]; u32x2 graw[4];
            if (OUT) {
#pragma unroll
                for (int ks = 0; ks < 4; ++ks) qraw[ks] = *(const u32x4*)(((bf16_t*)(p.ws + OFF_QH)) + (row0 + 16 * wi + fr) * 128 + hoff + ks * 32 + fq * 8);
#pragma unroll
                for (int vb = 0; vb < 4; ++vb) graw[vb] = *(const u32x2*)(((bf16_t*)(p.ws + OFF_GH)) + (row0 + 16 * wi + fr) * 128 + hoff + 64 * wh + 16 * vb + fq * 4);
            }
            {
                float ra = 0.f, rb = 0.f, ka[8], kb2[8];
#pragma unroll
                for (int e = 0; e < 8; ++e) {
                    ka[e] = 1.0f - __expf(la[e]); kb2[e] = 1.0f - __expf(lb2[e]);
                    *(f32x2*)(sKm + (8 * tq + e) * 132 + d2) = (f32x2){ka[e], kb2[e]};
                    ra += la[e]; la[e] = ra; rb += lb2[e]; lb2[e] = rb;
                }
                *(f32x2*)(sPart + tq * 128 + d2) = (f32x2){ra, rb};
                {
                    const int s_ = tid & 63, pc = tid >> 6;
#pragma unroll
                    for (int e = 0; e < 8; ++e) {
                        sVT[(pc * 8 + e) * 72 + s_] = (bf16_t)((e & 1) ? (vr0[e >> 1] >> 16) : (vr0[e >> 1] & 0xffffu));
                        sVT[(64 + pc * 8 + e) * 72 + s_] = (bf16_t)((e & 1) ? (vr1[e >> 1] >> 16) : (vr1[e >> 1] & 0xffffu));
                    }
                }
                __syncthreads();
                float offa = 0.f, offb = 0.f, tota = 0.f, totb = 0.f;
#pragma unroll
                for (int q = 0; q < 8; ++q) { const f32x2 pq = *(const f32x2*)(sPart + q * 128 + d2); tota += pq[0]; totb += pq[1]; if (q < tq) { offa += pq[0]; offb += pq[1]; } }
                if (tq == 0) { *(f32x2*)(sE + d2) = (f32x2){__expf(tota), __expf(totb)}; }
                u32x4 kwa, kwb;
#pragma unroll
                for (int e = 0; e < 8; e += 2) {
                    const float a0 = la[e] + offa, a1 = la[e + 1] + offa, b0 = lb2[e] + offb, b1 = lb2[e + 1] + offb;
                    *(f32x2*)(sB + (8 * tq + e) * 132 + d2) = (f32x2){a0, b0}; *(f32x2*)(sB + (8 * tq + e + 1) * 132 + d2) = (f32x2){a1, b1};
                    kwa[e >> 1] = cvt_pk_bf16(ka[e] * __expf(tota - a0), ka[e + 1] * __expf(tota - a1));
                    kwb[e >> 1] = cvt_pk_bf16(kb2[e] * __expf(totb - b0), kb2[e + 1] * __expf(totb - b1));
                }
                *(u32x4*)(sKT + d2 * 72 + 8 * tq) = kwa; *(u32x4*)(sKT + (d2 + 1) * 72 + 8 * tq) = kwb;
            }
            __syncthreads();
            if (ch + 1 < sc * 32 + 32) {
                const size_t r1 = row0 + 64;
                const bf16_t* lp = LFb + (r1 + 8 * tq) * 128 + hoff + d2;
#pragma unroll
                for (int e = 0; e < 8; ++e) lfn[e] = *(const unsigned*)(lp + (size_t)e * 128);
                vn0 = *(const u32x4*)(((bf16_t*)(p.ws + OFF_VH)) + (r1 + (tid & 63)) * 128 + hoff + (tid >> 6) * 8);
                vn1 = *(const u32x4*)(((bf16_t*)(p.ws + OFF_VH)) + (r1 + (tid & 63)) * 128 + hoff + 64 + (tid >> 6) * 8);
            }
            if (OUT) {
                const int i = wi, hh = wh, t_ = 16 * i + fr;
                bf16x8 qt[4];
#pragma unroll
                for (int ks = 0; ks < 4; ++ks) {
                    const int d0 = ks * 32 + fq * 8;
                    const f32x4 b0 = *(const f32x4*)(sB + t_ * 132 + d0), b1 = *(const f32x4*)(sB + t_ * 132 + d0 + 4);
                    f32x4 r0 = (f32x4){0.f, 0.f, 0.f, 0.f}, r1 = r0;
                    if (i > 0) { r0 = *(const f32x4*)(sB + (16 * i - 1) * 132 + d0); r1 = *(const f32x4*)(sB + (16 * i - 1) * 132 + d0 + 4); }
                    float qv[8], ql[8];
#pragma unroll
                    for (int e = 0; e < 4; ++e) { qv[2 * e] = bflo(qraw[ks][e]); qv[2 * e + 1] = bfhi(qraw[ks][e]); }
#pragma unroll
                    for (int e = 0; e < 4; ++e) { ql[e] = qv[e] * __expf(b0[e] - r0[e]); ql[4 + e] = qv[4 + e] * __expf(b1[e] - r1[e]); }
                    u32x4 pw; pw.x = cvt_pk_bf16(ql[0], ql[1]); pw.y = cvt_pk_bf16(ql[2], ql[3]); pw.z = cvt_pk_bf16(ql[4], ql[5]); pw.w = cvt_pk_bf16(ql[6], ql[7]);
                    qt[ks] = __builtin_bit_cast(bf16x8, pw);
                    if ((ks >> 1) == hh) {
#pragma unroll
                        for (int e = 0; e < 4; ++e) { ql[e] = qv[e] * __expf(b0[e]); ql[4 + e] = qv[4 + e] * __expf(b1[e]); }
                        u32x4 qw; qw.x = cvt_pk_bf16(ql[0], ql[1]); qw.y = cvt_pk_bf16(ql[2], ql[3]); qw.z = cvt_pk_bf16(ql[4], ql[5]); qw.w = cvt_pk_bf16(ql[6], ql[7]);
                        *(u32x4*)(sQb + t_ * 136 + d0) = qw;
                    }
                }
#pragma unroll
                for (int j2 = 0; j2 < 2; ++j2) {
                    const int j = hh + 2 * j2;
                    if (j <= i) {
                        f32x4 acc = (f32x4){0.f, 0.f, 0.f, 0.f};
                        const int s_ = 16 * j + fr;
#pragma unroll
                        for (int ks = 0; ks < 4; ++ks) {
                            const int d0 = ks * 32 + fq * 8;
                            const f32x4 k0 = *(const f32x4*)(sKm + s_ * 132 + d0), k1 = *(const f32x4*)(sKm + s_ * 132 + d0 + 4);
                            const f32x4 b0 = *(const f32x4*)(sB + s_ * 132 + d0), b1 = *(const f32x4*)(sB + s_ * 132 + d0 + 4);
                            f32x4 r0 = (f32x4){0.f, 0.f, 0.f, 0.f}, r1 = r0;
                            if (i > 0) { r0 = *(const f32x4*)(sB + (16 * i - 1) * 132 + d0); r1 = *(const f32x4*)(sB + (16 * i - 1) * 132 + d0 + 4); }
                            float kl[8];
#pragma unroll
                            for (int e = 0; e < 4; ++e) { kl[e] = k0[e] * __expf(fminf(r0[e] - b0[e], 80.f)); kl[4 + e] = k1[e] * __expf(fminf(r1[e] - b1[e], 80.f)); }
                            u32x4 kw; kw.x = cvt_pk_bf16(kl[0], kl[1]); kw.y = cvt_pk_bf16(kl[2], kl[3]); kw.z = cvt_pk_bf16(kl[4], kl[5]); kw.w = cvt_pk_bf16(kl[6], kl[7]);
                            acc = __builtin_amdgcn_mfma_f32_16x16x32_bf16(qt[ks], __builtin_bit_cast(bf16x8, kw), acc, 0, 0, 0);
                        }
#pragma unroll
                        for (int jj = 0; jj < 4; ++jj) {
                            float vv = acc[jj];
                            if (i == j && fr > fq * 4 + jj) vv = 0.f;
                            sA[(16 * i + fq * 4 + jj) * 72 + 16 * j + fr] = (bf16_t)(cvt_pk_bf16(vv, 0.f) & 0xffffu);
                        }
                    } else {
#pragma unroll
                        for (int jj = 0; jj < 4; ++jj) sA[(16 * i + fq * 4 + jj) * 72 + 16 * j + fr] = (bf16_t)0;
                    }
                }
            }
            __syncthreads();
            if (OUT) {
#pragma unroll
                for (int db = 0; db < 8; ++db) { u32x2 sw; sw.x = cvt_pk_bf16(S[db][0], S[db][1]); sw.y = cvt_pk_bf16(S[db][2], S[db][3]); *(u32x2*)(sST + (16 * w + fr) * 136 + 16 * db + fq * 4) = sw; }
                __syncthreads();
            }
            f32x4 o[4];
            if (OUT) {
                const int i = wi;
#pragma unroll
                for (int vb = 0; vb < 4; ++vb) o[vb] = (f32x4){0.f, 0.f, 0.f, 0.f};
#pragma unroll
                for (int kk = 0; kk < 2; ++kk) {
                    if (kk <= (i >> 1)) {
                        const bf16x8 af = *(const bf16x8*)(sA + (16 * i + fr) * 72 + kk * 32 + fq * 8);
#pragma unroll
                        for (int vb = 0; vb < 4; ++vb) { const bf16x8 vf = *(const bf16x8*)(sVT + (64 * wh + 16 * vb + fr) * 72 + kk * 32 + fq * 8); o[vb] = __builtin_amdgcn_mfma_f32_16x16x32_bf16(vf, af, o[vb], 0, 0, 0); }
                    }
                }
#pragma unroll
                for (int ks = 0; ks < 4; ++ks) {
                    const bf16x8 qf = *(const bf16x8*)(sQb + (16 * i + fr) * 136 + ks * 32 + fq * 8);
#pragma unroll
                    for (int vb = 0; vb < 4; ++vb) { const bf16x8 sf = *(const bf16x8*)(sST + (64 * wh + 16 * vb + fr) * 136 + ks * 32 + fq * 8); o[vb] = __builtin_amdgcn_mfma_f32_16x16x32_bf16(sf, qf, o[vb], 0, 0, 0); }
                }
                float ss = 0.f;
#pragma unroll
                for (int vb = 0; vb < 4; ++vb)
#pragma unroll
                    for (int jj = 0; jj < 4; ++jj) ss += o[vb][jj] * o[vb][jj];
                ss += __shfl_xor(ss, 16); ss += __shfl_xor(ss, 32);
                if (fq == 0) sNrm[wh * 64 + 16 * i + fr] = ss;
            }
#pragma unroll
            for (int db = 0; db < 8; ++db) { const f32x4 e4 = *(const f32x4*)(sE + 16 * db + fq * 4); S[db] = S[db] * e4; }
#pragma unroll
            for (int ks = 0; ks < 2; ++ks) {
                const bf16x8 vf = *(const bf16x8*)(sVT + (16 * w + fr) * 72 + ks * 32 + fq * 8);
#pragma unroll
                for (int db = 0; db < 8; ++db) { const bf16x8 kf = *(const bf16x8*)(sKT + (16 * db + fr) * 72 + ks * 32 + fq * 8); S[db] = __builtin_amdgcn_mfma_f32_16x16x32_bf16(kf, vf, S[db], 0, 0, 0); }
            }
            __syncthreads();
            if (OUT) {
                const int i = wi;
                const float tot = sNrm[16 * i + fr] + sNrm[64 + 16 * i + fr];
                const float rstd = rsqrtf(tot * (1.0f / 128.0f) + 1e-6f);
                bf16_t* op = ((bf16_t*)(p.ws + OFF_U)) + (row0 + 16 * i + fr) * D + h * 128 + 64 * wh + fq * 4;
#pragma unroll
                for (int vb = 0; vb < 4; ++vb) {
                    const f32x4 gn = *(const f32x4*)(ogain + 64 * wh + 16 * vb + fq * 4);
                    const float g0 = bflo(graw[vb].x), g1 = bfhi(graw[vb].x), g2 = bflo(graw[vb].y), g3 = bfhi(graw[vb].y);
                    u32x2 ow; ow.x = cvt_pk_bf16(o[vb][0] * rstd * gn[0] * g0, o[vb][1] * rstd * gn[1] * g1); ow.y = cvt_pk_bf16(o[vb][2] * rstd * gn[2] * g2, o[vb][3] * rstd * gn[3] * g3);
                    *(u32x2*)(op + 16 * vb) = ow;
                }
            }
        }
        if (!OUT) {
            float* sl = ((float*)(p.ws + OFF_SLOC)) + (size_t)(bh * 4 + sc) * 16384;
#pragma unroll
            for (int db = 0; db < 8; ++db) *(f32x4*)(sl + ((w * 8 + db) * 64 + lane) * 4) = S[db];
            if (tid < 128) ((float*)(p.ws + OFF_DLOG))[(bh * 4 + sc) * 128 + tid] = dlacc;
        }
    }
    __syncthreads();
}

__device__ void rec_passA(const Params& p, unsigned char* shm) {
    bf16_t* sKT = (bf16_t*)shm;
    bf16_t* sVT = (bf16_t*)(shm + 34816);
    float* sE = (float*)(shm + 69632);
    float* sPart = (float*)(shm + 70144);
    const int tid = opaque_tid(), lane = tid & 63, w = tid >> 6, fr = lane & 15, fq = lane >> 4;
    const int d2 = (tid & 63) * 2, tq = tid >> 6;
    const int vs = tid & 127, vq = tid >> 7;
    const bf16_t* LFb = (const bf16_t*)(p.ws + OFF_LF); const bf16_t* Vp = (const bf16_t*)(p.ws + OFF_VH);
    for (int task = blockIdx.x; task < 192; task += gridDim.x) {
        const int sc = task % 3, bh = task / 3, b = bh >> 3, h = bh & 7;
        const size_t hoff = (size_t)b * SEQ * 896 + (size_t)h * SEQ * 128;
        f32x4 S[8];
#pragma unroll
        for (int db = 0; db < 8; ++db) S[db] = (f32x4){0.f, 0.f, 0.f, 0.f};
        float dla = 0.f, dlb = 0.f;
        const size_t rbase = (size_t)b * SEQ + (size_t)sc * 2048;
        unsigned lfn[16]; u32x4 vn[4];
        {
            const bf16_t* lp = LFb + (rbase + 16 * tq) * 128 + hoff + d2;
#pragma unroll
            for (int e = 0; e < 16; ++e) lfn[e] = *(const unsigned*)(lp + (size_t)e * 128);
#pragma unroll
            for (int i = 0; i < 4; ++i) vn[i] = *(const u32x4*)(Vp + (rbase + vs) * 128 + hoff + (vq + 4 * i) * 8);
        }
        __syncthreads();
        for (int cc = 0; cc < 16; ++cc) {
            const size_t row0 = rbase + (size_t)cc * 128;
            unsigned lf[16]; u32x4 vr[4];
            float ra = 0.f, rb = 0.f;
#pragma unroll
            for (int e = 0; e < 16; ++e) { lf[e] = lfn[e]; ra += bflo(lf[e]); rb += bfhi(lf[e]); }
#pragma unroll
            for (int i = 0; i < 4; ++i) vr[i] = vn[i];
            *(f32x2*)(sPart + tq * 128 + d2) = (f32x2){ra, rb};
            __syncthreads();
            if (cc + 1 < 16) {
                const bf16_t* lp = LFb + (row0 + 128 + 16 * tq) * 128 + hoff + d2;
#pragma unroll
                for (int e = 0; e < 16; ++e) lfn[e] = *(const unsigned*)(lp + (size_t)e * 128);
#pragma unroll
                for (int i = 0; i < 4; ++i) vn[i] = *(const u32x4*)(Vp + (row0 + 128 + vs) * 128 + hoff + (vq + 4 * i) * 8);
            }
            float ba = 0.f, bb = 0.f, tota = 0.f, totb = 0.f;
#pragma unroll
            for (int q = 0; q < 8; ++q) { const f32x2 pq = *(const f32x2*)(sPart + q * 128 + d2); tota += pq[0]; totb += pq[1]; if (q < tq) { ba += pq[0]; bb += pq[1]; } }
            if (tq == 0) { *(f32x2*)(sE + d2) = (f32x2){__expf(tota), __expf(totb)}; dla += tota; dlb += totb; }
#pragma unroll
            for (int g8 = 0; g8 < 2; ++g8) {
                u32x4 kwa, kwb;
#pragma unroll
                for (int e = 0; e < 8; e += 2) {
                    const float la0 = bflo(lf[8 * g8 + e]), lb0 = bfhi(lf[8 * g8 + e]), la1 = bflo(lf[8 * g8 + e + 1]), lb1 = bfhi(lf[8 * g8 + e + 1]);
                    const float a0 = ba + la0, a1 = a0 + la1; ba = a1;
                    const float b0 = bb + lb0, b1 = b0 + lb1; bb = b1;
                    kwa[e >> 1] = cvt_pk_bf16((1.0f - __expf(la0)) * __expf(tota - a0), (1.0f - __expf(la1)) * __expf(tota - a1));
                    kwb[e >> 1] = cvt_pk_bf16((1.0f - __expf(lb0)) * __expf(totb - b0), (1.0f - __expf(lb1)) * __expf(totb - b1));
                }
                *(u32x4*)(sKT + d2 * 136 + 16 * tq + 8 * g8) = kwa; *(u32x4*)(sKT + (d2 + 1) * 136 + 16 * tq + 8 * g8) = kwb;
            }
#pragma unroll
            for (int i = 0; i < 4; ++i)
#pragma unroll
                for (int e = 0; e < 8; ++e) sVT[((vq + 4 * i) * 8 + e) * 136 + vs] = (bf16_t)((e & 1) ? (vr[i][e >> 1] >> 16) : (vr[i][e >> 1] & 0xffffu));
            __syncthreads();
#pragma unroll
            for (int db = 0; db < 8; ++db) { const f32x4 e4 = *(const f32x4*)(sE + 16 * db + fq * 4); S[db] = S[db] * e4; }
#pragma unroll
            for (int ks = 0; ks < 4; ++ks) {
                const bf16x8 vf = *(const bf16x8*)(sVT + (16 * w + fr) * 136 + ks * 32 + fq * 8);
#pragma unroll
                for (int db = 0; db < 8; ++db) { const bf16x8 kf = *(const bf16x8*)(sKT + (16 * db + fr) * 136 + ks * 32 + fq * 8); S[db] = __builtin_amdgcn_mfma_f32_16x16x32_bf16(kf, vf, S[db], 0, 0, 0); }
            }
        }
        float* sl = (float*)(p.ws + OFF_SLOC) + (size_t)(bh * 4 + sc) * 16384;
#pragma unroll
        for (int db = 0; db < 8; ++db) *(f32x4*)(sl + ((w * 8 + db) * 64 + lane) * 4) = S[db];
        if (tq == 0) *(f32x2*)((float*)(p.ws + OFF_DLOG) + (bh * 4 + sc) * 128 + d2) = (f32x2){dla, dlb};
    }
    __syncthreads();
}

__device__ void attn_phase(const Params& p, int jl, unsigned char* shm) {
    bf16_t* sK = (bf16_t*)shm;
    bf16_t* sVT = sK + 2 * 9216;
    float* sB = (float*)(sVT + 2 * 8704);
    const int tid = opaque_tid(), lane = tid & 63, w = tid >> 6, fr = lane & 15, fq = lane >> 4;
    const int cq = w >> 1, half = w & 1;
    const float LOG2E = 1.4426950408889634f;
    const int skey = tid >> 3, spiece = tid & 7, vkey = tid & 63, vpiece = tid >> 6;
    const bf16_t* Kg = (const bf16_t*)(p.ws + OFF_KB); const bf16_t* Vg = (const bf16_t*)(p.ws + OFF_VB); const bf16_t* Qg = (const bf16_t*)(p.ws + OFF_QB);
    for (int task = blockIdx.x; task < 4096; task += gridDim.x) {
        const int g = task & 31, h = (task >> 5) & 15, b = task >> 9;
        const int c = 4 * g + cq;
        const int dt0 = (2 * g - 4 > 0) ? 2 * g - 4 : 0, dt1 = 2 * g + 1;
        __syncthreads();
        for (int i = tid; i < 384; i += 512) { int r = i - 64; r = r < 0 ? 0 : (r > 319 ? 319 : r); sB[i] = p.in[18][((size_t)jl * 320 + r) * 16 + h] * LOG2E; }
        bf16x8 qf[2][2];
        {
            const bf16_t* qp = Qg + ((size_t)b * SEQ + c * 64 + half * 32) * D + h * 64;
#pragma unroll
            for (int qb = 0; qb < 2; ++qb)
#pragma unroll
                for (int ks = 0; ks < 2; ++ks) qf[qb][ks] = *(const bf16x8*)(qp + (size_t)(qb * 16 + fr) * D + ks * 32 + fq * 8);
        }
        f32x4 oacc[4][2];
#pragma unroll
        for (int db = 0; db < 4; ++db)
#pragma unroll
            for (int qb = 0; qb < 2; ++qb) oacc[db][qb] = (f32x4){0.f, 0.f, 0.f, 0.f};
        float mrun[2] = {0.f, 0.f}, lrun[2] = {0.f, 0.f};
        bool first = true;
        u32x4 kreg[2], vreg[2];
        const size_t tokb = (size_t)b * SEQ;
        const size_t hoffk = (size_t)b * SEQ * 960 + (size_t)h * SEQ * 64;
#define ATT_GLOAD(dt_) do { _Pragma("unroll") for (int hf_ = 0; hf_ < 2; ++hf_) { \
            kreg[hf_] = *(const u32x4*)(Kg + (tokb + (size_t)(dt_) * 128 + hf_ * 64 + skey) * 64 + hoffk + spiece * 8); \
            vreg[hf_] = *(const u32x4*)(Vg + (tokb + (size_t)(dt_) * 128 + hf_ * 64 + vkey) * 64 + hoffk + vpiece * 8); } } while (0)
#define ATT_LSTORE(buf_) do { _Pragma("unroll") for (int hf_ = 0; hf_ < 2; ++hf_) { \
            *(u32x4*)(sK + (buf_) * 9216 + (hf_ * 64 + skey) * 72 + spiece * 8) = kreg[hf_]; \
            bf16_t* vt_ = sVT + (buf_) * 8704 + (vpiece * 8) * 136 + hf_ * 64 + vkey; \
            _Pragma("unroll") for (int e_ = 0; e_ < 8; ++e_) vt_[e_ * 136] = (bf16_t)((e_ & 1) ? (vreg[hf_][e_ >> 1] >> 16) : (vreg[hf_][e_ >> 1] & 0xffffu)); } } while (0)
        ATT_GLOAD(dt0); ATT_LSTORE(0);
        __syncthreads();
        for (int dt = dt0; dt <= dt1; ++dt) {
            const int buf = (dt - dt0) & 1;
            if (dt < dt1) ATT_GLOAD(dt + 1);
            const bool act0 = (2 * dt >= c - 8) && (2 * dt <= c), act1 = (2 * dt + 1 >= c - 8) && (2 * dt + 1 <= c);
            if (act0 || act1) {
                const bf16_t* kb_ = sK + buf * 9216; const bf16_t* vb_ = sVT + buf * 8704;
                f32x4 sacc[2][4][2];
                const float b0 = sB[0];
#pragma unroll
                for (int hf = 0; hf < 2; ++hf) {
                    if (hf == 0 ? act0 : act1) {
                        const float cb = (2 * dt + hf - c <= -5) ? b0 : 0.f;
#pragma unroll
                        for (int kb = 0; kb < 4; ++kb)
#pragma unroll
                            for (int qb = 0; qb < 2; ++qb) { const float iv = cb - mrun[qb]; sacc[hf][kb][qb] = (f32x4){iv, iv, iv, iv}; }
#pragma unroll
                        for (int kb = 0; kb < 4; ++kb)
#pragma unroll
                            for (int ks = 0; ks < 2; ++ks) {
                                const bf16x8 kf = *(const bf16x8*)(kb_ + (hf * 64 + kb * 16 + fr) * 72 + ks * 32 + fq * 8);
#pragma unroll
                                for (int qb = 0; qb < 2; ++qb) sacc[hf][kb][qb] = __builtin_amdgcn_mfma_f32_16x16x32_bf16(kf, qf[qb][ks], sacc[hf][kb][qb], 0, 0, 0);
                            }
                    }
                }
                float mx[2] = {-3e38f, -3e38f};
#pragma unroll
                for (int hf = 0; hf < 2; ++hf) {
                    if (hf == 0 ? act0 : act1) {
                        const int dk = 2 * dt + hf - c;
                        if (dk > -5) {
                            const float* bp = sB + (dk * 64 + fq * 4 - half * 32 - fr + 256 + 64 - 16);
#pragma unroll
                            for (int kb = 0; kb < 4; ++kb)
#pragma unroll
                                for (int qb = 0; qb < 2; ++qb)
#pragma unroll
                                    for (int j = 0; j < 4; ++j) sacc[hf][kb][qb][j] += bp[kb * 16 + j - qb * 16 + 16];
                        }
#pragma unroll
                        for (int qb = 0; qb < 2; ++qb)
#pragma unroll
                            for (int kb = 0; kb < 4; ++kb)
#pragma unroll
                                for (int j = 0; j < 4; ++j) mx[qb] = fmaxf(mx[qb], sacc[hf][kb][qb][j]);
                    }
                }
                if (first || __any((mx[0] > 6.0f) || (mx[1] > 6.0f))) {
#pragma unroll
                    for (int qb = 0; qb < 2; ++qb) {
                        float m2 = fmaxf(mx[qb], __shfl_xor(mx[qb], 16)); m2 = fmaxf(m2, __shfl_xor(m2, 32));
                        const float delta = first ? m2 : fmaxf(m2, 0.f), corr = first ? 1.0f : __builtin_amdgcn_exp2f(-delta);
                        mrun[qb] += delta; lrun[qb] *= corr;
#pragma unroll
                        for (int db = 0; db < 4; ++db) oacc[db][qb] = oacc[db][qb] * corr;
#pragma unroll
                        for (int hf = 0; hf < 2; ++hf)
#pragma unroll
                            for (int kb = 0; kb < 4; ++kb) sacc[hf][kb][qb] = sacc[hf][kb][qb] - delta;
                    }
                    first = false;
                }
#pragma unroll
                for (int hf = 0; hf < 2; ++hf) {
                    if (hf == 0 ? act0 : act1) {
                        bf16x8 pf[2][2];
#pragma unroll
                        for (int qb = 0; qb < 2; ++qb) {
                            float ps = 0.f;
#pragma unroll
                            for (int kb = 0; kb < 4; ++kb)
#pragma unroll
                                for (int j = 0; j < 4; ++j) { const float pv = __builtin_amdgcn_exp2f(sacc[hf][kb][qb][j]); sacc[hf][kb][qb][j] = pv; ps += pv; }
                            lrun[qb] += ps;
#pragma unroll
                            for (int kk = 0; kk < 2; ++kk) {
                                u32x4 pw;
                                pw.x = cvt_pk_bf16(sacc[hf][2 * kk][qb][0], sacc[hf][2 * kk][qb][1]); pw.y = cvt_pk_bf16(sacc[hf][2 * kk][qb][2], sacc[hf][2 * kk][qb][3]);
                                pw.z = cvt_pk_bf16(sacc[hf][2 * kk + 1][qb][0], sacc[hf][2 * kk + 1][qb][1]); pw.w = cvt_pk_bf16(sacc[hf][2 * kk + 1][qb][2], sacc[hf][2 * kk + 1][qb][3]);
                                pf[qb][kk] = __builtin_bit_cast(bf16x8, pw);
                            }
                        }
#pragma unroll
                        for (int db = 0; db < 4; ++db)
#pragma unroll
                            for (int kk = 0; kk < 2; ++kk) {
                                const u32x2 lo = *(const u32x2*)(vb_ + (db * 16 + fr) * 136 + hf * 64 + (2 * kk) * 16 + fq * 4);
                                const u32x2 hi = *(const u32x2*)(vb_ + (db * 16 + fr) * 136 + hf * 64 + (2 * kk + 1) * 16 + fq * 4);
                                u32x4 vw; vw.x = lo.x; vw.y = lo.y; vw.z = hi.x; vw.w = hi.y;
                                const bf16x8 vf = __builtin_bit_cast(bf16x8, vw);
#pragma unroll
                                for (int qb = 0; qb < 2; ++qb) oacc[db][qb] = __builtin_amdgcn_mfma_f32_16x16x32_bf16(vf, pf[qb][kk], oacc[db][qb], 0, 0, 0);
                            }
                    }
                }
            }
            if (dt < dt1) ATT_LSTORE(buf ^ 1);
            __syncthreads();
        }
#undef ATT_GLOAD
#undef ATT_LSTORE
#pragma unroll
        for (int qb = 0; qb < 2; ++qb) {
            float lt = lrun[qb]; lt += __shfl_xor(lt, 16); lt += __shfl_xor(lt, 32);
            const float inv = 1.0f / lt;
            bf16_t* op = (bf16_t*)(p.ws + OFF_U) + (tokb + c * 64 + half * 32 + qb * 16 + fr) * D + h * 64 + fq * 4;
#pragma unroll
            for (int db = 0; db < 4; ++db) {
                u32x2 ow; ow.x = cvt_pk_bf16(oacc[db][qb][0] * inv, oacc[db][qb][1] * inv); ow.y = cvt_pk_bf16(oacc[db][qb][2] * inv, oacc[db][qb][3] * inv);
                *(u32x2*)(op + db * 16) = ow;
            }
        }
    }
    __syncthreads();
}

#ifndef REP_ATTN
#define REP_ATTN 1
#endif
#ifndef REP_REC
#define REP_REC 1
#endif
#ifndef REP_NORM
#define REP_NORM 1
#endif
#ifndef REP_SYNC
#define REP_SYNC 1
#endif
#ifndef REP_PREP
#define REP_PREP 1
#endif
#ifndef REP_G3
#define REP_G3 1
#endif
#define GSYNC() do { for (int r_ = 0; r_ < REP_SYNC; ++r_) xcd_barrier(xb); } while (0)
__global__ void __launch_bounds__(512, 2) yoco_fwd(Params p) {
    extern __shared__ __attribute__((aligned(16))) unsigned char shm[];
    cg::grid_group grid = cg::this_grid();
    {
        const int t0 = threadIdx.x;
        if ((t0 & 63) == 0) *(volatile LAS int*)(LAS unsigned char*)(shm + WAVE_TAB_OFF + 4 * hw_wave_slot()) = t0 >> 6;
        __syncthreads();
    }
    const int tid0 = opaque_tid();
    unsigned* barw = (unsigned*)(p.ws + OFF_BAR);
    for (int i = blockIdx.x * 512 + tid0; i < XCD_BAR_WORDS; i += gridDim.x * 512) barw[i] = 0u;
    {
        u32x4* z = (u32x4*)(p.ws + OFF_ROWSS); const int nz = (int)((8 * (size_t)MTOK * 8) / 16);
        for (int i = blockIdx.x * 512 + tid0; i < nz; i += gridDim.x * 512) z[i] = (u32x4){0u, 0u, 0u, 0u};
    }
    volatile LAS unsigned* xst = (volatile LAS unsigned*)(LAS unsigned char*)(shm + LDS_BYTES - 16);
    if (tid0 == 0) { xst[0] = 0u; xst[1] = 0u; }
    for (int r = 0; r < REP_PREP; ++r) prep_phase(p, shm);
    grid.sync();
    XcdBarrier xb = xcd_barrier_post(barw, xst);
    {
        const float* mv = (const float*)(p.ws + OFF_MODV);
        for (int r = 0; r < REP_NORM; ++r) norm_phase(p.in[0], (bf16_t*)(p.ws + OFF_U), p.in[4], mv, mv + D, 6144, nullptr, nullptr, nullptr, nullptr, 0);
    }
    GSYNC();
    for (int l = 0; l < 4; ++l) {
        const float* hsrc = (l == 0) ? p.in[0] : p.h;
        const float* mv = (const float*)(p.ws + OFF_MODV) + (size_t)l * 8 * 6144;
        bf16_t* UF = (l < 2) ? (bf16_t*)(p.ws + OFF_UF_A) : (bf16_t*)(p.ws + OFF_QB);
        if (l < 2) {
            pg8::EpiHgrnIn e; e.QVG = (bf16_t*)(p.ws + OFF_QH); e.LF = (bf16_t*)(p.ws + OFF_LF); e.lb = (const float*)(p.ws + OFF_LBV) + l * D;
            run_gemm(shm, (const bf16_t*)(p.ws + OFF_U), (const bf16_t*)(p.ws + OFF_WB_A_IN) + (size_t)l * AIN * D, AIN, D, e);
            GSYNC();
            for (int r = 0; r < REP_REC; ++r) rec_passA(p, shm);
            GSYNC();
            for (int r = 0; r < REP_REC; ++r) rec_pass<true>(p, l, shm);
        } else {
            if (l == 2) { pg8::EpiBf16Split e; e.d0 = (bf16_t*)(p.ws + OFF_KB); e.scale = 1.0f; e.hm = 1;
                run_gemm(shm, (const bf16_t*)(p.ws + OFF_QB), (const bf16_t*)(p.ws + OFF_WB_KV), 2048, D, e);
                GSYNC(); }
            { pg8::EpiBf16Split e; e.d0 = (bf16_t*)(p.ws + OFF_QB); e.hm = 0; e.scale = 0.125f * 1.4426950408889634f;   run_gemm(shm, (const bf16_t*)(p.ws + OFF_U), (const bf16_t*)(p.ws + OFF_WB_Q) + (size_t)(l - 2) * D * D, D, D, e); }
            GSYNC();
            for (int r = 0; r < REP_ATTN; ++r) attn_phase(p, l - 2, shm);
        }
        GSYNC();
        {
            pg8::EpiResid e; e.in = p.in; e.ws = p.ws; e.hbuf = p.h; e.l = l; e.which = 0;
            run_gemm(shm, (const bf16_t*)(p.ws + OFF_U), (l < 2) ? (const bf16_t*)(p.ws + OFF_WB_A_OUT) + (size_t)l * D * D : (const bf16_t*)(p.ws + OFF_WB_O) + (size_t)(l - 2) * D * D, D, D, e);
        }
        GSYNC();
        for (int r = 0; r < REP_G3; ++r) { pg8::EpiSwiglu e; e.act = (bf16_t*)(p.ws + OFF_ACT); run_gemm(shm, UF, (const bf16_t*)(p.ws + OFF_WB_FFN_IN) + (size_t)l * 2 * FFN * D, 2 * FFN, D, e); }
        GSYNC();
        {
            pg8::EpiResid e; e.in = p.in; e.ws = p.ws; e.hbuf = p.h; e.l = l; e.which = 1;
            run_gemm(shm, (const bf16_t*)(p.ws + OFF_ACT), (const bf16_t*)(p.ws + OFF_WB_FFN_OUT) + (size_t)l * D * FFN, D, FFN, e);
        }
        if (l < 3) GSYNC();
    }
}

extern "C" void kernel_launch(void* const* d_in, const int* in_sizes, int n_in, void* d_out, int out_size, void* d_ws, size_t ws_size, hipStream_t stream) {
    static int grid_blocks = 0;
    if (!grid_blocks) {
        int dev = 0, cus = 0, per_cu = 0;
        hipGetDevice(&dev);
        hipDeviceGetAttribute(&cus, hipDeviceAttributeMultiprocessorCount, dev);
        hipFuncSetAttribute((const void*)yoco_fwd, hipFuncAttributeMaxDynamicSharedMemorySize, LDS_BYTES);
        hipOccupancyMaxActiveBlocksPerMultiprocessor(&per_cu, (const void*)yoco_fwd, 512, LDS_BYTES);
        if (per_cu < 1) per_cu = 1;
        grid_blocks = cus * per_cu;
        (void)hipGetLastError();
    }
    Params p{};
    for (int i = 0; i < 20; ++i) p.in[i] = (const float*)d_in[i];
    p.h = (float*)d_out; p.ws = (unsigned char*)d_ws;
    if (ws_size < WS_END || n_in != 20) { fprintf(stderr, "kernel_launch: workspace too small (%zu < %zu) or unexpected inputs\n", ws_size, (size_t)WS_END); return; }
    void* args[] = {&p};
    hipError_t e = hipLaunchCooperativeKernel((const void*)yoco_fwd, dim3(grid_blocks), dim3(512), args, LDS_BYTES, stream);
    if (e != hipSuccess) fprintf(stderr, "cooperative launch failed: %s (grid %d)\n", hipGetErrorString(e), grid_blocks);
}
```

```cpp
#include <hip/hip_runtime.h>
#include <hip/hip_cooperative_groups.h>
#include <cstdio>
namespace cg = cooperative_groups;

#define LAS __attribute__((address_space(3)))
typedef unsigned short bf16_t;
typedef short bf16x8 __attribute__((ext_vector_type(8)));
typedef float f32x4 __attribute__((ext_vector_type(4)));
typedef unsigned u32x4 __attribute__((ext_vector_type(4)));
typedef unsigned u32x2 __attribute__((ext_vector_type(2)));
typedef float f32x2 __attribute__((ext_vector_type(2)));

constexpr int D = 1024, BATCH = 8, SEQ = 8192, MTOK = BATCH * SEQ, FFN = 2816, AIN = 4096;
constexpr int LDS_BYTES = 144 * 1024;
constexpr int XCD_BAR_WORDS_C = 3456;

__device__ __forceinline__ unsigned cvt_pk_bf16(float lo, float hi) { unsigned r; asm volatile("v_cvt_pk_bf16_f32 %0, %1, %2" : "=v"(r) : "v"(lo), "v"(hi)); return r; }
__device__ __forceinline__ float bf2f(unsigned short h) { return __uint_as_float((unsigned)h << 16); }
__device__ __forceinline__ float bflo(unsigned w) { return __uint_as_float(w << 16); }
__device__ __forceinline__ float bfhi(unsigned w) { return __uint_as_float(w & 0xffff0000u); }
__device__ __forceinline__ float silu_f(float x) { return x * __builtin_amdgcn_rcpf(1.0f + __expf(-x)); }

constexpr int WAVE_TAB_OFF = LDS_BYTES - 16 - 256;
__device__ __forceinline__ unsigned hw_wave_slot() { return (unsigned)__builtin_amdgcn_s_getreg(((6 - 1) << 11) | 4); }
__device__ __forceinline__ int opaque_tid() {
    extern __shared__ __attribute__((aligned(16))) unsigned char shm_tid_[];
    const int wv = __builtin_amdgcn_readfirstlane(*(volatile LAS int*)(LAS unsigned char*)(shm_tid_ + WAVE_TAB_OFF + 4 * hw_wave_slot()));
    int lane_;
    asm volatile("v_mbcnt_lo_u32_b32 %0, -1, 0\n\tv_mbcnt_hi_u32_b32 %0, -1, %0" : "=&v"(lane_));
    int t = wv * 64 + lane_;
    asm volatile("" : "+v"(t)); return t;
}
struct Params { const float* in[20]; float* h; unsigned char* ws; };
constexpr size_t ACTB = (size_t)MTOK * D * 2;
constexpr size_t OFF_WB_A_IN = 0;
constexpr size_t OFF_WB_A_OUT = OFF_WB_A_IN + (size_t)2 * AIN * D * 2;
constexpr size_t OFF_WB_FFN_IN = OFF_WB_A_OUT + (size_t)2 * D * D * 2;
constexpr size_t OFF_WB_FFN_OUT = OFF_WB_FFN_IN + (size_t)4 * 2 * FFN * D * 2;
constexpr size_t OFF_WB_KV = OFF_WB_FFN_OUT + (size_t)4 * D * FFN * 2;
constexpr size_t OFF_WB_Q = OFF_WB_KV + (size_t)2 * D * D * 2;
constexpr size_t OFF_WB_O = OFF_WB_Q + (size_t)2 * D * D * 2;
constexpr size_t OFF_MODV = OFF_WB_O + (size_t)2 * D * D * 2;
constexpr size_t OFF_KVMOD = OFF_MODV + (size_t)4 * 8 * 6144 * 4;
constexpr size_t OFF_LBV = OFF_KVMOD + (size_t)8 * 2048 * 4;
constexpr size_t OFF_U = OFF_LBV + (size_t)2 * D * 4;
constexpr size_t OFF_R = OFF_U + ACTB;
constexpr size_t OFF_QH = OFF_R, OFF_VH = OFF_R + ACTB, OFF_GH = OFF_R + 2 * ACTB, OFF_LF = OFF_R + 3 * ACTB;
constexpr size_t OFF_ACT = OFF_R;
constexpr size_t OFF_UF_A = OFF_R + 4 * ACTB;
constexpr size_t OFF_KB = OFF_R + (size_t)MTOK * FFN * 2, OFF_VB = OFF_KB + ACTB, OFF_QB = OFF_VB + ACTB;
constexpr size_t OFF_SLOC = OFF_R + 5 * ACTB, OFF_DLOG = OFF_SLOC + (size_t)256 * 16384 * 4;
constexpr size_t OFF_BAR = OFF_QB + ACTB;
constexpr size_t OFF_ROWSS = OFF_BAR + (size_t)16384;
constexpr size_t WS_END = OFF_ROWSS + (size_t)8 * MTOK * 8;


#define XB_TMO      128
#define XB_XCNT(j)  (256  + 64 * (j))
#define XB_XSUB(j)  (1280 + 64 * (j))
#define XB_XGEN(j)  (2304 + 64 * (j))
#define XB_TOP      3328
#define XB_TOPGEN   3392
#define XCD_BAR_WORDS 3456
#define XB_SPIN_CAP (1u << 18)
__device__ __forceinline__ unsigned xb_ld(unsigned* p)              { return __hip_atomic_load(p, __ATOMIC_RELAXED, __HIP_MEMORY_SCOPE_AGENT); }
__device__ __forceinline__ unsigned xb_add(unsigned* p, unsigned v) { return __hip_atomic_fetch_add(p, v, __ATOMIC_RELAXED, __HIP_MEMORY_SCOPE_AGENT); }
__device__ __forceinline__ unsigned xb_xcc_id() { return (unsigned)__builtin_amdgcn_s_getreg((3 << 11) | 20) & 0xFu; }
#define XB_SPIN(cond, bar) do { unsigned _sp = 0; while (cond) { __builtin_amdgcn_s_sleep(1); \
    if ((++_sp & 255u) == 0u) { if (xb_ld(&(bar)[XB_TMO])) break; if (_sp > XB_SPIN_CAP) { atomicAdd(&(bar)[XB_TMO], 1u); break; } } } } while (0)
struct XcdBarrier { unsigned* bar; unsigned x; volatile LAS unsigned* st; };
__device__ __forceinline__ XcdBarrier xcd_barrier_post(unsigned* bar, volatile LAS unsigned* st) {
    XcdBarrier b; b.bar = bar; b.x = xb_xcc_id(); b.st = st;
    if (opaque_tid() == 0) (void)xb_add(&bar[XB_XCNT(b.x)], 1u);
    return b;
}
__device__ __forceinline__ void xcd_barrier_complete(unsigned* bar, unsigned x, unsigned& nloc, unsigned& nx) {
    const unsigned G = gridDim.x * gridDim.y * gridDim.z;
    unsigned sum, cnt, mine, sp = 0u;
    for (;;) {
        sum = 0u; cnt = 0u; mine = 0u;
#pragma unroll
        for (unsigned j = 0; j < 16; ++j) { const unsigned c = xb_ld(&bar[XB_XCNT(j)]); sum += c; cnt += (c > 0u) ? 1u : 0u; mine = (j == x) ? c : mine; }
        if (sum == G) break;
        __builtin_amdgcn_s_sleep(1);
        if ((++sp & 255u) == 0u) { if (xb_ld(&bar[XB_TMO])) break; if (sp > XB_SPIN_CAP) { atomicAdd(&bar[XB_TMO], 1u); break; } }
    }
    nloc = mine > 0u ? mine : 1u; nx = cnt > 0u ? cnt : 1u;
}
__device__ __forceinline__ void xcd_barrier(const XcdBarrier& b) {
    asm volatile("s_waitcnt vmcnt(0)" ::: "memory");
    __syncthreads();
    if (opaque_tid() == 0) {
        unsigned* bar = b.bar;
        __builtin_amdgcn_s_waitcnt(0);
        unsigned nloc = b.st[0], nx = b.st[1];
        if (nloc == 0u) { xcd_barrier_complete(bar, b.x, nloc, nx); b.st[0] = nloc; b.st[1] = nx; }
        const unsigned old = xb_add(&bar[XB_XSUB(b.x)], 1u);
        const unsigned gen = old / nloc;
        if (old + 1u == (gen + 1u) * nloc) {
            __builtin_amdgcn_fence(__ATOMIC_RELEASE, "agent");
            asm volatile("s_waitcnt vmcnt(0)" ::: "memory");
            const unsigned og = xb_add(&bar[XB_TOP], 1u);
            const unsigned tg = og / nx;
            if (og + 1u == (tg + 1u) * nx) xb_add(&bar[XB_TOPGEN], 1u);
            else XB_SPIN(xb_ld(&bar[XB_TOPGEN]) == tg, bar);
            __builtin_amdgcn_fence(__ATOMIC_ACQUIRE, "agent");
            xb_add(&bar[XB_XGEN(b.x)], 1u);
            asm volatile("s_waitcnt vmcnt(0)" ::: "memory");
        } else {
            XB_SPIN(xb_ld(&bar[XB_XGEN(b.x)]) == gen, bar);
            __builtin_amdgcn_fence(__ATOMIC_ACQUIRE, "agent");
            asm volatile("s_waitcnt vmcnt(0)" ::: "memory");
        }
    }
    __syncthreads();
}

namespace pg8 {
constexpr int BM = 256, BK = 64, HALF = 128, HTB = HALF * BK * 2, STAGE_BYTES = 8 * HTB, NXCD = 8, WGM = 8;
__device__ __forceinline__ int lds_byte(int r, int c) { const int st = (r >> 4) * 2 + (c >> 5), rr = r & 15, cc = c & 31, ob = rr * 64 + cc * 2; return st * 1024 + (ob ^ (((ob >> 9) & 1) << 5)); }
__device__ __forceinline__ void stage_rc(int b, int& R, int& C) { const int st = b / 1024, sb = b % 1024, swz = sb ^ (((sb >> 9) & 1) << 5); R = (st >> 1) * 16 + swz / 64; C = (st & 1) * 32 + (swz % 64) / 2; }
__device__ __forceinline__ int perm32(int rho) { const int n = rho >> 4, i = rho & 15; return 8 * (i >> 2) + 4 * n + (i & 3); }
struct Unit { int pm, pn; };
struct Gemm { const bf16_t* A; const bf16_t* Bt; int M, N, K; };
struct StaticOrder {
    int nM, nN, nwg, G, c;
    __device__ void init(int M, int N, int G_, int c_) { nM = M / BM; nN = N / BM; nwg = nM * nN; G = G_; c = c_; }
    __device__ bool next(int i, Unit& u) const {
        const long L = (long)i * G + c; if (L >= nwg) return false;
        int wgid = (int)L; { const int q = nwg / NXCD, r = nwg % NXCD, xcd = wgid % NXCD, off = wgid / NXCD; wgid = (xcd < r ? xcd * (q + 1) : r * (q + 1) + (xcd - r) * q) + off; }
        const int nig = WGM * nN, gid = wgid / nig, fm = gid * WGM, gsz = (nM - fm) < WGM ? (nM - fm) : WGM;
        u.pm = fm + ((wgid % nig) % gsz); u.pn = (wgid % nig) / gsz; return true;
    }
};

template <class Epi>
__device__ __forceinline__ void gemm_phase(LAS unsigned char* lds, const Gemm g, const StaticOrder& S, const Epi& E) {
    const int tid = opaque_tid(), wid = __builtin_amdgcn_readfirstlane(tid >> 6), lane = tid & 63, wr = wid >> 2, wc = wid & 3, fr = lane & 15, fq = lane >> 4;
    const int K = g.K, nt = K / BK;
    unsigned voffA[2], voffB[2];
#pragma unroll
    for (int i = 0; i < 2; ++i) { int R, C; stage_rc(tid * 16 + i * 8192, R, C); const int Rb = Epi::PERM ? ((R & ~31) + perm32(R & 31)) : R;
        voffA[i] = (unsigned)(R * K + C) * 2u; voffB[i] = (unsigned)(Rb * K + C) * 2u; }
    const size_t kstep = (size_t)(BK * 2);
    const size_t hstep = (size_t)HALF * K * 2;
    const size_t tstep = 2 * hstep;
    const unsigned ldsw = (unsigned)wid * 1024u;
    const int aoff = lds_byte(wr * 64 + fr, fq * 8), boff = lds_byte(wc * 32 + fr, fq * 8);
#define PG8_SA(b, h) (((b) * 2 + (h)) * HTB)
#define PG8_SB(b, h) ((4 + (b) * 2 + (h)) * HTB)
#define PG8_STAGE(bufoff, gbase, voff) do { _Pragma("unroll") for (int _i = 0; _i < 2; ++_i) \
        __builtin_amdgcn_global_load_lds((const unsigned*)((const char*)(gbase) + (voff)[_i]), (LAS unsigned*)(lds + (bufoff) + ldsw + _i * 8192), 16, 0, 0); } while (0)
#define PG8_LDA(dst, b, h) do { _Pragma("unroll") for (int m = 0; m < 4; ++m) _Pragma("unroll") for (int k = 0; k < 2; ++k) dst[m][k] = *(const LAS bf16x8*)(lds + PG8_SA(b, h) + aoff + m * 2048 + k * 1024); } while (0)
#define PG8_LDB(dst, b, h) do { _Pragma("unroll") for (int n = 0; n < 2; ++n) _Pragma("unroll") for (int k = 0; k < 2; ++k) dst[n][k] = *(const LAS bf16x8*)(lds + PG8_SB(b, h) + boff + n * 2048 + k * 1024); } while (0)
#define PG8_MMA(ai, bj, At, Bt) do { __builtin_amdgcn_s_setprio(1); _Pragma("unroll") for (int m = 0; m < 4; ++m) _Pragma("unroll") for (int n = 0; n < 2; ++n) _Pragma("unroll") for (int k = 0; k < 2; ++k) \
        acc[ai][bj][m][n] = __builtin_amdgcn_mfma_f32_16x16x32_bf16(Bt[n][k], At[m][k], acc[ai][bj][m][n], 0, 0, 0); __builtin_amdgcn_s_setprio(0); } while (0)
#define PG8_WAIT_V(n) asm volatile("s_waitcnt vmcnt(" #n ")" ::: "memory")
#define PG8_WAIT_L(n) asm volatile("s_waitcnt lgkmcnt(" #n ")" ::: "memory")
#define PG8_BAR __builtin_amdgcn_s_barrier()
#define PG8_SCHED __builtin_amdgcn_sched_barrier(0)
    Unit cur, nxt; int ui = 0;
    if (!S.next(0, cur)) return;
    f32x4 acc[2][2][4][2];
#pragma unroll
    for (int a = 0; a < 2; ++a)
#pragma unroll
        for (int b = 0; b < 2; ++b)
#pragma unroll
            for (int m = 0; m < 4; ++m)
#pragma unroll
                for (int n = 0; n < 2; ++n) acc[a][b][m][n] = (f32x4){0.f, 0.f, 0.f, 0.f};
    bf16x8 At[4][2], B0[2][2], B1[2][2];
    const char* cA = (const char*)g.A + (size_t)cur.pm * tstep; const char* cB = (const char*)g.Bt + (size_t)cur.pn * tstep;
    PG8_STAGE(PG8_SB(0, 0), cB, voffB); PG8_STAGE(PG8_SA(0, 0), cA, voffA); PG8_STAGE(PG8_SB(0, 1), cB + hstep, voffB); PG8_STAGE(PG8_SA(0, 1), cA + hstep, voffA);
    if (wr == 1) PG8_BAR;
    PG8_WAIT_V(4); PG8_BAR;
    PG8_STAGE(PG8_SB(1, 0), cB + kstep, voffB); PG8_STAGE(PG8_SA(1, 0), cA + kstep, voffA); PG8_STAGE(PG8_SB(1, 1), cB + hstep + kstep, voffB);
    PG8_WAIT_V(6); PG8_BAR;
    for (;;) {
        const bool has_next = S.next(ui + 1, nxt);
        const char* nA = has_next ? (const char*)g.A + (size_t)nxt.pm * tstep : cA; const char* nB = has_next ? (const char*)g.Bt + (size_t)nxt.pn * tstep : cB;
        for (int t = 0; t < nt; t += 2) {
            const bool last = (t == nt - 2);
            const char* a1 = cA + (size_t)(t + 1) * kstep;
            const char* a2 = last ? nA : cA + (size_t)(t + 2) * kstep; const char* b2 = last ? nB : cB + (size_t)(t + 2) * kstep;
            const char* a3 = a2 + kstep; const char* b3 = b2 + kstep;
            PG8_LDB(B0, 0, 0); PG8_SCHED; PG8_LDA(At, 0, 0); PG8_STAGE(PG8_SA(1, 1), a1 + hstep, voffA);
            PG8_WAIT_L(8); PG8_BAR; PG8_WAIT_L(0); PG8_MMA(0, 0, At, B0); PG8_BAR; PG8_SCHED;
            PG8_LDB(B1, 0, 1); PG8_STAGE(PG8_SB(0, 0), b2, voffB);
            PG8_BAR; PG8_WAIT_L(0); PG8_MMA(0, 1, At, B1); PG8_BAR;
            PG8_LDA(At, 0, 1); PG8_STAGE(PG8_SA(0, 0), a2, voffA);
            PG8_BAR; PG8_WAIT_L(0); PG8_MMA(1, 0, At, B0); PG8_BAR; PG8_SCHED;
            PG8_STAGE(PG8_SB(0, 1), b2 + hstep, voffB);
            PG8_WAIT_V(6); PG8_BAR; PG8_MMA(1, 1, At, B1); PG8_BAR;
            PG8_LDB(B0, 1, 0); PG8_SCHED; PG8_LDA(At, 1, 0); PG8_STAGE(PG8_SA(0, 1), a2 + hstep, voffA);
            PG8_WAIT_L(8); PG8_BAR; PG8_WAIT_L(0); PG8_MMA(0, 0, At, B0); PG8_BAR; PG8_SCHED;
            PG8_LDB(B1, 1, 1); PG8_STAGE(PG8_SB(1, 0), b3, voffB);
            PG8_BAR; PG8_WAIT_L(0); PG8_MMA(0, 1, At, B1); PG8_BAR;
            PG8_LDA(At, 1, 1); PG8_STAGE(PG8_SA(1, 0), a3, voffA);
            PG8_BAR; PG8_WAIT_L(0); PG8_MMA(1, 0, At, B0); PG8_BAR; PG8_SCHED;
            PG8_STAGE(PG8_SB(1, 1), b3 + hstep, voffB);
            PG8_WAIT_V(6); PG8_BAR; PG8_MMA(1, 1, At, B1); PG8_BAR;
        }
        E(acc, cur, wr, wc, fr, fq);
        if (!has_next) break;
#pragma unroll
        for (int a = 0; a < 2; ++a)
#pragma unroll
            for (int b = 0; b < 2; ++b)
#pragma unroll
                for (int m = 0; m < 4; ++m)
#pragma unroll
                    for (int n = 0; n < 2; ++n) acc[a][b][m][n] = (f32x4){0.f, 0.f, 0.f, 0.f};
        cur = nxt; cA = nA; cB = nB; ++ui;
    }
    PG8_WAIT_V(0);
    if (wr == 0) PG8_BAR;
    PG8_BAR;
#undef PG8_SA
#undef PG8_SB
#undef PG8_STAGE
#undef PG8_LDA
#undef PG8_LDB
#undef PG8_MMA
#undef PG8_WAIT_V
#undef PG8_WAIT_L
#undef PG8_BAR
#undef PG8_SCHED
}

struct EpiHgrnIn {
    static constexpr bool PERM = true;
    bf16_t* QVG; bf16_t* LF; const float* lb;
    __device__ __forceinline__ void operator()(const f32x4 (&acc)[2][2][4][2], const Unit& u, int wr, int wc, int fr, int fq) const {
        const int seg = u.pn >> 2, colt = (u.pn & 3) * 256;
        const int row0 = u.pm * BM + wr * 64 + fr, col0 = colt + wc * 32 + 8 * fq;
        const size_t hm0 = (size_t)(u.pm >> 5) * SEQ * 896 + (size_t)(2 * (u.pn & 3)) * SEQ * 128 + wc * 32 + 8 * fq;
        if (seg == 1) {
#pragma unroll
            for (int bj = 0; bj < 2; ++bj) {
                const f32x4 l0 = *(const f32x4*)(lb + col0 + bj * HALF), l1 = *(const f32x4*)(lb + col0 + bj * HALF + 4);
#pragma unroll
                for (int ai = 0; ai < 2; ++ai)
#pragma unroll
                    for (int m = 0; m < 4; ++m) {
                        bf16_t* rowp = LF + (size_t)(row0 + ai * HALF + m * 16) * 128 + hm0 + (size_t)bj * SEQ * 128;
                        f32x4 o0, o1;
#pragma unroll
                        for (int j = 0; j < 4; ++j) {
                            float z = acc[ai][bj][m][0][j]; float sg = __builtin_amdgcn_rcpf(1.0f + __expf(-z)); float f = l0[j] + (1.0f - l0[j]) * sg; o0[j] = __logf(fmaxf(f, 1e-30f));
                            z = acc[ai][bj][m][1][j]; sg = __builtin_amdgcn_rcpf(1.0f + __expf(-z)); f = l1[j] + (1.0f - l1[j]) * sg; o1[j] = __logf(fmaxf(f, 1e-30f));
                        }
                        u32x4 lw; lw.x = cvt_pk_bf16(o0[0], o0[1]); lw.y = cvt_pk_bf16(o0[2], o0[3]); lw.z = cvt_pk_bf16(o1[0], o1[1]); lw.w = cvt_pk_bf16(o1[2], o1[3]);
                        *(u32x4*)rowp = lw;
                    }
            }
        } else {
            bf16_t* base = QVG + (size_t)(seg == 0 ? 0 : (seg == 2 ? 1 : 2)) * ((size_t)MTOK * D);
            const bool act = (seg != 2);
#pragma unroll
            for (int ai = 0; ai < 2; ++ai)
#pragma unroll
                for (int m = 0; m < 4; ++m)
#pragma unroll
                    for (int bj = 0; bj < 2; ++bj) {
                        f32x4 v0 = acc[ai][bj][m][0], v1 = acc[ai][bj][m][1];
                        if (act) {
#pragma unroll
                            for (int j = 0; j < 4; ++j) { v0[j] = silu_f(v0[j]); v1[j] = silu_f(v1[j]); }
                        }
                        u32x4 w; w.x = cvt_pk_bf16(v0[0], v0[1]); w.y = cvt_pk_bf16(v0[2], v0[3]); w.z = cvt_pk_bf16(v1[0], v1[1]); w.w = cvt_pk_bf16(v1[2], v1[3]);
                        *(u32x4*)(base + (size_t)(row0 + ai * HALF + m * 16) * 128 + hm0 + (size_t)bj * SEQ * 128) = w;
                    }
        }
    }
};
struct EpiResid {
    static constexpr bool PERM = true;
    const float* const* in; unsigned char* ws; float* hbuf; int l, which;
    __device__ __forceinline__ void emit(const f32x4 (&v)[2][2][4][2], const float (&rs)[2][4], bf16_t* U, const float* gain, const float* sh, const float* sc, int bs, int b, int row0, int col0) const {
#pragma unroll
        for (int bj = 0; bj < 2; ++bj) {
            const int c = col0 + bj * HALF;
            f32x4 a0, a1, t0, t1;
            { const f32x4 g0 = *(const f32x4*)(gain + c), s0 = *(const f32x4*)(sc + (size_t)b * bs + c); a0 = g0 * (s0 + 1.0f); t0 = *(const f32x4*)(sh + (size_t)b * bs + c); }
            { const f32x4 g1 = *(const f32x4*)(gain + c + 4), s1 = *(const f32x4*)(sc + (size_t)b * bs + c + 4); a1 = g1 * (s1 + 1.0f); t1 = *(const f32x4*)(sh + (size_t)b * bs + c + 4); }
#pragma unroll
            for (int ai = 0; ai < 2; ++ai)
#pragma unroll
                for (int m = 0; m < 4; ++m) {
                    const f32x4 u0 = (v[ai][bj][m][0] * rs[ai][m]) * a0 + t0, u1 = (v[ai][bj][m][1] * rs[ai][m]) * a1 + t1;
                    u32x4 w; w.x = cvt_pk_bf16(u0[0], u0[1]); w.y = cvt_pk_bf16(u0[2], u0[3]); w.z = cvt_pk_bf16(u1[0], u1[1]); w.w = cvt_pk_bf16(u1[2], u1[3]);
                    *(u32x4*)(U + (size_t)(row0 + ai * HALF + m * 16) * D + c) = w;
                }
            __builtin_amdgcn_sched_barrier(0);
        }
    }
    __device__ __forceinline__ void operator()(f32x4 (&acc)[2][2][4][2], const Unit& u, int wr, int wc, int fr, int fq) const {
        __builtin_amdgcn_sched_barrier(0);
        const int b = u.pm >> 5;
        const float* mv = (const float*)(ws + OFF_MODV) + (size_t)l * 8 * 6144;
        const float* src = (l == 0 && which == 0) ? in[0] : hbuf; float* dst = hbuf;
        const int mode = (l == 3 && which == 1) ? 1 : 0;
        unsigned long long* rowacc = (unsigned long long*)(ws + OFF_ROWSS) + (size_t)(2 * l + which) * MTOK;
        const float* gp = mv + (which ? 5 : 2) * D + (size_t)b * 6144;
        const int row0 = u.pm * BM + wr * 64 + fr, col0 = u.pn * BM + wc * 32 + 8 * fq;
        {
            f32x4 gv[2][2];
#pragma unroll
            for (int bj = 0; bj < 2; ++bj)
#pragma unroll
                for (int n = 0; n < 2; ++n) gv[bj][n] = *(const f32x4*)(gp + col0 + bj * HALF + 4 * n);
#pragma unroll
            for (int ai = 0; ai < 2; ++ai)
#pragma unroll
                for (int m = 0; m < 4; ++m) {
                    const size_t ro = (size_t)(row0 + ai * HALF + m * 16) * D + col0;
                    float pt = 0.f;
#pragma unroll
                    for (int bj = 0; bj < 2; ++bj)
#pragma unroll
                        for (int n = 0; n < 2; ++n) {
                            const f32x4 v = *(const f32x4*)(src + ro + bj * HALF + 4 * n) + gv[bj][n] * acc[ai][bj][m][n];
                            acc[ai][bj][m][n] = v;
                            if (mode == 0) *(f32x4*)(dst + ro + bj * HALF + 4 * n) = v;
                            pt += (v[0] * v[0] + v[1] * v[1]) + (v[2] * v[2] + v[3] * v[3]);
                        }
                    pt += __shfl_xor(pt, 16); pt += __shfl_xor(pt, 32);
                    if (fq == 0) (void)__hip_atomic_fetch_add(rowacc + row0 + ai * HALF + m * 16, (1ull << 48) + (unsigned long long)(pt * 65536.0f + 0.5f), __ATOMIC_RELAXED, __HIP_MEMORY_SCOPE_AGENT);
                    __builtin_amdgcn_sched_barrier(0);
                }
        }
        float rs[2][4];
        {
            unsigned spins = 0;
            for (;;) {
                bool done = true;
#pragma unroll
                for (int ai = 0; ai < 2; ++ai)
#pragma unroll
                    for (int m = 0; m < 4; ++m) {
                        const unsigned long long q = __hip_atomic_load(rowacc + row0 + ai * HALF + m * 16, __ATOMIC_RELAXED, __HIP_MEMORY_SCOPE_AGENT);
                        done = done && ((q >> 48) >= 16ull);
                        rs[ai][m] = rsqrtf((float)(q & 0xffffffffffffull) * (1.0f / 65536.0f) * (1.0f / D) + 1e-6f);
                    }
                if (__all(done) || ++spins > (1u << 16)) break;
                __builtin_amdgcn_s_sleep(2);
            }
        }
        asm volatile("" ::: "memory");
        __builtin_amdgcn_sched_barrier(0);
        if (mode == 1) {
            const float* gain1 = in[19];
#pragma unroll
            for (int bj = 0; bj < 2; ++bj) {
                const f32x4 g0 = *(const f32x4*)(gain1 + col0 + bj * HALF), g1 = *(const f32x4*)(gain1 + col0 + bj * HALF + 4);
#pragma unroll
                for (int ai = 0; ai < 2; ++ai)
#pragma unroll
                    for (int m = 0; m < 4; ++m) {
                        float* op = dst + (size_t)(row0 + ai * HALF + m * 16) * D + col0 + bj * HALF;
                        *(f32x4*)op = (acc[ai][bj][m][0] * rs[ai][m]) * g0; *(f32x4*)(op + 4) = (acc[ai][bj][m][1] * rs[ai][m]) * g1;
                    }
            }
        } else {
            if (which == 0) emit(acc, rs, (l < 2) ? (bf16_t*)(ws + OFF_UF_A) : (bf16_t*)(ws + OFF_QB), in[5] + l * D, mv + 3 * D, mv + 4 * D, 6144, b, row0, col0);
            else {
                const float* mvn = mv + (size_t)8 * 6144;
                emit(acc, rs, (bf16_t*)(ws + OFF_U), in[4] + (l + 1) * D, mvn, mvn + D, 6144, b, row0, col0);
                if (l == 1) { const float* kvm = (const float*)(ws + OFF_KVMOD); emit(acc, rs, (bf16_t*)(ws + OFF_QB), in[12], kvm, kvm + D, 2048, b, row0, col0); }
            }
        }
    }
};
struct EpiSwiglu {
    static constexpr bool PERM = true;
    bf16_t* act;
    __device__ __forceinline__ void operator()(const f32x4 (&acc)[2][2][4][2], const Unit& u, int wr, int wc, int fr, int fq) const {
        const int row0 = u.pm * BM + wr * 64 + fr, col0 = u.pn * HALF + wc * 32 + 8 * fq;
#pragma unroll
        for (int ai = 0; ai < 2; ++ai)
#pragma unroll
            for (int m = 0; m < 4; ++m) {
                f32x4 r0, r1;
#pragma unroll
                for (int j = 0; j < 4; ++j) { r0[j] = silu_f(acc[ai][0][m][0][j]) * acc[ai][1][m][0][j]; r1[j] = silu_f(acc[ai][0][m][1][j]) * acc[ai][1][m][1][j]; }
                u32x4 w; w.x = cvt_pk_bf16(r0[0], r0[1]); w.y = cvt_pk_bf16(r0[2], r0[3]); w.z = cvt_pk_bf16(r1[0], r1[1]); w.w = cvt_pk_bf16(r1[2], r1[3]);
                *(u32x4*)(act + (size_t)(row0 + ai * HALF + m * 16) * FFN + col0) = w;
            }
    }
};
struct EpiBf16Split {
    static constexpr bool PERM = true;
    bf16_t* d0; float scale; int hm;
    __device__ __forceinline__ void operator()(const f32x4 (&acc)[2][2][4][2], const Unit& u, int wr, int wc, int fr, int fq) const {
        bf16_t* base = d0 + (size_t)(u.pn >> 2) * ((size_t)MTOK * D);
        const int row0 = u.pm * BM + wr * 64 + fr, col0 = (u.pn & 3) * 256 + wc * 32 + 8 * fq;
#pragma unroll
        for (int ai = 0; ai < 2; ++ai)
#pragma unroll
            for (int m = 0; m < 4; ++m)
#pragma unroll
                for (int bj = 0; bj < 2; ++bj) {
                    const f32x4 v0 = acc[ai][bj][m][0] * scale, v1 = acc[ai][bj][m][1] * scale;
                    u32x4 w; w.x = cvt_pk_bf16(v0[0], v0[1]); w.y = cvt_pk_bf16(v0[2], v0[3]); w.z = cvt_pk_bf16(v1[0], v1[1]); w.w = cvt_pk_bf16(v1[2], v1[3]);
                    const int row = row0 + ai * HALF + m * 16;
                    if (hm) *(u32x4*)(base + (size_t)row * 64 + (size_t)(u.pm >> 5) * SEQ * 960 + (size_t)((col0 + bj * HALF) >> 6) * SEQ * 64 + ((col0 + bj * HALF) & 63)) = w;
                    else *(u32x4*)(base + (size_t)row * D + col0 + bj * HALF) = w;
                }
    }
};
}

template <class Epi>
__device__ __forceinline__ void run_gemm(unsigned char* shm, const bf16_t* A, const bf16_t* Bt, int N, int K, const Epi& E) {
    pg8::Gemm g; g.A = A; g.Bt = Bt; g.M = MTOK; g.N = N; g.K = K;
    pg8::StaticOrder S; S.init(MTOK, N, (int)gridDim.x, (int)blockIdx.x);
    pg8::gemm_phase<Epi>((LAS unsigned char*)shm, g, S, E);
    __syncthreads();
}

__device__ __forceinline__ int ffnmap(int nn) { return nn < FFN ? ((nn >> 7) * 256 + (nn & 127)) : (((nn - FFN) >> 7) * 256 + 128 + ((nn - FFN) & 127)); }

__device__ __forceinline__ void conv_group(const float* src0, bf16_t* dst0, const int K, const int N, const int L, const int mode, unsigned char* shm, const int tid) {
    float* st = (float*)shm;
    const int per = (K / 128) * (N / 64), total = L * per, ntn = N / 64;
    f32x4 v[4];
    int tile = blockIdx.x;
    if (tile < total) {
        const int l = tile / per, tt = tile % per, k0 = (tt / ntn) * 128, n0 = (tt % ntn) * 64;
        const float* src = src0 + (size_t)l * K * N;
#pragma unroll
        for (int it = 0; it < 4; ++it) { const int idx = tid + it * 512, k = idx >> 4, n4 = idx & 15; v[it] = *(const f32x4*)(src + (size_t)(k0 + k) * N + n0 + 4 * n4); }
    }
    for (; tile < total; tile += gridDim.x) {
        const int l = tile / per, tt = tile % per, k0 = (tt / ntn) * 128, n0 = (tt % ntn) * 64;
        bf16_t* dst = dst0 + (size_t)l * K * N;
        __syncthreads();
#pragma unroll
        for (int it = 0; it < 4; ++it) { const int idx = tid + it * 512, k = idx >> 4, n4 = idx & 15;
#pragma unroll
            for (int e = 0; e < 4; ++e) st[k * 65 + 4 * n4 + e] = v[it][e]; }
        __syncthreads();
        const int nt_ = tile + (int)gridDim.x;
        if (nt_ < total) {
            const int l2 = nt_ / per, t2 = nt_ % per, k2 = (t2 / ntn) * 128, n2 = (t2 % ntn) * 64;
            const float* src = src0 + (size_t)l2 * K * N;
#pragma unroll
            for (int it = 0; it < 4; ++it) { const int idx = tid + it * 512, k = idx >> 4, n4 = idx & 15; v[it] = *(const f32x4*)(src + (size_t)(k2 + k) * N + n2 + 4 * n4); }
        }
#pragma unroll
        for (int it = 0; it < 2; ++it) { const int idx = tid + it * 512, n = idx >> 4, kg = idx & 15; const int nn = n0 + n; const int drow = mode ? ffnmap(nn) : nn;
            u32x4 w;
#pragma unroll
            for (int e = 0; e < 4; ++e) w[e] = cvt_pk_bf16(st[(8 * kg + 2 * e) * 65 + n], st[(8 * kg + 2 * e + 1) * 65 + n]);
            *(u32x4*)(dst + (size_t)drow * K + k0 + 8 * kg) = w; }
    }
}

__device__ void prep_phase(const Params& p, unsigned char* shm) {
    const int tid = opaque_tid();
    {
        float* cact = (float*)shm;
        float* red = cact + 8192;
        bool loaded = false;
        const int wv = tid >> 6, lane = tid & 63;
        for (int task = blockIdx.x; task < 416; task += gridDim.x) {
            if (!loaded) {
                for (int i = tid; i < 8192; i += 512) { const int k = i >> 3, b = i & 7; cact[i] = silu_f(p.in[1][b * D + k]); }
                loaded = true;
            }
            __syncthreads();
            const int c0 = task * 64;
            const float* src; const float* bias; float* dst; int stride, dstride;
            if (c0 < 24576) { const int l = c0 / 6144, j = c0 % 6144; src = p.in[2] + (size_t)l * D * 6144 + j; stride = 6144; bias = p.in[3] + l * 6144 + j; dst = ((float*)(p.ws + OFF_MODV)) + (size_t)l * 8 * 6144 + j; dstride = 6144; }
            else { const int j = c0 - 24576; src = p.in[13] + j; stride = 2048; bias = p.in[14] + j; dst = ((float*)(p.ws + OFF_KVMOD)) + j; dstride = 2048; }
            float a[8];
#pragma unroll
            for (int b = 0; b < 8; ++b) a[b] = 0.f;
            const float* sp = src + (size_t)(wv * 128) * stride + lane;
#pragma unroll 8
            for (int k = 0; k < 128; ++k) {
                const float w = sp[(size_t)k * stride];
                const f32x4 c0v = *(const f32x4*)(cact + (wv * 128 + k) * 8), c1v = *(const f32x4*)(cact + (wv * 128 + k) * 8 + 4);
                a[0] += w * c0v[0]; a[1] += w * c0v[1]; a[2] += w * c0v[2]; a[3] += w * c0v[3];
                a[4] += w * c1v[0]; a[5] += w * c1v[1]; a[6] += w * c1v[2]; a[7] += w * c1v[3];
            }
#pragma unroll
            for (int b = 0; b < 8; ++b) red[(wv * 8 + b) * 64 + lane] = a[b];
            __syncthreads();
            {
                const int b = tid >> 6, col = tid & 63;
                float s = bias[col];
#pragma unroll
                for (int w = 0; w < 8; ++w) s += red[(w * 8 + b) * 64 + col];
                dst[(size_t)b * dstride + col] = s;
            }
        }
        __syncthreads();
    }
    for (int i = blockIdx.x * 512 + tid; i < 1024; i += gridDim.x * 512) {
        const float a0 = p.in[10][i], a1 = p.in[10][1024 + i];
        const float mx = fmaxf(a0, a1), e0 = __expf(a0 - mx), e1 = __expf(a1 - mx);
        ((float*)(p.ws + OFF_LBV))[i] = 0.f; ((float*)(p.ws + OFF_LBV))[1024 + i] = e1 / (e0 + e1);
    }
    conv_group(p.in[8], (bf16_t*)(p.ws + OFF_WB_A_IN), D, AIN, 2, 0, shm, tid);
    conv_group(p.in[9], (bf16_t*)(p.ws + OFF_WB_A_OUT), D, D, 2, 0, shm, tid);
    conv_group(p.in[6], (bf16_t*)(p.ws + OFF_WB_FFN_IN), D, 2 * FFN, 4, 1, shm, tid);
    conv_group(p.in[7], (bf16_t*)(p.ws + OFF_WB_FFN_OUT), FFN, D, 4, 0, shm, tid);
    conv_group(p.in[15], (bf16_t*)(p.ws + OFF_WB_KV), D, 2 * D, 1, 0, shm, tid);
    conv_group(p.in[16], (bf16_t*)(p.ws + OFF_WB_Q), D, D, 2, 0, shm, tid);
    conv_group(p.in[17], (bf16_t*)(p.ws + OFF_WB_O), D, D, 2, 0, shm, tid);
    __syncthreads();
}

__device__ void norm_phase(const float* src, bf16_t* U1, const float* gain1, const float* sh1, const float* sc1, int bs1,
                           bf16_t* U2, const float* gain2, const float* sh2, const float* sc2, int bs2) {
    const int tid_ = opaque_tid(); const int lane = tid_ & 63, gw = blockIdx.x * 8 + (tid_ >> 6), nw = gridDim.x * 8;
    for (int row = 2 * gw; row < MTOK; row += 2 * nw) {
        const int b = row >> 13;
        const float* xp = src + (size_t)row * D;
        f32x4 xv[2][4]; float ss[2] = {0.f, 0.f};
#pragma unroll
        for (int r = 0; r < 2; ++r)
#pragma unroll
            for (int i = 0; i < 4; ++i) xv[r][i] = *(const f32x4*)(xp + (size_t)r * D + i * 256 + lane * 4);
#pragma unroll
        for (int r = 0; r < 2; ++r)
#pragma unroll
            for (int i = 0; i < 4; ++i) ss[r] += xv[r][i][0] * xv[r][i][0] + xv[r][i][1] * xv[r][i][1] + xv[r][i][2] * xv[r][i][2] + xv[r][i][3] * xv[r][i][3];
#pragma unroll
        for (int o = 1; o < 64; o <<= 1) { ss[0] += __shfl_xor(ss[0], o); ss[1] += __shfl_xor(ss[1], o); }
        const float rstd0 = rsqrtf(ss[0] * (1.0f / D) + 1e-6f), rstd1 = rsqrtf(ss[1] * (1.0f / D) + 1e-6f);
#pragma unroll
        for (int i = 0; i < 4; ++i) {
            const int k = i * 256 + lane * 4;
            const f32x4 g = *(const f32x4*)(gain1 + k), s = *(const f32x4*)(sc1 + (size_t)b * bs1 + k), t = *(const f32x4*)(sh1 + (size_t)b * bs1 + k);
            f32x4 u0, u1;
#pragma unroll
            for (int j = 0; j < 4; ++j) { const float ga = g[j] * (1.0f + s[j]); u0[j] = (xv[0][i][j] * rstd0) * ga + t[j]; u1[j] = (xv[1][i][j] * rstd1) * ga + t[j]; }
            u32x2 w0, w1; w0.x = cvt_pk_bf16(u0[0], u0[1]); w0.y = cvt_pk_bf16(u0[2], u0[3]); w1.x = cvt_pk_bf16(u1[0], u1[1]); w1.y = cvt_pk_bf16(u1[2], u1[3]);
            *(u32x2*)(U1 + (size_t)row * D + k) = w0; *(u32x2*)(U1 + (size_t)(row + 1) * D + k) = w1;
        }
        if (U2) {
#pragma unroll
            for (int i = 0; i < 4; ++i) {
                const int k = i * 256 + lane * 4;
                const f32x4 g = *(const f32x4*)(gain2 + k), s = *(const f32x4*)(sc2 + (size_t)b * bs2 + k), t = *(const f32x4*)(sh2 + (size_t)b * bs2 + k);
                f32x4 u0, u1;
#pragma unroll
                for (int j = 0; j < 4; ++j) { const float ga = g[j] * (1.0f + s[j]); u0[j] = (xv[0][i][j] * rstd0) * ga + t[j]; u1[j] = (xv[1][i][j] * rstd1) * ga + t[j]; }
                u32x2 w0, w1; w0.x = cvt_pk_bf16(u0[0], u0[1]); w0.y = cvt_pk_bf16(u0[2], u0[3]); w1.x = cvt_pk_bf16(u1[0], u1[1]); w1.y = cvt_pk_bf16(u1[2], u1[3]);
                *(u32x2*)(U2 + (size_t)row * D + k) = w0; *(u32x2*)(U2 + (size_t)(row + 1) * D + k) = w1;
            }
        }
    }
}
__device__ void final_norm_phase(float* h, const float* gain) {
    const int tid_ = opaque_tid(); const int lane = tid_ & 63, gw = blockIdx.x * 8 + (tid_ >> 6), nw = gridDim.x * 8;
    for (int row = gw; row < MTOK; row += nw) {
        float* xp = h + (size_t)row * D;
        f32x4 xv[4]; float ss = 0.f;
#pragma unroll
        for (int i = 0; i < 4; ++i) { xv[i] = *(const f32x4*)(xp + i * 256 + lane * 4); ss += xv[i][0] * xv[i][0] + xv[i][1] * xv[i][1] + xv[i][2] * xv[i][2] + xv[i][3] * xv[i][3]; }
#pragma unroll
        for (int o = 1; o < 64; o <<= 1) ss += __shfl_xor(ss, o);
        const float rstd = rsqrtf(ss * (1.0f / D) + 1e-6f);
#pragma unroll
        for (int i = 0; i < 4; ++i) {
            const int k = i * 256 + lane * 4;
            const f32x4 g = *(const f32x4*)(gain + k);
            f32x4 u;
#pragma unroll
            for (int j = 0; j < 4; ++j) u[j] = xv[i][j] * rstd * g[j];
            *(f32x4*)(xp + k) = u;
        }
    }
}

template <bool OUT>
__device__ void rec_pass(const Params& p, int layer, unsigned char* shm) {
    float* sB = (float*)shm;
    float* sKm = (float*)(shm + 33792);
    bf16_t* sST = (bf16_t*)shm;
    bf16_t* sQb = (bf16_t*)(shm + 67584);
    bf16_t* sA = (bf16_t*)(shm + 84992);
    bf16_t* sKT = (bf16_t*)(shm + 94208);
    bf16_t* sVT = (bf16_t*)(shm + 112640);
    float* sE = (float*)(shm + 131072);
    float* sPart = (float*)(shm + 131584);
    float* sNrm = (float*)(shm + 135680);
    const int tid = opaque_tid(), lane = tid & 63, w = tid >> 6, fr = lane & 15, fq = lane >> 4;
    const int wi = w >> 1, wh = w & 1;
    const int ntask = OUT ? 256 : 192;
    const float* ogain = p.in[11] + layer * 128;
    for (int task = blockIdx.x; task < ntask; task += gridDim.x) {
        int sc, bh; if (OUT) { sc = task & 3; bh = task >> 2; } else { sc = task % 3; bh = task / 3; }
        const int b = bh >> 3, h = bh & 7;
        const size_t hoff = (size_t)b * SEQ * 896 + (size_t)h * SEQ * 128;
        f32x4 S[8];
#pragma unroll
        for (int db = 0; db < 8; ++db) S[db] = (f32x4){0.f, 0.f, 0.f, 0.f};
        if (OUT) {
            for (int s2 = 0; s2 < sc; ++s2) {
                const float* sl = ((float*)(p.ws + OFF_SLOC)) + (size_t)(bh * 4 + s2) * 16384; const float* dl = ((float*)(p.ws + OFF_DLOG)) + (bh * 4 + s2) * 128;
#pragma unroll
                for (int db = 0; db < 8; ++db) {
                    const f32x4 x = *(const f32x4*)(sl + ((w * 8 + db) * 64 + lane) * 4), dv = *(const f32x4*)(dl + 16 * db + fq * 4);
#pragma unroll
                    for (int j = 0; j < 4; ++j) S[db][j] = S[db][j] * __expf(dv[j]) + x[j];
                }
            }
        }
        float dlacc = 0.f;
        unsigned lfn[8]; u32x4 vn0, vn1;
        const bf16_t* LFb = (const bf16_t*)(p.ws + OFF_LF);
        const int d2 = (tid & 63) * 2, tq = tid >> 6;
        {
            const size_t r0 = (size_t)b * SEQ + (size_t)(sc * 32) * 64;
            const bf16_t* lp = LFb + (r0 + 8 * tq) * 128 + hoff + d2;
#pragma unroll
            for (int e = 0; e < 8; ++e) lfn[e] = *(const unsigned*)(lp + (size_t)e * 128);
            vn0 = *(const u32x4*)(((bf16_t*)(p.ws + OFF_VH)) + (r0 + (tid & 63)) * 128 + hoff + (tid >> 6) * 8);
            vn1 = *(const u32x4*)(((bf16_t*)(p.ws + OFF_VH)) + (r0 + (tid & 63)) * 128 + hoff + 64 + (tid >> 6) * 8);
        }
        for (int ch = sc * 32; ch < sc * 32 + 32; ++ch) {
            const size_t row0 = (size_t)b * SEQ + (size_t)ch * 64;
            float la[8], lb2[8];
#pragma unroll
            for (int e = 0; e < 8; ++e) { la[e] = bflo(lfn[e]); lb2[e] = bfhi(lfn[e]); }
            const u32x4 vr0 = vn0, vr1 = vn1;
            u32x4 qraw[4]; u32x2 graw[4];
            if (OUT) {
#pragma unroll
                for (int ks = 0; ks < 4; ++ks) qraw[ks] = *(const u32x4*)(((bf16_t*)(p.ws + OFF_QH)) + (row0 + 16 * wi + fr) * 128 + hoff + ks * 32 + fq * 8);
#pragma unroll
                for (int vb = 0; vb < 4; ++vb) graw[vb] = *(const u32x2*)(((bf16_t*)(p.ws + OFF_GH)) + (row0 + 16 * wi + fr) * 128 + hoff + 64 * wh + 16 * vb + fq * 4);
            }
            {
                float ra = 0.f, rb = 0.f, ka[8], kb2[8];
#pragma unroll
                for (int e = 0; e < 8; ++e) {
                    ka[e] = 1.0f - __expf(la[e]); kb2[e] = 1.0f - __expf(lb2[e]);
                    *(f32x2*)(sKm + (8 * tq + e) * 132 + d2) = (f32x2){ka[e], kb2[e]};
                    ra += la[e]; la[e] = ra; rb += lb2[e]; lb2[e] = rb;
                }
                *(f32x2*)(sPart + tq * 128 + d2) = (f32x2){ra, rb};
                {
                    const int s_ = tid & 63, pc = tid >> 6;
#pragma unroll
                    for (int e = 0; e < 8; ++e) {
                        sVT[(pc * 8 + e) * 72 + s_] = (bf16_t)((e & 1) ? (vr0[e >> 1] >> 16) : (vr0[e >> 1] & 0xffffu));
                        sVT[(64 + pc * 8 + e) * 72 + s_] = (bf16_t)((e & 1) ? (vr1[e >> 1] >> 16) : (vr1[e >> 1] & 0xffffu));
                    }
                }
                __syncthreads();
                float offa = 0.f, offb = 0.f, tota = 0.f, totb = 0.f;
#pragma unroll
                for (int q = 0; q < 8; ++q) { const f32x2 pq = *(const f32x2*)(sPart + q * 128 + d2); tota += pq[0]; totb += pq[1]; if (q < tq) { offa += pq[0]; offb += pq[1]; } }
                if (tq == 0) { *(f32x2*)(sE + d2) = (f32x2){__expf(tota), __expf(totb)}; }
                u32x4 kwa, kwb;
#pragma unroll
                for (int e = 0; e < 8; e += 2) {
                    const float a0 = la[e] + offa, a1 = la[e + 1] + offa, b0 = lb2[e] + offb, b1 = lb2[e + 1] + offb;
                    *(f32x2*)(sB + (8 * tq + e) * 132 + d2) = (f32x2){a0, b0}; *(f32x2*)(sB + (8 * tq + e + 1) * 132 + d2) = (f32x2){a1, b1};
                    kwa[e >> 1] = cvt_pk_bf16(ka[e] * __expf(tota - a0), ka[e + 1] * __expf(tota - a1));
                    kwb[e >> 1] = cvt_pk_bf16(kb2[e] * __expf(totb - b0), kb2[e + 1] * __expf(totb - b1));
                }
                *(u32x4*)(sKT + d2 * 72 + 8 * tq) = kwa; *(u32x4*)(sKT + (d2 + 1) * 72 + 8 * tq) = kwb;
            }
            __syncthreads();
            if (ch + 1 < sc * 32 + 32) {
                const size_t r1 = row0 + 64;
                const bf16_t* lp = LFb + (r1 + 8 * tq) * 128 + hoff + d2;
#pragma unroll
                for (int e = 0; e < 8; ++e) lfn[e] = *(const unsigned*)(lp + (size_t)e * 128);
                vn0 = *(const u32x4*)(((bf16_t*)(p.ws + OFF_VH)) + (r1 + (tid & 63)) * 128 + hoff + (tid >> 6) * 8);
                vn1 = *(const u32x4*)(((bf16_t*)(p.ws + OFF_VH)) + (r1 + (tid & 63)) * 128 + hoff + 64 + (tid >> 6) * 8);
            }
            if (OUT) {
                const int i = wi, hh = wh, t_ = 16 * i + fr;
                bf16x8 qt[4];
#pragma unroll
                for (int ks = 0; ks < 4; ++ks) {
                    const int d0 = ks * 32 + fq * 8;
                    const f32x4 b0 = *(const f32x4*)(sB + t_ * 132 + d0), b1 = *(const f32x4*)(sB + t_ * 132 + d0 + 4);
                    f32x4 r0 = (f32x4){0.f, 0.f, 0.f, 0.f}, r1 = r0;
                    if (i > 0) { r0 = *(const f32x4*)(sB + (16 * i - 1) * 132 + d0); r1 = *(const f32x4*)(sB + (16 * i - 1) * 132 + d0 + 4); }
                    float qv[8], ql[8];
#pragma unroll
                    for (int e = 0; e < 4; ++e) { qv[2 * e] = bflo(qraw[ks][e]); qv[2 * e + 1] = bfhi(qraw[ks][e]); }
#pragma unroll
                    for (int e = 0; e < 4; ++e) { ql[e] = qv[e] * __expf(b0[e] - r0[e]); ql[4 + e] = qv[4 + e] * __expf(b1[e] - r1[e]); }
                    u32x4 pw; pw.x = cvt_pk_bf16(ql[0], ql[1]); pw.y = cvt_pk_bf16(ql[2], ql[3]); pw.z = cvt_pk_bf16(ql[4], ql[5]); pw.w = cvt_pk_bf16(ql[6], ql[7]);
                    qt[ks] = __builtin_bit_cast(bf16x8, pw);
                    if ((ks >> 1) == hh) {
#pragma unroll
                        for (int e = 0; e < 4; ++e) { ql[e] = qv[e] * __expf(b0[e]); ql[4 + e] = qv[4 + e] * __expf(b1[e]); }
                        u32x4 qw; qw.x = cvt_pk_bf16(ql[0], ql[1]); qw.y = cvt_pk_bf16(ql[2], ql[3]); qw.z = cvt_pk_bf16(ql[4], ql[5]); qw.w = cvt_pk_bf16(ql[6], ql[7]);
                        *(u32x4*)(sQb + t_ * 136 + d0) = qw;
                    }
                }
#pragma unroll
                for (int j2 = 0; j2 < 2; ++j2) {
                    const int j = hh + 2 * j2;
                    if (j <= i) {
                        f32x4 acc = (f32x4){0.f, 0.f, 0.f, 0.f};
                        const int s_ = 16 * j + fr;
#pragma unroll
                        for (int ks = 0; ks < 4; ++ks) {
                            const int d0 = ks * 32 + fq * 8;
                            const f32x4 k0 = *(const f32x4*)(sKm + s_ * 132 + d0), k1 = *(const f32x4*)(sKm + s_ * 132 + d0 + 4);
                            const f32x4 b0 = *(const f32x4*)(sB + s_ * 132 + d0), b1 = *(const f32x4*)(sB + s_ * 132 + d0 + 4);
                            f32x4 r0 = (f32x4){0.f, 0.f, 0.f, 0.f}, r1 = r0;
                            if (i > 0) { r0 = *(const f32x4*)(sB + (16 * i - 1) * 132 + d0); r1 = *(const f32x4*)(sB + (16 * i - 1) * 132 + d0 + 4); }
                            float kl[8];
#pragma unroll
                            for (int e = 0; e < 4; ++e) { kl[e] = k0[e] * __expf(fminf(r0[e] - b0[e], 80.f)); kl[4 + e] = k1[e] * __expf(fminf(r1[e] - b1[e], 80.f)); }
                            u32x4 kw; kw.x = cvt_pk_bf16(kl[0], kl[1]); kw.y = cvt_pk_bf16(kl[2], kl[3]); kw.z = cvt_pk_bf16(kl[4], kl[5]); kw.w = cvt_pk_bf16(kl[6], kl[7]);
                            acc = __builtin_amdgcn_mfma_f32_16x16x32_bf16(qt[ks], __builtin_bit_cast(bf16x8, kw), acc, 0, 0, 0);
                        }
#pragma unroll
                        for (int jj = 0; jj < 4; ++jj) {
                            float vv = acc[jj];
                            if (i == j && fr > fq * 4 + jj) vv = 0.f;
                            sA[(16 * i + fq * 4 + jj) * 72 + 16 * j + fr] = (bf16_t)(cvt_pk_bf16(vv, 0.f) & 0xffffu);
                        }
                    } else {
#pragma unroll
                        for (int jj = 0; jj < 4; ++jj) sA[(16 * i + fq * 4 + jj) * 72 + 16 * j + fr] = (bf16_t)0;
                    }
                }
            }
            __syncthreads();
            if (OUT) {
#pragma unroll
                for (int db = 0; db < 8; ++db) { u32x2 sw; sw.x = cvt_pk_bf16(S[db][0], S[db][1]); sw.y = cvt_pk_bf16(S[db][2], S[db][3]); *(u32x2*)(sST + (16 * w + fr) * 136 + 16 * db + fq * 4) = sw; }
                __syncthreads();
            }
            f32x4 o[4];
            if (OUT) {
                const int i = wi;
#pragma unroll
                for (int vb = 0; vb < 4; ++vb) o[vb] = (f32x4){0.f, 0.f, 0.f, 0.f};
#pragma unroll
                for (int kk = 0; kk < 2; ++kk) {
                    if (kk <= (i >> 1)) {
                        const bf16x8 af = *(const bf16x8*)(sA + (16 * i + fr) * 72 + kk * 32 + fq * 8);
#pragma unroll
                        for (int vb = 0; vb < 4; ++vb) { const bf16x8 vf = *(const bf16x8*)(sVT + (64 * wh + 16 * vb + fr) * 72 + kk * 32 + fq * 8); o[vb] = __builtin_amdgcn_mfma_f32_16x16x32_bf16(vf, af, o[vb], 0, 0, 0); }
                    }
                }
#pragma unroll
                for (int ks = 0; ks < 4; ++ks) {
                    const bf16x8 qf = *(const bf16x8*)(sQb + (16 * i + fr) * 136 + ks * 32 + fq * 8);
#pragma unroll
                    for (int vb = 0; vb < 4; ++vb) { const bf16x8 sf = *(const bf16x8*)(sST + (64 * wh + 16 * vb + fr) * 136 + ks * 32 + fq * 8); o[vb] = __builtin_amdgcn_mfma_f32_16x16x32_bf16(sf, qf, o[vb], 0, 0, 0); }
                }
                float ss = 0.f;
#pragma unroll
                for (int vb = 0; vb < 4; ++vb)
#pragma unroll
                    for (int jj = 0; jj < 4; ++jj) ss += o[vb][jj] * o[vb][jj];
                ss += __shfl_xor(ss, 16); ss += __shfl_xor(ss, 32);
                if (fq == 0) sNrm[wh * 64 + 16 * i + fr] = ss;
            }
#pragma unroll
            for (int db = 0; db < 8; ++db) { const f32x4 e4 = *(const f32x4*)(sE + 16 * db + fq * 4); S[db] = S[db] * e4; }
#pragma unroll
            for (int ks = 0; ks < 2; ++ks) {
                const bf16x8 vf = *(const bf16x8*)(sVT + (16 * w + fr) * 72 + ks * 32 + fq * 8);
#pragma unroll
                for (int db = 0; db < 8; ++db) { const bf16x8 kf = *(const bf16x8*)(sKT + (16 * db + fr) * 72 + ks * 32 + fq * 8); S[db] = __builtin_amdgcn_mfma_f32_16x16x32_bf16(kf, vf, S[db], 0, 0, 0); }
            }
            __syncthreads();
            if (OUT) {
                const int i = wi;
                const float tot = sNrm[16 * i + fr] + sNrm[64 + 16 * i + fr];
                const float rstd = rsqrtf(tot * (1.0f / 128.0f) + 1e-6f);
                bf16_t* op = ((bf16_t*)(p.ws + OFF_U)) + (row0 + 16 * i + fr) * D + h * 128 + 64 * wh + fq * 4;
#pragma unroll
                for (int vb = 0; vb < 4; ++vb) {
                    const f32x4 gn = *(const f32x4*)(ogain + 64 * wh + 16 * vb + fq * 4);
                    const float g0 = bflo(graw[vb].x), g1 = bfhi(graw[vb].x), g2 = bflo(graw[vb].y), g3 = bfhi(graw[vb].y);
                    u32x2 ow; ow.x = cvt_pk_bf16(o[vb][0] * rstd * gn[0] * g0, o[vb][1] * rstd * gn[1] * g1); ow.y = cvt_pk_bf16(o[vb][2] * rstd * gn[2] * g2, o[vb][3] * rstd * gn[3] * g3);
                    *(u32x2*)(op + 16 * vb) = ow;
                }
            }
        }
        if (!OUT) {
            float* sl = ((float*)(p.ws + OFF_SLOC)) + (size_t)(bh * 4 + sc) * 16384;
#pragma unroll
            for (int db = 0; db < 8; ++db) *(f32x4*)(sl + ((w * 8 + db) * 64 + lane) * 4) = S[db];
            if (tid < 128) ((float*)(p.ws + OFF_DLOG))[(bh * 4 + sc) * 128 + tid] = dlacc;
        }
    }
    __syncthreads();
}

__device__ void rec_passA(const Params& p, unsigned char* shm) {
    bf16_t* sKT = (bf16_t*)shm;
    bf16_t* sVT = (bf16_t*)(shm + 34816);
    float* sE = (float*)(shm + 69632);
    float* sPart = (float*)(shm + 70144);
    const int tid = opaque_tid(), lane = tid & 63, w = tid >> 6, fr = lane & 15, fq = lane >> 4;
    const int d2 = (tid & 63) * 2, tq = tid >> 6;
    const int vs = tid & 127, vq = tid >> 7;
    const bf16_t* LFb = (const bf16_t*)(p.ws + OFF_LF); const bf16_t* Vp = (const bf16_t*)(p.ws + OFF_VH);
    for (int task = blockIdx.x; task < 192; task += gridDim.x) {
        const int sc = task % 3, bh = task / 3, b = bh >> 3, h = bh & 7;
        const size_t hoff = (size_t)b * SEQ * 896 + (size_t)h * SEQ * 128;
        f32x4 S[8];
#pragma unroll
        for (int db = 0; db < 8; ++db) S[db] = (f32x4){0.f, 0.f, 0.f, 0.f};
        float dla = 0.f, dlb = 0.f;
        const size_t rbase = (size_t)b * SEQ + (size_t)sc * 2048;
        unsigned lfn[16]; u32x4 vn[4];
        {
            const bf16_t* lp = LFb + (rbase + 16 * tq) * 128 + hoff + d2;
#pragma unroll
            for (int e = 0; e < 16; ++e) lfn[e] = *(const unsigned*)(lp + (size_t)e * 128);
#pragma unroll
            for (int i = 0; i < 4; ++i) vn[i] = *(const u32x4*)(Vp + (rbase + vs) * 128 + hoff + (vq + 4 * i) * 8);
        }
        __syncthreads();
        for (int cc = 0; cc < 16; ++cc) {
            const size_t row0 = rbase + (size_t)cc * 128;
            unsigned lf[16]; u32x4 vr[4];
            float ra = 0.f, rb = 0.f;
#pragma unroll
            for (int e = 0; e < 16; ++e) { lf[e] = lfn[e]; ra += bflo(lf[e]); rb += bfhi(lf[e]); }
#pragma unroll
            for (int i = 0; i < 4; ++i) vr[i] = vn[i];
            *(f32x2*)(sPart + tq * 128 + d2) = (f32x2){ra, rb};
            __syncthreads();
            if (cc + 1 < 16) {
                const bf16_t* lp = LFb + (row0 + 128 + 16 * tq) * 128 + hoff + d2;
#pragma unroll
                for (int e = 0; e < 16; ++e) lfn[e] = *(const unsigned*)(lp + (size_t)e * 128);
#pragma unroll
                for (int i = 0; i < 4; ++i) vn[i] = *(const u32x4*)(Vp + (row0 + 128 + vs) * 128 + hoff + (vq + 4 * i) * 8);
            }
            float ba = 0.f, bb = 0.f, tota = 0.f, totb = 0.f;
#pragma unroll
            for (int q = 0; q < 8; ++q) { const f32x2 pq = *(const f32x2*)(sPart + q * 128 + d2); tota += pq[0]; totb += pq[1]; if (q < tq) { ba += pq[0]; bb += pq[1]; } }
            if (tq == 0) { *(f32x2*)(sE + d2) = (f32x2){__expf(tota), __expf(totb)}; dla += tota; dlb += totb; }
#pragma unroll
            for (int g8 = 0; g8 < 2; ++g8) {
                u32x4 kwa, kwb;
#pragma unroll
                for (int e = 0; e < 8; e += 2) {
                    const float la0 = bflo(lf[8 * g8 + e]), lb0 = bfhi(lf[8 * g8 + e]), la1 = bflo(lf[8 * g8 + e + 1]), lb1 = bfhi(lf[8 * g8 + e + 1]);
                    const float a0 = ba + la0, a1 = a0 + la1; ba = a1;
                    const float b0 = bb + lb0, b1 = b0 + lb1; bb = b1;
                    kwa[e >> 1] = cvt_pk_bf16((1.0f - __expf(la0)) * __expf(tota - a0), (1.0f - __expf(la1)) * __expf(tota - a1));
                    kwb[e >> 1] = cvt_pk_bf16((1.0f - __expf(lb0)) * __expf(totb - b0), (1.0f - __expf(lb1)) * __expf(totb - b1));
                }
                *(u32x4*)(sKT + d2 * 136 + 16 * tq + 8 * g8) = kwa; *(u32x4*)(sKT + (d2 + 1) * 136 + 16 * tq + 8 * g8) = kwb;
            }
#pragma unroll
            for (int i = 0; i < 4; ++i)
#pragma unroll
                for (int e = 0; e < 8; ++e) sVT[((vq + 4 * i) * 8 + e) * 136 + vs] = (bf16_t)((e & 1) ? (vr[i][e >> 1] >> 16) : (vr[i][e >> 1] & 0xffffu));
            __syncthreads();
#pragma unroll
            for (int db = 0; db < 8; ++db) { const f32x4 e4 = *(const f32x4*)(sE + 16 * db + fq * 4); S[db] = S[db] * e4; }
#pragma unroll
            for (int ks = 0; ks < 4; ++ks) {
                const bf16x8 vf = *(const bf16x8*)(sVT + (16 * w + fr) * 136 + ks * 32 + fq * 8);
#pragma unroll
                for (int db = 0; db < 8; ++db) { const bf16x8 kf = *(const bf16x8*)(sKT + (16 * db + fr) * 136 + ks * 32 + fq * 8); S[db] = __builtin_amdgcn_mfma_f32_16x16x32_bf16(kf, vf, S[db], 0, 0, 0); }
            }
        }
        float* sl = (float*)(p.ws + OFF_SLOC) + (size_t)(bh * 4 + sc) * 16384;
#pragma unroll
        for (int db = 0; db < 8; ++db) *(f32x4*)(sl + ((w * 8 + db) * 64 + lane) * 4) = S[db];
        if (tq == 0) *(f32x2*)((float*)(p.ws + OFF_DLOG) + (bh * 4 + sc) * 128 + d2) = (f32x2){dla, dlb};
    }
    __syncthreads();
}

__device__ void attn_phase(const Params& p, int jl, unsigned char* shm) {
    bf16_t* sK = (bf16_t*)shm;
    bf16_t* sVT = sK + 2 * 9216;
    float* sB = (float*)(sVT + 2 * 8704);
    const int tid = opaque_tid(), lane = tid & 63, w = tid >> 6, fr = lane & 15, fq = lane >> 4;
    const int cq = w >> 1, half = w & 1;
    const float LOG2E = 1.4426950408889634f;
    const int skey = tid >> 3, spiece = tid & 7, vkey = tid & 63, vpiece = tid >> 6;
    const bf16_t* Kg = (const bf16_t*)(p.ws + OFF_KB); const bf16_t* Vg = (const bf16_t*)(p.ws + OFF_VB); const bf16_t* Qg = (const bf16_t*)(p.ws + OFF_QB);
    for (int task = blockIdx.x; task < 4096; task += gridDim.x) {
        const int g = task & 31, h = (task >> 5) & 15, b = task >> 9;
        const int c = 4 * g + cq;
        const int dt0 = (2 * g - 4 > 0) ? 2 * g - 4 : 0, dt1 = 2 * g + 1;
        __syncthreads();
        for (int i = tid; i < 384; i += 512) { int r = i - 64; r = r < 0 ? 0 : (r > 319 ? 319 : r); sB[i] = p.in[18][((size_t)jl * 320 + r) * 16 + h] * LOG2E; }
        bf16x8 qf[2][2];
        {
            const bf16_t* qp = Qg + ((size_t)b * SEQ + c * 64 + half * 32) * D + h * 64;
#pragma unroll
            for (int qb = 0; qb < 2; ++qb)
#pragma unroll
                for (int ks = 0; ks < 2; ++ks) qf[qb][ks] = *(const bf16x8*)(qp + (size_t)(qb * 16 + fr) * D + ks * 32 + fq * 8);
        }
        f32x4 oacc[4][2];
#pragma unroll
        for (int db = 0; db < 4; ++db)
#pragma unroll
            for (int qb = 0; qb < 2; ++qb) oacc[db][qb] = (f32x4){0.f, 0.f, 0.f, 0.f};
        float mrun[2] = {0.f, 0.f}, lrun[2] = {0.f, 0.f};
        bool first = true;
        u32x4 kreg[2], vreg[2];
        const size_t tokb = (size_t)b * SEQ;
        const size_t hoffk = (size_t)b * SEQ * 960 + (size_t)h * SEQ * 64;
#define ATT_GLOAD(dt_) do { _Pragma("unroll") for (int hf_ = 0; hf_ < 2; ++hf_) { \
            kreg[hf_] = *(const u32x4*)(Kg + (tokb + (size_t)(dt_) * 128 + hf_ * 64 + skey) * 64 + hoffk + spiece * 8); \
            vreg[hf_] = *(const u32x4*)(Vg + (tokb + (size_t)(dt_) * 128 + hf_ * 64 + vkey) * 64 + hoffk + vpiece * 8); } } while (0)
#define ATT_LSTORE(buf_) do { _Pragma("unroll") for (int hf_ = 0; hf_ < 2; ++hf_) { \
            *(u32x4*)(sK + (buf_) * 9216 + (hf_ * 64 + skey) * 72 + spiece * 8) = kreg[hf_]; \
            bf16_t* vt_ = sVT + (buf_) * 8704 + (vpiece * 8) * 136 + hf_ * 64 + vkey; \
            _Pragma("unroll") for (int e_ = 0; e_ < 8; ++e_) vt_[e_ * 136] = (bf16_t)((e_ & 1) ? (vreg[hf_][e_ >> 1] >> 16) : (vreg[hf_][e_ >> 1] & 0xffffu)); } } while (0)
        ATT_GLOAD(dt0); ATT_LSTORE(0);
        __syncthreads();
        for (int dt = dt0; dt <= dt1; ++dt) {
            const int buf = (dt - dt0) & 1;
            if (dt < dt1) ATT_GLOAD(dt + 1);
            const bool act0 = (2 * dt >= c - 8) && (2 * dt <= c), act1 = (2 * dt + 1 >= c - 8) && (2 * dt + 1 <= c);
            if (act0 || act1) {
                const bf16_t* kb_ = sK + buf * 9216; const bf16_t* vb_ = sVT + buf * 8704;
                f32x4 sacc[2][4][2];
                const float b0 = sB[0];
#pragma unroll
                for (int hf = 0; hf < 2; ++hf) {
                    if (hf == 0 ? act0 : act1) {
                        const float cb = (2 * dt + hf - c <= -5) ? b0 : 0.f;
#pragma unroll
                        for (int kb = 0; kb < 4; ++kb)
#pragma unroll
                            for (int qb = 0; qb < 2; ++qb) { const float iv = cb - mrun[qb]; sacc[hf][kb][qb] = (f32x4){iv, iv, iv, iv}; }
#pragma unroll
                        for (int kb = 0; kb < 4; ++kb)
#pragma unroll
                            for (int ks = 0; ks < 2; ++ks) {
                                const bf16x8 kf = *(const bf16x8*)(kb_ + (hf * 64 + kb * 16 + fr) * 72 + ks * 32 + fq * 8);
#pragma unroll
                                for (int qb = 0; qb < 2; ++qb) sacc[hf][kb][qb] = __builtin_amdgcn_mfma_f32_16x16x32_bf16(kf, qf[qb][ks], sacc[hf][kb][qb], 0, 0, 0);
                            }
                    }
                }
                float mx[2] = {-3e38f, -3e38f};
#pragma unroll
                for (int hf = 0; hf < 2; ++hf) {
                    if (hf == 0 ? act0 : act1) {
                        const int dk = 2 * dt + hf - c;
                        if (dk > -5) {
                            const float* bp = sB + (dk * 64 + fq * 4 - half * 32 - fr + 256 + 64 - 16);
#pragma unroll
                            for (int kb = 0; kb < 4; ++kb)
#pragma unroll
                                for (int qb = 0; qb < 2; ++qb)
#pragma unroll
                                    for (int j = 0; j < 4; ++j) sacc[hf][kb][qb][j] += bp[kb * 16 + j - qb * 16 + 16];
                        }
#pragma unroll
                        for (int qb = 0; qb < 2; ++qb)
#pragma unroll
                            for (int kb = 0; kb < 4; ++kb)
#pragma unroll
                                for (int j = 0; j < 4; ++j) mx[qb] = fmaxf(mx[qb], sacc[hf][kb][qb][j]);
                    }
                }
                if (first || __any((mx[0] > 6.0f) || (mx[1] > 6.0f))) {
#pragma unroll
                    for (int qb = 0; qb < 2; ++qb) {
                        float m2 = fmaxf(mx[qb], __shfl_xor(mx[qb], 16)); m2 = fmaxf(m2, __shfl_xor(m2, 32));
                        const float delta = first ? m2 : fmaxf(m2, 0.f), corr = first ? 1.0f : __builtin_amdgcn_exp2f(-delta);
                        mrun[qb] += delta; lrun[qb] *= corr;
#pragma unroll
                        for (int db = 0; db < 4; ++db) oacc[db][qb] = oacc[db][qb] * corr;
#pragma unroll
                        for (int hf = 0; hf < 2; ++hf)
#pragma unroll
                            for (int kb = 0; kb < 4; ++kb) sacc[hf][kb][qb] = sacc[hf][kb][qb] - delta;
                    }
                    first = false;
                }
#pragma unroll
                for (int hf = 0; hf < 2; ++hf) {
                    if (hf == 0 ? act0 : act1) {
                        bf16x8 pf[2][2];
#pragma unroll
                        for (int qb = 0; qb < 2; ++qb) {
                            float ps = 0.f;
#pragma unroll
                            for (int kb = 0; kb < 4; ++kb)
#pragma unroll
                                for (int j = 0; j < 4; ++j) { const float pv = __builtin_amdgcn_exp2f(sacc[hf][kb][qb][j]); sacc[hf][kb][qb][j] = pv; ps += pv; }
                            lrun[qb] += ps;
#pragma unroll
                            for (int kk = 0; kk < 2; ++kk) {
                                u32x4 pw;
                                pw.x = cvt_pk_bf16(sacc[hf][2 * kk][qb][0], sacc[hf][2 * kk][qb][1]); pw.y = cvt_pk_bf16(sacc[hf][2 * kk][qb][2], sacc[hf][2 * kk][qb][3]);
                                pw.z = cvt_pk_bf16(sacc[hf][2 * kk + 1][qb][0], sacc[hf][2 * kk + 1][qb][1]); pw.w = cvt_pk_bf16(sacc[hf][2 * kk + 1][qb][2], sacc[hf][2 * kk + 1][qb][3]);
                                pf[qb][kk] = __builtin_bit_cast(bf16x8, pw);
                            }
                        }
#pragma unroll
                        for (int db = 0; db < 4; ++db)
#pragma unroll
                            for (int kk = 0; kk < 2; ++kk) {
                                const u32x2 lo = *(const u32x2*)(vb_ + (db * 16 + fr) * 136 + hf * 64 + (2 * kk) * 16 + fq * 4);
                                const u32x2 hi = *(const u32x2*)(vb_ + (db * 16 + fr) * 136 + hf * 64 + (2 * kk + 1) * 16 + fq * 4);
                                u32x4 vw; vw.x = lo.x; vw.y = lo.y; vw.z = hi.x; vw.w = hi.y;
                                const bf16x8 vf = __builtin_bit_cast(bf16x8, vw);
#pragma unroll
                                for (int qb = 0; qb < 2; ++qb) oacc[db][qb] = __builtin_amdgcn_mfma_f32_16x16x32_bf16(vf, pf[qb][kk], oacc[db][qb], 0, 0, 0);
                            }
                    }
                }
            }
            if (dt < dt1) ATT_LSTORE(buf ^ 1);
            __syncthreads();
        }
#undef ATT_GLOAD
#undef ATT_LSTORE
#pragma unroll
        for (int qb = 0; qb < 2; ++qb) {
            float lt = lrun[qb]; lt += __shfl_xor(lt, 16); lt += __shfl_xor(lt, 32);
            const float inv = 1.0f / lt;
            bf16_t* op = (bf16_t*)(p.ws + OFF_U) + (tokb + c * 64 + half * 32 + qb * 16 + fr) * D + h * 64 + fq * 4;
#pragma unroll
            for (int db = 0; db < 4; ++db) {
                u32x2 ow; ow.x = cvt_pk_bf16(oacc[db][qb][0] * inv, oacc[db][qb][1] * inv); ow.y = cvt_pk_bf16(oacc[db][qb][2] * inv, oacc[db][qb][3] * inv);
                *(u32x2*)(op + db * 16) = ow;
            }
        }
    }
    __syncthreads();
}

#ifndef REP_ATTN
#define REP_ATTN 1
#endif
#ifndef REP_REC
#define REP_REC 1
#endif
#ifndef REP_NORM
#define REP_NORM 1
#endif
#ifndef REP_SYNC
#define REP_SYNC 1
#endif
#ifndef REP_PREP
#define REP_PREP 1
#endif
#ifndef REP_G3
#define REP_G3 1
#endif
#define GSYNC() do { for (int r_ = 0; r_ < REP_SYNC; ++r_) xcd_barrier(xb); } while (0)
__global__ void __launch_bounds__(512, 2) yoco_fwd(Params p) {
    extern __shared__ __attribute__((aligned(16))) unsigned char shm[];
    cg::grid_group grid = cg::this_grid();
    {
        const int t0 = threadIdx.x;
        if ((t0 & 63) == 0) *(volatile LAS int*)(LAS unsigned char*)(shm + WAVE_TAB_OFF + 4 * hw_wave_slot()) = t0 >> 6;
        __syncthreads();
    }
    const int tid0 = opaque_tid();
    unsigned* barw = (unsigned*)(p.ws + OFF_BAR);
    for (int i = blockIdx.x * 512 + tid0; i < XCD_BAR_WORDS; i += gridDim.x * 512) barw[i] = 0u;
    {
        u32x4* z = (u32x4*)(p.ws + OFF_ROWSS); const int nz = (int)((8 * (size_t)MTOK * 8) / 16);
        for (int i = blockIdx.x * 512 + tid0; i < nz; i += gridDim.x * 512) z[i] = (u32x4){0u, 0u, 0u, 0u};
    }
    volatile LAS unsigned* xst = (volatile LAS unsigned*)(LAS unsigned char*)(shm + LDS_BYTES - 16);
    if (tid0 == 0) { xst[0] = 0u; xst[1] = 0u; }
    for (int r = 0; r < REP_PREP; ++r) prep_phase(p, shm);
    grid.sync();
    XcdBarrier xb = xcd_barrier_post(barw, xst);
    {
        const float* mv = (const float*)(p.ws + OFF_MODV);
        for (int r = 0; r < REP_NORM; ++r) norm_phase(p.in[0], (bf16_t*)(p.ws + OFF_U), p.in[4], mv, mv + D, 6144, nullptr, nullptr, nullptr, nullptr, 0);
    }
    GSYNC();
    for (int l = 0; l < 4; ++l) {
        const float* hsrc = (l == 0) ? p.in[0] : p.h;
        const float* mv = (const float*)(p.ws + OFF_MODV) + (size_t)l * 8 * 6144;
        bf16_t* UF = (l < 2) ? (bf16_t*)(p.ws + OFF_UF_A) : (bf16_t*)(p.ws + OFF_QB);
        if (l < 2) {
            pg8::EpiHgrnIn e; e.QVG = (bf16_t*)(p.ws + OFF_QH); e.LF = (bf16_t*)(p.ws + OFF_LF); e.lb = (const float*)(p.ws + OFF_LBV) + l * D;
            run_gemm(shm, (const bf16_t*)(p.ws + OFF_U), (const bf16_t*)(p.ws + OFF_WB_A_IN) + (size_t)l * AIN * D, AIN, D, e);
            GSYNC();
            for (int r = 0; r < REP_REC; ++r) rec_passA(p, shm);
            GSYNC();
            for (int r = 0; r < REP_REC; ++r) rec_pass<true>(p, l, shm);
        } else {
            if (l == 2) { pg8::EpiBf16Split e; e.d0 = (bf16_t*)(p.ws + OFF_KB); e.scale = 1.0f; e.hm = 1;
                run_gemm(shm, (const bf16_t*)(p.ws + OFF_QB), (const bf16_t*)(p.ws + OFF_WB_KV), 2048, D, e);
                GSYNC(); }
            { pg8::EpiBf16Split e; e.d0 = (bf16_t*)(p.ws + OFF_QB); e.hm = 0; e.scale = 0.125f * 1.4426950408889634f;   run_gemm(shm, (const bf16_t*)(p.ws + OFF_U), (const bf16_t*)(p.ws + OFF_WB_Q) + (size_t)(l - 2) * D * D, D, D, e); }
            GSYNC();
            for (int r = 0; r < REP_ATTN; ++r) attn_phase(p, l - 2, shm);
        }
        GSYNC();
        {
            pg8::EpiResid e; e.in = p.in; e.ws = p.ws; e.hbuf = p.h; e.l = l; e.which = 0;
            run_gemm(shm, (const bf16_t*)(p.ws + OFF_U), (l < 2) ? (const bf16_t*)(p.ws + OFF_WB_A_OUT) + (size_t)l * D * D : (const bf16_t*)(p.ws + OFF_WB_O) + (size_t)(l - 2) * D * D, D, D, e);
        }
        GSYNC();
        for (int r = 0; r < REP_G3; ++r) { pg8::EpiSwiglu e; e.act = (bf16_t*)(p.ws + OFF_ACT); run_gemm(shm, UF, (const bf16_t*)(p.ws + OFF_WB_FFN_IN) + (size_t)l * 2 * FFN * D, 2 * FFN, D, e); }
        GSYNC();
        {
            pg8::EpiResid e; e.in = p.in; e.ws = p.ws; e.hbuf = p.h; e.l = l; e.which = 1;
            run_gemm(shm, (const bf16_t*)(p.ws + OFF_ACT), (const bf16_t*)(p.ws + OFF_WB_FFN_OUT) + (size_t)l * D * FFN, D, FFN, e);
        }
        if (l < 3) GSYNC();
    }
}

extern "C" void kernel_launch(void* const* d_in, const int* in_sizes, int n_in, void* d_out, int out_size, void* d_ws, size_t ws_size, hipStream_t stream) {
    static int grid_blocks = 0;
    if (!grid_blocks) {
        int dev = 0, cus = 0, per_cu = 0;
        hipGetDevice(&dev);
        hipDeviceGetAttribute(&cus, hipDeviceAttributeMultiprocessorCount, dev);
        hipFuncSetAttribute((const void*)yoco_fwd, hipFuncAttributeMaxDynamicSharedMemorySize, LDS_BYTES);
        hipOccupancyMaxActiveBlocksPerMultiprocessor(&per_cu, (const void*)yoco_fwd, 512, LDS_BYTES);
        if (per_cu < 1) per_cu = 1;
        grid_blocks = cus * per_cu;
        (void)hipGetLastError();
    }
    Params p{};
    for (int i = 0; i < 20; ++i) p.in[i] = (const float*)d_in[i];
    p.h = (float*)d_out; p.ws = (unsigned char*)d_ws;
    if (ws_size < WS_END || n_in != 20) { fprintf(stderr, "kernel_launch: workspace too small (%zu < %zu) or unexpected inputs\n", ws_size, (size_t)WS_END); return; }
    void* args[] = {&p};
    hipError_t e = hipLaunchCooperativeKernel((const void*)yoco_fwd, dim3(grid_blocks), dim3(512), args, LDS_BYTES, stream);
    if (e != hipSuccess) fprintf(stderr, "cooperative launch failed: %s (grid %d)\n", hipGetErrorString(e), grid_blocks);
}
```

```cpp
#include <hip/hip_runtime.h>
#include <hip/hip_cooperative_groups.h>
#include <cstdio>
namespace cg = cooperative_groups;

#define LAS __attribute__((address_space(3)))
typedef unsigned short bf16_t;
typedef short bf16x8 __attribute__((ext_vector_type(8)));
typedef float f32x4 __attribute__((ext_vector_type(4)));
typedef unsigned u32x4 __attribute__((ext_vector_type(4)));
typedef unsigned u32x2 __attribute__((ext_vector_type(2)));
typedef float f32x2 __attribute__((ext_vector_type(2)));

constexpr int D = 1024, BATCH = 8, SEQ = 8192, MTOK = BATCH * SEQ, FFN = 2816, AIN = 4096;
constexpr int LDS_BYTES = 144 * 1024;
constexpr int XCD_BAR_WORDS_C = 3456;

__device__ __forceinline__ unsigned cvt_pk_bf16(float lo, float hi) { unsigned r; asm volatile("v_cvt_pk_bf16_f32 %0, %1, %2" : "=v"(r) : "v"(lo), "v"(hi)); return r; }
__device__ __forceinline__ float bf2f(unsigned short h) { return __uint_as_float((unsigned)h << 16); }
__device__ __forceinline__ float bflo(unsigned w) { return __uint_as_float(w << 16); }
__device__ __forceinline__ float bfhi(unsigned w) { return __uint_as_float(w & 0xffff0000u); }
__device__ __forceinline__ float silu_f(float x) { return x * __builtin_amdgcn_rcpf(1.0f + __expf(-x)); }

constexpr int WAVE_TAB_OFF = LDS_BYTES - 16 - 256;
__device__ __forceinline__ unsigned hw_wave_slot() { return (unsigned)__builtin_amdgcn_s_getreg(((6 - 1) << 11) | 4); }
__device__ __forceinline__ int opaque_tid() {
    extern __shared__ __attribute__((aligned(16))) unsigned char shm_tid_[];
    const int wv = __builtin_amdgcn_readfirstlane(*(volatile LAS int*)(LAS unsigned char*)(shm_tid_ + WAVE_TAB_OFF + 4 * hw_wave_slot()));
    int lane_;
    asm volatile("v_mbcnt_lo_u32_b32 %0, -1, 0\n\tv_mbcnt_hi_u32_b32 %0, -1, %0" : "=&v"(lane_));
    int t = wv * 64 + lane_;
    asm volatile("" : "+v"(t)); return t;
}
struct Params { const float* in[20]; float* h; unsigned char* ws; };
constexpr size_t ACTB = (size_t)MTOK * D * 2;
constexpr size_t OFF_WB_A_IN = 0;
constexpr size_t OFF_WB_A_OUT = OFF_WB_A_IN + (size_t)2 * AIN * D * 2;
constexpr size_t OFF_WB_FFN_IN = OFF_WB_A_OUT + (size_t)2 * D * D * 2;
constexpr size_t OFF_WB_FFN_OUT = OFF_WB_FFN_IN + (size_t)4 * 2 * FFN * D * 2;
constexpr size_t OFF_WB_KV = OFF_WB_FFN_OUT + (size_t)4 * D * FFN * 2;
constexpr size_t OFF_WB_Q = OFF_WB_KV + (size_t)2 * D * D * 2;
constexpr size_t OFF_WB_O = OFF_WB_Q + (size_t)2 * D * D * 2;
constexpr size_t OFF_MODV = OFF_WB_O + (size_t)2 * D * D * 2;
constexpr size_t OFF_KVMOD = OFF_MODV + (size_t)4 * 8 * 6144 * 4;
constexpr size_t OFF_LBV = OFF_KVMOD + (size_t)8 * 2048 * 4;
constexpr size_t OFF_U = OFF_LBV + (size_t)2 * D * 4;
constexpr size_t OFF_H = OFF_U;
constexpr size_t OFF_R = OFF_U + ACTB;
constexpr size_t OFF_QH = OFF_R, OFF_VH = OFF_R + ACTB, OFF_GH = OFF_R + 2 * ACTB, OFF_LF = OFF_R + 3 * ACTB;
constexpr size_t OFF_ACT = OFF_R;
constexpr size_t OFF_UF_A = OFF_R + 4 * ACTB;
constexpr size_t OFF_KB = OFF_R + (size_t)MTOK * FFN * 2, OFF_VB = OFF_KB + ACTB, OFF_QB = OFF_VB + ACTB;
constexpr size_t OFF_SLOC = OFF_R + 5 * ACTB, OFF_DLOG = OFF_SLOC + (size_t)256 * 16384 * 4;
constexpr size_t OFF_BAR = OFF_QB + ACTB;
constexpr size_t OFF_ROWSS = OFF_BAR + (size_t)16384;
constexpr size_t WS_END = OFF_ROWSS + (size_t)8 * MTOK * 8;


#define XB_TMO      128
#define XB_XCNT(j)  (256  + 64 * (j))
#define XB_XSUB(j)  (1280 + 64 * (j))
#define XB_XGEN(j)  (2304 + 64 * (j))
#define XB_TOP      3328
#define XB_TOPGEN   3392
#define XCD_BAR_WORDS 3456
#define XB_SPIN_CAP (1u << 18)
__device__ __forceinline__ unsigned xb_ld(unsigned* p)              { return __hip_atomic_load(p, __ATOMIC_RELAXED, __HIP_MEMORY_SCOPE_AGENT); }
__device__ __forceinline__ unsigned xb_add(unsigned* p, unsigned v) { return __hip_atomic_fetch_add(p, v, __ATOMIC_RELAXED, __HIP_MEMORY_SCOPE_AGENT); }
__device__ __forceinline__ unsigned xb_xcc_id() { return (unsigned)__builtin_amdgcn_s_getreg((3 << 11) | 20) & 0xFu; }
#define XB_SPIN(cond, bar) do { unsigned _sp = 0; while (cond) { __builtin_amdgcn_s_sleep(1); \
    if ((++_sp & 255u) == 0u) { if (xb_ld(&(bar)[XB_TMO])) break; if (_sp > XB_SPIN_CAP) { atomicAdd(&(bar)[XB_TMO], 1u); break; } } } } while (0)
struct XcdBarrier { unsigned* bar; unsigned x; volatile LAS unsigned* st; };
__device__ __forceinline__ XcdBarrier xcd_barrier_post(unsigned* bar, volatile LAS unsigned* st) {
    XcdBarrier b; b.bar = bar; b.x = xb_xcc_id(); b.st = st;
    if (opaque_tid() == 0) (void)xb_add(&bar[XB_XCNT(b.x)], 1u);
    return b;
}
__device__ __forceinline__ void xcd_barrier_complete(unsigned* bar, unsigned x, unsigned& nloc, unsigned& nx) {
    const unsigned G = gridDim.x * gridDim.y * gridDim.z;
    unsigned sum, cnt, mine, sp = 0u;
    for (;;) {
        sum = 0u; cnt = 0u; mine = 0u;
#pragma unroll
        for (unsigned j = 0; j < 16; ++j) { const unsigned c = xb_ld(&bar[XB_XCNT(j)]); sum += c; cnt += (c > 0u) ? 1u : 0u; mine = (j == x) ? c : mine; }
        if (sum == G) break;
        __builtin_amdgcn_s_sleep(1);
        if ((++sp & 255u) == 0u) { if (xb_ld(&bar[XB_TMO])) break; if (sp > XB_SPIN_CAP) { atomicAdd(&bar[XB_TMO], 1u); break; } }
    }
    nloc = mine > 0u ? mine : 1u; nx = cnt > 0u ? cnt : 1u;
}
__device__ __forceinline__ void xcd_barrier(const XcdBarrier& b) {
    asm volatile("s_waitcnt vmcnt(0)" ::: "memory");
    __syncthreads();
    if (opaque_tid() == 0) {
        unsigned* bar = b.bar;
        __builtin_amdgcn_s_waitcnt(0);
        unsigned nloc = b.st[0], nx = b.st[1];
        if (nloc == 0u) { xcd_barrier_complete(bar, b.x, nloc, nx); b.st[0] = nloc; b.st[1] = nx; }
        const unsigned old = xb_add(&bar[XB_XSUB(b.x)], 1u);
        const unsigned gen = old / nloc;
        if (old + 1u == (gen + 1u) * nloc) {
            __builtin_amdgcn_fence(__ATOMIC_RELEASE, "agent");
            asm volatile("s_waitcnt vmcnt(0)" ::: "memory");
            const unsigned og = xb_add(&bar[XB_TOP], 1u);
            const unsigned tg = og / nx;
            if (og + 1u == (tg + 1u) * nx) xb_add(&bar[XB_TOPGEN], 1u);
            else XB_SPIN(xb_ld(&bar[XB_TOPGEN]) == tg, bar);
            __builtin_amdgcn_fence(__ATOMIC_ACQUIRE, "agent");
            xb_add(&bar[XB_XGEN(b.x)], 1u);
            asm volatile("s_waitcnt vmcnt(0)" ::: "memory");
        } else {
            XB_SPIN(xb_ld(&bar[XB_XGEN(b.x)]) == gen, bar);
            __builtin_amdgcn_fence(__ATOMIC_ACQUIRE, "agent");
            asm volatile("s_waitcnt vmcnt(0)" ::: "memory");
        }
    }
    __syncthreads();
}

namespace pg8 {
constexpr int BM = 256, BK = 64, HALF = 128, HTB = HALF * BK * 2, STAGE_BYTES = 8 * HTB, NXCD = 8, WGM = 8;
__device__ __forceinline__ int lds_byte(int r, int c) { const int st = (r >> 4) * 2 + (c >> 5), rr = r & 15, cc = c & 31, ob = rr * 64 + cc * 2; return st * 1024 + (ob ^ (((ob >> 9) & 1) << 5)); }
__device__ __forceinline__ void stage_rc(int b, int& R, int& C) { const int st = b / 1024, sb = b % 1024, swz = sb ^ (((sb >> 9) & 1) << 5); R = (st >> 1) * 16 + swz / 64; C = (st & 1) * 32 + (swz % 64) / 2; }
__device__ __forceinline__ int perm32(int rho) { const int n = rho >> 4, i = rho & 15; return 8 * (i >> 2) + 4 * n + (i & 3); }
struct Unit { int pm, pn; };
struct Gemm { const bf16_t* A; const bf16_t* Bt; int M, N, K; };
struct StaticOrder {
    int nM, nN, nwg, G, c;
    __device__ void init(int M, int N, int G_, int c_) { nM = M / BM; nN = N / BM; nwg = nM * nN; G = G_; c = c_; }
    __device__ bool next(int i, Unit& u) const {
        const long L = (long)i * G + c; if (L >= nwg) return false;
        int wgid = (int)L; { const int q = nwg / NXCD, r = nwg % NXCD, xcd = wgid % NXCD, off = wgid / NXCD; wgid = (xcd < r ? xcd * (q + 1) : r * (q + 1) + (xcd - r) * q) + off; }
        const int nig = WGM * nN, gid = wgid / nig, fm = gid * WGM, gsz = (nM - fm) < WGM ? (nM - fm) : WGM;
        u.pm = fm + ((wgid % nig) % gsz); u.pn = (wgid % nig) / gsz; return true;
    }
};

template <class Epi>
__device__ __forceinline__ void gemm_phase(LAS unsigned char* lds, const Gemm g, const StaticOrder& S, const Epi& E) {
    const int tid = opaque_tid(), wid = __builtin_amdgcn_readfirstlane(tid >> 6), lane = tid & 63, wr = wid >> 2, wc = wid & 3, fr = lane & 15, fq = lane >> 4;
    const int K = g.K, nt = K / BK;
    unsigned voffA[2], voffB[2];
#pragma unroll
    for (int i = 0; i < 2; ++i) { int R, C; stage_rc(tid * 16 + i * 8192, R, C); const int Rb = Epi::PERM ? ((R & ~31) + perm32(R & 31)) : R;
        voffA[i] = (unsigned)(R * K + C) * 2u; voffB[i] = (unsigned)(Rb * K + C) * 2u; }
    const size_t kstep = (size_t)(BK * 2);
    const size_t hstep = (size_t)HALF * K * 2;
    const size_t tstep = 2 * hstep;
    const unsigned ldsw = (unsigned)wid * 1024u;
    const int aoff = lds_byte(wr * 64 + fr, fq * 8), boff = lds_byte(wc * 32 + fr, fq * 8);
#define PG8_SA(b, h) (((b) * 2 + (h)) * HTB)
#define PG8_SB(b, h) ((4 + (b) * 2 + (h)) * HTB)
#define PG8_STAGE(bufoff, gbase, voff) do { _Pragma("unroll") for (int _i = 0; _i < 2; ++_i) \
        __builtin_amdgcn_global_load_lds((const unsigned*)((const char*)(gbase) + (voff)[_i]), (LAS unsigned*)(lds + (bufoff) + ldsw + _i * 8192), 16, 0, 0); } while (0)
#define PG8_LDA(dst, b, h) do { _Pragma("unroll") for (int m = 0; m < 4; ++m) _Pragma("unroll") for (int k = 0; k < 2; ++k) dst[m][k] = *(const LAS bf16x8*)(lds + PG8_SA(b, h) + aoff + m * 2048 + k * 1024); } while (0)
#define PG8_LDB(dst, b, h) do { _Pragma("unroll") for (int n = 0; n < 2; ++n) _Pragma("unroll") for (int k = 0; k < 2; ++k) dst[n][k] = *(const LAS bf16x8*)(lds + PG8_SB(b, h) + boff + n * 2048 + k * 1024); } while (0)
#define PG8_MMA(ai, bj, At, Bt) do { __builtin_amdgcn_s_setprio(1); _Pragma("unroll") for (int m = 0; m < 4; ++m) _Pragma("unroll") for (int n = 0; n < 2; ++n) _Pragma("unroll") for (int k = 0; k < 2; ++k) \
        acc[ai][bj][m][n] = __builtin_amdgcn_mfma_f32_16x16x32_bf16(Bt[n][k], At[m][k], acc[ai][bj][m][n], 0, 0, 0); __builtin_amdgcn_s_setprio(0); } while (0)
#define PG8_WAIT_V(n) asm volatile("s_waitcnt vmcnt(" #n ")" ::: "memory")
#define PG8_WAIT_L(n) asm volatile("s_waitcnt lgkmcnt(" #n ")" ::: "memory")
#define PG8_BAR __builtin_amdgcn_s_barrier()
#define PG8_SCHED __builtin_amdgcn_sched_barrier(0)
    Unit cur, nxt; int ui = 0;
    if (!S.next(0, cur)) return;
    f32x4 acc[2][2][4][2];
#pragma unroll
    for (int a = 0; a < 2; ++a)
#pragma unroll
        for (int b = 0; b < 2; ++b)
#pragma unroll
            for (int m = 0; m < 4; ++m)
#pragma unroll
                for (int n = 0; n < 2; ++n) acc[a][b][m][n] = (f32x4){0.f, 0.f, 0.f, 0.f};
    bf16x8 At[4][2], B0[2][2], B1[2][2];
    const char* cA = (const char*)g.A + (size_t)cur.pm * tstep; const char* cB = (const char*)g.Bt + (size_t)cur.pn * tstep;
    PG8_STAGE(PG8_SB(0, 0), cB, voffB); PG8_STAGE(PG8_SA(0, 0), cA, voffA); PG8_STAGE(PG8_SB(0, 1), cB + hstep, voffB); PG8_STAGE(PG8_SA(0, 1), cA + hstep, voffA);
    if (wr == 1) PG8_BAR;
    PG8_WAIT_V(4); PG8_BAR;
    PG8_STAGE(PG8_SB(1, 0), cB + kstep, voffB); PG8_STAGE(PG8_SA(1, 0), cA + kstep, voffA); PG8_STAGE(PG8_SB(1, 1), cB + hstep + kstep, voffB);
    PG8_WAIT_V(6); PG8_BAR;
    for (;;) {
        const bool has_next = S.next(ui + 1, nxt);
        const char* nA = has_next ? (const char*)g.A + (size_t)nxt.pm * tstep : cA; const char* nB = has_next ? (const char*)g.Bt + (size_t)nxt.pn * tstep : cB;
        for (int t = 0; t < nt; t += 2) {
            const bool last = (t == nt - 2);
            const char* a1 = cA + (size_t)(t + 1) * kstep;
            const char* a2 = last ? nA : cA + (size_t)(t + 2) * kstep; const char* b2 = last ? nB : cB + (size_t)(t + 2) * kstep;
            const char* a3 = a2 + kstep; const char* b3 = b2 + kstep;
            PG8_LDB(B0, 0, 0); PG8_SCHED; PG8_LDA(At, 0, 0); PG8_STAGE(PG8_SA(1, 1), a1 + hstep, voffA);
            PG8_WAIT_L(8); PG8_BAR; PG8_WAIT_L(0); PG8_MMA(0, 0, At, B0); PG8_BAR; PG8_SCHED;
            PG8_LDB(B1, 0, 1); PG8_STAGE(PG8_SB(0, 0), b2, voffB);
            PG8_BAR; PG8_WAIT_L(0); PG8_MMA(0, 1, At, B1); PG8_BAR;
            PG8_LDA(At, 0, 1); PG8_STAGE(PG8_SA(0, 0), a2, voffA);
            PG8_BAR; PG8_WAIT_L(0); PG8_MMA(1, 0, At, B0); PG8_BAR; PG8_SCHED;
            PG8_STAGE(PG8_SB(0, 1), b2 + hstep, voffB);
            PG8_WAIT_V(6); PG8_BAR; PG8_MMA(1, 1, At, B1); PG8_BAR;
            PG8_LDB(B0, 1, 0); PG8_SCHED; PG8_LDA(At, 1, 0); PG8_STAGE(PG8_SA(0, 1), a2 + hstep, voffA);
            PG8_WAIT_L(8); PG8_BAR; PG8_WAIT_L(0); PG8_MMA(0, 0, At, B0); PG8_BAR; PG8_SCHED;
            PG8_LDB(B1, 1, 1); PG8_STAGE(PG8_SB(1, 0), b3, voffB);
            PG8_BAR; PG8_WAIT_L(0); PG8_MMA(0, 1, At, B1); PG8_BAR;
            PG8_LDA(At, 1, 1); PG8_STAGE(PG8_SA(1, 0), a3, voffA);
            PG8_BAR; PG8_WAIT_L(0); PG8_MMA(1, 0, At, B0); PG8_BAR; PG8_SCHED;
            PG8_STAGE(PG8_SB(1, 1), b3 + hstep, voffB);
            PG8_WAIT_V(6); PG8_BAR; PG8_MMA(1, 1, At, B1); PG8_BAR;
        }
        E(acc, cur, wr, wc, fr, fq);
        if (!has_next) break;
#pragma unroll
        for (int a = 0; a < 2; ++a)
#pragma unroll
            for (int b = 0; b < 2; ++b)
#pragma unroll
                for (int m = 0; m < 4; ++m)
#pragma unroll
                    for (int n = 0; n < 2; ++n) acc[a][b][m][n] = (f32x4){0.f, 0.f, 0.f, 0.f};
        cur = nxt; cA = nA; cB = nB; ++ui;
    }
    PG8_WAIT_V(0);
    if (wr == 0) PG8_BAR;
    PG8_BAR;
#undef PG8_SA
#undef PG8_SB
#undef PG8_STAGE
#undef PG8_LDA
#undef PG8_LDB
#undef PG8_MMA
#undef PG8_WAIT_V
#undef PG8_WAIT_L
#undef PG8_BAR
#undef PG8_SCHED
}

struct EpiHgrnIn {
    static constexpr bool PERM = true;
    bf16_t* QVG; bf16_t* LF; const float* lb;
    __device__ __forceinline__ void operator()(const f32x4 (&acc)[2][2][4][2], const Unit& u, int wr, int wc, int fr, int fq) const {
        const int seg = u.pn >> 2, colt = (u.pn & 3) * 256;
        const int row0 = u.pm * BM + wr * 64 + fr, col0 = colt + wc * 32 + 8 * fq;
        const size_t hm0 = (size_t)(u.pm >> 5) * SEQ * 896 + (size_t)(2 * (u.pn & 3)) * SEQ * 128 + wc * 32 + 8 * fq;
        if (seg == 1) {
#pragma unroll
            for (int bj = 0; bj < 2; ++bj) {
                const f32x4 l0 = *(const f32x4*)(lb + col0 + bj * HALF), l1 = *(const f32x4*)(lb + col0 + bj * HALF + 4);
#pragma unroll
                for (int ai = 0; ai < 2; ++ai)
#pragma unroll
                    for (int m = 0; m < 4; ++m) {
                        bf16_t* rowp = LF + (size_t)(row0 + ai * HALF + m * 16) * 128 + hm0 + (size_t)bj * SEQ * 128;
                        f32x4 o0, o1;
#pragma unroll
                        for (int j = 0; j < 4; ++j) {
                            float z = acc[ai][bj][m][0][j]; float sg = __builtin_amdgcn_rcpf(1.0f + __expf(-z)); float f = l0[j] + (1.0f - l0[j]) * sg; o0[j] = __logf(fmaxf(f, 1e-30f));
                            z = acc[ai][bj][m][1][j]; sg = __builtin_amdgcn_rcpf(1.0f + __expf(-z)); f = l1[j] + (1.0f - l1[j]) * sg; o1[j] = __logf(fmaxf(f, 1e-30f));
                        }
                        u32x4 lw; lw.x = cvt_pk_bf16(o0[0], o0[1]); lw.y = cvt_pk_bf16(o0[2], o0[3]); lw.z = cvt_pk_bf16(o1[0], o1[1]); lw.w = cvt_pk_bf16(o1[2], o1[3]);
                        *(u32x4*)rowp = lw;
                    }
            }
        } else {
            bf16_t* base = QVG + (size_t)(seg == 0 ? 0 : (seg == 2 ? 1 : 2)) * ((size_t)MTOK * D);
            const bool act = (seg != 2);
#pragma unroll
            for (int ai = 0; ai < 2; ++ai)
#pragma unroll
                for (int m = 0; m < 4; ++m)
#pragma unroll
                    for (int bj = 0; bj < 2; ++bj) {
                        f32x4 v0 = acc[ai][bj][m][0], v1 = acc[ai][bj][m][1];
                        if (act) {
#pragma unroll
                            for (int j = 0; j < 4; ++j) { v0[j] = silu_f(v0[j]); v1[j] = silu_f(v1[j]); }
                        }
                        u32x4 w; w.x = cvt_pk_bf16(v0[0], v0[1]); w.y = cvt_pk_bf16(v0[2], v0[3]); w.z = cvt_pk_bf16(v1[0], v1[1]); w.w = cvt_pk_bf16(v1[2], v1[3]);
                        *(u32x4*)(base + (size_t)(row0 + ai * HALF + m * 16) * 128 + hm0 + (size_t)bj * SEQ * 128) = w;
                    }
        }
    }
};
struct EpiResid {
    static constexpr bool PERM = true;
    const float* const* in; unsigned char* ws; float* hbuf; int l, which;
    __device__ __forceinline__ void emit(const f32x4 (&v)[2][2][4][2], const float (&rs)[2][4], bf16_t* U, const float* gain, const float* sh, const float* sc, int bs, int b, int row0, int col0) const {
#pragma unroll
        for (int bj = 0; bj < 2; ++bj) {
            const int c = col0 + bj * HALF;
            f32x4 a0, a1, t0, t1;
            { const f32x4 g0 = *(const f32x4*)(gain + c), s0 = *(const f32x4*)(sc + (size_t)b * bs + c); a0 = g0 * (s0 + 1.0f); t0 = *(const f32x4*)(sh + (size_t)b * bs + c); }
            { const f32x4 g1 = *(const f32x4*)(gain + c + 4), s1 = *(const f32x4*)(sc + (size_t)b * bs + c + 4); a1 = g1 * (s1 + 1.0f); t1 = *(const f32x4*)(sh + (size_t)b * bs + c + 4); }
#pragma unroll
            for (int ai = 0; ai < 2; ++ai)
#pragma unroll
                for (int m = 0; m < 4; ++m) {
                    const f32x4 u0 = (v[ai][bj][m][0] * rs[ai][m]) * a0 + t0, u1 = (v[ai][bj][m][1] * rs[ai][m]) * a1 + t1;
                    u32x4 w; w.x = cvt_pk_bf16(u0[0], u0[1]); w.y = cvt_pk_bf16(u0[2], u0[3]); w.z = cvt_pk_bf16(u1[0], u1[1]); w.w = cvt_pk_bf16(u1[2], u1[3]);
                    *(u32x4*)(U + (size_t)(row0 + ai * HALF + m * 16) * D + c) = w;
                }
            __builtin_amdgcn_sched_barrier(0);
        }
    }
    __device__ __forceinline__ void operator()(f32x4 (&acc)[2][2][4][2], const Unit& u, int wr, int wc, int fr, int fq) const {
        __builtin_amdgcn_sched_barrier(0);
        const int b = u.pm >> 5;
        const float* mv = (const float*)(ws + OFF_MODV) + (size_t)l * 8 * 6144;
        const bool src_x = (l == 0 && which == 0);
        const float* xin = in[0]; bf16_t* hb = (bf16_t*)(ws + OFF_H); float* dst = hbuf;
        const int mode = (l == 3 && which == 1) ? 1 : 0;
        unsigned long long* rowacc = (unsigned long long*)(ws + OFF_ROWSS) + (size_t)(2 * l + which) * MTOK;
        const float* gp = mv + (which ? 5 : 2) * D + (size_t)b * 6144;
        const int row0 = u.pm * BM + wr * 64 + fr, col0 = u.pn * BM + wc * 32 + 8 * fq;
        {
            f32x4 gv[2][2];
#pragma unroll
            for (int bj = 0; bj < 2; ++bj)
#pragma unroll
                for (int n = 0; n < 2; ++n) gv[bj][n] = *(const f32x4*)(gp + col0 + bj * HALF + 4 * n);
#pragma unroll
            for (int ai = 0; ai < 2; ++ai)
#pragma unroll
                for (int m = 0; m < 4; ++m) {
                    const size_t ro = (size_t)(row0 + ai * HALF + m * 16) * D + col0;
                    float pt = 0.f;
#pragma unroll
                    for (int bj = 0; bj < 2; ++bj) {
                        f32x4 s0, s1;
                        if (src_x) { s0 = *(const f32x4*)(xin + ro + bj * HALF); s1 = *(const f32x4*)(xin + ro + bj * HALF + 4); }
                        else { const u32x4 hw = *(const u32x4*)(hb + ro + bj * HALF);
                            s0 = (f32x4){bflo(hw.x), bfhi(hw.x), bflo(hw.y), bfhi(hw.y)}; s1 = (f32x4){bflo(hw.z), bfhi(hw.z), bflo(hw.w), bfhi(hw.w)}; }
                        const f32x4 v0 = s0 + gv[bj][0] * acc[ai][bj][m][0], v1 = s1 + gv[bj][1] * acc[ai][bj][m][1];
                        acc[ai][bj][m][0] = v0; acc[ai][bj][m][1] = v1;
                        if (mode == 0) { u32x4 w; w.x = cvt_pk_bf16(v0[0], v0[1]); w.y = cvt_pk_bf16(v0[2], v0[3]); w.z = cvt_pk_bf16(v1[0], v1[1]); w.w = cvt_pk_bf16(v1[2], v1[3]);
                            *(u32x4*)(hb + ro + bj * HALF) = w; }
                        pt += ((v0[0] * v0[0] + v0[1] * v0[1]) + (v0[2] * v0[2] + v0[3] * v0[3])) + ((v1[0] * v1[0] + v1[1] * v1[1]) + (v1[2] * v1[2] + v1[3] * v1[3]));
                    }
                    pt += __shfl_xor(pt, 16); pt += __shfl_xor(pt, 32);
                    if (fq == 0) (void)__hip_atomic_fetch_add(rowacc + row0 + ai * HALF + m * 16, (1ull << 48) + (unsigned long long)(pt * 65536.0f + 0.5f), __ATOMIC_RELAXED, __HIP_MEMORY_SCOPE_AGENT);
                    __builtin_amdgcn_sched_barrier(0);
                }
        }
        float rs[2][4];
        {
            unsigned spins = 0;
            for (;;) {
                bool done = true;
#pragma unroll
                for (int ai = 0; ai < 2; ++ai)
#pragma unroll
                    for (int m = 0; m < 4; ++m) {
                        const unsigned long long q = __hip_atomic_load(rowacc + row0 + ai * HALF + m * 16, __ATOMIC_RELAXED, __HIP_MEMORY_SCOPE_AGENT);
                        done = done && ((q >> 48) >= 16ull);
                        rs[ai][m] = rsqrtf((float)(q & 0xffffffffffffull) * (1.0f / 65536.0f) * (1.0f / D) + 1e-6f);
                    }
                if (__all(done) || ++spins > (1u << 16)) break;
                __builtin_amdgcn_s_sleep(2);
            }
        }
        asm volatile("" ::: "memory");
        __builtin_amdgcn_sched_barrier(0);
        if (mode == 1) {
            const float* gain1 = in[19];
#pragma unroll
            for (int bj = 0; bj < 2; ++bj) {
                const f32x4 g0 = *(const f32x4*)(gain1 + col0 + bj * HALF), g1 = *(const f32x4*)(gain1 + col0 + bj * HALF + 4);
#pragma unroll
                for (int ai = 0; ai < 2; ++ai)
#pragma unroll
                    for (int m = 0; m < 4; ++m) {
                        float* op = dst + (size_t)(row0 + ai * HALF + m * 16) * D + col0 + bj * HALF;
                        *(f32x4*)op = (acc[ai][bj][m][0] * rs[ai][m]) * g0; *(f32x4*)(op + 4) = (acc[ai][bj][m][1] * rs[ai][m]) * g1;
                    }
            }
        } else {
            if (which == 0) emit(acc, rs, (l < 2) ? (bf16_t*)(ws + OFF_UF_A) : (bf16_t*)((unsigned char*)hbuf + ACTB), in[5] + l * D, mv + 3 * D, mv + 4 * D, 6144, b, row0, col0);
            else {
                const float* mvn = mv + (size_t)8 * 6144;
                emit(acc, rs, (bf16_t*)((unsigned char*)hbuf), in[4] + (l + 1) * D, mvn, mvn + D, 6144, b, row0, col0);
                if (l == 1) { const float* kvm = (const float*)(ws + OFF_KVMOD); emit(acc, rs, (bf16_t*)((unsigned char*)hbuf + ACTB), in[12], kvm, kvm + D, 2048, b, row0, col0); }
            }
        }
    }
};
struct EpiSwiglu {
    static constexpr bool PERM = true;
    bf16_t* act;
    __device__ __forceinline__ void operator()(const f32x4 (&acc)[2][2][4][2], const Unit& u, int wr, int wc, int fr, int fq) const {
        const int row0 = u.pm * BM + wr * 64 + fr, col0 = u.pn * HALF + wc * 32 + 8 * fq;
#pragma unroll
        for (int ai = 0; ai < 2; ++ai)
#pragma unroll
            for (int m = 0; m < 4; ++m) {
                f32x4 r0, r1;
#pragma unroll
                for (int j = 0; j < 4; ++j) { r0[j] = silu_f(acc[ai][0][m][0][j]) * acc[ai][1][m][0][j]; r1[j] = silu_f(acc[ai][0][m][1][j]) * acc[ai][1][m][1][j]; }
                u32x4 w; w.x = cvt_pk_bf16(r0[0], r0[1]); w.y = cvt_pk_bf16(r0[2], r0[3]); w.z = cvt_pk_bf16(r1[0], r1[1]); w.w = cvt_pk_bf16(r1[2], r1[3]);
                *(u32x4*)(act + (size_t)(row0 + ai * HALF + m * 16) * FFN + col0) = w;
            }
    }
};
struct EpiBf16Split {
    static constexpr bool PERM = true;
    bf16_t* d0; float scale; int hm;
    __device__ __forceinline__ void operator()(const f32x4 (&acc)[2][2][4][2], const Unit& u, int wr, int wc, int fr, int fq) const {
        bf16_t* base = d0 + (size_t)(u.pn >> 2) * ((size_t)MTOK * D);
        const int row0 = u.pm * BM + wr * 64 + fr, col0 = (u.pn & 3) * 256 + wc * 32 + 8 * fq;
#pragma unroll
        for (int ai = 0; ai < 2; ++ai)
#pragma unroll
            for (int m = 0; m < 4; ++m)
#pragma unroll
                for (int bj = 0; bj < 2; ++bj) {
                    const f32x4 v0 = acc[ai][bj][m][0] * scale, v1 = acc[ai][bj][m][1] * scale;
                    u32x4 w; w.x = cvt_pk_bf16(v0[0], v0[1]); w.y = cvt_pk_bf16(v0[2], v0[3]); w.z = cvt_pk_bf16(v1[0], v1[1]); w.w = cvt_pk_bf16(v1[2], v1[3]);
                    const int row = row0 + ai * HALF + m * 16;
                    if (hm) *(u32x4*)(base + (size_t)row * 64 + (size_t)(u.pm >> 5) * SEQ * 960 + (size_t)((col0 + bj * HALF) >> 6) * SEQ * 64 + ((col0 + bj * HALF) & 63)) = w;
                    else *(u32x4*)(base + (size_t)row * D + col0 + bj * HALF) = w;
                }
    }
};
}

template <class Epi>
__device__ __forceinline__ void run_gemm(unsigned char* shm, const bf16_t* A, const bf16_t* Bt, int N, int K, const Epi& E) {
    pg8::Gemm g; g.A = A; g.Bt = Bt; g.M = MTOK; g.N = N; g.K = K;
    pg8::StaticOrder S; S.init(MTOK, N, (int)gridDim.x, (int)blockIdx.x);
    pg8::gemm_phase<Epi>((LAS unsigned char*)shm, g, S, E);
    __syncthreads();
}

__device__ __forceinline__ int ffnmap(int nn) { return nn < FFN ? ((nn >> 7) * 256 + (nn & 127)) : (((nn - FFN) >> 7) * 256 + 128 + ((nn - FFN) & 127)); }

__device__ __forceinline__ void conv_group(const float* src0, bf16_t* dst0, const int K, const int N, const int L, const int mode, unsigned char* shm, const int tid) {
    float* st = (float*)shm;
    const int per = (K / 128) * (N / 64), total = L * per, ntn = N / 64;
    f32x4 v[4];
    int tile = blockIdx.x;
    if (tile < total) {
        const int l = tile / per, tt = tile % per, k0 = (tt / ntn) * 128, n0 = (tt % ntn) * 64;
        const float* src = src0 + (size_t)l * K * N;
#pragma unroll
        for (int it = 0; it < 4; ++it) { const int idx = tid + it * 512, k = idx >> 4, n4 = idx & 15; v[it] = *(const f32x4*)(src + (size_t)(k0 + k) * N + n0 + 4 * n4); }
    }
    for (; tile < total; tile += gridDim.x) {
        const int l = tile / per, tt = tile % per, k0 = (tt / ntn) * 128, n0 = (tt % ntn) * 64;
        bf16_t* dst = dst0 + (size_t)l * K * N;
        __syncthreads();
#pragma unroll
        for (int it = 0; it < 4; ++it) { const int idx = tid + it * 512, k = idx >> 4, n4 = idx & 15;
#pragma unroll
            for (int e = 0; e < 4; ++e) st[k * 65 + 4 * n4 + e] = v[it][e]; }
        __syncthreads();
        const int nt_ = tile + (int)gridDim.x;
        if (nt_ < total) {
            const int l2 = nt_ / per, t2 = nt_ % per, k2 = (t2 / ntn) * 128, n2 = (t2 % ntn) * 64;
            const float* src = src0 + (size_t)l2 * K * N;
#pragma unroll
            for (int it = 0; it < 4; ++it) { const int idx = tid + it * 512, k = idx >> 4, n4 = idx & 15; v[it] = *(const f32x4*)(src + (size_t)(k2 + k) * N + n2 + 4 * n4); }
        }
#pragma unroll
        for (int it = 0; it < 2; ++it) { const int idx = tid + it * 512, n = idx >> 4, kg = idx & 15; const int nn = n0 + n; const int drow = mode ? ffnmap(nn) : nn;
            u32x4 w;
#pragma unroll
            for (int e = 0; e < 4; ++e) w[e] = cvt_pk_bf16(st[(8 * kg + 2 * e) * 65 + n], st[(8 * kg + 2 * e + 1) * 65 + n]);
            *(u32x4*)(dst + (size_t)drow * K + k0 + 8 * kg) = w; }
    }
}

__device__ void prep_phase(const Params& p, unsigned char* shm) {
    const int tid = opaque_tid();
    {
        float* cact = (float*)shm;
        float* red = cact + 8192;
        bool loaded = false;
        const int wv = tid >> 6, lane = tid & 63;
        for (int task = blockIdx.x; task < 416; task += gridDim.x) {
            if (!loaded) {
                for (int i = tid; i < 8192; i += 512) { const int k = i >> 3, b = i & 7; cact[i] = silu_f(p.in[1][b * D + k]); }
                loaded = true;
            }
            __syncthreads();
            const int c0 = task * 64;
            const float* src; const float* bias; float* dst; int stride, dstride;
            if (c0 < 24576) { const int l = c0 / 6144, j = c0 % 6144; src = p.in[2] + (size_t)l * D * 6144 + j; stride = 6144; bias = p.in[3] + l * 6144 + j; dst = ((float*)(p.ws + OFF_MODV)) + (size_t)l * 8 * 6144 + j; dstride = 6144; }
            else { const int j = c0 - 24576; src = p.in[13] + j; stride = 2048; bias = p.in[14] + j; dst = ((float*)(p.ws + OFF_KVMOD)) + j; dstride = 2048; }
            float a[8];
#pragma unroll
            for (int b = 0; b < 8; ++b) a[b] = 0.f;
            const float* sp = src + (size_t)(wv * 128) * stride + lane;
#pragma unroll 8
            for (int k = 0; k < 128; ++k) {
                const float w = sp[(size_t)k * stride];
                const f32x4 c0v = *(const f32x4*)(cact + (wv * 128 + k) * 8), c1v = *(const f32x4*)(cact + (wv * 128 + k) * 8 + 4);
                a[0] += w * c0v[0]; a[1] += w * c0v[1]; a[2] += w * c0v[2]; a[3] += w * c0v[3];
                a[4] += w * c1v[0]; a[5] += w * c1v[1]; a[6] += w * c1v[2]; a[7] += w * c1v[3];
            }
#pragma unroll
            for (int b = 0; b < 8; ++b) red[(wv * 8 + b) * 64 + lane] = a[b];
            __syncthreads();
            {
                const int b = tid >> 6, col = tid & 63;
                float s = bias[col];
#pragma unroll
                for (int w = 0; w < 8; ++w) s += red[(w * 8 + b) * 64 + col];
                dst[(size_t)b * dstride + col] = s;
            }
        }
        __syncthreads();
    }
    for (int i = blockIdx.x * 512 + tid; i < 1024; i += gridDim.x * 512) {
        const float a0 = p.in[10][i], a1 = p.in[10][1024 + i];
        const float mx = fmaxf(a0, a1), e0 = __expf(a0 - mx), e1 = __expf(a1 - mx);
        ((float*)(p.ws + OFF_LBV))[i] = 0.f; ((float*)(p.ws + OFF_LBV))[1024 + i] = e1 / (e0 + e1);
    }
    conv_group(p.in[8], (bf16_t*)(p.ws + OFF_WB_A_IN), D, AIN, 2, 0, shm, tid);
    conv_group(p.in[9], (bf16_t*)(p.ws + OFF_WB_A_OUT), D, D, 2, 0, shm, tid);
    conv_group(p.in[6], (bf16_t*)(p.ws + OFF_WB_FFN_IN), D, 2 * FFN, 4, 1, shm, tid);
    conv_group(p.in[7], (bf16_t*)(p.ws + OFF_WB_FFN_OUT), FFN, D, 4, 0, shm, tid);
    conv_group(p.in[15], (bf16_t*)(p.ws + OFF_WB_KV), D, 2 * D, 1, 0, shm, tid);
    conv_group(p.in[16], (bf16_t*)(p.ws + OFF_WB_Q), D, D, 2, 0, shm, tid);
    conv_group(p.in[17], (bf16_t*)(p.ws + OFF_WB_O), D, D, 2, 0, shm, tid);
    __syncthreads();
}

__device__ void norm_phase(const float* src, bf16_t* U1, const float* gain1, const float* sh1, const float* sc1, int bs1,
                           bf16_t* U2, const float* gain2, const float* sh2, const float* sc2, int bs2) {
    const int tid_ = opaque_tid(); const int lane = tid_ & 63, gw = blockIdx.x * 8 + (tid_ >> 6), nw = gridDim.x * 8;
    for (int row = 2 * gw; row < MTOK; row += 2 * nw) {
        const int b = row >> 13;
        const float* xp = src + (size_t)row * D;
        f32x4 xv[2][4]; float ss[2] = {0.f, 0.f};
#pragma unroll
        for (int r = 0; r < 2; ++r)
#pragma unroll
            for (int i = 0; i < 4; ++i) xv[r][i] = *(const f32x4*)(xp + (size_t)r * D + i * 256 + lane * 4);
#pragma unroll
        for (int r = 0; r < 2; ++r)
#pragma unroll
            for (int i = 0; i < 4; ++i) ss[r] += xv[r][i][0] * xv[r][i][0] + xv[r][i][1] * xv[r][i][1] + xv[r][i][2] * xv[r][i][2] + xv[r][i][3] * xv[r][i][3];
#pragma unroll
        for (int o = 1; o < 64; o <<= 1) { ss[0] += __shfl_xor(ss[0], o); ss[1] += __shfl_xor(ss[1], o); }
        const float rstd0 = rsqrtf(ss[0] * (1.0f / D) + 1e-6f), rstd1 = rsqrtf(ss[1] * (1.0f / D) + 1e-6f);
#pragma unroll
        for (int i = 0; i < 4; ++i) {
            const int k = i * 256 + lane * 4;
            const f32x4 g = *(const f32x4*)(gain1 + k), s = *(const f32x4*)(sc1 + (size_t)b * bs1 + k), t = *(const f32x4*)(sh1 + (size_t)b * bs1 + k);
            f32x4 u0, u1;
#pragma unroll
            for (int j = 0; j < 4; ++j) { const float ga = g[j] * (1.0f + s[j]); u0[j] = (xv[0][i][j] * rstd0) * ga + t[j]; u1[j] = (xv[1][i][j] * rstd1) * ga + t[j]; }
            u32x2 w0, w1; w0.x = cvt_pk_bf16(u0[0], u0[1]); w0.y = cvt_pk_bf16(u0[2], u0[3]); w1.x = cvt_pk_bf16(u1[0], u1[1]); w1.y = cvt_pk_bf16(u1[2], u1[3]);
            *(u32x2*)(U1 + (size_t)row * D + k) = w0; *(u32x2*)(U1 + (size_t)(row + 1) * D + k) = w1;
        }
        if (U2) {
#pragma unroll
            for (int i = 0; i < 4; ++i) {
                const int k = i * 256 + lane * 4;
                const f32x4 g = *(const f32x4*)(gain2 + k), s = *(const f32x4*)(sc2 + (size_t)b * bs2 + k), t = *(const f32x4*)(sh2 + (size_t)b * bs2 + k);
                f32x4 u0, u1;
#pragma unroll
                for (int j = 0; j < 4; ++j) { const float ga = g[j] * (1.0f + s[j]); u0[j] = (xv[0][i][j] * rstd0) * ga + t[j]; u1[j] = (xv[1][i][j] * rstd1) * ga + t[j]; }
                u32x2 w0, w1; w0.x = cvt_pk_bf16(u0[0], u0[1]); w0.y = cvt_pk_bf16(u0[2], u0[3]); w1.x = cvt_pk_bf16(u1[0], u1[1]); w1.y = cvt_pk_bf16(u1[2], u1[3]);
                *(u32x2*)(U2 + (size_t)row * D + k) = w0; *(u32x2*)(U2 + (size_t)(row + 1) * D + k) = w1;
            }
        }
    }
}
__device__ void final_norm_phase(float* h, const float* gain) {
    const int tid_ = opaque_tid(); const int lane = tid_ & 63, gw = blockIdx.x * 8 + (tid_ >> 6), nw = gridDim.x * 8;
    for (int row = gw; row < MTOK; row += nw) {
        float* xp = h + (size_t)row * D;
        f32x4 xv[4]; float ss = 0.f;
#pragma unroll
        for (int i = 0; i < 4; ++i) { xv[i] = *(const f32x4*)(xp + i * 256 + lane * 4); ss += xv[i][0] * xv[i][0] + xv[i][1] * xv[i][1] + xv[i][2] * xv[i][2] + xv[i][3] * xv[i][3]; }
#pragma unroll
        for (int o = 1; o < 64; o <<= 1) ss += __shfl_xor(ss, o);
        const float rstd = rsqrtf(ss * (1.0f / D) + 1e-6f);
#pragma unroll
        for (int i = 0; i < 4; ++i) {
            const int k = i * 256 + lane * 4;
            const f32x4 g = *(const f32x4*)(gain + k);
            f32x4 u;
#pragma unroll
            for (int j = 0; j < 4; ++j) u[j] = xv[i][j] * rstd * g[j];
            *(f32x4*)(xp + k) = u;
        }
    }
}

template <bool OUT>
__device__ void rec_pass(const Params& p, int layer, unsigned char* shm) {
    float* sB = (float*)shm;
    float* sKm = (float*)(shm + 33792);
    bf16_t* sST = (bf16_t*)shm;
    bf16_t* sQb = (bf16_t*)(shm + 67584);
    bf16_t* sA = (bf16_t*)(shm + 84992);
    bf16_t* sKT = (bf16_t*)(shm + 94208);
    bf16_t* sVT = (bf16_t*)(shm + 112640);
    float* sE = (float*)(shm + 131072);
    float* sPart = (float*)(shm + 131584);
    float* sNrm = (float*)(shm + 135680);
    const int tid = opaque_tid(), lane = tid & 63, w = tid >> 6, fr = lane & 15, fq = lane >> 4;
    const int wi = w >> 1, wh = w & 1;
    const int ntask = OUT ? 256 : 192;
    const float* ogain = p.in[11] + layer * 128;
    for (int task = blockIdx.x; task < ntask; task += gridDim.x) {
        int sc, bh; if (OUT) { sc = task & 3; bh = task >> 2; } else { sc = task % 3; bh = task / 3; }
        const int b = bh >> 3, h = bh & 7;
        const size_t hoff = (size_t)b * SEQ * 896 + (size_t)h * SEQ * 128;
        f32x4 S[8];
#pragma unroll
        for (int db = 0; db < 8; ++db) S[db] = (f32x4){0.f, 0.f, 0.f, 0.f};
        if (OUT) {
            for (int s2 = 0; s2 < sc; ++s2) {
                const float* sl = ((float*)(p.ws + OFF_SLOC)) + (size_t)(bh * 4 + s2) * 16384; const float* dl = ((float*)(p.ws + OFF_DLOG)) + (bh * 4 + s2) * 128;
#pragma unroll
                for (int db = 0; db < 8; ++db) {
                    const f32x4 x = *(const f32x4*)(sl + ((w * 8 + db) * 64 + lane) * 4), dv = *(const f32x4*)(dl + 16 * db + fq * 4);
#pragma unroll
                    for (int j = 0; j < 4; ++j) S[db][j] = S[db][j] * __expf(dv[j]) + x[j];
                }
            }
        }
        float dlacc = 0.f;
        unsigned lfn[8]; u32x4 vn0, vn1;
        const bf16_t* LFb = (const bf16_t*)(p.ws + OFF_LF);
        const int d2 = (tid & 63) * 2, tq = tid >> 6;
        {
            const size_t r0 = (size_t)b * SEQ + (size_t)(sc * 32) * 64;
            const bf16_t* lp = LFb + (r0 + 8 * tq) * 128 + hoff + d2;
#pragma unroll
            for (int e = 0; e < 8; ++e) lfn[e] = *(const unsigned*)(lp + (size_t)e * 128);
            vn0 = *(const u32x4*)(((bf16_t*)(p.ws + OFF_VH)) + (r0 + (tid & 63)) * 128 + hoff + (tid >> 6) * 8);
            vn1 = *(const u32x4*)(((bf16_t*)(p.ws + OFF_VH)) + (r0 + (tid & 63)) * 128 + hoff + 64 + (tid >> 6) * 8);
        }
        for (int ch = sc * 32; ch < sc * 32 + 32; ++ch) {
            const size_t row0 = (size_t)b * SEQ + (size_t)ch * 64;
            float la[8], lb2[8];
#pragma unroll
            for (int e = 0; e < 8; ++e) { la[e] = bflo(lfn[e]); lb2[e] = bfhi(lfn[e]); }
            const u32x4 vr0 = vn0, vr1 = vn1;
            u32x4 qraw[4]; u32x2 graw[4];
            if (OUT) {
#pragma unroll
                for (int ks = 0; ks < 4; ++ks) qraw[ks] = *(const u32x4*)(((bf16_t*)(p.ws + OFF_QH)) + (row0 + 16 * wi + fr) * 128 + hoff + ks * 32 + fq * 8);
#pragma unroll
                for (int vb = 0; vb < 4; ++vb) graw[vb] = *(const u32x2*)(((bf16_t*)(p.ws + OFF_GH)) + (row0 + 16 * wi + fr) * 128 + hoff + 64 * wh + 16 * vb + fq * 4);
            }
            {
                float ra = 0.f, rb = 0.f, ka[8], kb2[8];
#pragma unroll
                for (int e = 0; e < 8; ++e) {
                    ka[e] = 1.0f - __expf(la[e]); kb2[e] = 1.0f - __expf(lb2[e]);
                    *(f32x2*)(sKm + (8 * tq + e) * 132 + d2) = (f32x2){ka[e], kb2[e]};
                    ra += la[e]; la[e] = ra; rb += lb2[e]; lb2[e] = rb;
                }
                *(f32x2*)(sPart + tq * 128 + d2) = (f32x2){ra, rb};
                {
                    const int s_ = tid & 63, pc = tid >> 6;
#pragma unroll
                    for (int e = 0; e < 8; ++e) {
                        sVT[(pc * 8 + e) * 72 + s_] = (bf16_t)((e & 1) ? (vr0[e >> 1] >> 16) : (vr0[e >> 1] & 0xffffu));
                        sVT[(64 + pc * 8 + e) * 72 + s_] = (bf16_t)((e & 1) ? (vr1[e >> 1] >> 16) : (vr1[e >> 1] & 0xffffu));
                    }
                }
                __syncthreads();
                float offa = 0.f, offb = 0.f, tota = 0.f, totb = 0.f;
#pragma unroll
                for (int q = 0; q < 8; ++q) { const f32x2 pq = *(const f32x2*)(sPart + q * 128 + d2); tota += pq[0]; totb += pq[1]; if (q < tq) { offa += pq[0]; offb += pq[1]; } }
                if (tq == 0) { *(f32x2*)(sE + d2) = (f32x2){__expf(tota), __expf(totb)}; }
                u32x4 kwa, kwb;
#pragma unroll
                for (int e = 0; e < 8; e += 2) {
                    const float a0 = la[e] + offa, a1 = la[e + 1] + offa, b0 = lb2[e] + offb, b1 = lb2[e + 1] + offb;
                    *(f32x2*)(sB + (8 * tq + e) * 132 + d2) = (f32x2){a0, b0}; *(f32x2*)(sB + (8 * tq + e + 1) * 132 + d2) = (f32x2){a1, b1};
                    kwa[e >> 1] = cvt_pk_bf16(ka[e] * __expf(tota - a0), ka[e + 1] * __expf(tota - a1));
                    kwb[e >> 1] = cvt_pk_bf16(kb2[e] * __expf(totb - b0), kb2[e + 1] * __expf(totb - b1));
                }
                *(u32x4*)(sKT + d2 * 72 + 8 * tq) = kwa; *(u32x4*)(sKT + (d2 + 1) * 72 + 8 * tq) = kwb;
            }
            __syncthreads();
            if (ch + 1 < sc * 32 + 32) {
                const size_t r1 = row0 + 64;
                const bf16_t* lp = LFb + (r1 + 8 * tq) * 128 + hoff + d2;
#pragma unroll
                for (int e = 0; e < 8; ++e) lfn[e] = *(const unsigned*)(lp + (size_t)e * 128);
                vn0 = *(const u32x4*)(((bf16_t*)(p.ws + OFF_VH)) + (r1 + (tid & 63)) * 128 + hoff + (tid >> 6) * 8);
                vn1 = *(const u32x4*)(((bf16_t*)(p.ws + OFF_VH)) + (r1 + (tid & 63)) * 128 + hoff + 64 + (tid >> 6) * 8);
            }
            if (OUT) {
                const int i = wi, hh = wh, t_ = 16 * i + fr;
                bf16x8 qt[4];
#pragma unroll
                for (int ks = 0; ks < 4; ++ks) {
                    const int d0 = ks * 32 + fq * 8;
                    const f32x4 b0 = *(const f32x4*)(sB + t_ * 132 + d0), b1 = *(const f32x4*)(sB + t_ * 132 + d0 + 4);
                    f32x4 r0 = (f32x4){0.f, 0.f, 0.f, 0.f}, r1 = r0;
                    if (i > 0) { r0 = *(const f32x4*)(sB + (16 * i - 1) * 132 + d0); r1 = *(const f32x4*)(sB + (16 * i - 1) * 132 + d0 + 4); }
                    float qv[8], ql[8];
#pragma unroll
                    for (int e = 0; e < 4; ++e) { qv[2 * e] = bflo(qraw[ks][e]); qv[2 * e + 1] = bfhi(qraw[ks][e]); }
#pragma unroll
                    for (int e = 0; e < 4; ++e) { ql[e] = qv[e] * __expf(b0[e] - r0[e]); ql[4 + e] = qv[4 + e] * __expf(b1[e] - r1[e]); }
                    u32x4 pw; pw.x = cvt_pk_bf16(ql[0], ql[1]); pw.y = cvt_pk_bf16(ql[2], ql[3]); pw.z = cvt_pk_bf16(ql[4], ql[5]); pw.w = cvt_pk_bf16(ql[6], ql[7]);
                    qt[ks] = __builtin_bit_cast(bf16x8, pw);
                    if ((ks >> 1) == hh) {
#pragma unroll
                        for (int e = 0; e < 4; ++e) { ql[e] = qv[e] * __expf(b0[e]); ql[4 + e] = qv[4 + e] * __expf(b1[e]); }
                        u32x4 qw; qw.x = cvt_pk_bf16(ql[0], ql[1]); qw.y = cvt_pk_bf16(ql[2], ql[3]); qw.z = cvt_pk_bf16(ql[4], ql[5]); qw.w = cvt_pk_bf16(ql[6], ql[7]);
                        *(u32x4*)(sQb + t_ * 136 + d0) = qw;
                    }
                }
#pragma unroll
                for (int j2 = 0; j2 < 2; ++j2) {
                    const int j = hh + 2 * j2;
                    if (j <= i) {
                        f32x4 acc = (f32x4){0.f, 0.f, 0.f, 0.f};
                        const int s_ = 16 * j + fr;
#pragma unroll
                        for (int ks = 0; ks < 4; ++ks) {
                            const int d0 = ks * 32 + fq * 8;
                            const f32x4 k0 = *(const f32x4*)(sKm + s_ * 132 + d0), k1 = *(const f32x4*)(sKm + s_ * 132 + d0 + 4);
                            const f32x4 b0 = *(const f32x4*)(sB + s_ * 132 + d0), b1 = *(const f32x4*)(sB + s_ * 132 + d0 + 4);
                            f32x4 r0 = (f32x4){0.f, 0.f, 0.f, 0.f}, r1 = r0;
                            if (i > 0) { r0 = *(const f32x4*)(sB + (16 * i - 1) * 132 + d0); r1 = *(const f32x4*)(sB + (16 * i - 1) * 132 + d0 + 4); }
                            float kl[8];
#pragma unroll
                            for (int e = 0; e < 4; ++e) { kl[e] = k0[e] * __expf(fminf(r0[e] - b0[e], 80.f)); kl[4 + e] = k1[e] * __expf(fminf(r1[e] - b1[e], 80.f)); }
                            u32x4 kw; kw.x = cvt_pk_bf16(kl[0], kl[1]); kw.y = cvt_pk_bf16(kl[2], kl[3]); kw.z = cvt_pk_bf16(kl[4], kl[5]); kw.w = cvt_pk_bf16(kl[6], kl[7]);
                            acc = __builtin_amdgcn_mfma_f32_16x16x32_bf16(qt[ks], __builtin_bit_cast(bf16x8, kw), acc, 0, 0, 0);
                        }
#pragma unroll
                        for (int jj = 0; jj < 4; ++jj) {
                            float vv = acc[jj];
                            if (i == j && fr > fq * 4 + jj) vv = 0.f;
                            sA[(16 * i + fq * 4 + jj) * 72 + 16 * j + fr] = (bf16_t)(cvt_pk_bf16(vv, 0.f) & 0xffffu);
                        }
                    } else {
#pragma unroll
                        for (int jj = 0; jj < 4; ++jj) sA[(16 * i + fq * 4 + jj) * 72 + 16 * j + fr] = (bf16_t)0;
                    }
                }
            }
            __syncthreads();
            if (OUT) {
#pragma unroll
                for (int db = 0; db < 8; ++db) { u32x2 sw; sw.x = cvt_pk_bf16(S[db][0], S[db][1]); sw.y = cvt_pk_bf16(S[db][2], S[db][3]); *(u32x2*)(sST + (16 * w + fr) * 136 + 16 * db + fq * 4) = sw; }
                __syncthreads();
            }
            f32x4 o[4];
            if (OUT) {
                const int i = wi;
#pragma unroll
                for (int vb = 0; vb < 4; ++vb) o[vb] = (f32x4){0.f, 0.f, 0.f, 0.f};
#pragma unroll
                for (int kk = 0; kk < 2; ++kk) {
                    if (kk <= (i >> 1)) {
                        const bf16x8 af = *(const bf16x8*)(sA + (16 * i + fr) * 72 + kk * 32 + fq * 8);
#pragma unroll
                        for (int vb = 0; vb < 4; ++vb) { const bf16x8 vf = *(const bf16x8*)(sVT + (64 * wh + 16 * vb + fr) * 72 + kk * 32 + fq * 8); o[vb] = __builtin_amdgcn_mfma_f32_16x16x32_bf16(vf, af, o[vb], 0, 0, 0); }
                    }
                }
#pragma unroll
                for (int ks = 0; ks < 4; ++ks) {
                    const bf16x8 qf = *(const bf16x8*)(sQb + (16 * i + fr) * 136 + ks * 32 + fq * 8);
#pragma unroll
                    for (int vb = 0; vb < 4; ++vb) { const bf16x8 sf = *(const bf16x8*)(sST + (64 * wh + 16 * vb + fr) * 136 + ks * 32 + fq * 8); o[vb] = __builtin_amdgcn_mfma_f32_16x16x32_bf16(sf, qf, o[vb], 0, 0, 0); }
                }
                float ss = 0.f;
#pragma unroll
                for (int vb = 0; vb < 4; ++vb)
#pragma unroll
                    for (int jj = 0; jj < 4; ++jj) ss += o[vb][jj] * o[vb][jj];
                ss += __shfl_xor(ss, 16); ss += __shfl_xor(ss, 32);
                if (fq == 0) sNrm[wh * 64 + 16 * i + fr] = ss;
            }
#pragma unroll
            for (int db = 0; db < 8; ++db) { const f32x4 e4 = *(const f32x4*)(sE + 16 * db + fq * 4); S[db] = S[db] * e4; }
#pragma unroll
            for (int ks = 0; ks < 2; ++ks) {
                const bf16x8 vf = *(const bf16x8*)(sVT + (16 * w + fr) * 72 + ks * 32 + fq * 8);
#pragma unroll
                for (int db = 0; db < 8; ++db) { const bf16x8 kf = *(const bf16x8*)(sKT + (16 * db + fr) * 72 + ks * 32 + fq * 8); S[db] = __builtin_amdgcn_mfma_f32_16x16x32_bf16(kf, vf, S[db], 0, 0, 0); }
            }
            __syncthreads();
            if (OUT) {
                const int i = wi;
                const float tot = sNrm[16 * i + fr] + sNrm[64 + 16 * i + fr];
                const float rstd = rsqrtf(tot * (1.0f / 128.0f) + 1e-6f);
                bf16_t* op = ((bf16_t*)((unsigned char*)p.h)) + (row0 + 16 * i + fr) * D + h * 128 + 64 * wh + fq * 4;
#pragma unroll
                for (int vb = 0; vb < 4; ++vb) {
                    const f32x4 gn = *(const f32x4*)(ogain + 64 * wh + 16 * vb + fq * 4);
                    const float g0 = bflo(graw[vb].x), g1 = bfhi(graw[vb].x), g2 = bflo(graw[vb].y), g3 = bfhi(graw[vb].y);
                    u32x2 ow; ow.x = cvt_pk_bf16(o[vb][0] * rstd * gn[0] * g0, o[vb][1] * rstd * gn[1] * g1); ow.y = cvt_pk_bf16(o[vb][2] * rstd * gn[2] * g2, o[vb][3] * rstd * gn[3] * g3);
                    *(u32x2*)(op + 16 * vb) = ow;
                }
            }
        }
        if (!OUT) {
            float* sl = ((float*)(p.ws + OFF_SLOC)) + (size_t)(bh * 4 + sc) * 16384;
#pragma unroll
            for (int db = 0; db < 8; ++db) *(f32x4*)(sl + ((w * 8 + db) * 64 + lane) * 4) = S[db];
            if (tid < 128) ((float*)(p.ws + OFF_DLOG))[(bh * 4 + sc) * 128 + tid] = dlacc;
        }
    }
    __syncthreads();
}

__device__ void rec_passA(const Params& p, unsigned char* shm) {
    bf16_t* sKT = (bf16_t*)shm;
    bf16_t* sVT = (bf16_t*)(shm + 34816);
    float* sE = (float*)(shm + 69632);
    float* sPart = (float*)(shm + 70144);
    const int tid = opaque_tid(), lane = tid & 63, w = tid >> 6, fr = lane & 15, fq = lane >> 4;
    const int d2 = (tid & 63) * 2, tq = tid >> 6;
    const int vs = tid & 127, vq = tid >> 7;
    const bf16_t* LFb = (const bf16_t*)(p.ws + OFF_LF); const bf16_t* Vp = (const bf16_t*)(p.ws + OFF_VH);
    for (int task = blockIdx.x; task < 192; task += gridDim.x) {
        const int sc = task % 3, bh = task / 3, b = bh >> 3, h = bh & 7;
        const size_t hoff = (size_t)b * SEQ * 896 + (size_t)h * SEQ * 128;
        f32x4 S[8];
#pragma unroll
        for (int db = 0; db < 8; ++db) S[db] = (f32x4){0.f, 0.f, 0.f, 0.f};
        float dla = 0.f, dlb = 0.f;
        const size_t rbase = (size_t)b * SEQ + (size_t)sc * 2048;
        unsigned lfn[16]; u32x4 vn[4];
        {
            const bf16_t* lp = LFb + (rbase + 16 * tq) * 128 + hoff + d2;
#pragma unroll
            for (int e = 0; e < 16; ++e) lfn[e] = *(const unsigned*)(lp + (size_t)e * 128);
#pragma unroll
            for (int i = 0; i < 4; ++i) vn[i] = *(const u32x4*)(Vp + (rbase + vs) * 128 + hoff + (vq + 4 * i) * 8);
        }
        __syncthreads();
        for (int cc = 0; cc < 16; ++cc) {
            const size_t row0 = rbase + (size_t)cc * 128;
            unsigned lf[16]; u32x4 vr[4];
            float ra = 0.f, rb = 0.f;
#pragma unroll
            for (int e = 0; e < 16; ++e) { lf[e] = lfn[e]; ra += bflo(lf[e]); rb += bfhi(lf[e]); }
#pragma unroll
            for (int i = 0; i < 4; ++i) vr[i] = vn[i];
            *(f32x2*)(sPart + tq * 128 + d2) = (f32x2){ra, rb};
            __syncthreads();
            if (cc + 1 < 16) {
                const bf16_t* lp = LFb + (row0 + 128 + 16 * tq) * 128 + hoff + d2;
#pragma unroll
                for (int e = 0; e < 16; ++e) lfn[e] = *(const unsigned*)(lp + (size_t)e * 128);
#pragma unroll
                for (int i = 0; i < 4; ++i) vn[i] = *(const u32x4*)(Vp + (row0 + 128 + vs) * 128 + hoff + (vq + 4 * i) * 8);
            }
            float ba = 0.f, bb = 0.f, tota = 0.f, totb = 0.f;
#pragma unroll
            for (int q = 0; q < 8; ++q) { const f32x2 pq = *(const f32x2*)(sPart + q * 128 + d2); tota += pq[0]; totb += pq[1]; if (q < tq) { ba += pq[0]; bb += pq[1]; } }
            if (tq == 0) { *(f32x2*)(sE + d2) = (f32x2){__expf(tota), __expf(totb)}; dla += tota; dlb += totb; }
#pragma unroll
            for (int g8 = 0; g8 < 2; ++g8) {
                u32x4 kwa, kwb;
#pragma unroll
                for (int e = 0; e < 8; e += 2) {
                    const float la0 = bflo(lf[8 * g8 + e]), lb0 = bfhi(lf[8 * g8 + e]), la1 = bflo(lf[8 * g8 + e + 1]), lb1 = bfhi(lf[8 * g8 + e + 1]);
                    const float a0 = ba + la0, a1 = a0 + la1; ba = a1;
                    const float b0 = bb + lb0, b1 = b0 + lb1; bb = b1;
                    kwa[e >> 1] = cvt_pk_bf16((1.0f - __expf(la0)) * __expf(tota - a0), (1.0f - __expf(la1)) * __expf(tota - a1));
                    kwb[e >> 1] = cvt_pk_bf16((1.0f - __expf(lb0)) * __expf(totb - b0), (1.0f - __expf(lb1)) * __expf(totb - b1));
                }
                *(u32x4*)(sKT + d2 * 136 + 16 * tq + 8 * g8) = kwa; *(u32x4*)(sKT + (d2 + 1) * 136 + 16 * tq + 8 * g8) = kwb;
            }
#pragma unroll
            for (int i = 0; i < 4; ++i)
#pragma unroll
                for (int e = 0; e < 8; ++e) sVT[((vq + 4 * i) * 8 + e) * 136 + vs] = (bf16_t)((e & 1) ? (vr[i][e >> 1] >> 16) : (vr[i][e >> 1] & 0xffffu));
            __syncthreads();
#pragma unroll
            for (int db = 0; db < 8; ++db) { const f32x4 e4 = *(const f32x4*)(sE + 16 * db + fq * 4); S[db] = S[db] * e4; }
#pragma unroll
            for (int ks = 0; ks < 4; ++ks) {
                const bf16x8 vf = *(const bf16x8*)(sVT + (16 * w + fr) * 136 + ks * 32 + fq * 8);
#pragma unroll
                for (int db = 0; db < 8; ++db) { const bf16x8 kf = *(const bf16x8*)(sKT + (16 * db + fr) * 136 + ks * 32 + fq * 8); S[db] = __builtin_amdgcn_mfma_f32_16x16x32_bf16(kf, vf, S[db], 0, 0, 0); }
            }
        }
        float* sl = (float*)(p.ws + OFF_SLOC) + (size_t)(bh * 4 + sc) * 16384;
#pragma unroll
        for (int db = 0; db < 8; ++db) *(f32x4*)(sl + ((w * 8 + db) * 64 + lane) * 4) = S[db];
        if (tq == 0) *(f32x2*)((float*)(p.ws + OFF_DLOG) + (bh * 4 + sc) * 128 + d2) = (f32x2){dla, dlb};
    }
    __syncthreads();
}

__device__ void attn_phase(const Params& p, int jl, unsigned char* shm) {
    bf16_t* sK = (bf16_t*)shm;
    bf16_t* sVT = sK + 2 * 9216;
    float* sB = (float*)(sVT + 2 * 8704);
    const int tid = opaque_tid(), lane = tid & 63, w = tid >> 6, fr = lane & 15, fq = lane >> 4;
    const int cq = w >> 1, half = w & 1;
    const float LOG2E = 1.4426950408889634f;
    const int skey = tid >> 3, spiece = tid & 7, vkey = tid & 63, vpiece = tid >> 6;
    const bf16_t* Kg = (const bf16_t*)(p.ws + OFF_KB); const bf16_t* Vg = (const bf16_t*)(p.ws + OFF_VB); const bf16_t* Qg = (const bf16_t*)((unsigned char*)p.h + ACTB);
    for (int task = blockIdx.x; task < 4096; task += gridDim.x) {
        const int g = task & 31, h = (task >> 5) & 15, b = task >> 9;
        const int c = 4 * g + cq;
        const int dt0 = (2 * g - 4 > 0) ? 2 * g - 4 : 0, dt1 = 2 * g + 1;
        __syncthreads();
        for (int i = tid; i < 384; i += 512) { int r = i - 64; r = r < 0 ? 0 : (r > 319 ? 319 : r); sB[i] = p.in[18][((size_t)jl * 320 + r) * 16 + h] * LOG2E; }
        bf16x8 qf[2][2];
        {
            const bf16_t* qp = Qg + ((size_t)b * SEQ + c * 64 + half * 32) * D + h * 64;
#pragma unroll
            for (int qb = 0; qb < 2; ++qb)
#pragma unroll
                for (int ks = 0; ks < 2; ++ks) qf[qb][ks] = *(const bf16x8*)(qp + (size_t)(qb * 16 + fr) * D + ks * 32 + fq * 8);
        }
        f32x4 oacc[4][2];
#pragma unroll
        for (int db = 0; db < 4; ++db)
#pragma unroll
            for (int qb = 0; qb < 2; ++qb) oacc[db][qb] = (f32x4){0.f, 0.f, 0.f, 0.f};
        float mrun[2] = {0.f, 0.f}, lrun[2] = {0.f, 0.f};
        bool first = true;
        u32x4 kreg[2], vreg[2];
        const size_t tokb = (size_t)b * SEQ;
        const size_t hoffk = (size_t)b * SEQ * 960 + (size_t)h * SEQ * 64;
#define ATT_GLOAD(dt_) do { _Pragma("unroll") for (int hf_ = 0; hf_ < 2; ++hf_) { \
            kreg[hf_] = *(const u32x4*)(Kg + (tokb + (size_t)(dt_) * 128 + hf_ * 64 + skey) * 64 + hoffk + spiece * 8); \
            vreg[hf_] = *(const u32x4*)(Vg + (tokb + (size_t)(dt_) * 128 + hf_ * 64 + vkey) * 64 + hoffk + vpiece * 8); } } while (0)
#define ATT_LSTORE(buf_) do { _Pragma("unroll") for (int hf_ = 0; hf_ < 2; ++hf_) { \
            *(u32x4*)(sK + (buf_) * 9216 + (hf_ * 64 + skey) * 72 + spiece * 8) = kreg[hf_]; \
            bf16_t* vt_ = sVT + (buf_) * 8704 + (vpiece * 8) * 136 + hf_ * 64 + vkey; \
            _Pragma("unroll") for (int e_ = 0; e_ < 8; ++e_) vt_[e_ * 136] = (bf16_t)((e_ & 1) ? (vreg[hf_][e_ >> 1] >> 16) : (vreg[hf_][e_ >> 1] & 0xffffu)); } } while (0)
        ATT_GLOAD(dt0); ATT_LSTORE(0);
        __syncthreads();
        for (int dt = dt0; dt <= dt1; ++dt) {
            const int buf = (dt - dt0) & 1;
            if (dt < dt1) ATT_GLOAD(dt + 1);
            const bool act0 = (2 * dt >= c - 8) && (2 * dt <= c), act1 = (2 * dt + 1 >= c - 8) && (2 * dt + 1 <= c);
            if (act0 || act1) {
                const bf16_t* kb_ = sK + buf * 9216; const bf16_t* vb_ = sVT + buf * 8704;
                f32x4 sacc[2][4][2];
                const float b0 = sB[0];
#pragma unroll
                for (int hf = 0; hf < 2; ++hf) {
                    if (hf == 0 ? act0 : act1) {
                        const float cb = (2 * dt + hf - c <= -5) ? b0 : 0.f;
#pragma unroll
                        for (int kb = 0; kb < 4; ++kb)
#pragma unroll
                            for (int qb = 0; qb < 2; ++qb) { const float iv = cb - mrun[qb]; sacc[hf][kb][qb] = (f32x4){iv, iv, iv, iv}; }
#pragma unroll
                        for (int kb = 0; kb < 4; ++kb)
#pragma unroll
                            for (int ks = 0; ks < 2; ++ks) {
                                const bf16x8 kf = *(const bf16x8*)(kb_ + (hf * 64 + kb * 16 + fr) * 72 + ks * 32 + fq * 8);
#pragma unroll
                                for (int qb = 0; qb < 2; ++qb) sacc[hf][kb][qb] = __builtin_amdgcn_mfma_f32_16x16x32_bf16(kf, qf[qb][ks], sacc[hf][kb][qb], 0, 0, 0);
                            }
                    }
                }
                float mx[2] = {-3e38f, -3e38f};
#pragma unroll
                for (int hf = 0; hf < 2; ++hf) {
                    if (hf == 0 ? act0 : act1) {
                        const int dk = 2 * dt + hf - c;
                        if (dk > -5) {
                            const float* bp = sB + (dk * 64 + fq * 4 - half * 32 - fr + 256 + 64 - 16);
#pragma unroll
                            for (int kb = 0; kb < 4; ++kb)
#pragma unroll
                                for (int qb = 0; qb < 2; ++qb)
#pragma unroll
                                    for (int j = 0; j < 4; ++j) sacc[hf][kb][qb][j] += bp[kb * 16 + j - qb * 16 + 16];
                        }
#pragma unroll
                        for (int qb = 0; qb < 2; ++qb)
#pragma unroll
                            for (int kb = 0; kb < 4; ++kb)
#pragma unroll
                                for (int j = 0; j < 4; ++j) mx[qb] = fmaxf(mx[qb], sacc[hf][kb][qb][j]);
                    }
                }
                if (first || __any((mx[0] > 6.0f) || (mx[1] > 6.0f))) {
#pragma unroll
                    for (int qb = 0; qb < 2; ++qb) {
                        float m2 = fmaxf(mx[qb], __shfl_xor(mx[qb], 16)); m2 = fmaxf(m2, __shfl_xor(m2, 32));
                        const float delta = first ? m2 : fmaxf(m2, 0.f), corr = first ? 1.0f : __builtin_amdgcn_exp2f(-delta);
                        mrun[qb] += delta; lrun[qb] *= corr;
#pragma unroll
                        for (int db = 0; db < 4; ++db) oacc[db][qb] = oacc[db][qb] * corr;
#pragma unroll
                        for (int hf = 0; hf < 2; ++hf)
#pragma unroll
                            for (int kb = 0; kb < 4; ++kb) sacc[hf][kb][qb] = sacc[hf][kb][qb] - delta;
                    }
                    first = false;
                }
#pragma unroll
                for (int hf = 0; hf < 2; ++hf) {
                    if (hf == 0 ? act0 : act1) {
                        bf16x8 pf[2][2];
#pragma unroll
                        for (int qb = 0; qb < 2; ++qb) {
                            float ps = 0.f;
#pragma unroll
                            for (int kb = 0; kb < 4; ++kb)
#pragma unroll
                                for (int j = 0; j < 4; ++j) { const float pv = __builtin_amdgcn_exp2f(sacc[hf][kb][qb][j]); sacc[hf][kb][qb][j] = pv; ps += pv; }
                            lrun[qb] += ps;
#pragma unroll
                            for (int kk = 0; kk < 2; ++kk) {
                                u32x4 pw;
                                pw.x = cvt_pk_bf16(sacc[hf][2 * kk][qb][0], sacc[hf][2 * kk][qb][1]); pw.y = cvt_pk_bf16(sacc[hf][2 * kk][qb][2], sacc[hf][2 * kk][qb][3]);
                                pw.z = cvt_pk_bf16(sacc[hf][2 * kk + 1][qb][0], sacc[hf][2 * kk + 1][qb][1]); pw.w = cvt_pk_bf16(sacc[hf][2 * kk + 1][qb][2], sacc[hf][2 * kk + 1][qb][3]);
                                pf[qb][kk] = __builtin_bit_cast(bf16x8, pw);
                            }
                        }
#pragma unroll
                        for (int db = 0; db < 4; ++db)
#pragma unroll
                            for (int kk = 0; kk < 2; ++kk) {
                                const u32x2 lo = *(const u32x2*)(vb_ + (db * 16 + fr) * 136 + hf * 64 + (2 * kk) * 16 + fq * 4);
                                const u32x2 hi = *(const u32x2*)(vb_ + (db * 16 + fr) * 136 + hf * 64 + (2 * kk + 1) * 16 + fq * 4);
                                u32x4 vw; vw.x = lo.x; vw.y = lo.y; vw.z = hi.x; vw.w = hi.y;
                                const bf16x8 vf = __builtin_bit_cast(bf16x8, vw);
#pragma unroll
                                for (int qb = 0; qb < 2; ++qb) oacc[db][qb] = __builtin_amdgcn_mfma_f32_16x16x32_bf16(vf, pf[qb][kk], oacc[db][qb], 0, 0, 0);
                            }
                    }
                }
            }
            if (dt < dt1) ATT_LSTORE(buf ^ 1);
            __syncthreads();
        }
#undef ATT_GLOAD
#undef ATT_LSTORE
#pragma unroll
        for (int qb = 0; qb < 2; ++qb) {
            float lt = lrun[qb]; lt += __shfl_xor(lt, 16); lt += __shfl_xor(lt, 32);
            const float inv = 1.0f / lt;
            bf16_t* op = (bf16_t*)((unsigned char*)p.h) + (tokb + c * 64 + half * 32 + qb * 16 + fr) * D + h * 64 + fq * 4;
#pragma unroll
            for (int db = 0; db < 4; ++db) {
                u32x2 ow; ow.x = cvt_pk_bf16(oacc[db][qb][0] * inv, oacc[db][qb][1] * inv); ow.y = cvt_pk_bf16(oacc[db][qb][2] * inv, oacc[db][qb][3] * inv);
                *(u32x2*)(op + db * 16) = ow;
            }
        }
    }
    __syncthreads();
}

#ifndef REP_ATTN
#define REP_ATTN 1
#endif
#ifndef REP_REC
#define REP_REC 1
#endif
#ifndef REP_NORM
#define REP_NORM 1
#endif
#ifndef REP_SYNC
#define REP_SYNC 1
#endif
#ifndef REP_PREP
#define REP_PREP 1
#endif
#ifndef REP_G3
#define REP_G3 1
#endif
#define GSYNC() do { for (int r_ = 0; r_ < REP_SYNC; ++r_) xcd_barrier(xb); } while (0)
__global__ void __launch_bounds__(512, 2) yoco_fwd(Params p) {
    extern __shared__ __attribute__((aligned(16))) unsigned char shm[];
    cg::grid_group grid = cg::this_grid();
    {
        const int t0 = threadIdx.x;
        if ((t0 & 63) == 0) *(volatile LAS int*)(LAS unsigned char*)(shm + WAVE_TAB_OFF + 4 * hw_wave_slot()) = t0 >> 6;
        __syncthreads();
    }
    const int tid0 = opaque_tid();
    unsigned* barw = (unsigned*)(p.ws + OFF_BAR);
    for (int i = blockIdx.x * 512 + tid0; i < XCD_BAR_WORDS; i += gridDim.x * 512) barw[i] = 0u;
    {
        u32x4* z = (u32x4*)(p.ws + OFF_ROWSS); const int nz = (int)((8 * (size_t)MTOK * 8) / 16);
        for (int i = blockIdx.x * 512 + tid0; i < nz; i += gridDim.x * 512) z[i] = (u32x4){0u, 0u, 0u, 0u};
    }
    volatile LAS unsigned* xst = (volatile LAS unsigned*)(LAS unsigned char*)(shm + LDS_BYTES - 16);
    if (tid0 == 0) { xst[0] = 0u; xst[1] = 0u; }
    for (int r = 0; r < REP_PREP; ++r) prep_phase(p, shm);
    grid.sync();
    XcdBarrier xb = xcd_barrier_post(barw, xst);
    {
        const float* mv = (const float*)(p.ws + OFF_MODV);
        for (int r = 0; r < REP_NORM; ++r) norm_phase(p.in[0], (bf16_t*)((unsigned char*)p.h), p.in[4], mv, mv + D, 6144, nullptr, nullptr, nullptr, nullptr, 0);
    }
    GSYNC();
    for (int l = 0; l < 4; ++l) {
        const float* hsrc = (l == 0) ? p.in[0] : p.h;
        const float* mv = (const float*)(p.ws + OFF_MODV) + (size_t)l * 8 * 6144;
        bf16_t* UF = (l < 2) ? (bf16_t*)(p.ws + OFF_UF_A) : (bf16_t*)((unsigned char*)p.h + ACTB);
        if (l < 2) {
            pg8::EpiHgrnIn e; e.QVG = (bf16_t*)(p.ws + OFF_QH); e.LF = (bf16_t*)(p.ws + OFF_LF); e.lb = (const float*)(p.ws + OFF_LBV) + l * D;
            run_gemm(shm, (const bf16_t*)((unsigned char*)p.h), (const bf16_t*)(p.ws + OFF_WB_A_IN) + (size_t)l * AIN * D, AIN, D, e);
            GSYNC();
            for (int r = 0; r < REP_REC; ++r) rec_passA(p, shm);
            GSYNC();
            for (int r = 0; r < REP_REC; ++r) rec_pass<true>(p, l, shm);
        } else {
            if (l == 2) { pg8::EpiBf16Split e; e.d0 = (bf16_t*)(p.ws + OFF_KB); e.scale = 1.0f; e.hm = 1;
                run_gemm(shm, (const bf16_t*)((unsigned char*)p.h + ACTB), (const bf16_t*)(p.ws + OFF_WB_KV), 2048, D, e);
                GSYNC(); }
            { pg8::EpiBf16Split e; e.d0 = (bf16_t*)((unsigned char*)p.h + ACTB); e.hm = 0; e.scale = 0.125f * 1.4426950408889634f;   run_gemm(shm, (const bf16_t*)((unsigned char*)p.h), (const bf16_t*)(p.ws + OFF_WB_Q) + (size_t)(l - 2) * D * D, D, D, e); }
            GSYNC();
            for (int r = 0; r < REP_ATTN; ++r) attn_phase(p, l - 2, shm);
        }
        GSYNC();
        {
            pg8::EpiResid e; e.in = p.in; e.ws = p.ws; e.hbuf = p.h; e.l = l; e.which = 0;
            run_gemm(shm, (const bf16_t*)((unsigned char*)p.h), (l < 2) ? (const bf16_t*)(p.ws + OFF_WB_A_OUT) + (size_t)l * D * D : (const bf16_t*)(p.ws + OFF_WB_O) + (size_t)(l - 2) * D * D, D, D, e);
        }
        GSYNC();
        for (int r = 0; r < REP_G3; ++r) { pg8::EpiSwiglu e; e.act = (bf16_t*)(p.ws + OFF_ACT); run_gemm(shm, UF, (const bf16_t*)(p.ws + OFF_WB_FFN_IN) + (size_t)l * 2 * FFN * D, 2 * FFN, D, e); }
        GSYNC();
        {
            pg8::EpiResid e; e.in = p.in; e.ws = p.ws; e.hbuf = p.h; e.l = l; e.which = 1;
            run_gemm(shm, (const bf16_t*)(p.ws + OFF_ACT), (const bf16_t*)(p.ws + OFF_WB_FFN_OUT) + (size_t)l * D * FFN, D, FFN, e);
        }
        if (l < 3) GSYNC();
    }
}

extern "C" void kernel_launch(void* const* d_in, const int* in_sizes, int n_in, void* d_out, int out_size, void* d_ws, size_t ws_size, hipStream_t stream) {
    static int grid_blocks = 0;
    if (!grid_blocks) {
        int dev = 0, cus = 0, per_cu = 0;
        hipGetDevice(&dev);
        hipDeviceGetAttribute(&cus, hipDeviceAttributeMultiprocessorCount, dev);
        hipFuncSetAttribute((const void*)yoco_fwd, hipFuncAttributeMaxDynamicSharedMemorySize, LDS_BYTES);
        hipOccupancyMaxActiveBlocksPerMultiprocessor(&per_cu, (const void*)yoco_fwd, 512, LDS_BYTES);
        if (per_cu < 1) per_cu = 1;
        grid_blocks = cus * per_cu;
        (void)hipGetLastError();
    }
    Params p{};
    for (int i = 0; i < 20; ++i) p.in[i] = (const float*)d_in[i];
    p.h = (float*)d_out; p.ws = (unsigned char*)d_ws;
    if (ws_size < WS_END || n_in != 20) { fprintf(stderr, "kernel_launch: workspace too small (%zu < %zu) or unexpected inputs\n", ws_size, (size_t)WS_END); return; }
    void* args[] = {&p};
    hipError_t e = hipLaunchCooperativeKernel((const void*)yoco_fwd, dim3(grid_blocks), dim3(512), args, LDS_BYTES, stream);
    if (e != hipSuccess) fprintf(stderr, "cooperative launch failed: %s (grid %d)\n", hipGetErrorString(e), grid_blocks);
}
```

```cpp
#include <hip/hip_runtime.h>
#include <hip/hip_cooperative_groups.h>
#include <cstdio>
namespace cg = cooperative_groups;

#define LAS __attribute__((address_space(3)))
typedef unsigned short bf16_t;
typedef short bf16x8 __attribute__((ext_vector_type(8)));
typedef float f32x4 __attribute__((ext_vector_type(4)));
typedef unsigned u32x4 __attribute__((ext_vector_type(4)));
typedef unsigned u32x2 __attribute__((ext_vector_type(2)));
typedef float f32x2 __attribute__((ext_vector_type(2)));

constexpr int D = 1024, BATCH = 8, SEQ = 8192, MTOK = BATCH * SEQ, FFN = 2816, AIN = 4096;
constexpr int LDS_BYTES = 144 * 1024;
constexpr int XCD_BAR_WORDS_C = 3456;

__device__ __forceinline__ unsigned cvt_pk_bf16(float lo, float hi) { unsigned r; asm volatile("v_cvt_pk_bf16_f32 %0, %1, %2" : "=v"(r) : "v"(lo), "v"(hi)); return r; }
__device__ __forceinline__ float bf2f(unsigned short h) { return __uint_as_float((unsigned)h << 16); }
__device__ __forceinline__ float bflo(unsigned w) { return __uint_as_float(w << 16); }
__device__ __forceinline__ float bfhi(unsigned w) { return __uint_as_float(w & 0xffff0000u); }
__device__ __forceinline__ float silu_f(float x) { return x * __builtin_amdgcn_rcpf(1.0f + __expf(-x)); }

constexpr int WAVE_TAB_OFF = LDS_BYTES - 16 - 256;
__device__ __forceinline__ unsigned hw_wave_slot() { return (unsigned)__builtin_amdgcn_s_getreg(((6 - 1) << 11) | 4); }
__device__ __forceinline__ int opaque_tid() {
    extern __shared__ __attribute__((aligned(16))) unsigned char shm_tid_[];
    const int wv = __builtin_amdgcn_readfirstlane(*(volatile LAS int*)(LAS unsigned char*)(shm_tid_ + WAVE_TAB_OFF + 4 * hw_wave_slot()));
    int lane_;
    asm volatile("v_mbcnt_lo_u32_b32 %0, -1, 0\n\tv_mbcnt_hi_u32_b32 %0, -1, %0" : "=&v"(lane_));
    int t = wv * 64 + lane_;
    asm volatile("" : "+v"(t)); return t;
}
struct Params { const float* in[20]; float* h; unsigned char* ws; };
constexpr size_t ACTB = (size_t)MTOK * D * 2;
constexpr size_t OFF_WB_A_IN = 0;
constexpr size_t OFF_WB_A_OUT = OFF_WB_A_IN + (size_t)2 * AIN * D * 2;
constexpr size_t OFF_WB_FFN_IN = OFF_WB_A_OUT + (size_t)2 * D * D * 2;
constexpr size_t OFF_WB_FFN_OUT = OFF_WB_FFN_IN + (size_t)4 * 2 * FFN * D * 2;
constexpr size_t OFF_WB_KV = OFF_WB_FFN_OUT + (size_t)4 * D * FFN * 2;
constexpr size_t OFF_WB_Q = OFF_WB_KV + (size_t)2 * D * D * 2;
constexpr size_t OFF_WB_O = OFF_WB_Q + (size_t)2 * D * D * 2;
constexpr size_t OFF_MODV = OFF_WB_O + (size_t)2 * D * D * 2;
constexpr size_t OFF_KVMOD = OFF_MODV + (size_t)4 * 8 * 6144 * 4;
constexpr size_t OFF_LBV = OFF_KVMOD + (size_t)8 * 2048 * 4;
constexpr size_t OFF_U = OFF_LBV + (size_t)2 * D * 4;
constexpr size_t OFF_H = OFF_U;
constexpr size_t OFF_R = OFF_U + ACTB;
constexpr size_t OFF_QH = OFF_R, OFF_VH = OFF_R + ACTB, OFF_GH = OFF_R + 2 * ACTB, OFF_LF = OFF_R + 3 * ACTB;
constexpr size_t OFF_ACT = OFF_R;
constexpr size_t OFF_UF_A = OFF_R + 4 * ACTB;
constexpr size_t OFF_KB = OFF_R + (size_t)MTOK * FFN * 2, OFF_VB = OFF_KB + ACTB, OFF_QB = OFF_VB + ACTB;
constexpr size_t OFF_SLOC = OFF_R + 5 * ACTB, OFF_DLOG = OFF_SLOC + (size_t)256 * 16384 * 4;
constexpr size_t OFF_BAR = OFF_QB + ACTB;
constexpr size_t OFF_ROWSS = OFF_BAR + (size_t)16384;
constexpr size_t WS_END = OFF_ROWSS + (size_t)8 * MTOK * 8;


#define XB_TMO      128
#define XB_XCNT(j)  (256  + 64 * (j))
#define XB_XSUB(j)  (1280 + 64 * (j))
#define XB_XGEN(j)  (2304 + 64 * (j))
#define XB_TOP      3328
#define XB_TOPGEN   3392
#define XCD_BAR_WORDS 3456
#define XB_SPIN_CAP (1u << 18)
__device__ __forceinline__ unsigned xb_ld(unsigned* p)              { return __hip_atomic_load(p, __ATOMIC_RELAXED, __HIP_MEMORY_SCOPE_AGENT); }
__device__ __forceinline__ unsigned xb_add(unsigned* p, unsigned v) { return __hip_atomic_fetch_add(p, v, __ATOMIC_RELAXED, __HIP_MEMORY_SCOPE_AGENT); }
__device__ __forceinline__ unsigned xb_xcc_id() { return (unsigned)__builtin_amdgcn_s_getreg((3 << 11) | 20) & 0xFu; }
#define XB_SPIN(cond, bar) do { unsigned _sp = 0; while (cond) { __builtin_amdgcn_s_sleep(1); \
    if ((++_sp & 255u) == 0u) { if (xb_ld(&(bar)[XB_TMO])) break; if (_sp > XB_SPIN_CAP) { atomicAdd(&(bar)[XB_TMO], 1u); break; } } } } while (0)
struct XcdBarrier { unsigned* bar; unsigned x; volatile LAS unsigned* st; };
__device__ __forceinline__ XcdBarrier xcd_barrier_post(unsigned* bar, volatile LAS unsigned* st) {
    XcdBarrier b; b.bar = bar; b.x = xb_xcc_id(); b.st = st;
    if (opaque_tid() == 0) (void)xb_add(&bar[XB_XCNT(b.x)], 1u);
    return b;
}
__device__ __forceinline__ void xcd_barrier_complete(unsigned* bar, unsigned x, unsigned& nloc, unsigned& nx) {
    const unsigned G = gridDim.x * gridDim.y * gridDim.z;
    unsigned sum, cnt, mine, sp = 0u;
    for (;;) {
        sum = 0u; cnt = 0u; mine = 0u;
#pragma unroll
        for (unsigned j = 0; j < 16; ++j) { const unsigned c = xb_ld(&bar[XB_XCNT(j)]); sum += c; cnt += (c > 0u) ? 1u : 0u; mine = (j == x) ? c : mine; }
        if (sum == G) break;
        __builtin_amdgcn_s_sleep(1);
        if ((++sp & 255u) == 0u) { if (xb_ld(&bar[XB_TMO])) break; if (sp > XB_SPIN_CAP) { atomicAdd(&bar[XB_TMO], 1u); break; } }
    }
    nloc = mine > 0u ? mine : 1u; nx = cnt > 0u ? cnt : 1u;
}
__device__ __forceinline__ void xcd_barrier(const XcdBarrier& b) {
    asm volatile("s_waitcnt vmcnt(0)" ::: "memory");
    __syncthreads();
    if (opaque_tid() == 0) {
        unsigned* bar = b.bar;
        __builtin_amdgcn_s_waitcnt(0);
        unsigned nloc = b.st[0], nx = b.st[1];
        if (nloc == 0u) { xcd_barrier_complete(bar, b.x, nloc, nx); b.st[0] = nloc; b.st[1] = nx; }
        const unsigned old = xb_add(&bar[XB_XSUB(b.x)], 1u);
        const unsigned gen = old / nloc;
        if (old + 1u == (gen + 1u) * nloc) {
            __builtin_amdgcn_fence(__ATOMIC_RELEASE, "agent");
            asm volatile("s_waitcnt vmcnt(0)" ::: "memory");
            const unsigned og = xb_add(&bar[XB_TOP], 1u);
            const unsigned tg = og / nx;
            if (og + 1u == (tg + 1u) * nx) xb_add(&bar[XB_TOPGEN], 1u);
            else XB_SPIN(xb_ld(&bar[XB_TOPGEN]) == tg, bar);
            __builtin_amdgcn_fence(__ATOMIC_ACQUIRE, "agent");
            xb_add(&bar[XB_XGEN(b.x)], 1u);
            asm volatile("s_waitcnt vmcnt(0)" ::: "memory");
        } else {
            XB_SPIN(xb_ld(&bar[XB_XGEN(b.x)]) == gen, bar);
            __builtin_amdgcn_fence(__ATOMIC_ACQUIRE, "agent");
            asm volatile("s_waitcnt vmcnt(0)" ::: "memory");
        }
    }
    __syncthreads();
}

namespace pg8 {
constexpr int BM = 256, BK = 64, HALF = 128, HTB = HALF * BK * 2, STAGE_BYTES = 8 * HTB, NXCD = 8, WGM = 8;
__device__ __forceinline__ int lds_byte(int r, int c) { const int st = (r >> 4) * 2 + (c >> 5), rr = r & 15, cc = c & 31, ob = rr * 64 + cc * 2; return st * 1024 + (ob ^ (((ob >> 9) & 1) << 5)); }
__device__ __forceinline__ void stage_rc(int b, int& R, int& C) { const int st = b / 1024, sb = b % 1024, swz = sb ^ (((sb >> 9) & 1) << 5); R = (st >> 1) * 16 + swz / 64; C = (st & 1) * 32 + (swz % 64) / 2; }
__device__ __forceinline__ int perm32(int rho) { const int n = rho >> 4, i = rho & 15; return 8 * (i >> 2) + 4 * n + (i & 3); }
struct Unit { int pm, pn; };
struct Gemm { const bf16_t* A; const bf16_t* Bt; int M, N, K; };
struct StaticOrder {
    int nM, nN, nwg, G, c;
    __device__ void init(int M, int N, int G_, int c_) { nM = M / BM; nN = N / BM; nwg = nM * nN; G = G_; c = c_; }
    __device__ bool next(int i, Unit& u) const {
        const long L = (long)i * G + c; if (L >= nwg) return false;
        int wgid = (int)L; { const int q = nwg / NXCD, r = nwg % NXCD, xcd = wgid % NXCD, off = wgid / NXCD; wgid = (xcd < r ? xcd * (q + 1) : r * (q + 1) + (xcd - r) * q) + off; }
        const int nig = WGM * nN, gid = wgid / nig, fm = gid * WGM, gsz = (nM - fm) < WGM ? (nM - fm) : WGM;
        u.pm = fm + ((wgid % nig) % gsz); u.pn = (wgid % nig) / gsz; return true;
    }
};

template <class Epi>
__device__ __forceinline__ void gemm_phase(LAS unsigned char* lds, const Gemm g, const StaticOrder& S, const Epi& E) {
    const int tid = opaque_tid(), wid = __builtin_amdgcn_readfirstlane(tid >> 6), lane = tid & 63, wr = wid >> 2, wc = wid & 3, fr = lane & 15, fq = lane >> 4;
    const int K = g.K, nt = K / BK;
    unsigned voffA[2], voffB[2];
#pragma unroll
    for (int i = 0; i < 2; ++i) { int R, C; stage_rc(tid * 16 + i * 8192, R, C); const int Rb = Epi::PERM ? ((R & ~31) + perm32(R & 31)) : R;
        voffA[i] = (unsigned)(R * K + C) * 2u; voffB[i] = (unsigned)(Rb * K + C) * 2u; }
    const size_t kstep = (size_t)(BK * 2);
    const size_t hstep = (size_t)HALF * K * 2;
    const size_t tstep = 2 * hstep;
    const unsigned ldsw = (unsigned)wid * 1024u;
    const int aoff = lds_byte(wr * 64 + fr, fq * 8), boff = lds_byte(wc * 32 + fr, fq * 8);
#define PG8_SA(b, h) (((b) * 2 + (h)) * HTB)
#define PG8_SB(b, h) ((4 + (b) * 2 + (h)) * HTB)
#define PG8_STAGE(bufoff, gbase, voff) do { _Pragma("unroll") for (int _i = 0; _i < 2; ++_i) \
        __builtin_amdgcn_global_load_lds((const unsigned*)((const char*)(gbase) + (voff)[_i]), (LAS unsigned*)(lds + (bufoff) + ldsw + _i * 8192), 16, 0, 0); } while (0)
#define PG8_LDA(dst, b, h) do { _Pragma("unroll") for (int m = 0; m < 4; ++m) _Pragma("unroll") for (int k = 0; k < 2; ++k) dst[m][k] = *(const LAS bf16x8*)(lds + PG8_SA(b, h) + aoff + m * 2048 + k * 1024); } while (0)
#define PG8_LDB(dst, b, h) do { _Pragma("unroll") for (int n = 0; n < 2; ++n) _Pragma("unroll") for (int k = 0; k < 2; ++k) dst[n][k] = *(const LAS bf16x8*)(lds + PG8_SB(b, h) + boff + n * 2048 + k * 1024); } while (0)
#define PG8_MMA(ai, bj, At, Bt) do { __builtin_amdgcn_s_setprio(1); _Pragma("unroll") for (int m = 0; m < 4; ++m) _Pragma("unroll") for (int n = 0; n < 2; ++n) _Pragma("unroll") for (int k = 0; k < 2; ++k) \
        acc[ai][bj][m][n] = __builtin_amdgcn_mfma_f32_16x16x32_bf16(Bt[n][k], At[m][k], acc[ai][bj][m][n], 0, 0, 0); __builtin_amdgcn_s_setprio(0); } while (0)
#define PG8_WAIT_V(n) asm volatile("s_waitcnt vmcnt(" #n ")" ::: "memory")
#define PG8_WAIT_L(n) asm volatile("s_waitcnt lgkmcnt(" #n ")" ::: "memory")
#define PG8_BAR __builtin_amdgcn_s_barrier()
#define PG8_SCHED __builtin_amdgcn_sched_barrier(0)
    Unit cur, nxt; int ui = 0;
    if (!S.next(0, cur)) return;
    f32x4 acc[2][2][4][2];
#pragma unroll
    for (int a = 0; a < 2; ++a)
#pragma unroll
        for (int b = 0; b < 2; ++b)
#pragma unroll
            for (int m = 0; m < 4; ++m)
#pragma unroll
                for (int n = 0; n < 2; ++n) acc[a][b][m][n] = (f32x4){0.f, 0.f, 0.f, 0.f};
    bf16x8 At[4][2], B0[2][2], B1[2][2];
    const char* cA = (const char*)g.A + (size_t)cur.pm * tstep; const char* cB = (const char*)g.Bt + (size_t)cur.pn * tstep;
    PG8_STAGE(PG8_SB(0, 0), cB, voffB); PG8_STAGE(PG8_SA(0, 0), cA, voffA); PG8_STAGE(PG8_SB(0, 1), cB + hstep, voffB); PG8_STAGE(PG8_SA(0, 1), cA + hstep, voffA);
    if (wr == 1) PG8_BAR;
    PG8_WAIT_V(4); PG8_BAR;
    PG8_STAGE(PG8_SB(1, 0), cB + kstep, voffB); PG8_STAGE(PG8_SA(1, 0), cA + kstep, voffA); PG8_STAGE(PG8_SB(1, 1), cB + hstep + kstep, voffB);
    PG8_WAIT_V(6); PG8_BAR;
    for (;;) {
        const bool has_next = S.next(ui + 1, nxt);
        const char* nA = has_next ? (const char*)g.A + (size_t)nxt.pm * tstep : cA; const char* nB = has_next ? (const char*)g.Bt + (size_t)nxt.pn * tstep : cB;
        for (int t = 0; t < nt; t += 2) {
            const bool last = (t == nt - 2);
            const char* a1 = cA + (size_t)(t + 1) * kstep;
            const char* a2 = last ? nA : cA + (size_t)(t + 2) * kstep; const char* b2 = last ? nB : cB + (size_t)(t + 2) * kstep;
            const char* a3 = a2 + kstep; const char* b3 = b2 + kstep;
            PG8_LDB(B0, 0, 0); PG8_SCHED; PG8_LDA(At, 0, 0); PG8_STAGE(PG8_SA(1, 1), a1 + hstep, voffA);
            PG8_WAIT_L(8); PG8_BAR; PG8_WAIT_L(0); PG8_MMA(0, 0, At, B0); PG8_BAR; PG8_SCHED;
            PG8_LDB(B1, 0, 1); PG8_STAGE(PG8_SB(0, 0), b2, voffB);
            PG8_BAR; PG8_WAIT_L(0); PG8_MMA(0, 1, At, B1); PG8_BAR;
            PG8_LDA(At, 0, 1); PG8_STAGE(PG8_SA(0, 0), a2, voffA);
            PG8_BAR; PG8_WAIT_L(0); PG8_MMA(1, 0, At, B0); PG8_BAR; PG8_SCHED;
            PG8_STAGE(PG8_SB(0, 1), b2 + hstep, voffB);
            PG8_WAIT_V(6); PG8_BAR; PG8_MMA(1, 1, At, B1); PG8_BAR;
            PG8_LDB(B0, 1, 0); PG8_SCHED; PG8_LDA(At, 1, 0); PG8_STAGE(PG8_SA(0, 1), a2 + hstep, voffA);
            PG8_WAIT_L(8); PG8_BAR; PG8_WAIT_L(0); PG8_MMA(0, 0, At, B0); PG8_BAR; PG8_SCHED;
            PG8_LDB(B1, 1, 1); PG8_STAGE(PG8_SB(1, 0), b3, voffB);
            PG8_BAR; PG8_WAIT_L(0); PG8_MMA(0, 1, At, B1); PG8_BAR;
            PG8_LDA(At, 1, 1); PG8_STAGE(PG8_SA(1, 0), a3, voffA);
            PG8_BAR; PG8_WAIT_L(0); PG8_MMA(1, 0, At, B0); PG8_BAR; PG8_SCHED;
            PG8_STAGE(PG8_SB(1, 1), b3 + hstep, voffB);
            PG8_WAIT_V(6); PG8_BAR; PG8_MMA(1, 1, At, B1); PG8_BAR;
        }
        if (wr == 0) PG8_BAR;
        E(acc, cur, wr, wc, fr, fq);
        if (!has_next) break;
#pragma unroll
        for (int a = 0; a < 2; ++a)
#pragma unroll
            for (int b = 0; b < 2; ++b)
#pragma unroll
                for (int m = 0; m < 4; ++m)
#pragma unroll
                    for (int n = 0; n < 2; ++n) acc[a][b][m][n] = (f32x4){0.f, 0.f, 0.f, 0.f};
        cur = nxt; cA = nA; cB = nB; ++ui;
        if (wr == 1) PG8_BAR;
    }
    PG8_WAIT_V(0);
    PG8_BAR;
#undef PG8_SA
#undef PG8_SB
#undef PG8_STAGE
#undef PG8_LDA
#undef PG8_LDB
#undef PG8_MMA
#undef PG8_WAIT_V
#undef PG8_WAIT_L
#undef PG8_BAR
#undef PG8_SCHED
}

struct EpiHgrnIn {
    static constexpr bool PERM = true;
    bf16_t* QVG; bf16_t* LF; const float* lb;
    __device__ __forceinline__ void operator()(const f32x4 (&acc)[2][2][4][2], const Unit& u, int wr, int wc, int fr, int fq) const {
        const int seg = u.pn >> 2, colt = (u.pn & 3) * 256;
        const int row0 = u.pm * BM + wr * 64 + fr, col0 = colt + wc * 32 + 8 * fq;
        const size_t hm0 = (size_t)(u.pm >> 5) * SEQ * 896 + (size_t)(2 * (u.pn & 3)) * SEQ * 128 + wc * 32 + 8 * fq;
        if (seg == 1) {
#pragma unroll
            for (int bj = 0; bj < 2; ++bj) {
                const f32x4 l0 = *(const f32x4*)(lb + col0 + bj * HALF), l1 = *(const f32x4*)(lb + col0 + bj * HALF + 4);
#pragma unroll
                for (int ai = 0; ai < 2; ++ai)
#pragma unroll
                    for (int m = 0; m < 4; ++m) {
                        bf16_t* rowp = LF + (size_t)(row0 + ai * HALF + m * 16) * 128 + hm0 + (size_t)bj * SEQ * 128;
                        f32x4 o0, o1;
#pragma unroll
                        for (int j = 0; j < 4; ++j) {
                            float z = acc[ai][bj][m][0][j]; float sg = __builtin_amdgcn_rcpf(1.0f + __expf(-z)); float f = l0[j] + (1.0f - l0[j]) * sg; o0[j] = __logf(fmaxf(f, 1e-30f));
                            z = acc[ai][bj][m][1][j]; sg = __builtin_amdgcn_rcpf(1.0f + __expf(-z)); f = l1[j] + (1.0f - l1[j]) * sg; o1[j] = __logf(fmaxf(f, 1e-30f));
                        }
                        u32x4 lw; lw.x = cvt_pk_bf16(o0[0], o0[1]); lw.y = cvt_pk_bf16(o0[2], o0[3]); lw.z = cvt_pk_bf16(o1[0], o1[1]); lw.w = cvt_pk_bf16(o1[2], o1[3]);
                        *(u32x4*)rowp = lw;
                    }
            }
        } else {
            bf16_t* base = QVG + (size_t)(seg == 0 ? 0 : (seg == 2 ? 1 : 2)) * ((size_t)MTOK * D);
            const bool act = (seg != 2);
#pragma unroll
            for (int ai = 0; ai < 2; ++ai)
#pragma unroll
                for (int m = 0; m < 4; ++m)
#pragma unroll
                    for (int bj = 0; bj < 2; ++bj) {
                        f32x4 v0 = acc[ai][bj][m][0], v1 = acc[ai][bj][m][1];
                        if (act) {
#pragma unroll
                            for (int j = 0; j < 4; ++j) { v0[j] = silu_f(v0[j]); v1[j] = silu_f(v1[j]); }
                        }
                        u32x4 w; w.x = cvt_pk_bf16(v0[0], v0[1]); w.y = cvt_pk_bf16(v0[2], v0[3]); w.z = cvt_pk_bf16(v1[0], v1[1]); w.w = cvt_pk_bf16(v1[2], v1[3]);
                        *(u32x4*)(base + (size_t)(row0 + ai * HALF + m * 16) * 128 + hm0 + (size_t)bj * SEQ * 128) = w;
                    }
        }
    }
};
struct EpiResid {
    static constexpr bool PERM = true;
    const float* const* in; unsigned char* ws; float* hbuf; int l, which;
    __device__ __forceinline__ void emit(const f32x4 (&v)[2][2][4][2], const float (&rs)[2][4], bf16_t* U, const LAS float* tab, int row0, int col0, int cl0) const {
#pragma unroll
        for (int bj = 0; bj < 2; ++bj) {
            const int c = col0 + bj * HALF, cl = cl0 + bj * HALF;
            const f32x4 a0 = *(const LAS f32x4*)(tab + cl), a1 = *(const LAS f32x4*)(tab + cl + 4), t0 = *(const LAS f32x4*)(tab + 256 + cl), t1 = *(const LAS f32x4*)(tab + 256 + cl + 4);
#pragma unroll
            for (int ai = 0; ai < 2; ++ai)
#pragma unroll
                for (int m = 0; m < 4; ++m) {
                    const f32x4 u0 = (v[ai][bj][m][0] * rs[ai][m]) * a0 + t0, u1 = (v[ai][bj][m][1] * rs[ai][m]) * a1 + t1;
                    u32x4 w; w.x = cvt_pk_bf16(u0[0], u0[1]); w.y = cvt_pk_bf16(u0[2], u0[3]); w.z = cvt_pk_bf16(u1[0], u1[1]); w.w = cvt_pk_bf16(u1[2], u1[3]);
                    *(u32x4*)(U + (size_t)(row0 + ai * HALF + m * 16) * D + c) = w;
                }
            __builtin_amdgcn_sched_barrier(0);
        }
    }
    __device__ __forceinline__ void fill_tables(unsigned char* shm, int tid) const {
        float* t = (float*)(shm + 131072);
        const int pn = (int)blockIdx.x >> 6, b = (int)blockIdx.x & 7, c = pn * 256 + (tid & 255), second = tid >> 8;
        const float* mv = (const float*)(ws + OFF_MODV) + (size_t)l * 8 * 6144;
        if (second == 0) {
            float ga, shv;
            if (which == 0) { ga = in[5][l * D + c] * (1.0f + mv[(size_t)b * 6144 + 4 * D + c]); shv = mv[(size_t)b * 6144 + 3 * D + c]; }
            else if (l == 3) { ga = in[19][c]; shv = 0.f; }
            else { const float* mvn = mv + (size_t)8 * 6144; ga = in[4][(l + 1) * D + c] * (1.0f + mvn[(size_t)b * 6144 + D + c]); shv = mvn[(size_t)b * 6144 + c]; }
            t[tid & 255] = ga; t[256 + (tid & 255)] = shv;
        } else if (which == 1 && l == 1) {
            const float* kvm = (const float*)(ws + OFF_KVMOD);
            t[512 + (tid & 255)] = in[12][c] * (1.0f + kvm[(size_t)b * 2048 + D + c]); t[768 + (tid & 255)] = kvm[(size_t)b * 2048 + c];
        }
    }
    __device__ __forceinline__ void operator()(f32x4 (&acc)[2][2][4][2], const Unit& u, int wr, int wc, int fr, int fq) const {
        __builtin_amdgcn_sched_barrier(0);
        const int b = u.pm >> 5;
        const float* mv = (const float*)(ws + OFF_MODV) + (size_t)l * 8 * 6144;
        const bool src_x = (l == 0 && which == 0);
        const float* xin = in[0]; bf16_t* hb = (bf16_t*)(ws + OFF_H); float* dst = hbuf;
        const int mode = (l == 3 && which == 1) ? 1 : 0;
        unsigned long long* rowacc = (unsigned long long*)(ws + OFF_ROWSS) + (size_t)(2 * l + which) * MTOK;
        const float* gp = mv + (which ? 5 : 2) * D + (size_t)b * 6144;
        const int row0 = u.pm * BM + wr * 64 + fr, col0 = u.pn * BM + wc * 32 + 8 * fq;
        {
            f32x4 gv[2][2];
#pragma unroll
            for (int bj = 0; bj < 2; ++bj)
#pragma unroll
                for (int n = 0; n < 2; ++n) gv[bj][n] = *(const f32x4*)(gp + col0 + bj * HALF + 4 * n);
#pragma unroll
            for (int ai = 0; ai < 2; ++ai) {
                u32x4 hw[4][2];
                if (!src_x) {
#pragma unroll
                    for (int m = 0; m < 4; ++m)
#pragma unroll
                        for (int bj = 0; bj < 2; ++bj) hw[m][bj] = *(const u32x4*)(hb + (size_t)(row0 + ai * HALF + m * 16) * D + col0 + bj * HALF);
                }
#pragma unroll
                for (int m = 0; m < 4; ++m) {
                    const size_t ro = (size_t)(row0 + ai * HALF + m * 16) * D + col0;
                    float pt = 0.f;
#pragma unroll
                    for (int bj = 0; bj < 2; ++bj) {
                        f32x4 s0, s1;
                        if (src_x) { s0 = *(const f32x4*)(xin + ro + bj * HALF); s1 = *(const f32x4*)(xin + ro + bj * HALF + 4); }
                        else { const u32x4 q = hw[m][bj];
                            s0 = (f32x4){bflo(q.x), bfhi(q.x), bflo(q.y), bfhi(q.y)}; s1 = (f32x4){bflo(q.z), bfhi(q.z), bflo(q.w), bfhi(q.w)}; }
                        const f32x4 v0 = s0 + gv[bj][0] * acc[ai][bj][m][0], v1 = s1 + gv[bj][1] * acc[ai][bj][m][1];
                        acc[ai][bj][m][0] = v0; acc[ai][bj][m][1] = v1;
                        if (mode == 0) { u32x4 w; w.x = cvt_pk_bf16(v0[0], v0[1]); w.y = cvt_pk_bf16(v0[2], v0[3]); w.z = cvt_pk_bf16(v1[0], v1[1]); w.w = cvt_pk_bf16(v1[2], v1[3]);
                            *(u32x4*)(hb + ro + bj * HALF) = w; }
                        pt += ((v0[0] * v0[0] + v0[1] * v0[1]) + (v0[2] * v0[2] + v0[3] * v0[3])) + ((v1[0] * v1[0] + v1[1] * v1[1]) + (v1[2] * v1[2] + v1[3] * v1[3]));
                    }
                    pt += __shfl_xor(pt, 16); pt += __shfl_xor(pt, 32);
                    if (fq == 0) (void)__hip_atomic_fetch_add(rowacc + row0 + ai * HALF + m * 16, (1ull << 48) + (unsigned long long)(pt * 65536.0f + 0.5f), __ATOMIC_RELAXED, __HIP_MEMORY_SCOPE_AGENT);
                    if (src_x) __builtin_amdgcn_sched_barrier(0);
                }
                __builtin_amdgcn_sched_barrier(0);
            }
        }
        float rs[2][4];
        {
            unsigned spins = 0;
            __builtin_amdgcn_s_sleep(8);
            for (;;) {
                bool done = true;
#pragma unroll
                for (int ai = 0; ai < 2; ++ai)
#pragma unroll
                    for (int m = 0; m < 4; ++m) {
                        const unsigned long long q = __hip_atomic_load(rowacc + row0 + ai * HALF + m * 16, __ATOMIC_RELAXED, __HIP_MEMORY_SCOPE_AGENT);
                        done = done && ((q >> 48) >= 16ull);
                        rs[ai][m] = rsqrtf((float)(q & 0xffffffffffffull) * (1.0f / 65536.0f) * (1.0f / D) + 1e-6f);
                    }
                if (__all(done) || ++spins > (1u << 17)) break;
                __builtin_amdgcn_s_sleep(2);
            }
        }
        asm volatile("" ::: "memory");
        __builtin_amdgcn_sched_barrier(0);
        const LAS float* tab = (const LAS float*)(unsigned)131072u;
        int cl0 = wc * 32 + 8 * fq; asm volatile("" : "+v"(cl0));
        if (mode == 1) {
#pragma unroll
            for (int bj = 0; bj < 2; ++bj) {
                const f32x4 g0 = *(const LAS f32x4*)(tab + cl0 + bj * HALF), g1 = *(const LAS f32x4*)(tab + cl0 + bj * HALF + 4);
#pragma unroll
                for (int ai = 0; ai < 2; ++ai)
#pragma unroll
                    for (int m = 0; m < 4; ++m) {
                        float* op = dst + (size_t)(row0 + ai * HALF + m * 16) * D + col0 + bj * HALF;
                        *(f32x4*)op = (acc[ai][bj][m][0] * rs[ai][m]) * g0; *(f32x4*)(op + 4) = (acc[ai][bj][m][1] * rs[ai][m]) * g1;
                    }
            }
        } else {
            if (which == 0) emit(acc, rs, (l < 2) ? (bf16_t*)(ws + OFF_UF_A) : (bf16_t*)((unsigned char*)hbuf + ACTB), tab, row0, col0, cl0);
            else {
                emit(acc, rs, (bf16_t*)((unsigned char*)hbuf), tab, row0, col0, cl0);
                if (l == 1) emit(acc, rs, (bf16_t*)(ws + OFF_QB), tab + 512, row0, col0, cl0);
            }
        }
    }
};
struct EpiSwiglu {
    static constexpr bool PERM = true;
    bf16_t* act;
    __device__ __forceinline__ void operator()(const f32x4 (&acc)[2][2][4][2], const Unit& u, int wr, int wc, int fr, int fq) const {
        const int row0 = u.pm * BM + wr * 64 + fr, col0 = u.pn * HALF + wc * 32 + 8 * fq;
#pragma unroll
        for (int ai = 0; ai < 2; ++ai)
#pragma unroll
            for (int m = 0; m < 4; ++m) {
                f32x4 r0, r1;
#pragma unroll
                for (int j = 0; j < 4; ++j) { r0[j] = silu_f(acc[ai][0][m][0][j]) * acc[ai][1][m][0][j]; r1[j] = silu_f(acc[ai][0][m][1][j]) * acc[ai][1][m][1][j]; }
                u32x4 w; w.x = cvt_pk_bf16(r0[0], r0[1]); w.y = cvt_pk_bf16(r0[2], r0[3]); w.z = cvt_pk_bf16(r1[0], r1[1]); w.w = cvt_pk_bf16(r1[2], r1[3]);
                *(u32x4*)(act + (size_t)(row0 + ai * HALF + m * 16) * FFN + col0) = w;
            }
    }
};
struct EpiBf16Split {
    static constexpr bool PERM = true;
    bf16_t* d0; float scale; int hm;
    __device__ __forceinline__ void operator()(const f32x4 (&acc)[2][2][4][2], const Unit& u, int wr, int wc, int fr, int fq) const {
        bf16_t* base = d0 + (size_t)(u.pn >> 2) * ((size_t)MTOK * D);
        const int row0 = u.pm * BM + wr * 64 + fr, col0 = (u.pn & 3) * 256 + wc * 32 + 8 * fq;
#pragma unroll
        for (int ai = 0; ai < 2; ++ai)
#pragma unroll
            for (int m = 0; m < 4; ++m)
#pragma unroll
                for (int bj = 0; bj < 2; ++bj) {
                    const f32x4 v0 = acc[ai][bj][m][0] * scale, v1 = acc[ai][bj][m][1] * scale;
                    u32x4 w; w.x = cvt_pk_bf16(v0[0], v0[1]); w.y = cvt_pk_bf16(v0[2], v0[3]); w.z = cvt_pk_bf16(v1[0], v1[1]); w.w = cvt_pk_bf16(v1[2], v1[3]);
                    const int row = row0 + ai * HALF + m * 16;
                    if (hm) *(u32x4*)(base + (size_t)row * 64 + (size_t)(u.pm >> 5) * SEQ * 960 + (size_t)((col0 + bj * HALF) >> 6) * SEQ * 64 + ((col0 + bj * HALF) & 63)) = w;
                    else *(u32x4*)(base + (size_t)row * D + col0 + bj * HALF) = w;
                }
    }
};
}

template <class Epi>
__device__ __forceinline__ void run_gemm(unsigned char* shm, const bf16_t* A, const bf16_t* Bt, int N, int K, const Epi& E) {
    pg8::Gemm g; g.A = A; g.Bt = Bt; g.M = MTOK; g.N = N; g.K = K;
    pg8::StaticOrder S; S.init(MTOK, N, (int)gridDim.x, (int)blockIdx.x);
    pg8::gemm_phase<Epi>((LAS unsigned char*)shm, g, S, E);
    __syncthreads();
}

__device__ __forceinline__ int ffnmap(int nn) { return nn < FFN ? ((nn >> 7) * 256 + (nn & 127)) : (((nn - FFN) >> 7) * 256 + 128 + ((nn - FFN) & 127)); }

__device__ __forceinline__ void conv_group(const float* src0, bf16_t* dst0, const int K, const int N, const int L, const int mode, unsigned char* shm, const int tid) {
    float* st = (float*)shm;
    const int per = (K / 128) * (N / 64), total = L * per, ntn = N / 64;
    f32x4 v[4];
    int tile = blockIdx.x;
    if (tile < total) {
        const int l = tile / per, tt = tile % per, k0 = (tt / ntn) * 128, n0 = (tt % ntn) * 64;
        const float* src = src0 + (size_t)l * K * N;
#pragma unroll
        for (int it = 0; it < 4; ++it) { const int idx = tid + it * 512, k = idx >> 4, n4 = idx & 15; v[it] = *(const f32x4*)(src + (size_t)(k0 + k) * N + n0 + 4 * n4); }
    }
    for (; tile < total; tile += gridDim.x) {
        const int l = tile / per, tt = tile % per, k0 = (tt / ntn) * 128, n0 = (tt % ntn) * 64;
        bf16_t* dst = dst0 + (size_t)l * K * N;
        __syncthreads();
#pragma unroll
        for (int it = 0; it < 4; ++it) { const int idx = tid + it * 512, k = idx >> 4, n4 = idx & 15;
#pragma unroll
            for (int e = 0; e < 4; ++e) st[k * 65 + 4 * n4 + e] = v[it][e]; }
        __syncthreads();
        const int nt_ = tile + (int)gridDim.x;
        if (nt_ < total) {
            const int l2 = nt_ / per, t2 = nt_ % per, k2 = (t2 / ntn) * 128, n2 = (t2 % ntn) * 64;
            const float* src = src0 + (size_t)l2 * K * N;
#pragma unroll
            for (int it = 0; it < 4; ++it) { const int idx = tid + it * 512, k = idx >> 4, n4 = idx & 15; v[it] = *(const f32x4*)(src + (size_t)(k2 + k) * N + n2 + 4 * n4); }
        }
#pragma unroll
        for (int it = 0; it < 2; ++it) { const int idx = tid + it * 512, n = idx >> 4, kg = idx & 15; const int nn = n0 + n; const int drow = mode ? ffnmap(nn) : nn;
            u32x4 w;
#pragma unroll
            for (int e = 0; e < 4; ++e) w[e] = cvt_pk_bf16(st[(8 * kg + 2 * e) * 65 + n], st[(8 * kg + 2 * e + 1) * 65 + n]);
            *(u32x4*)(dst + (size_t)drow * K + k0 + 8 * kg) = w; }
    }
}

__device__ void prep_phase(const Params& p, unsigned char* shm) {
    const int tid = opaque_tid();
    {
        float* cact = (float*)shm;
        float* red = cact + 8192;
        bool loaded = false;
        const int wv = tid >> 6, lane = tid & 63;
        for (int task = blockIdx.x; task < 416; task += gridDim.x) {
            if (!loaded) {
                for (int i = tid; i < 8192; i += 512) { const int k = i >> 3, b = i & 7; cact[i] = silu_f(p.in[1][b * D + k]); }
                loaded = true;
            }
            __syncthreads();
            const int c0 = task * 64;
            const float* src; const float* bias; float* dst; int stride, dstride;
            if (c0 < 24576) { const int l = c0 / 6144, j = c0 % 6144; src = p.in[2] + (size_t)l * D * 6144 + j; stride = 6144; bias = p.in[3] + l * 6144 + j; dst = ((float*)(p.ws + OFF_MODV)) + (size_t)l * 8 * 6144 + j; dstride = 6144; }
            else { const int j = c0 - 24576; src = p.in[13] + j; stride = 2048; bias = p.in[14] + j; dst = ((float*)(p.ws + OFF_KVMOD)) + j; dstride = 2048; }
            float a[8];
#pragma unroll
            for (int b = 0; b < 8; ++b) a[b] = 0.f;
            const float* sp = src + (size_t)(wv * 128) * stride + lane;
#pragma unroll 8
            for (int k = 0; k < 128; ++k) {
                const float w = sp[(size_t)k * stride];
                const f32x4 c0v = *(const f32x4*)(cact + (wv * 128 + k) * 8), c1v = *(const f32x4*)(cact + (wv * 128 + k) * 8 + 4);
                a[0] += w * c0v[0]; a[1] += w * c0v[1]; a[2] += w * c0v[2]; a[3] += w * c0v[3];
                a[4] += w * c1v[0]; a[5] += w * c1v[1]; a[6] += w * c1v[2]; a[7] += w * c1v[3];
            }
#pragma unroll
            for (int b = 0; b < 8; ++b) red[(wv * 8 + b) * 64 + lane] = a[b];
            __syncthreads();
            {
                const int b = tid >> 6, col = tid & 63;
                float s = bias[col];
#pragma unroll
                for (int w = 0; w < 8; ++w) s += red[(w * 8 + b) * 64 + col];
                dst[(size_t)b * dstride + col] = s;
            }
        }
        __syncthreads();
    }
    for (int i = blockIdx.x * 512 + tid; i < 1024; i += gridDim.x * 512) {
        const float a0 = p.in[10][i], a1 = p.in[10][1024 + i];
        const float mx = fmaxf(a0, a1), e0 = __expf(a0 - mx), e1 = __expf(a1 - mx);
        ((float*)(p.ws + OFF_LBV))[i] = 0.f; ((float*)(p.ws + OFF_LBV))[1024 + i] = e1 / (e0 + e1);
    }
    conv_group(p.in[8], (bf16_t*)(p.ws + OFF_WB_A_IN), D, AIN, 2, 0, shm, tid);
    conv_group(p.in[9], (bf16_t*)(p.ws + OFF_WB_A_OUT), D, D, 2, 0, shm, tid);
    conv_group(p.in[6], (bf16_t*)(p.ws + OFF_WB_FFN_IN), D, 2 * FFN, 4, 1, shm, tid);
    conv_group(p.in[7], (bf16_t*)(p.ws + OFF_WB_FFN_OUT), FFN, D, 4, 0, shm, tid);
    conv_group(p.in[15], (bf16_t*)(p.ws + OFF_WB_KV), D, 2 * D, 1, 0, shm, tid);
    conv_group(p.in[16], (bf16_t*)(p.ws + OFF_WB_Q), D, D, 2, 0, shm, tid);
    conv_group(p.in[17], (bf16_t*)(p.ws + OFF_WB_O), D, D, 2, 0, shm, tid);
    __syncthreads();
}

__device__ void norm_phase(const float* src, bf16_t* U1, const float* gain1, const float* sh1, const float* sc1, int bs1,
                           bf16_t* U2, const float* gain2, const float* sh2, const float* sc2, int bs2) {
    const int tid_ = opaque_tid(); const int lane = tid_ & 63, gw = blockIdx.x * 8 + (tid_ >> 6), nw = gridDim.x * 8;
    for (int row = 2 * gw; row < MTOK; row += 2 * nw) {
        const int b = row >> 13;
        const float* xp = src + (size_t)row * D;
        f32x4 xv[2][4]; float ss[2] = {0.f, 0.f};
#pragma unroll
        for (int r = 0; r < 2; ++r)
#pragma unroll
            for (int i = 0; i < 4; ++i) xv[r][i] = *(const f32x4*)(xp + (size_t)r * D + i * 256 + lane * 4);
#pragma unroll
        for (int r = 0; r < 2; ++r)
#pragma unroll
            for (int i = 0; i < 4; ++i) ss[r] += xv[r][i][0] * xv[r][i][0] + xv[r][i][1] * xv[r][i][1] + xv[r][i][2] * xv[r][i][2] + xv[r][i][3] * xv[r][i][3];
#pragma unroll
        for (int o = 1; o < 64; o <<= 1) { ss[0] += __shfl_xor(ss[0], o); ss[1] += __shfl_xor(ss[1], o); }
        const float rstd0 = rsqrtf(ss[0] * (1.0f / D) + 1e-6f), rstd1 = rsqrtf(ss[1] * (1.0f / D) + 1e-6f);
#pragma unroll
        for (int i = 0; i < 4; ++i) {
            const int k = i * 256 + lane * 4;
            const f32x4 g = *(const f32x4*)(gain1 + k), s = *(const f32x4*)(sc1 + (size_t)b * bs1 + k), t = *(const f32x4*)(sh1 + (size_t)b * bs1 + k);
            f32x4 u0, u1;
#pragma unroll
            for (int j = 0; j < 4; ++j) { const float ga = g[j] * (1.0f + s[j]); u0[j] = (xv[0][i][j] * rstd0) * ga + t[j]; u1[j] = (xv[1][i][j] * rstd1) * ga + t[j]; }
            u32x2 w0, w1; w0.x = cvt_pk_bf16(u0[0], u0[1]); w0.y = cvt_pk_bf16(u0[2], u0[3]); w1.x = cvt_pk_bf16(u1[0], u1[1]); w1.y = cvt_pk_bf16(u1[2], u1[3]);
            *(u32x2*)(U1 + (size_t)row * D + k) = w0; *(u32x2*)(U1 + (size_t)(row + 1) * D + k) = w1;
        }
        if (U2) {
#pragma unroll
            for (int i = 0; i < 4; ++i) {
                const int k = i * 256 + lane * 4;
                const f32x4 g = *(const f32x4*)(gain2 + k), s = *(const f32x4*)(sc2 + (size_t)b * bs2 + k), t = *(const f32x4*)(sh2 + (size_t)b * bs2 + k);
                f32x4 u0, u1;
#pragma unroll
                for (int j = 0; j < 4; ++j) { const float ga = g[j] * (1.0f + s[j]); u0[j] = (xv[0][i][j] * rstd0) * ga + t[j]; u1[j] = (xv[1][i][j] * rstd1) * ga + t[j]; }
                u32x2 w0, w1; w0.x = cvt_pk_bf16(u0[0], u0[1]); w0.y = cvt_pk_bf16(u0[2], u0[3]); w1.x = cvt_pk_bf16(u1[0], u1[1]); w1.y = cvt_pk_bf16(u1[2], u1[3]);
                *(u32x2*)(U2 + (size_t)row * D + k) = w0; *(u32x2*)(U2 + (size_t)(row + 1) * D + k) = w1;
            }
        }
    }
}
__device__ void final_norm_phase(float* h, const float* gain) {
    const int tid_ = opaque_tid(); const int lane = tid_ & 63, gw = blockIdx.x * 8 + (tid_ >> 6), nw = gridDim.x * 8;
    for (int row = gw; row < MTOK; row += nw) {
        float* xp = h + (size_t)row * D;
        f32x4 xv[4]; float ss = 0.f;
#pragma unroll
        for (int i = 0; i < 4; ++i) { xv[i] = *(const f32x4*)(xp + i * 256 + lane * 4); ss += xv[i][0] * xv[i][0] + xv[i][1] * xv[i][1] + xv[i][2] * xv[i][2] + xv[i][3] * xv[i][3]; }
#pragma unroll
        for (int o = 1; o < 64; o <<= 1) ss += __shfl_xor(ss, o);
        const float rstd = rsqrtf(ss * (1.0f / D) + 1e-6f);
#pragma unroll
        for (int i = 0; i < 4; ++i) {
            const int k = i * 256 + lane * 4;
            const f32x4 g = *(const f32x4*)(gain + k);
            f32x4 u;
#pragma unroll
            for (int j = 0; j < 4; ++j) u[j] = xv[i][j] * rstd * g[j];
            *(f32x4*)(xp + k) = u;
        }
    }
}

template <bool OUT>
__device__ void rec_pass(const Params& p, int layer, unsigned char* shm) {
    float* sB = (float*)shm;
    float* sKm = (float*)(shm + 33792);
    bf16_t* sST = (bf16_t*)shm;
    bf16_t* sQb = (bf16_t*)(shm + 67584);
    bf16_t* sA = (bf16_t*)(shm + 84992);
    bf16_t* sKT = (bf16_t*)(shm + 94208);
    bf16_t* sVT = (bf16_t*)(shm + 112640);
    float* sE = (float*)(shm + 131072);
    float* sPart = (float*)(shm + 131584);
    float* sNrm = (float*)(shm + 135680);
    const int tid = opaque_tid(), lane = tid & 63, w = tid >> 6, fr = lane & 15, fq = lane >> 4;
    const int wi = w >> 1, wh = w & 1;
    const int ntask = OUT ? 256 : 192;
    const float* ogain = p.in[11] + layer * 128;
    for (int task = blockIdx.x; task < ntask; task += gridDim.x) {
        int sc, bh; if (OUT) { sc = task & 3; bh = task >> 2; } else { sc = task % 3; bh = task / 3; }
        const int b = bh >> 3, h = bh & 7;
        const size_t hoff = (size_t)b * SEQ * 896 + (size_t)h * SEQ * 128;
        f32x4 S[8];
#pragma unroll
        for (int db = 0; db < 8; ++db) S[db] = (f32x4){0.f, 0.f, 0.f, 0.f};
        if (OUT) {
            for (int s2 = 0; s2 < sc; ++s2) {
                const float* sl = ((float*)(p.ws + OFF_SLOC)) + (size_t)(bh * 4 + s2) * 16384; const float* dl = ((float*)(p.ws + OFF_DLOG)) + (bh * 4 + s2) * 128;
#pragma unroll
                for (int db = 0; db < 8; ++db) {
                    const f32x4 x = *(const f32x4*)(sl + ((w * 8 + db) * 64 + lane) * 4), dv = *(const f32x4*)(dl + 16 * db + fq * 4);
#pragma unroll
                    for (int j = 0; j < 4; ++j) S[db][j] = S[db][j] * __expf(dv[j]) + x[j];
                }
            }
        }
        float dlacc = 0.f;
        unsigned lfn[8]; u32x4 vn0, vn1;
        const bf16_t* LFb = (const bf16_t*)(p.ws + OFF_LF);
        const int d2 = (tid & 63) * 2, tq = tid >> 6;
        {
            const size_t r0 = (size_t)b * SEQ + (size_t)(sc * 32) * 64;
            const bf16_t* lp = LFb + (r0 + 8 * tq) * 128 + hoff + d2;
#pragma unroll
            for (int e = 0; e < 8; ++e) lfn[e] = *(const unsigned*)(lp + (size_t)e * 128);
            vn0 = *(const u32x4*)(((bf16_t*)(p.ws + OFF_VH)) + (r0 + (tid & 63)) * 128 + hoff + (tid >> 6) * 8);
            vn1 = *(const u32x4*)(((bf16_t*)(p.ws + OFF_VH)) + (r0 + (tid & 63)) * 128 + hoff + 64 + (tid >> 6) * 8);
        }
        for (int ch = sc * 32; ch < sc * 32 + 32; ++ch) {
            const size_t row0 = (size_t)b * SEQ + (size_t)ch * 64;
            float la[8], lb2[8];
#pragma unroll
            for (int e = 0; e < 8; ++e) { la[e] = bflo(lfn[e]); lb2[e] = bfhi(lfn[e]); }
            const u32x4 vr0 = vn0, vr1 = vn1;
            u32x4 qraw[4]; u32x2 graw[4];
            if (OUT) {
#pragma unroll
                for (int ks = 0; ks < 4; ++ks) qraw[ks] = *(const u32x4*)(((bf16_t*)(p.ws + OFF_QH)) + (row0 + 16 * wi + fr) * 128 + hoff + ks * 32 + fq * 8);
#pragma unroll
                for (int vb = 0; vb < 4; ++vb) graw[vb] = *(const u32x2*)(((bf16_t*)(p.ws + OFF_GH)) + (row0 + 16 * wi + fr) * 128 + hoff + 64 * wh + 16 * vb + fq * 4);
            }
            {
                float ra = 0.f, rb = 0.f, ka[8], kb2[8];
#pragma unroll
                for (int e = 0; e < 8; ++e) {
                    ka[e] = 1.0f - __expf(la[e]); kb2[e] = 1.0f - __expf(lb2[e]);
                    *(f32x2*)(sKm + (8 * tq + e) * 132 + d2) = (f32x2){ka[e], kb2[e]};
                    ra += la[e]; la[e] = ra; rb += lb2[e]; lb2[e] = rb;
                }
                *(f32x2*)(sPart + tq * 128 + d2) = (f32x2){ra, rb};
                {
                    const int s_ = tid & 63, pc = tid >> 6;
#pragma unroll
                    for (int e = 0; e < 8; ++e) {
                        sVT[(pc * 8 + e) * 72 + s_] = (bf16_t)((e & 1) ? (vr0[e >> 1] >> 16) : (vr0[e >> 1] & 0xffffu));
                        sVT[(64 + pc * 8 + e) * 72 + s_] = (bf16_t)((e & 1) ? (vr1[e >> 1] >> 16) : (vr1[e >> 1] & 0xffffu));
                    }
                }
                __syncthreads();
                float offa = 0.f, offb = 0.f, tota = 0.f, totb = 0.f;
#pragma unroll
                for (int q = 0; q < 8; ++q) { const f32x2 pq = *(const f32x2*)(sPart + q * 128 + d2); tota += pq[0]; totb += pq[1]; if (q < tq) { offa += pq[0]; offb += pq[1]; } }
                if (tq == 0) { *(f32x2*)(sE + d2) = (f32x2){__expf(tota), __expf(totb)}; }
                u32x4 kwa, kwb;
#pragma unroll
                for (int e = 0; e < 8; e += 2) {
                    const float a0 = la[e] + offa, a1 = la[e + 1] + offa, b0 = lb2[e] + offb, b1 = lb2[e + 1] + offb;
                    *(f32x2*)(sB + (8 * tq + e) * 132 + d2) = (f32x2){a0, b0}; *(f32x2*)(sB + (8 * tq + e + 1) * 132 + d2) = (f32x2){a1, b1};
                    kwa[e >> 1] = cvt_pk_bf16(ka[e] * __expf(tota - a0), ka[e + 1] * __expf(tota - a1));
                    kwb[e >> 1] = cvt_pk_bf16(kb2[e] * __expf(totb - b0), kb2[e + 1] * __expf(totb - b1));
                }
                *(u32x4*)(sKT + d2 * 72 + 8 * tq) = kwa; *(u32x4*)(sKT + (d2 + 1) * 72 + 8 * tq) = kwb;
            }
            __syncthreads();
            if (ch + 1 < sc * 32 + 32) {
                const size_t r1 = row0 + 64;
                const bf16_t* lp = LFb + (r1 + 8 * tq) * 128 + hoff + d2;
#pragma unroll
                for (int e = 0; e < 8; ++e) lfn[e] = *(const unsigned*)(lp + (size_t)e * 128);
                vn0 = *(const u32x4*)(((bf16_t*)(p.ws + OFF_VH)) + (r1 + (tid & 63)) * 128 + hoff + (tid >> 6) * 8);
                vn1 = *(const u32x4*)(((bf16_t*)(p.ws + OFF_VH)) + (r1 + (tid & 63)) * 128 + hoff + 64 + (tid >> 6) * 8);
            }
            if (OUT) {
                const int i = wi, hh = wh, t_ = 16 * i + fr;
                bf16x8 qt[4];
#pragma unroll
                for (int ks = 0; ks < 4; ++ks) {
                    const int d0 = ks * 32 + fq * 8;
                    const f32x4 b0 = *(const f32x4*)(sB + t_ * 132 + d0), b1 = *(const f32x4*)(sB + t_ * 132 + d0 + 4);
                    f32x4 r0 = (f32x4){0.f, 0.f, 0.f, 0.f}, r1 = r0;
                    if (i > 0) { r0 = *(const f32x4*)(sB + (16 * i - 1) * 132 + d0); r1 = *(const f32x4*)(sB + (16 * i - 1) * 132 + d0 + 4); }
                    float qv[8], ql[8];
#pragma unroll
                    for (int e = 0; e < 4; ++e) { qv[2 * e] = bflo(qraw[ks][e]); qv[2 * e + 1] = bfhi(qraw[ks][e]); }
#pragma unroll
                    for (int e = 0; e < 4; ++e) { ql[e] = qv[e] * __expf(b0[e] - r0[e]); ql[4 + e] = qv[4 + e] * __expf(b1[e] - r1[e]); }
                    u32x4 pw; pw.x = cvt_pk_bf16(ql[0], ql[1]); pw.y = cvt_pk_bf16(ql[2], ql[3]); pw.z = cvt_pk_bf16(ql[4], ql[5]); pw.w = cvt_pk_bf16(ql[6], ql[7]);
                    qt[ks] = __builtin_bit_cast(bf16x8, pw);
                    if ((ks >> 1) == hh) {
#pragma unroll
                        for (int e = 0; e < 4; ++e) { ql[e] = qv[e] * __expf(b0[e]); ql[4 + e] = qv[4 + e] * __expf(b1[e]); }
                        u32x4 qw; qw.x = cvt_pk_bf16(ql[0], ql[1]); qw.y = cvt_pk_bf16(ql[2], ql[3]); qw.z = cvt_pk_bf16(ql[4], ql[5]); qw.w = cvt_pk_bf16(ql[6], ql[7]);
                        *(u32x4*)(sQb + t_ * 136 + d0) = qw;
                    }
                }
#pragma unroll
                for (int j2 = 0; j2 < 2; ++j2) {
                    const int j = hh + 2 * j2;
                    if (j <= i) {
                        f32x4 acc = (f32x4){0.f, 0.f, 0.f, 0.f};
                        const int s_ = 16 * j + fr;
#pragma unroll
                        for (int ks = 0; ks < 4; ++ks) {
                            const int d0 = ks * 32 + fq * 8;
                            const f32x4 k0 = *(const f32x4*)(sKm + s_ * 132 + d0), k1 = *(const f32x4*)(sKm + s_ * 132 + d0 + 4);
                            const f32x4 b0 = *(const f32x4*)(sB + s_ * 132 + d0), b1 = *(const f32x4*)(sB + s_ * 132 + d0 + 4);
                            f32x4 r0 = (f32x4){0.f, 0.f, 0.f, 0.f}, r1 = r0;
                            if (i > 0) { r0 = *(const f32x4*)(sB + (16 * i - 1) * 132 + d0); r1 = *(const f32x4*)(sB + (16 * i - 1) * 132 + d0 + 4); }
                            float kl[8];
#pragma unroll
                            for (int e = 0; e < 4; ++e) { kl[e] = k0[e] * __expf(fminf(r0[e] - b0[e], 80.f)); kl[4 + e] = k1[e] * __expf(fminf(r1[e] - b1[e], 80.f)); }
                            u32x4 kw; kw.x = cvt_pk_bf16(kl[0], kl[1]); kw.y = cvt_pk_bf16(kl[2], kl[3]); kw.z = cvt_pk_bf16(kl[4], kl[5]); kw.w = cvt_pk_bf16(kl[6], kl[7]);
                            acc = __builtin_amdgcn_mfma_f32_16x16x32_bf16(qt[ks], __builtin_bit_cast(bf16x8, kw), acc, 0, 0, 0);
                        }
#pragma unroll
                        for (int jj = 0; jj < 4; ++jj) {
                            float vv = acc[jj];
                            if (i == j && fr > fq * 4 + jj) vv = 0.f;
                            sA[(16 * i + fq * 4 + jj) * 72 + 16 * j + fr] = (bf16_t)(cvt_pk_bf16(vv, 0.f) & 0xffffu);
                        }
                    } else {
#pragma unroll
                        for (int jj = 0; jj < 4; ++jj) sA[(16 * i + fq * 4 + jj) * 72 + 16 * j + fr] = (bf16_t)0;
                    }
                }
            }
            __syncthreads();
            if (OUT) {
#pragma unroll
                for (int db = 0; db < 8; ++db) { u32x2 sw; sw.x = cvt_pk_bf16(S[db][0], S[db][1]); sw.y = cvt_pk_bf16(S[db][2], S[db][3]); *(u32x2*)(sST + (16 * w + fr) * 136 + 16 * db + fq * 4) = sw; }
                __syncthreads();
            }
            f32x4 o[4];
            if (OUT) {
                const int i = wi;
#pragma unroll
                for (int vb = 0; vb < 4; ++vb) o[vb] = (f32x4){0.f, 0.f, 0.f, 0.f};
#pragma unroll
                for (int kk = 0; kk < 2; ++kk) {
                    if (kk <= (i >> 1)) {
                        const bf16x8 af = *(const bf16x8*)(sA + (16 * i + fr) * 72 + kk * 32 + fq * 8);
#pragma unroll
                        for (int vb = 0; vb < 4; ++vb) { const bf16x8 vf = *(const bf16x8*)(sVT + (64 * wh + 16 * vb + fr) * 72 + kk * 32 + fq * 8); o[vb] = __builtin_amdgcn_mfma_f32_16x16x32_bf16(vf, af, o[vb], 0, 0, 0); }
                    }
                }
#pragma unroll
                for (int ks = 0; ks < 4; ++ks) {
                    const bf16x8 qf = *(const bf16x8*)(sQb + (16 * i + fr) * 136 + ks * 32 + fq * 8);
#pragma unroll
                    for (int vb = 0; vb < 4; ++vb) { const bf16x8 sf = *(const bf16x8*)(sST + (64 * wh + 16 * vb + fr) * 136 + ks * 32 + fq * 8); o[vb] = __builtin_amdgcn_mfma_f32_16x16x32_bf16(sf, qf, o[vb], 0, 0, 0); }
                }
                float ss = 0.f;
#pragma unroll
                for (int vb = 0; vb < 4; ++vb)
#pragma unroll
                    for (int jj = 0; jj < 4; ++jj) ss += o[vb][jj] * o[vb][jj];
                ss += __shfl_xor(ss, 16); ss += __shfl_xor(ss, 32);
                if (fq == 0) sNrm[wh * 64 + 16 * i + fr] = ss;
            }
#pragma unroll
            for (int db = 0; db < 8; ++db) { const f32x4 e4 = *(const f32x4*)(sE + 16 * db + fq * 4); S[db] = S[db] * e4; }
#pragma unroll
            for (int ks = 0; ks < 2; ++ks) {
                const bf16x8 vf = *(const bf16x8*)(sVT + (16 * w + fr) * 72 + ks * 32 + fq * 8);
#pragma unroll
                for (int db = 0; db < 8; ++db) { const bf16x8 kf = *(const bf16x8*)(sKT + (16 * db + fr) * 72 + ks * 32 + fq * 8); S[db] = __builtin_amdgcn_mfma_f32_16x16x32_bf16(kf, vf, S[db], 0, 0, 0); }
            }
            __syncthreads();
            if (OUT) {
                const int i = wi;
                const float tot = sNrm[16 * i + fr] + sNrm[64 + 16 * i + fr];
                const float rstd = rsqrtf(tot * (1.0f / 128.0f) + 1e-6f);
                bf16_t* op = ((bf16_t*)((unsigned char*)p.h)) + (row0 + 16 * i + fr) * D + h * 128 + 64 * wh + fq * 4;
#pragma unroll
                for (int vb = 0; vb < 4; ++vb) {
                    const f32x4 gn = *(const f32x4*)(ogain + 64 * wh + 16 * vb + fq * 4);
                    const float g0 = bflo(graw[vb].x), g1 = bfhi(graw[vb].x), g2 = bflo(graw[vb].y), g3 = bfhi(graw[vb].y);
                    u32x2 ow; ow.x = cvt_pk_bf16(o[vb][0] * rstd * gn[0] * g0, o[vb][1] * rstd * gn[1] * g1); ow.y = cvt_pk_bf16(o[vb][2] * rstd * gn[2] * g2, o[vb][3] * rstd * gn[3] * g3);
                    *(u32x2*)(op + 16 * vb) = ow;
                }
            }
        }
        if (!OUT) {
            float* sl = ((float*)(p.ws + OFF_SLOC)) + (size_t)(bh * 4 + sc) * 16384;
#pragma unroll
            for (int db = 0; db < 8; ++db) *(f32x4*)(sl + ((w * 8 + db) * 64 + lane) * 4) = S[db];
            if (tid < 128) ((float*)(p.ws + OFF_DLOG))[(bh * 4 + sc) * 128 + tid] = dlacc;
        }
    }
    __syncthreads();
}

__device__ void rec_passA(const Params& p, unsigned char* shm) {
    bf16_t* sKT = (bf16_t*)shm;
    bf16_t* sVT = (bf16_t*)(shm + 34816);
    float* sE = (float*)(shm + 69632);
    float* sPart = (float*)(shm + 70144);
    const int tid = opaque_tid(), lane = tid & 63, w = tid >> 6, fr = lane & 15, fq = lane >> 4;
    const int d2 = (tid & 63) * 2, tq = tid >> 6;
    const int vs = tid & 127, vq = tid >> 7;
    const bf16_t* LFb = (const bf16_t*)(p.ws + OFF_LF); const bf16_t* Vp = (const bf16_t*)(p.ws + OFF_VH);
    for (int task = blockIdx.x; task < 192; task += gridDim.x) {
        const int sc = task % 3, bh = task / 3, b = bh >> 3, h = bh & 7;
        const size_t hoff = (size_t)b * SEQ * 896 + (size_t)h * SEQ * 128;
        f32x4 S[8];
#pragma unroll
        for (int db = 0; db < 8; ++db) S[db] = (f32x4){0.f, 0.f, 0.f, 0.f};
        float dla = 0.f, dlb = 0.f;
        const size_t rbase = (size_t)b * SEQ + (size_t)sc * 2048;
        unsigned lfn[16]; u32x4 vn[4];
        {
            const bf16_t* lp = LFb + (rbase + 16 * tq) * 128 + hoff + d2;
#pragma unroll
            for (int e = 0; e < 16; ++e) lfn[e] = *(const unsigned*)(lp + (size_t)e * 128);
#pragma unroll
            for (int i = 0; i < 4; ++i) vn[i] = *(const u32x4*)(Vp + (rbase + vs) * 128 + hoff + (vq + 4 * i) * 8);
        }
        __syncthreads();
        for (int cc = 0; cc < 16; ++cc) {
            const size_t row0 = rbase + (size_t)cc * 128;
            unsigned lf[16]; u32x4 vr[4];
            float ra = 0.f, rb = 0.f;
#pragma unroll
            for (int e = 0; e < 16; ++e) { lf[e] = lfn[e]; ra += bflo(lf[e]); rb += bfhi(lf[e]); }
#pragma unroll
            for (int i = 0; i < 4; ++i) vr[i] = vn[i];
            *(f32x2*)(sPart + tq * 128 + d2) = (f32x2){ra, rb};
            __syncthreads();
            if (cc + 1 < 16) {
                const bf16_t* lp = LFb + (row0 + 128 + 16 * tq) * 128 + hoff + d2;
#pragma unroll
                for (int e = 0; e < 16; ++e) lfn[e] = *(const unsigned*)(lp + (size_t)e * 128);
#pragma unroll
                for (int i = 0; i < 4; ++i) vn[i] = *(const u32x4*)(Vp + (row0 + 128 + vs) * 128 + hoff + (vq + 4 * i) * 8);
            }
            float ba = 0.f, bb = 0.f, tota = 0.f, totb = 0.f;
#pragma unroll
            for (int q = 0; q < 8; ++q) { const f32x2 pq = *(const f32x2*)(sPart + q * 128 + d2); tota += pq[0]; totb += pq[1]; if (q < tq) { ba += pq[0]; bb += pq[1]; } }
            if (tq == 0) { *(f32x2*)(sE + d2) = (f32x2){__expf(tota), __expf(totb)}; dla += tota; dlb += totb; }
#pragma unroll
            for (int g8 = 0; g8 < 2; ++g8) {
                u32x4 kwa, kwb;
#pragma unroll
                for (int e = 0; e < 8; e += 2) {
                    const float la0 = bflo(lf[8 * g8 + e]), lb0 = bfhi(lf[8 * g8 + e]), la1 = bflo(lf[8 * g8 + e + 1]), lb1 = bfhi(lf[8 * g8 + e + 1]);
                    const float a0 = ba + la0, a1 = a0 + la1; ba = a1;
                    const float b0 = bb + lb0, b1 = b0 + lb1; bb = b1;
                    kwa[e >> 1] = cvt_pk_bf16((1.0f - __expf(la0)) * __expf(tota - a0), (1.0f - __expf(la1)) * __expf(tota - a1));
                    kwb[e >> 1] = cvt_pk_bf16((1.0f - __expf(lb0)) * __expf(totb - b0), (1.0f - __expf(lb1)) * __expf(totb - b1));
                }
                *(u32x4*)(sKT + d2 * 136 + 16 * tq + 8 * g8) = kwa; *(u32x4*)(sKT + (d2 + 1) * 136 + 16 * tq + 8 * g8) = kwb;
            }
#pragma unroll
            for (int i = 0; i < 4; ++i)
#pragma unroll
                for (int e = 0; e < 8; ++e) sVT[((vq + 4 * i) * 8 + e) * 136 + vs] = (bf16_t)((e & 1) ? (vr[i][e >> 1] >> 16) : (vr[i][e >> 1] & 0xffffu));
            __syncthreads();
#pragma unroll
            for (int db = 0; db < 8; ++db) { const f32x4 e4 = *(const f32x4*)(sE + 16 * db + fq * 4); S[db] = S[db] * e4; }
#pragma unroll
            for (int ks = 0; ks < 4; ++ks) {
                const bf16x8 vf = *(const bf16x8*)(sVT + (16 * w + fr) * 136 + ks * 32 + fq * 8);
#pragma unroll
                for (int db = 0; db < 8; ++db) { const bf16x8 kf = *(const bf16x8*)(sKT + (16 * db + fr) * 136 + ks * 32 + fq * 8); S[db] = __builtin_amdgcn_mfma_f32_16x16x32_bf16(kf, vf, S[db], 0, 0, 0); }
            }
        }
        float* sl = (float*)(p.ws + OFF_SLOC) + (size_t)(bh * 4 + sc) * 16384;
#pragma unroll
        for (int db = 0; db < 8; ++db) *(f32x4*)(sl + ((w * 8 + db) * 64 + lane) * 4) = S[db];
        if (tq == 0) *(f32x2*)((float*)(p.ws + OFF_DLOG) + (bh * 4 + sc) * 128 + d2) = (f32x2){dla, dlb};
    }
    __syncthreads();
}

__device__ void attn_phase(const Params& p, int jl, unsigned char* shm) {
    bf16_t* sK = (bf16_t*)shm;
    bf16_t* sVT = sK + 5 * 4608;
    float* sB = (float*)(sVT + 5 * 4608);
    const int tid = opaque_tid(), lane = tid & 63, w = tid >> 6, fr = lane & 15, fq = lane >> 4;
    const int cq = w >> 1, half = w & 1;
    const float LOG2E = 1.4426950408889634f;
    const int skey = tid >> 3, spiece = tid & 7, vkey = tid & 63, vpiece = tid >> 6;
    const bf16_t* Kg = (const bf16_t*)(p.ws + OFF_KB); const bf16_t* Vg = (const bf16_t*)(p.ws + OFF_VB); const bf16_t* Qg = (const bf16_t*)((unsigned char*)p.h + ACTB);
    for (int task = blockIdx.x; task < 4096; task += gridDim.x) {
        const int g = task & 31, h = (task >> 5) & 15, b = task >> 9;
        const int c = 4 * g + cq;
        __syncthreads();
        for (int i = tid; i < 384; i += 512) { int r = i - 64; r = r < 0 ? 0 : (r > 319 ? 319 : r); sB[i] = p.in[18][((size_t)jl * 320 + r) * 16 + h] * LOG2E; }
        bf16x8 qf[2][2];
        {
            const bf16_t* qp = Qg + ((size_t)b * SEQ + c * 64 + half * 32) * D + h * 64;
#pragma unroll
            for (int qb = 0; qb < 2; ++qb)
#pragma unroll
                for (int ks = 0; ks < 2; ++ks) qf[qb][ks] = *(const bf16x8*)(qp + (size_t)(qb * 16 + fr) * D + ks * 32 + fq * 8);
        }
        f32x4 oacc[4][2];
#pragma unroll
        for (int db = 0; db < 4; ++db)
#pragma unroll
            for (int qb = 0; qb < 2; ++qb) oacc[db][qb] = (f32x4){0.f, 0.f, 0.f, 0.f};
        float mrun[2] = {0.f, 0.f}, lrun[2] = {0.f, 0.f};
        bool first = true;
        const size_t tokb = (size_t)b * SEQ;
        const size_t hoffk = (size_t)b * SEQ * 960 + (size_t)h * SEQ * 64;
        u32x4 kreg, vreg;
#define ATT_GLOAD(kc_) do { kreg = *(const u32x4*)(Kg + (tokb + (size_t)(kc_) * 64 + skey) * 64 + hoffk + spiece * 8); \
                            vreg = *(const u32x4*)(Vg + (tokb + (size_t)(kc_) * 64 + skey) * 64 + hoffk + spiece * 8); } while (0)
#define ATT_LSTORE(kc_) do { const int sl_ = ((kc_) + 10) % 5; *(u32x4*)(sK + sl_ * 4608 + skey * 72 + spiece * 8) = kreg; \
                             *(u32x4*)(sVT + sl_ * 4608 + skey * 72 + spiece * 8) = vreg; } while (0)
        {
            u32x4 k4[4], v4[4];
#pragma unroll
            for (int j = 0; j < 4; ++j) { const int kc = 4 * g - 8 + j; if (kc >= 0) { ATT_GLOAD(kc); k4[j] = kreg; v4[j] = vreg; } }
#pragma unroll
            for (int j = 0; j < 4; ++j) { const int kc = 4 * g - 8 + j; if (kc >= 0) { kreg = k4[j]; vreg = v4[j]; ATT_LSTORE(kc); } }
        }
        __syncthreads();
        for (int i = 0; i < 9; ++i) {
            const int knew = 4 * g - 4 + i;
            const bool ld = (i < 8) && (knew >= 0);
            if (ld) ATT_GLOAD(knew);
            const int kt = c - 8 + i;
            if (kt >= 0) {
                const int sl = (kt + 10) % 5, dk = i - 8;
                const bf16_t* kb_ = sK + sl * 4608; const bf16_t* vb_ = sVT + sl * 4608;
                f32x4 sacc[4][2];
                const float cb = (dk <= -5) ? sB[0] : 0.f;
                bf16x8 kfr[4][2];
#pragma unroll
                for (int kb = 0; kb < 4; ++kb)
#pragma unroll
                    for (int ks = 0; ks < 2; ++ks) kfr[kb][ks] = *(const bf16x8*)(kb_ + (kb * 16 + fr) * 72 + ks * 32 + fq * 8);
                __builtin_amdgcn_s_setprio(1);
#pragma unroll
                for (int qb = 0; qb < 2; ++qb) {
                    const float iv = cb - mrun[qb];
#pragma unroll
                    for (int kb = 0; kb < 4; ++kb) sacc[kb][qb] = (f32x4){iv, iv, iv, iv};
#pragma unroll
                    for (int ks = 0; ks < 2; ++ks)
#pragma unroll
                        for (int kb = 0; kb < 4; ++kb) sacc[kb][qb] = __builtin_amdgcn_mfma_f32_16x16x32_bf16(kfr[kb][ks], qf[qb][ks], sacc[kb][qb], 0, 0, 0);
                }
                __builtin_amdgcn_s_setprio(0);
                const unsigned va = (unsigned)((const unsigned char*)vb_ - shm) + (unsigned)(((fq * 4 + (fr >> 2)) * 72 + (fr & 3) * 4) * 2);
                u32x2 lo0[4], hi0[4], lo1[4], hi1[4];
#define ATT_TR8(o0, o1, b0, b1) asm volatile( \
                    "ds_read_b64_tr_b16 %0, %8 offset:" #b0 "\n\tds_read_b64_tr_b16 %1, %8 offset:" #b0 "+32\n\tds_read_b64_tr_b16 %2, %8 offset:" #b0 "+64\n\tds_read_b64_tr_b16 %3, %8 offset:" #b0 "+96\n\t" \
                    "ds_read_b64_tr_b16 %4, %8 offset:" #b1 "\n\tds_read_b64_tr_b16 %5, %8 offset:" #b1 "+32\n\tds_read_b64_tr_b16 %6, %8 offset:" #b1 "+64\n\tds_read_b64_tr_b16 %7, %8 offset:" #b1 "+96\n\t" \
                    "s_waitcnt lgkmcnt(0)" : "=&v"(o0[0]), "=&v"(o0[1]), "=&v"(o0[2]), "=&v"(o0[3]), "=&v"(o1[0]), "=&v"(o1[1]), "=&v"(o1[2]), "=&v"(o1[3]) : "v"(va) : "memory")
                ATT_TR8(lo0, hi0, 0, 2304);
                ATT_TR8(lo1, hi1, 4608, 6912);
#undef ATT_TR8
                const float* bp = sB + (dk * 64 + fq * 4 - half * 32 - fr + 256 + 64 - 16);
                bool didre = false;
#pragma unroll
                for (int qb = 0; qb < 2; ++qb) {
                    if (dk > -5) {
#pragma unroll
                        for (int kb = 0; kb < 4; ++kb)
#pragma unroll
                            for (int j = 0; j < 4; ++j) sacc[kb][qb][j] += bp[kb * 16 + j - qb * 16 + 16];
                    }
                    float mx = -3e38f;
#pragma unroll
                    for (int kb = 0; kb < 4; ++kb)
#pragma unroll
                        for (int j = 0; j < 4; ++j) mx = fmaxf(mx, sacc[kb][qb][j]);
                    if (first || __any(mx > 6.0f)) {
                        float m2 = fmaxf(mx, __shfl_xor(mx, 16)); m2 = fmaxf(m2, __shfl_xor(m2, 32));
                        const float delta = first ? m2 : fmaxf(m2, 0.f), corr = first ? 1.0f : __builtin_amdgcn_exp2f(-delta);
                        mrun[qb] += delta; lrun[qb] *= corr;
#pragma unroll
                        for (int db = 0; db < 4; ++db) oacc[db][qb] = oacc[db][qb] * corr;
#pragma unroll
                        for (int kb = 0; kb < 4; ++kb) sacc[kb][qb] = sacc[kb][qb] - delta;
                        didre = true;
                    }
                    float ps = 0.f;
#pragma unroll
                    for (int kb = 0; kb < 4; ++kb)
#pragma unroll
                        for (int j = 0; j < 4; ++j) { const float pv = __builtin_amdgcn_exp2f(sacc[kb][qb][j]); sacc[kb][qb][j] = pv; ps += pv; }
                    lrun[qb] += ps;
                    bf16x8 pf0, pf1;
                    {
                        u32x4 pw;
                        pw.x = cvt_pk_bf16(sacc[0][qb][0], sacc[0][qb][1]); pw.y = cvt_pk_bf16(sacc[0][qb][2], sacc[0][qb][3]);
                        pw.z = cvt_pk_bf16(sacc[1][qb][0], sacc[1][qb][1]); pw.w = cvt_pk_bf16(sacc[1][qb][2], sacc[1][qb][3]);
                        pf0 = __builtin_bit_cast(bf16x8, pw);
                        pw.x = cvt_pk_bf16(sacc[2][qb][0], sacc[2][qb][1]); pw.y = cvt_pk_bf16(sacc[2][qb][2], sacc[2][qb][3]);
                        pw.z = cvt_pk_bf16(sacc[3][qb][0], sacc[3][qb][1]); pw.w = cvt_pk_bf16(sacc[3][qb][2], sacc[3][qb][3]);
                        pf1 = __builtin_bit_cast(bf16x8, pw);
                    }
                    __builtin_amdgcn_s_setprio(1);
#pragma unroll
                    for (int db = 0; db < 4; ++db) {
                        u32x4 vw; vw.x = lo0[db].x; vw.y = lo0[db].y; vw.z = hi0[db].x; vw.w = hi0[db].y;
                        oacc[db][qb] = __builtin_amdgcn_mfma_f32_16x16x32_bf16(__builtin_bit_cast(bf16x8, vw), pf0, oacc[db][qb], 0, 0, 0);
                    }
#pragma unroll
                    for (int db = 0; db < 4; ++db) {
                        u32x4 vw; vw.x = lo1[db].x; vw.y = lo1[db].y; vw.z = hi1[db].x; vw.w = hi1[db].y;
                        oacc[db][qb] = __builtin_amdgcn_mfma_f32_16x16x32_bf16(__builtin_bit_cast(bf16x8, vw), pf1, oacc[db][qb], 0, 0, 0);
                    }
                    __builtin_amdgcn_s_setprio(0);
                }
                first = false;
                (void)didre;
            }
            if (ld) ATT_LSTORE(knew);
            __syncthreads();
        }
#undef ATT_GLOAD
#undef ATT_LSTORE
#pragma unroll
        for (int qb = 0; qb < 2; ++qb) {
            float lt = lrun[qb]; lt += __shfl_xor(lt, 16); lt += __shfl_xor(lt, 32);
            const float inv = 1.0f / lt;
            bf16_t* op = (bf16_t*)((unsigned char*)p.h) + (tokb + c * 64 + half * 32 + qb * 16 + fr) * D + h * 64 + fq * 4;
#pragma unroll
            for (int db = 0; db < 4; ++db) {
                u32x2 ow; ow.x = cvt_pk_bf16(oacc[db][qb][0] * inv, oacc[db][qb][1] * inv); ow.y = cvt_pk_bf16(oacc[db][qb][2] * inv, oacc[db][qb][3] * inv);
                *(u32x2*)(op + db * 16) = ow;
            }
        }
    }
    __syncthreads();
}

#ifndef REP_ATTN
#define REP_ATTN 1
#endif
#ifndef REP_REC
#define REP_REC 1
#endif
#ifndef REP_NORM
#define REP_NORM 1
#endif
#ifndef REP_SYNC
#define REP_SYNC 1
#endif
#ifndef REP_PREP
#define REP_PREP 1
#endif
#ifndef REP_G3
#define REP_G3 1
#endif
#define GSYNC() do { for (int r_ = 0; r_ < REP_SYNC; ++r_) xcd_barrier(xb); } while (0)
__global__ void __launch_bounds__(512, 2) yoco_fwd(Params p) {
    extern __shared__ __attribute__((aligned(16))) unsigned char shm[];
    cg::grid_group grid = cg::this_grid();
    {
        const int t0 = threadIdx.x;
        if ((t0 & 63) == 0) *(volatile LAS int*)(LAS unsigned char*)(shm + WAVE_TAB_OFF + 4 * hw_wave_slot()) = t0 >> 6;
        __syncthreads();
    }
    const int tid0 = opaque_tid();
    unsigned* barw = (unsigned*)(p.ws + OFF_BAR);
    for (int i = blockIdx.x * 512 + tid0; i < XCD_BAR_WORDS; i += gridDim.x * 512) barw[i] = 0u;
    {
        u32x4* z = (u32x4*)(p.ws + OFF_ROWSS); const int nz = (int)((8 * (size_t)MTOK * 8) / 16);
        for (int i = blockIdx.x * 512 + tid0; i < nz; i += gridDim.x * 512) z[i] = (u32x4){0u, 0u, 0u, 0u};
    }
    volatile LAS unsigned* xst = (volatile LAS unsigned*)(LAS unsigned char*)(shm + LDS_BYTES - 16);
    if (tid0 == 0) { xst[0] = 0u; xst[1] = 0u; }
    for (int r = 0; r < REP_PREP; ++r) prep_phase(p, shm);
    grid.sync();
    XcdBarrier xb = xcd_barrier_post(barw, xst);
    {
        const float* mv = (const float*)(p.ws + OFF_MODV);
        for (int r = 0; r < REP_NORM; ++r) norm_phase(p.in[0], (bf16_t*)((unsigned char*)p.h), p.in[4], mv, mv + D, 6144, nullptr, nullptr, nullptr, nullptr, 0);
    }
    GSYNC();
    for (int l = 0; l < 4; ++l) {
        const float* hsrc = (l == 0) ? p.in[0] : p.h;
        const float* mv = (const float*)(p.ws + OFF_MODV) + (size_t)l * 8 * 6144;
        bf16_t* UF = (l < 2) ? (bf16_t*)(p.ws + OFF_UF_A) : (bf16_t*)((unsigned char*)p.h + ACTB);
        if (l < 2) {
            pg8::EpiHgrnIn e; e.QVG = (bf16_t*)(p.ws + OFF_QH); e.LF = (bf16_t*)(p.ws + OFF_LF); e.lb = (const float*)(p.ws + OFF_LBV) + l * D;
            run_gemm(shm, (const bf16_t*)((unsigned char*)p.h), (const bf16_t*)(p.ws + OFF_WB_A_IN) + (size_t)l * AIN * D, AIN, D, e);
            GSYNC();
            for (int r = 0; r < REP_REC; ++r) rec_passA(p, shm);
            GSYNC();
            for (int r = 0; r < REP_REC; ++r) rec_pass<true>(p, l, shm);
        } else {
            if (l == 2) { pg8::EpiBf16Split e; e.d0 = (bf16_t*)(p.ws + OFF_KB); e.scale = 1.0f; e.hm = 1;
                run_gemm(shm, (const bf16_t*)(p.ws + OFF_QB), (const bf16_t*)(p.ws + OFF_WB_KV), 2048, D, e); }
            { pg8::EpiBf16Split e; e.d0 = (bf16_t*)((unsigned char*)p.h + ACTB); e.hm = 0; e.scale = 0.125f * 1.4426950408889634f;   run_gemm(shm, (const bf16_t*)((unsigned char*)p.h), (const bf16_t*)(p.ws + OFF_WB_Q) + (size_t)(l - 2) * D * D, D, D, e); }
            GSYNC();
            for (int r = 0; r < REP_ATTN; ++r) attn_phase(p, l - 2, shm);
        }
        GSYNC();
        {
            pg8::EpiResid e; e.in = p.in; e.ws = p.ws; e.hbuf = p.h; e.l = l; e.which = 0;
            e.fill_tables(shm, opaque_tid()); __syncthreads();
            run_gemm(shm, (const bf16_t*)((unsigned char*)p.h), (l < 2) ? (const bf16_t*)(p.ws + OFF_WB_A_OUT) + (size_t)l * D * D : (const bf16_t*)(p.ws + OFF_WB_O) + (size_t)(l - 2) * D * D, D, D, e);
        }
        GSYNC();
        for (int r = 0; r < REP_G3; ++r) { pg8::EpiSwiglu e; e.act = (bf16_t*)(p.ws + OFF_ACT); run_gemm(shm, UF, (const bf16_t*)(p.ws + OFF_WB_FFN_IN) + (size_t)l * 2 * FFN * D, 2 * FFN, D, e); }
        GSYNC();
        {
            pg8::EpiResid e; e.in = p.in; e.ws = p.ws; e.hbuf = p.h; e.l = l; e.which = 1;
            e.fill_tables(shm, opaque_tid()); __syncthreads();
            run_gemm(shm, (const bf16_t*)(p.ws + OFF_ACT), (const bf16_t*)(p.ws + OFF_WB_FFN_OUT) + (size_t)l * D * FFN, D, FFN, e);
        }
        if (l < 3) GSYNC();
    }
}

extern "C" void kernel_launch(void* const* d_in, const int* in_sizes, int n_in, void* d_out, int out_size, void* d_ws, size_t ws_size, hipStream_t stream) {
    static int grid_blocks = 0;
    if (!grid_blocks) {
        int dev = 0, cus = 0, per_cu = 0;
        hipGetDevice(&dev);
        hipDeviceGetAttribute(&cus, hipDeviceAttributeMultiprocessorCount, dev);
        hipFuncSetAttribute((const void*)yoco_fwd, hipFuncAttributeMaxDynamicSharedMemorySize, LDS_BYTES);
        hipOccupancyMaxActiveBlocksPerMultiprocessor(&per_cu, (const void*)yoco_fwd, 512, LDS_BYTES);
        if (per_cu < 1) per_cu = 1;
        grid_blocks = cus * per_cu;
        (void)hipGetLastError();
    }
    Params p{};
    for (int i = 0; i < 20; ++i) p.in[i] = (const float*)d_in[i];
    p.h = (float*)d_out; p.ws = (unsigned char*)d_ws;
    if (ws_size < WS_END || n_in != 20) { fprintf(stderr, "kernel_launch: workspace too small (%zu < %zu) or unexpected inputs\n", ws_size, (size_t)WS_END); return; }
    void* args[] = {&p};
    hipError_t e = hipLaunchCooperativeKernel((const void*)yoco_fwd, dim3(grid_blocks), dim3(512), args, LDS_BYTES, stream);
    if (e != hipSuccess) fprintf(stderr, "cooperative launch failed: %s (grid %d)\n", hipGetErrorString(e), grid_blocks);
}
```

```cpp
#include <hip/hip_runtime.h>
#include <hip/hip_cooperative_groups.h>
#include <cstdio>
namespace cg = cooperative_groups;

#define LAS __attribute__((address_space(3)))
typedef unsigned short bf16_t;
typedef short bf16x8 __attribute__((ext_vector_type(8)));
typedef float f32x4 __attribute__((ext_vector_type(4)));
typedef unsigned u32x4 __attribute__((ext_vector_type(4)));
typedef unsigned u32x2 __attribute__((ext_vector_type(2)));
typedef float f32x2 __attribute__((ext_vector_type(2)));

constexpr int D = 1024, BATCH = 8, SEQ = 8192, MTOK = BATCH * SEQ, FFN = 2816, AIN = 4096;
constexpr int LDS_BYTES = 144 * 1024;
constexpr int XCD_BAR_WORDS_C = 3456;

__device__ __forceinline__ unsigned cvt_pk_bf16(float lo, float hi) { unsigned r; asm volatile("v_cvt_pk_bf16_f32 %0, %1, %2" : "=v"(r) : "v"(lo), "v"(hi)); return r; }
__device__ __forceinline__ float bf2f(unsigned short h) { return __uint_as_float((unsigned)h << 16); }
__device__ __forceinline__ float bflo(unsigned w) { return __uint_as_float(w << 16); }
__device__ __forceinline__ float bfhi(unsigned w) { return __uint_as_float(w & 0xffff0000u); }
__device__ __forceinline__ float silu_f(float x) { return x * __builtin_amdgcn_rcpf(1.0f + __expf(-x)); }

constexpr int WAVE_TAB_OFF = LDS_BYTES - 16 - 256;
__device__ __forceinline__ unsigned hw_wave_slot() { return (unsigned)__builtin_amdgcn_s_getreg(((6 - 1) << 11) | 4); }
__device__ __forceinline__ int opaque_tid() {
    extern __shared__ __attribute__((aligned(16))) unsigned char shm_tid_[];
    const int wv = __builtin_amdgcn_readfirstlane(*(volatile LAS int*)(LAS unsigned char*)(shm_tid_ + WAVE_TAB_OFF + 4 * hw_wave_slot()));
    int lane_;
    asm volatile("v_mbcnt_lo_u32_b32 %0, -1, 0\n\tv_mbcnt_hi_u32_b32 %0, -1, %0" : "=&v"(lane_));
    int t = wv * 64 + lane_;
    asm volatile("" : "+v"(t)); return t;
}
struct Params { const float* in[20]; float* h; unsigned char* ws; };
constexpr size_t ACTB = (size_t)MTOK * D * 2;
constexpr size_t OFF_WB_A_IN = 0;
constexpr size_t OFF_WB_A_OUT = OFF_WB_A_IN + (size_t)2 * AIN * D * 2;
constexpr size_t OFF_WB_FFN_IN = OFF_WB_A_OUT + (size_t)2 * D * D * 2;
constexpr size_t OFF_WB_FFN_OUT = OFF_WB_FFN_IN + (size_t)4 * 2 * FFN * D * 2;
constexpr size_t OFF_WB_KV = OFF_WB_FFN_OUT + (size_t)4 * D * FFN * 2;
constexpr size_t OFF_WB_Q = OFF_WB_KV + (size_t)2 * D * D * 2;
constexpr size_t OFF_WB_O = OFF_WB_Q + (size_t)2 * D * D * 2;
constexpr size_t OFF_MODV = OFF_WB_O + (size_t)2 * D * D * 2;
constexpr size_t OFF_KVMOD = OFF_MODV + (size_t)4 * 8 * 6144 * 4;
constexpr size_t OFF_LBV = OFF_KVMOD + (size_t)8 * 2048 * 4;
constexpr size_t OFF_U = OFF_LBV + (size_t)2 * D * 4;
constexpr size_t OFF_H = OFF_U;
constexpr size_t OFF_R = OFF_U + ACTB;
constexpr size_t OFF_QH = OFF_R, OFF_VH = OFF_R + ACTB, OFF_GH = OFF_R + 2 * ACTB, OFF_LF = OFF_R + 3 * ACTB;
constexpr size_t OFF_ACT = OFF_R;
constexpr size_t OFF_UF_A = OFF_R + 4 * ACTB;
constexpr size_t OFF_KB = OFF_R + (size_t)MTOK * FFN * 2, OFF_VB = OFF_KB + ACTB, OFF_QB = OFF_VB + ACTB;
constexpr size_t OFF_SLOC = OFF_R + 5 * ACTB, OFF_DLOG = OFF_SLOC + (size_t)256 * 16384 * 4;
constexpr size_t OFF_BAR = OFF_QB + ACTB;
constexpr size_t OFF_ROWSS = OFF_BAR + (size_t)16384;
constexpr size_t WS_END = OFF_ROWSS + (size_t)8 * MTOK * 8;


#define XB_TMO      128
#define XB_XCNT(j)  (256  + 64 * (j))
#define XB_XSUB(j)  (1280 + 64 * (j))
#define XB_XGEN(j)  (2304 + 64 * (j))
#define XB_TOP      3328
#define XB_TOPGEN   3392
#define XCD_BAR_WORDS 3456
#define XB_SPIN_CAP (1u << 18)
__device__ __forceinline__ unsigned xb_ld(unsigned* p)              { return __hip_atomic_load(p, __ATOMIC_RELAXED, __HIP_MEMORY_SCOPE_AGENT); }
__device__ __forceinline__ unsigned xb_add(unsigned* p, unsigned v) { return __hip_atomic_fetch_add(p, v, __ATOMIC_RELAXED, __HIP_MEMORY_SCOPE_AGENT); }
__device__ __forceinline__ unsigned xb_xcc_id() { return (unsigned)__builtin_amdgcn_s_getreg((3 << 11) | 20) & 0xFu; }
#define XB_SPIN(cond, bar) do { unsigned _sp = 0; while (cond) { __builtin_amdgcn_s_sleep(1); \
    if ((++_sp & 255u) == 0u) { if (xb_ld(&(bar)[XB_TMO])) break; if (_sp > XB_SPIN_CAP) { atomicAdd(&(bar)[XB_TMO], 1u); break; } } } } while (0)
struct XcdBarrier { unsigned* bar; unsigned x; volatile LAS unsigned* st; };
__device__ __forceinline__ XcdBarrier xcd_barrier_post(unsigned* bar, volatile LAS unsigned* st) {
    XcdBarrier b; b.bar = bar; b.x = xb_xcc_id(); b.st = st;
    if (opaque_tid() == 0) (void)xb_add(&bar[XB_XCNT(b.x)], 1u);
    return b;
}
__device__ __forceinline__ void xcd_barrier_complete(unsigned* bar, unsigned x, unsigned& nloc, unsigned& nx) {
    const unsigned G = gridDim.x * gridDim.y * gridDim.z;
    unsigned sum, cnt, mine, sp = 0u;
    for (;;) {
        sum = 0u; cnt = 0u; mine = 0u;
#pragma unroll
        for (unsigned j = 0; j < 16; ++j) { const unsigned c = xb_ld(&bar[XB_XCNT(j)]); sum += c; cnt += (c > 0u) ? 1u : 0u; mine = (j == x) ? c : mine; }
        if (sum == G) break;
        __builtin_amdgcn_s_sleep(1);
        if ((++sp & 255u) == 0u) { if (xb_ld(&bar[XB_TMO])) break; if (sp > XB_SPIN_CAP) { atomicAdd(&bar[XB_TMO], 1u); break; } }
    }
    nloc = mine > 0u ? mine : 1u; nx = cnt > 0u ? cnt : 1u;
}
__device__ __forceinline__ void xcd_barrier(const XcdBarrier& b) {
    asm volatile("s_waitcnt vmcnt(0)" ::: "memory");
    __syncthreads();
    if (opaque_tid() == 0) {
        unsigned* bar = b.bar;
        __builtin_amdgcn_s_waitcnt(0);
        unsigned nloc = b.st[0], nx = b.st[1];
        if (nloc == 0u) { xcd_barrier_complete(bar, b.x, nloc, nx); b.st[0] = nloc; b.st[1] = nx; }
        const unsigned old = xb_add(&bar[XB_XSUB(b.x)], 1u);
        const unsigned gen = old / nloc;
        if (old + 1u == (gen + 1u) * nloc) {
            __builtin_amdgcn_fence(__ATOMIC_RELEASE, "agent");
            asm volatile("s_waitcnt vmcnt(0)" ::: "memory");
            const unsigned og = xb_add(&bar[XB_TOP], 1u);
            const unsigned tg = og / nx;
            if (og + 1u == (tg + 1u) * nx) xb_add(&bar[XB_TOPGEN], 1u);
            else XB_SPIN(xb_ld(&bar[XB_TOPGEN]) == tg, bar);
            __builtin_amdgcn_fence(__ATOMIC_ACQUIRE, "agent");
            xb_add(&bar[XB_XGEN(b.x)], 1u);
            asm volatile("s_waitcnt vmcnt(0)" ::: "memory");
        } else {
            XB_SPIN(xb_ld(&bar[XB_XGEN(b.x)]) == gen, bar);
            __builtin_amdgcn_fence(__ATOMIC_ACQUIRE, "agent");
            asm volatile("s_waitcnt vmcnt(0)" ::: "memory");
        }
    }
    __syncthreads();
}

namespace pg8 {
constexpr int BM = 256, BK = 64, HALF = 128, HTB = HALF * BK * 2, STAGE_BYTES = 8 * HTB, NXCD = 8, WGM = 8;
__device__ __forceinline__ int lds_byte(int r, int c) { const int st = (r >> 4) * 2 + (c >> 5), rr = r & 15, cc = c & 31, ob = rr * 64 + cc * 2; return st * 1024 + (ob ^ (((ob >> 9) & 1) << 5)); }
__device__ __forceinline__ void stage_rc(int b, int& R, int& C) { const int st = b / 1024, sb = b % 1024, swz = sb ^ (((sb >> 9) & 1) << 5); R = (st >> 1) * 16 + swz / 64; C = (st & 1) * 32 + (swz % 64) / 2; }
__device__ __forceinline__ int perm32(int rho) { const int n = rho >> 4, i = rho & 15; return 8 * (i >> 2) + 4 * n + (i & 3); }
struct Unit { int pm, pn; };
struct Gemm { const bf16_t* A; const bf16_t* Bt; int M, N, K; };
struct StaticOrder {
    int nM, nN, nwg, G, c;
    __device__ void init(int M, int N, int G_, int c_) { nM = M / BM; nN = N / BM; nwg = nM * nN; G = G_; c = c_; }
    __device__ bool next(int i, Unit& u) const {
        const long L = (long)i * G + c; if (L >= nwg) return false;
        int wgid = (int)L; { const int q = nwg / NXCD, r = nwg % NXCD, xcd = wgid % NXCD, off = wgid / NXCD; wgid = (xcd < r ? xcd * (q + 1) : r * (q + 1) + (xcd - r) * q) + off; }
        const int nig = WGM * nN, gid = wgid / nig, fm = gid * WGM, gsz = (nM - fm) < WGM ? (nM - fm) : WGM;
        u.pm = fm + ((wgid % nig) % gsz); u.pn = (wgid % nig) / gsz; return true;
    }
};

template <class Epi>
__device__ __forceinline__ void gemm_phase(LAS unsigned char* lds, const Gemm g, const StaticOrder& S, const Epi& E) {
    const int tid = opaque_tid(), wid = __builtin_amdgcn_readfirstlane(tid >> 6), lane = tid & 63, wr = wid >> 2, wc = wid & 3, fr = lane & 15, fq = lane >> 4;
    const int K = g.K, nt = K / BK;
    unsigned voffA[2], voffB[2];
#pragma unroll
    for (int i = 0; i < 2; ++i) { int R, C; stage_rc(tid * 16 + i * 8192, R, C); const int Rb = Epi::PERM ? ((R & ~31) + perm32(R & 31)) : R;
        voffA[i] = (unsigned)(R * K + C) * 2u; voffB[i] = (unsigned)(Rb * K + C) * 2u; }
    const size_t kstep = (size_t)(BK * 2);
    const size_t hstep = (size_t)HALF * K * 2;
    const size_t tstep = 2 * hstep;
    const unsigned ldsw = (unsigned)wid * 1024u;
    const int aoff = lds_byte(wr * 64 + fr, fq * 8), boff = lds_byte(wc * 32 + fr, fq * 8);
#define PG8_SA(b, h) (((b) * 2 + (h)) * HTB)
#define PG8_SB(b, h) ((4 + (b) * 2 + (h)) * HTB)
#define PG8_STAGE(bufoff, gbase, voff) do { _Pragma("unroll") for (int _i = 0; _i < 2; ++_i) \
        __builtin_amdgcn_global_load_lds((const unsigned*)((const char*)(gbase) + (voff)[_i]), (LAS unsigned*)(lds + (bufoff) + ldsw + _i * 8192), 16, 0, 0); } while (0)
#define PG8_LDA(dst, b, h) do { _Pragma("unroll") for (int m = 0; m < 4; ++m) _Pragma("unroll") for (int k = 0; k < 2; ++k) dst[m][k] = *(const LAS bf16x8*)(lds + PG8_SA(b, h) + aoff + m * 2048 + k * 1024); } while (0)
#define PG8_LDB(dst, b, h) do { _Pragma("unroll") for (int n = 0; n < 2; ++n) _Pragma("unroll") for (int k = 0; k < 2; ++k) dst[n][k] = *(const LAS bf16x8*)(lds + PG8_SB(b, h) + boff + n * 2048 + k * 1024); } while (0)
#define PG8_MMA(ai, bj, At, Bt) do { __builtin_amdgcn_s_setprio(1); _Pragma("unroll") for (int m = 0; m < 4; ++m) _Pragma("unroll") for (int n = 0; n < 2; ++n) _Pragma("unroll") for (int k = 0; k < 2; ++k) \
        acc[ai][bj][m][n] = __builtin_amdgcn_mfma_f32_16x16x32_bf16(Bt[n][k], At[m][k], acc[ai][bj][m][n], 0, 0, 0); __builtin_amdgcn_s_setprio(0); } while (0)
#define PG8_WAIT_V(n) asm volatile("s_waitcnt vmcnt(" #n ")" ::: "memory")
#define PG8_WAIT_L(n) asm volatile("s_waitcnt lgkmcnt(" #n ")" ::: "memory")
#define PG8_BAR __builtin_amdgcn_s_barrier()
#define PG8_SCHED __builtin_amdgcn_sched_barrier(0)
    Unit cur, nxt; int ui = 0;
    if (!S.next(0, cur)) return;
    f32x4 acc[2][2][4][2];
#pragma unroll
    for (int a = 0; a < 2; ++a)
#pragma unroll
        for (int b = 0; b < 2; ++b)
#pragma unroll
            for (int m = 0; m < 4; ++m)
#pragma unroll
                for (int n = 0; n < 2; ++n) acc[a][b][m][n] = (f32x4){0.f, 0.f, 0.f, 0.f};
    bf16x8 At[4][2], B0[2][2], B1[2][2];
    const char* cA = (const char*)g.A + (size_t)cur.pm * tstep; const char* cB = (const char*)g.Bt + (size_t)cur.pn * tstep;
    PG8_STAGE(PG8_SB(0, 0), cB, voffB); PG8_STAGE(PG8_SA(0, 0), cA, voffA); PG8_STAGE(PG8_SB(0, 1), cB + hstep, voffB); PG8_STAGE(PG8_SA(0, 1), cA + hstep, voffA);
    if (wr == 1) PG8_BAR;
    PG8_WAIT_V(4); PG8_BAR;
    PG8_STAGE(PG8_SB(1, 0), cB + kstep, voffB); PG8_STAGE(PG8_SA(1, 0), cA + kstep, voffA); PG8_STAGE(PG8_SB(1, 1), cB + hstep + kstep, voffB);
    PG8_WAIT_V(6); PG8_BAR;
    for (;;) {
        const bool has_next = S.next(ui + 1, nxt);
        const char* nA = has_next ? (const char*)g.A + (size_t)nxt.pm * tstep : cA; const char* nB = has_next ? (const char*)g.Bt + (size_t)nxt.pn * tstep : cB;
        for (int t = 0; t < nt; t += 2) {
            const bool last = (t == nt - 2);
            const char* a1 = cA + (size_t)(t + 1) * kstep;
            const char* a2 = last ? nA : cA + (size_t)(t + 2) * kstep; const char* b2 = last ? nB : cB + (size_t)(t + 2) * kstep;
            const char* a3 = a2 + kstep; const char* b3 = b2 + kstep;
            PG8_LDB(B0, 0, 0); PG8_SCHED; PG8_LDA(At, 0, 0); PG8_STAGE(PG8_SA(1, 1), a1 + hstep, voffA);
            PG8_WAIT_L(8); PG8_BAR; PG8_WAIT_L(0); PG8_MMA(0, 0, At, B0); PG8_BAR; PG8_SCHED;
            PG8_LDB(B1, 0, 1); PG8_STAGE(PG8_SB(0, 0), b2, voffB);
            PG8_BAR; PG8_WAIT_L(0); PG8_MMA(0, 1, At, B1); PG8_BAR;
            PG8_LDA(At, 0, 1); PG8_STAGE(PG8_SA(0, 0), a2, voffA);
            PG8_BAR; PG8_WAIT_L(0); PG8_MMA(1, 0, At, B0); PG8_BAR; PG8_SCHED;
            PG8_STAGE(PG8_SB(0, 1), b2 + hstep, voffB);
            PG8_WAIT_V(6); PG8_BAR; PG8_MMA(1, 1, At, B1); PG8_BAR;
            PG8_LDB(B0, 1, 0); PG8_SCHED; PG8_LDA(At, 1, 0); PG8_STAGE(PG8_SA(0, 1), a2 + hstep, voffA);
            PG8_WAIT_L(8); PG8_BAR; PG8_WAIT_L(0); PG8_MMA(0, 0, At, B0); PG8_BAR; PG8_SCHED;
            PG8_LDB(B1, 1, 1); PG8_STAGE(PG8_SB(1, 0), b3, voffB);
            PG8_BAR; PG8_WAIT_L(0); PG8_MMA(0, 1, At, B1); PG8_BAR;
            PG8_LDA(At, 1, 1); PG8_STAGE(PG8_SA(1, 0), a3, voffA);
            PG8_BAR; PG8_WAIT_L(0); PG8_MMA(1, 0, At, B0); PG8_BAR; PG8_SCHED;
            PG8_STAGE(PG8_SB(1, 1), b3 + hstep, voffB);
            PG8_WAIT_V(6); PG8_BAR; PG8_MMA(1, 1, At, B1); PG8_BAR;
        }
        if (wr == 0) PG8_BAR;
        E(acc, cur, wr, wc, fr, fq);
        if (!has_next) break;
#pragma unroll
        for (int a = 0; a < 2; ++a)
#pragma unroll
            for (int b = 0; b < 2; ++b)
#pragma unroll
                for (int m = 0; m < 4; ++m)
#pragma unroll
                    for (int n = 0; n < 2; ++n) acc[a][b][m][n] = (f32x4){0.f, 0.f, 0.f, 0.f};
        cur = nxt; cA = nA; cB = nB; ++ui;
        if (wr == 1) PG8_BAR;
    }
    PG8_WAIT_V(0);
    PG8_BAR;
#undef PG8_SA
#undef PG8_SB
#undef PG8_STAGE
#undef PG8_LDA
#undef PG8_LDB
#undef PG8_MMA
#undef PG8_WAIT_V
#undef PG8_WAIT_L
#undef PG8_BAR
#undef PG8_SCHED
}

struct EpiHgrnIn {
    static constexpr bool PERM = true;
    bf16_t* QVG; bf16_t* LF; const float* lb;
    __device__ __forceinline__ void operator()(const f32x4 (&acc)[2][2][4][2], const Unit& u, int wr, int wc, int fr, int fq) const {
        const int seg = u.pn >> 2, colt = (u.pn & 3) * 256;
        const int row0 = u.pm * BM + wr * 64 + fr, col0 = colt + wc * 32 + 8 * fq;
        const size_t hm0 = (size_t)(u.pm >> 5) * SEQ * 896 + (size_t)(2 * (u.pn & 3)) * SEQ * 128 + wc * 32 + 8 * fq;
        if (seg == 1) {
#pragma unroll
            for (int bj = 0; bj < 2; ++bj) {
                const f32x4 l0 = *(const f32x4*)(lb + col0 + bj * HALF), l1 = *(const f32x4*)(lb + col0 + bj * HALF + 4);
#pragma unroll
                for (int ai = 0; ai < 2; ++ai)
#pragma unroll
                    for (int m = 0; m < 4; ++m) {
                        bf16_t* rowp = LF + (size_t)(row0 + ai * HALF + m * 16) * 128 + hm0 + (size_t)bj * SEQ * 128;
                        f32x4 o0, o1;
#pragma unroll
                        for (int j = 0; j < 4; ++j) {
                            float z = acc[ai][bj][m][0][j]; float sg = __builtin_amdgcn_rcpf(1.0f + __expf(-z)); float f = l0[j] + (1.0f - l0[j]) * sg; o0[j] = __logf(fmaxf(f, 1e-30f));
                            z = acc[ai][bj][m][1][j]; sg = __builtin_amdgcn_rcpf(1.0f + __expf(-z)); f = l1[j] + (1.0f - l1[j]) * sg; o1[j] = __logf(fmaxf(f, 1e-30f));
                        }
                        u32x4 lw; lw.x = cvt_pk_bf16(o0[0], o0[1]); lw.y = cvt_pk_bf16(o0[2], o0[3]); lw.z = cvt_pk_bf16(o1[0], o1[1]); lw.w = cvt_pk_bf16(o1[2], o1[3]);
                        *(u32x4*)rowp = lw;
                    }
            }
        } else {
            bf16_t* base = QVG + (size_t)(seg == 0 ? 0 : (seg == 2 ? 1 : 2)) * ((size_t)MTOK * D);
            const bool act = (seg != 2);
#pragma unroll
            for (int ai = 0; ai < 2; ++ai)
#pragma unroll
                for (int m = 0; m < 4; ++m)
#pragma unroll
                    for (int bj = 0; bj < 2; ++bj) {
                        f32x4 v0 = acc[ai][bj][m][0], v1 = acc[ai][bj][m][1];
                        if (act) {
#pragma unroll
                            for (int j = 0; j < 4; ++j) { v0[j] = silu_f(v0[j]); v1[j] = silu_f(v1[j]); }
                        }
                        u32x4 w; w.x = cvt_pk_bf16(v0[0], v0[1]); w.y = cvt_pk_bf16(v0[2], v0[3]); w.z = cvt_pk_bf16(v1[0], v1[1]); w.w = cvt_pk_bf16(v1[2], v1[3]);
                        *(u32x4*)(base + (size_t)(row0 + ai * HALF + m * 16) * 128 + hm0 + (size_t)bj * SEQ * 128) = w;
                    }
        }
    }
};
struct EpiResid {
    static constexpr bool PERM = true;
    const float* const* in; unsigned char* ws; float* hbuf; int l, which;
    __device__ __forceinline__ void emit(const f32x4 (&v)[2][2][4][2], const float (&rs)[2][4], bf16_t* U, const LAS float* tab, int row0, int col0, int cl0) const {
#pragma unroll
        for (int bj = 0; bj < 2; ++bj) {
            const int c = col0 + bj * HALF, cl = cl0 + bj * HALF;
            const f32x4 a0 = *(const LAS f32x4*)(tab + cl), a1 = *(const LAS f32x4*)(tab + cl + 4), t0 = *(const LAS f32x4*)(tab + 256 + cl), t1 = *(const LAS f32x4*)(tab + 256 + cl + 4);
#pragma unroll
            for (int ai = 0; ai < 2; ++ai)
#pragma unroll
                for (int m = 0; m < 4; ++m) {
                    const f32x4 u0 = (v[ai][bj][m][0] * rs[ai][m]) * a0 + t0, u1 = (v[ai][bj][m][1] * rs[ai][m]) * a1 + t1;
                    u32x4 w; w.x = cvt_pk_bf16(u0[0], u0[1]); w.y = cvt_pk_bf16(u0[2], u0[3]); w.z = cvt_pk_bf16(u1[0], u1[1]); w.w = cvt_pk_bf16(u1[2], u1[3]);
                    *(u32x4*)(U + (size_t)(row0 + ai * HALF + m * 16) * D + c) = w;
                }
            __builtin_amdgcn_sched_barrier(0);
        }
    }
    __device__ __forceinline__ void fill_tables(unsigned char* shm, int tid) const {
        float* t = (float*)(shm + 131072);
        const int pn = (int)blockIdx.x >> 6, b = (int)blockIdx.x & 7, c = pn * 256 + (tid & 255), second = tid >> 8;
        const float* mv = (const float*)(ws + OFF_MODV) + (size_t)l * 8 * 6144;
        if (second == 0) {
            float ga, shv;
            if (which == 0) { ga = in[5][l * D + c] * (1.0f + mv[(size_t)b * 6144 + 4 * D + c]); shv = mv[(size_t)b * 6144 + 3 * D + c]; }
            else if (l == 3) { ga = in[19][c]; shv = 0.f; }
            else { const float* mvn = mv + (size_t)8 * 6144; ga = in[4][(l + 1) * D + c] * (1.0f + mvn[(size_t)b * 6144 + D + c]); shv = mvn[(size_t)b * 6144 + c]; }
            t[tid & 255] = ga; t[256 + (tid & 255)] = shv;
        } else if (which == 1 && l == 1) {
            const float* kvm = (const float*)(ws + OFF_KVMOD);
            t[512 + (tid & 255)] = in[12][c] * (1.0f + kvm[(size_t)b * 2048 + D + c]); t[768 + (tid & 255)] = kvm[(size_t)b * 2048 + c];
        }
    }
    __device__ __forceinline__ void operator()(f32x4 (&acc)[2][2][4][2], const Unit& u, int wr, int wc, int fr, int fq) const {
        __builtin_amdgcn_sched_barrier(0);
        const int b = u.pm >> 5;
        const float* mv = (const float*)(ws + OFF_MODV) + (size_t)l * 8 * 6144;
        const bool src_x = (l == 0 && which == 0);
        const float* xin = in[0]; bf16_t* hb = (bf16_t*)(ws + OFF_H); float* dst = hbuf;
        const int mode = (l == 3 && which == 1) ? 1 : 0;
        unsigned long long* rowacc = (unsigned long long*)(ws + OFF_ROWSS) + (size_t)(2 * l + which) * MTOK;
        const float* gp = mv + (which ? 5 : 2) * D + (size_t)b * 6144;
        const int row0 = u.pm * BM + wr * 64 + fr, col0 = u.pn * BM + wc * 32 + 8 * fq;
        {
            f32x4 gv[2][2];
#pragma unroll
            for (int bj = 0; bj < 2; ++bj)
#pragma unroll
                for (int n = 0; n < 2; ++n) gv[bj][n] = *(const f32x4*)(gp + col0 + bj * HALF + 4 * n);
#pragma unroll
            for (int ai = 0; ai < 2; ++ai) {
                u32x4 hw[4][2];
                if (!src_x) {
#pragma unroll
                    for (int m = 0; m < 4; ++m)
#pragma unroll
                        for (int bj = 0; bj < 2; ++bj) hw[m][bj] = *(const u32x4*)(hb + (size_t)(row0 + ai * HALF + m * 16) * D + col0 + bj * HALF);
                }
#pragma unroll
                for (int m = 0; m < 4; ++m) {
                    const size_t ro = (size_t)(row0 + ai * HALF + m * 16) * D + col0;
                    float pt = 0.f;
#pragma unroll
                    for (int bj = 0; bj < 2; ++bj) {
                        f32x4 s0, s1;
                        if (src_x) { s0 = *(const f32x4*)(xin + ro + bj * HALF); s1 = *(const f32x4*)(xin + ro + bj * HALF + 4); }
                        else { const u32x4 q = hw[m][bj];
                            s0 = (f32x4){bflo(q.x), bfhi(q.x), bflo(q.y), bfhi(q.y)}; s1 = (f32x4){bflo(q.z), bfhi(q.z), bflo(q.w), bfhi(q.w)}; }
                        const f32x4 v0 = s0 + gv[bj][0] * acc[ai][bj][m][0], v1 = s1 + gv[bj][1] * acc[ai][bj][m][1];
                        acc[ai][bj][m][0] = v0; acc[ai][bj][m][1] = v1;
                        if (mode == 0) { u32x4 w; w.x = cvt_pk_bf16(v0[0], v0[1]); w.y = cvt_pk_bf16(v0[2], v0[3]); w.z = cvt_pk_bf16(v1[0], v1[1]); w.w = cvt_pk_bf16(v1[2], v1[3]);
                            *(u32x4*)(hb + ro + bj * HALF) = w; }
                        pt += ((v0[0] * v0[0] + v0[1] * v0[1]) + (v0[2] * v0[2] + v0[3] * v0[3])) + ((v1[0] * v1[0] + v1[1] * v1[1]) + (v1[2] * v1[2] + v1[3] * v1[3]));
                    }
                    pt += __shfl_xor(pt, 16); pt += __shfl_xor(pt, 32);
                    if (fq == 0) (void)__hip_atomic_fetch_add(rowacc + row0 + ai * HALF + m * 16, (1ull << 48) + (unsigned long long)(pt * 65536.0f + 0.5f), __ATOMIC_RELAXED, __HIP_MEMORY_SCOPE_AGENT);
                    if (src_x) __builtin_amdgcn_sched_barrier(0);
                }
                __builtin_amdgcn_sched_barrier(0);
            }
        }
        float rs[2][4];
        {
            unsigned spins = 0;
            __builtin_amdgcn_s_sleep(48);
            for (;;) {
                bool done = true;
#pragma unroll
                for (int ai = 0; ai < 2; ++ai)
#pragma unroll
                    for (int m = 0; m < 4; ++m) {
                        const unsigned long long q = __hip_atomic_load(rowacc + row0 + ai * HALF + m * 16, __ATOMIC_RELAXED, __HIP_MEMORY_SCOPE_AGENT);
                        done = done && ((q >> 48) >= 16ull);
                        rs[ai][m] = rsqrtf((float)(q & 0xffffffffffffull) * (1.0f / 65536.0f) * (1.0f / D) + 1e-6f);
                    }
                if (__all(done) || ++spins > (1u << 16)) break;
                __builtin_amdgcn_s_sleep(16);
            }
        }
        asm volatile("" ::: "memory");
        __builtin_amdgcn_sched_barrier(0);
        const LAS float* tab = (const LAS float*)(unsigned)131072u;
        int cl0 = wc * 32 + 8 * fq; asm volatile("" : "+v"(cl0));
        if (mode == 1) {
#pragma unroll
            for (int bj = 0; bj < 2; ++bj) {
                const f32x4 g0 = *(const LAS f32x4*)(tab + cl0 + bj * HALF), g1 = *(const LAS f32x4*)(tab + cl0 + bj * HALF + 4);
#pragma unroll
                for (int ai = 0; ai < 2; ++ai)
#pragma unroll
                    for (int m = 0; m < 4; ++m) {
                        float* op = dst + (size_t)(row0 + ai * HALF + m * 16) * D + col0 + bj * HALF;
                        *(f32x4*)op = (acc[ai][bj][m][0] * rs[ai][m]) * g0; *(f32x4*)(op + 4) = (acc[ai][bj][m][1] * rs[ai][m]) * g1;
                    }
            }
        } else {
            if (which == 0) emit(acc, rs, (l < 2) ? (bf16_t*)(ws + OFF_UF_A) : (bf16_t*)((unsigned char*)hbuf + ACTB), tab, row0, col0, cl0);
            else {
                emit(acc, rs, (bf16_t*)((unsigned char*)hbuf), tab, row0, col0, cl0);
                if (l == 1) emit(acc, rs, (bf16_t*)(ws + OFF_QB), tab + 512, row0, col0, cl0);
            }
        }
    }
};
struct EpiSwiglu {
    static constexpr bool PERM = true;
    bf16_t* act;
    __device__ __forceinline__ void operator()(const f32x4 (&acc)[2][2][4][2], const Unit& u, int wr, int wc, int fr, int fq) const {
        const int row0 = u.pm * BM + wr * 64 + fr, col0 = u.pn * HALF + wc * 32 + 8 * fq;
#pragma unroll
        for (int ai = 0; ai < 2; ++ai)
#pragma unroll
            for (int m = 0; m < 4; ++m) {
                f32x4 r0, r1;
#pragma unroll
                for (int j = 0; j < 4; ++j) { r0[j] = silu_f(acc[ai][0][m][0][j]) * acc[ai][1][m][0][j]; r1[j] = silu_f(acc[ai][0][m][1][j]) * acc[ai][1][m][1][j]; }
                u32x4 w; w.x = cvt_pk_bf16(r0[0], r0[1]); w.y = cvt_pk_bf16(r0[2], r0[3]); w.z = cvt_pk_bf16(r1[0], r1[1]); w.w = cvt_pk_bf16(r1[2], r1[3]);
                *(u32x4*)(act + (size_t)(row0 + ai * HALF + m * 16) * FFN + col0) = w;
            }
    }
};
struct EpiBf16Split {
    static constexpr bool PERM = true;
    bf16_t* d0; float scale; int hm;
    __device__ __forceinline__ void operator()(const f32x4 (&acc)[2][2][4][2], const Unit& u, int wr, int wc, int fr, int fq) const {
        bf16_t* base = d0 + (size_t)(u.pn >> 2) * ((size_t)MTOK * D);
        const int row0 = u.pm * BM + wr * 64 + fr, col0 = (u.pn & 3) * 256 + wc * 32 + 8 * fq;
#pragma unroll
        for (int ai = 0; ai < 2; ++ai)
#pragma unroll
            for (int m = 0; m < 4; ++m)
#pragma unroll
                for (int bj = 0; bj < 2; ++bj) {
                    const f32x4 v0 = acc[ai][bj][m][0] * scale, v1 = acc[ai][bj][m][1] * scale;
                    u32x4 w; w.x = cvt_pk_bf16(v0[0], v0[1]); w.y = cvt_pk_bf16(v0[2], v0[3]); w.z = cvt_pk_bf16(v1[0], v1[1]); w.w = cvt_pk_bf16(v1[2], v1[3]);
                    const int row = row0 + ai * HALF + m * 16;
                    if (hm) *(u32x4*)(base + (size_t)row * 64 + (size_t)(u.pm >> 5) * SEQ * 960 + (size_t)((col0 + bj * HALF) >> 6) * SEQ * 64 + ((col0 + bj * HALF) & 63)) = w;
                    else *(u32x4*)(base + (size_t)row * D + col0 + bj * HALF) = w;
                }
    }
};
}

template <class Epi>
__device__ __forceinline__ void run_gemm(unsigned char* shm, const bf16_t* A, const bf16_t* Bt, int N, int K, const Epi& E) {
    pg8::Gemm g; g.A = A; g.Bt = Bt; g.M = MTOK; g.N = N; g.K = K;
    pg8::StaticOrder S; S.init(MTOK, N, (int)gridDim.x, (int)blockIdx.x);
    pg8::gemm_phase<Epi>((LAS unsigned char*)shm, g, S, E);
    __syncthreads();
}

__device__ __forceinline__ int ffnmap(int nn) { return nn < FFN ? ((nn >> 7) * 256 + (nn & 127)) : (((nn - FFN) >> 7) * 256 + 128 + ((nn - FFN) & 127)); }

__device__ __forceinline__ void conv_group(const float* src0, bf16_t* dst0, const int K, const int N, const int L, const int mode, unsigned char* shm, const int tid) {
    float* st = (float*)shm;
    const int per = (K / 128) * (N / 64), total = L * per, ntn = N / 64;
    f32x4 v[4];
    int tile = blockIdx.x;
    if (tile < total) {
        const int l = tile / per, tt = tile % per, k0 = (tt / ntn) * 128, n0 = (tt % ntn) * 64;
        const float* src = src0 + (size_t)l * K * N;
#pragma unroll
        for (int it = 0; it < 4; ++it) { const int idx = tid + it * 512, k = idx >> 4, n4 = idx & 15; v[it] = *(const f32x4*)(src + (size_t)(k0 + k) * N + n0 + 4 * n4); }
    }
    for (; tile < total; tile += gridDim.x) {
        const int l = tile / per, tt = tile % per, k0 = (tt / ntn) * 128, n0 = (tt % ntn) * 64;
        bf16_t* dst = dst0 + (size_t)l * K * N;
        __syncthreads();
#pragma unroll
        for (int it = 0; it < 4; ++it) { const int idx = tid + it * 512, k = idx >> 4, n4 = idx & 15;
#pragma unroll
            for (int e = 0; e < 4; ++e) st[k * 65 + 4 * n4 + e] = v[it][e]; }
        __syncthreads();
        const int nt_ = tile + (int)gridDim.x;
        if (nt_ < total) {
            const int l2 = nt_ / per, t2 = nt_ % per, k2 = (t2 / ntn) * 128, n2 = (t2 % ntn) * 64;
            const float* src = src0 + (size_t)l2 * K * N;
#pragma unroll
            for (int it = 0; it < 4; ++it) { const int idx = tid + it * 512, k = idx >> 4, n4 = idx & 15; v[it] = *(const f32x4*)(src + (size_t)(k2 + k) * N + n2 + 4 * n4); }
        }
#pragma unroll
        for (int it = 0; it < 2; ++it) { const int idx = tid + it * 512, n = idx >> 4, kg = idx & 15; const int nn = n0 + n; const int drow = mode ? ffnmap(nn) : nn;
            u32x4 w;
#pragma unroll
            for (int e = 0; e < 4; ++e) w[e] = cvt_pk_bf16(st[(8 * kg + 2 * e) * 65 + n], st[(8 * kg + 2 * e + 1) * 65 + n]);
            *(u32x4*)(dst + (size_t)drow * K + k0 + 8 * kg) = w; }
    }
}

__device__ void prep_phase(const Params& p, unsigned char* shm) {
    const int tid = opaque_tid();
    {
        float* cact = (float*)shm;
        float* red = cact + 8192;
        bool loaded = false;
        const int wv = tid >> 6, lane = tid & 63;
        for (int task = blockIdx.x; task < 416; task += gridDim.x) {
            if (!loaded) {
                for (int i = tid; i < 8192; i += 512) { const int k = i >> 3, b = i & 7; cact[i] = silu_f(p.in[1][b * D + k]); }
                loaded = true;
            }
            __syncthreads();
            const int c0 = task * 64;
            const float* src; const float* bias; float* dst; int stride, dstride;
            if (c0 < 24576) { const int l = c0 / 6144, j = c0 % 6144; src = p.in[2] + (size_t)l * D * 6144 + j; stride = 6144; bias = p.in[3] + l * 6144 + j; dst = ((float*)(p.ws + OFF_MODV)) + (size_t)l * 8 * 6144 + j; dstride = 6144; }
            else { const int j = c0 - 24576; src = p.in[13] + j; stride = 2048; bias = p.in[14] + j; dst = ((float*)(p.ws + OFF_KVMOD)) + j; dstride = 2048; }
            float a[8];
#pragma unroll
            for (int b = 0; b < 8; ++b) a[b] = 0.f;
            const float* sp = src + (size_t)(wv * 128) * stride + lane;
#pragma unroll 8
            for (int k = 0; k < 128; ++k) {
                const float w = sp[(size_t)k * stride];
                const f32x4 c0v = *(const f32x4*)(cact + (wv * 128 + k) * 8), c1v = *(const f32x4*)(cact + (wv * 128 + k) * 8 + 4);
                a[0] += w * c0v[0]; a[1] += w * c0v[1]; a[2] += w * c0v[2]; a[3] += w * c0v[3];
                a[4] += w * c1v[0]; a[5] += w * c1v[1]; a[6] += w * c1v[2]; a[7] += w * c1v[3];
            }
#pragma unroll
            for (int b = 0; b < 8; ++b) red[(wv * 8 + b) * 64 + lane] = a[b];
            __syncthreads();
            {
                const int b = tid >> 6, col = tid & 63;
                float s = bias[col];
#pragma unroll
                for (int w = 0; w < 8; ++w) s += red[(w * 8 + b) * 64 + col];
                dst[(size_t)b * dstride + col] = s;
            }
        }
        __syncthreads();
    }
    for (int i = blockIdx.x * 512 + tid; i < 1024; i += gridDim.x * 512) {
        const float a0 = p.in[10][i], a1 = p.in[10][1024 + i];
        const float mx = fmaxf(a0, a1), e0 = __expf(a0 - mx), e1 = __expf(a1 - mx);
        ((float*)(p.ws + OFF_LBV))[i] = 0.f; ((float*)(p.ws + OFF_LBV))[1024 + i] = e1 / (e0 + e1);
    }
    conv_group(p.in[8], (bf16_t*)(p.ws + OFF_WB_A_IN), D, AIN, 2, 0, shm, tid);
    conv_group(p.in[9], (bf16_t*)(p.ws + OFF_WB_A_OUT), D, D, 2, 0, shm, tid);
    conv_group(p.in[6], (bf16_t*)(p.ws + OFF_WB_FFN_IN), D, 2 * FFN, 4, 1, shm, tid);
    conv_group(p.in[7], (bf16_t*)(p.ws + OFF_WB_FFN_OUT), FFN, D, 4, 0, shm, tid);
    conv_group(p.in[15], (bf16_t*)(p.ws + OFF_WB_KV), D, 2 * D, 1, 0, shm, tid);
    conv_group(p.in[16], (bf16_t*)(p.ws + OFF_WB_Q), D, D, 2, 0, shm, tid);
    conv_group(p.in[17], (bf16_t*)(p.ws + OFF_WB_O), D, D, 2, 0, shm, tid);
    __syncthreads();
}

__device__ void norm_phase(const float* src, bf16_t* U1, const float* gain1, const float* sh1, const float* sc1, int bs1,
                           bf16_t* U2, const float* gain2, const float* sh2, const float* sc2, int bs2) {
    const int tid_ = opaque_tid(); const int lane = tid_ & 63, gw = blockIdx.x * 8 + (tid_ >> 6), nw = gridDim.x * 8;
    for (int row = 2 * gw; row < MTOK; row += 2 * nw) {
        const int b = row >> 13;
        const float* xp = src + (size_t)row * D;
        f32x4 xv[2][4]; float ss[2] = {0.f, 0.f};
#pragma unroll
        for (int r = 0; r < 2; ++r)
#pragma unroll
            for (int i = 0; i < 4; ++i) xv[r][i] = *(const f32x4*)(xp + (size_t)r * D + i * 256 + lane * 4);
#pragma unroll
        for (int r = 0; r < 2; ++r)
#pragma unroll
            for (int i = 0; i < 4; ++i) ss[r] += xv[r][i][0] * xv[r][i][0] + xv[r][i][1] * xv[r][i][1] + xv[r][i][2] * xv[r][i][2] + xv[r][i][3] * xv[r][i][3];
#pragma unroll
        for (int o = 1; o < 64; o <<= 1) { ss[0] += __shfl_xor(ss[0], o); ss[1] += __shfl_xor(ss[1], o); }
        const float rstd0 = rsqrtf(ss[0] * (1.0f / D) + 1e-6f), rstd1 = rsqrtf(ss[1] * (1.0f / D) + 1e-6f);
#pragma unroll
        for (int i = 0; i < 4; ++i) {
            const int k = i * 256 + lane * 4;
            const f32x4 g = *(const f32x4*)(gain1 + k), s = *(const f32x4*)(sc1 + (size_t)b * bs1 + k), t = *(const f32x4*)(sh1 + (size_t)b * bs1 + k);
            f32x4 u0, u1;
#pragma unroll
            for (int j = 0; j < 4; ++j) { const float ga = g[j] * (1.0f + s[j]); u0[j] = (xv[0][i][j] * rstd0) * ga + t[j]; u1[j] = (xv[1][i][j] * rstd1) * ga + t[j]; }
            u32x2 w0, w1; w0.x = cvt_pk_bf16(u0[0], u0[1]); w0.y = cvt_pk_bf16(u0[2], u0[3]); w1.x = cvt_pk_bf16(u1[0], u1[1]); w1.y = cvt_pk_bf16(u1[2], u1[3]);
            *(u32x2*)(U1 + (size_t)row * D + k) = w0; *(u32x2*)(U1 + (size_t)(row + 1) * D + k) = w1;
        }
        if (U2) {
#pragma unroll
            for (int i = 0; i < 4; ++i) {
                const int k = i * 256 + lane * 4;
                const f32x4 g = *(const f32x4*)(gain2 + k), s = *(const f32x4*)(sc2 + (size_t)b * bs2 + k), t = *(const f32x4*)(sh2 + (size_t)b * bs2 + k);
                f32x4 u0, u1;
#pragma unroll
                for (int j = 0; j < 4; ++j) { const float ga = g[j] * (1.0f + s[j]); u0[j] = (xv[0][i][j] * rstd0) * ga + t[j]; u1[j] = (xv[1][i][j] * rstd1) * ga + t[j]; }
                u32x2 w0, w1; w0.x = cvt_pk_bf16(u0[0], u0[1]); w0.y = cvt_pk_bf16(u0[2], u0[3]); w1.x = cvt_pk_bf16(u1[0], u1[1]); w1.y = cvt_pk_bf16(u1[2], u1[3]);
                *(u32x2*)(U2 + (size_t)row * D + k) = w0; *(u32x2*)(U2 + (size_t)(row + 1) * D + k) = w1;
            }
        }
    }
}
__device__ void final_norm_phase(float* h, const float* gain) {
    const int tid_ = opaque_tid(); const int lane = tid_ & 63, gw = blockIdx.x * 8 + (tid_ >> 6), nw = gridDim.x * 8;
    for (int row = gw; row < MTOK; row += nw) {
        float* xp = h + (size_t)row * D;
        f32x4 xv[4]; float ss = 0.f;
#pragma unroll
        for (int i = 0; i < 4; ++i) { xv[i] = *(const f32x4*)(xp + i * 256 + lane * 4); ss += xv[i][0] * xv[i][0] + xv[i][1] * xv[i][1] + xv[i][2] * xv[i][2] + xv[i][3] * xv[i][3]; }
#pragma unroll
        for (int o = 1; o < 64; o <<= 1) ss += __shfl_xor(ss, o);
        const float rstd = rsqrtf(ss * (1.0f / D) + 1e-6f);
#pragma unroll
        for (int i = 0; i < 4; ++i) {
            const int k = i * 256 + lane * 4;
            const f32x4 g = *(const f32x4*)(gain + k);
            f32x4 u;
#pragma unroll
            for (int j = 0; j < 4; ++j) u[j] = xv[i][j] * rstd * g[j];
            *(f32x4*)(xp + k) = u;
        }
    }
}

template <bool OUT>
__device__ void rec_pass(const Params& p, int layer, unsigned char* shm) {
    float* sB = (float*)shm;
    float* sKm = (float*)(shm + 33792);
    bf16_t* sST = (bf16_t*)shm;
    bf16_t* sQb = (bf16_t*)(shm + 67584);
    bf16_t* sA = (bf16_t*)(shm + 84992);
    bf16_t* sKT = (bf16_t*)(shm + 94208);
    bf16_t* sVT = (bf16_t*)(shm + 112640);
    float* sE = (float*)(shm + 131072);
    float* sPart = (float*)(shm + 131584);
    float* sNrm = (float*)(shm + 135680);
    const int tid = opaque_tid(), lane = tid & 63, w = tid >> 6, fr = lane & 15, fq = lane >> 4;
    const int wi = w >> 1, wh = w & 1;
    const int ntask = OUT ? 256 : 192;
    const float* ogain = p.in[11] + layer * 128;
    for (int task = blockIdx.x; task < ntask; task += gridDim.x) {
        int sc, bh; if (OUT) { sc = task & 3; bh = task >> 2; } else { sc = task % 3; bh = task / 3; }
        const int b = bh >> 3, h = bh & 7;
        const size_t hoff = (size_t)b * SEQ * 896 + (size_t)h * SEQ * 128;
        f32x4 S[8];
#pragma unroll
        for (int db = 0; db < 8; ++db) S[db] = (f32x4){0.f, 0.f, 0.f, 0.f};
        if (OUT) {
            for (int s2 = 0; s2 < sc; ++s2) {
                const float* sl = ((float*)(p.ws + OFF_SLOC)) + (size_t)(bh * 4 + s2) * 16384; const float* dl = ((float*)(p.ws + OFF_DLOG)) + (bh * 4 + s2) * 128;
#pragma unroll
                for (int db = 0; db < 8; ++db) {
                    const f32x4 x = *(const f32x4*)(sl + ((w * 8 + db) * 64 + lane) * 4), dv = *(const f32x4*)(dl + 16 * db + fq * 4);
#pragma unroll
                    for (int j = 0; j < 4; ++j) S[db][j] = S[db][j] * __expf(dv[j]) + x[j];
                }
            }
        }
        float dlacc = 0.f;
        unsigned lfn[8]; u32x4 vn0, vn1;
        const bf16_t* LFb = (const bf16_t*)(p.ws + OFF_LF);
        const int d2 = (tid & 63) * 2, tq = tid >> 6;
        {
            const size_t r0 = (size_t)b * SEQ + (size_t)(sc * 32) * 64;
            const bf16_t* lp = LFb + (r0 + 8 * tq) * 128 + hoff + d2;
#pragma unroll
            for (int e = 0; e < 8; ++e) lfn[e] = *(const unsigned*)(lp + (size_t)e * 128);
            vn0 = *(const u32x4*)(((bf16_t*)(p.ws + OFF_VH)) + (r0 + (tid & 63)) * 128 + hoff + (tid >> 6) * 8);
            vn1 = *(const u32x4*)(((bf16_t*)(p.ws + OFF_VH)) + (r0 + (tid & 63)) * 128 + hoff + 64 + (tid >> 6) * 8);
        }
        for (int ch = sc * 32; ch < sc * 32 + 32; ++ch) {
            const size_t row0 = (size_t)b * SEQ + (size_t)ch * 64;
            float la[8], lb2[8];
#pragma unroll
            for (int e = 0; e < 8; ++e) { la[e] = bflo(lfn[e]); lb2[e] = bfhi(lfn[e]); }
            const u32x4 vr0 = vn0, vr1 = vn1;
            u32x4 qraw[4]; u32x2 graw[4];
            if (OUT) {
#pragma unroll
                for (int ks = 0; ks < 4; ++ks) qraw[ks] = *(const u32x4*)(((bf16_t*)(p.ws + OFF_QH)) + (row0 + 16 * wi + fr) * 128 + hoff + ks * 32 + fq * 8);
#pragma unroll
                for (int vb = 0; vb < 4; ++vb) graw[vb] = *(const u32x2*)(((bf16_t*)(p.ws + OFF_GH)) + (row0 + 16 * wi + fr) * 128 + hoff + 64 * wh + 16 * vb + fq * 4);
            }
            {
                float ra = 0.f, rb = 0.f, ka[8], kb2[8];
#pragma unroll
                for (int e = 0; e < 8; ++e) {
                    ka[e] = 1.0f - __expf(la[e]); kb2[e] = 1.0f - __expf(lb2[e]);
                    *(f32x2*)(sKm + (8 * tq + e) * 132 + d2) = (f32x2){ka[e], kb2[e]};
                    ra += la[e]; la[e] = ra; rb += lb2[e]; lb2[e] = rb;
                }
                *(f32x2*)(sPart + tq * 128 + d2) = (f32x2){ra, rb};
                {
                    const int s_ = tid & 63, pc = tid >> 6;
#pragma unroll
                    for (int e = 0; e < 8; ++e) {
                        sVT[(pc * 8 + e) * 72 + s_] = (bf16_t)((e & 1) ? (vr0[e >> 1] >> 16) : (vr0[e >> 1] & 0xffffu));
                        sVT[(64 + pc * 8 + e) * 72 + s_] = (bf16_t)((e & 1) ? (vr1[e >> 1] >> 16) : (vr1[e >> 1] & 0xffffu));
                    }
                }
                __syncthreads();
                float offa = 0.f, offb = 0.f, tota = 0.f, totb = 0.f;
#pragma unroll
                for (int q = 0; q < 8; ++q) { const f32x2 pq = *(const f32x2*)(sPart + q * 128 + d2); tota += pq[0]; totb += pq[1]; if (q < tq) { offa += pq[0]; offb += pq[1]; } }
                if (tq == 0) { *(f32x2*)(sE + d2) = (f32x2){__expf(tota), __expf(totb)}; }
                u32x4 kwa, kwb;
#pragma unroll
                for (int e = 0; e < 8; e += 2) {
                    const float a0 = la[e] + offa, a1 = la[e + 1] + offa, b0 = lb2[e] + offb, b1 = lb2[e + 1] + offb;
                    *(f32x2*)(sB + (8 * tq + e) * 132 + d2) = (f32x2){a0, b0}; *(f32x2*)(sB + (8 * tq + e + 1) * 132 + d2) = (f32x2){a1, b1};
                    kwa[e >> 1] = cvt_pk_bf16(ka[e] * __expf(tota - a0), ka[e + 1] * __expf(tota - a1));
                    kwb[e >> 1] = cvt_pk_bf16(kb2[e] * __expf(totb - b0), kb2[e + 1] * __expf(totb - b1));
                }
                *(u32x4*)(sKT + d2 * 72 + 8 * tq) = kwa; *(u32x4*)(sKT + (d2 + 1) * 72 + 8 * tq) = kwb;
            }
            __syncthreads();
            if (ch + 1 < sc * 32 + 32) {
                const size_t r1 = row0 + 64;
                const bf16_t* lp = LFb + (r1 + 8 * tq) * 128 + hoff + d2;
#pragma unroll
                for (int e = 0; e < 8; ++e) lfn[e] = *(const unsigned*)(lp + (size_t)e * 128);
                vn0 = *(const u32x4*)(((bf16_t*)(p.ws + OFF_VH)) + (r1 + (tid & 63)) * 128 + hoff + (tid >> 6) * 8);
                vn1 = *(const u32x4*)(((bf16_t*)(p.ws + OFF_VH)) + (r1 + (tid & 63)) * 128 + hoff + 64 + (tid >> 6) * 8);
            }
            if (OUT) {
                const int i = wi, hh = wh, t_ = 16 * i + fr;
                bf16x8 qt[4];
#pragma unroll
                for (int ks = 0; ks < 4; ++ks) {
                    const int d0 = ks * 32 + fq * 8;
                    const f32x4 b0 = *(const f32x4*)(sB + t_ * 132 + d0), b1 = *(const f32x4*)(sB + t_ * 132 + d0 + 4);
                    f32x4 r0 = (f32x4){0.f, 0.f, 0.f, 0.f}, r1 = r0;
                    if (i > 0) { r0 = *(const f32x4*)(sB + (16 * i - 1) * 132 + d0); r1 = *(const f32x4*)(sB + (16 * i - 1) * 132 + d0 + 4); }
                    float qv[8], ql[8];
#pragma unroll
                    for (int e = 0; e < 4; ++e) { qv[2 * e] = bflo(qraw[ks][e]); qv[2 * e + 1] = bfhi(qraw[ks][e]); }
#pragma unroll
                    for (int e = 0; e < 4; ++e) { ql[e] = qv[e] * __expf(b0[e] - r0[e]); ql[4 + e] = qv[4 + e] * __expf(b1[e] - r1[e]); }
                    u32x4 pw; pw.x = cvt_pk_bf16(ql[0], ql[1]); pw.y = cvt_pk_bf16(ql[2], ql[3]); pw.z = cvt_pk_bf16(ql[4], ql[5]); pw.w = cvt_pk_bf16(ql[6], ql[7]);
                    qt[ks] = __builtin_bit_cast(bf16x8, pw);
                    if ((ks >> 1) == hh) {
#pragma unroll
                        for (int e = 0; e < 4; ++e) { ql[e] = qv[e] * __expf(b0[e]); ql[4 + e] = qv[4 + e] * __expf(b1[e]); }
                        u32x4 qw; qw.x = cvt_pk_bf16(ql[0], ql[1]); qw.y = cvt_pk_bf16(ql[2], ql[3]); qw.z = cvt_pk_bf16(ql[4], ql[5]); qw.w = cvt_pk_bf16(ql[6], ql[7]);
                        *(u32x4*)(sQb + t_ * 136 + d0) = qw;
                    }
                }
#pragma unroll
                for (int j2 = 0; j2 < 2; ++j2) {
                    const int j = hh + 2 * j2;
                    if (j <= i) {
                        f32x4 acc = (f32x4){0.f, 0.f, 0.f, 0.f};
                        const int s_ = 16 * j + fr;
#pragma unroll
                        for (int ks = 0; ks < 4; ++ks) {
                            const int d0 = ks * 32 + fq * 8;
                            const f32x4 k0 = *(const f32x4*)(sKm + s_ * 132 + d0), k1 = *(const f32x4*)(sKm + s_ * 132 + d0 + 4);
                            const f32x4 b0 = *(const f32x4*)(sB + s_ * 132 + d0), b1 = *(const f32x4*)(sB + s_ * 132 + d0 + 4);
                            f32x4 r0 = (f32x4){0.f, 0.f, 0.f, 0.f}, r1 = r0;
                            if (i > 0) { r0 = *(const f32x4*)(sB + (16 * i - 1) * 132 + d0); r1 = *(const f32x4*)(sB + (16 * i - 1) * 132 + d0 + 4); }
                            float kl[8];
#pragma unroll
                            for (int e = 0; e < 4; ++e) { kl[e] = k0[e] * __expf(fminf(r0[e] - b0[e], 80.f)); kl[4 + e] = k1[e] * __expf(fminf(r1[e] - b1[e], 80.f)); }
                            u32x4 kw; kw.x = cvt_pk_bf16(kl[0], kl[1]); kw.y = cvt_pk_bf16(kl[2], kl[3]); kw.z = cvt_pk_bf16(kl[4], kl[5]); kw.w = cvt_pk_bf16(kl[6], kl[7]);
                            acc = __builtin_amdgcn_mfma_f32_16x16x32_bf16(qt[ks], __builtin_bit_cast(bf16x8, kw), acc, 0, 0, 0);
                        }
#pragma unroll
                        for (int jj = 0; jj < 4; ++jj) {
                            float vv = acc[jj];
                            if (i == j && fr > fq * 4 + jj) vv = 0.f;
                            sA[(16 * i + fq * 4 + jj) * 72 + 16 * j + fr] = (bf16_t)(cvt_pk_bf16(vv, 0.f) & 0xffffu);
                        }
                    } else {
#pragma unroll
                        for (int jj = 0; jj < 4; ++jj) sA[(16 * i + fq * 4 + jj) * 72 + 16 * j + fr] = (bf16_t)0;
                    }
                }
            }
            __syncthreads();
            if (OUT) {
#pragma unroll
                for (int db = 0; db < 8; ++db) { u32x2 sw; sw.x = cvt_pk_bf16(S[db][0], S[db][1]); sw.y = cvt_pk_bf16(S[db][2], S[db][3]); *(u32x2*)(sST + (16 * w + fr) * 136 + 16 * db + fq * 4) = sw; }
                __syncthreads();
            }
            f32x4 o[4];
            if (OUT) {
                const int i = wi;
#pragma unroll
                for (int vb = 0; vb < 4; ++vb) o[vb] = (f32x4){0.f, 0.f, 0.f, 0.f};
#pragma unroll
                for (int kk = 0; kk < 2; ++kk) {
                    if (kk <= (i >> 1)) {
                        const bf16x8 af = *(const bf16x8*)(sA + (16 * i + fr) * 72 + kk * 32 + fq * 8);
#pragma unroll
                        for (int vb = 0; vb < 4; ++vb) { const bf16x8 vf = *(const bf16x8*)(sVT + (64 * wh + 16 * vb + fr) * 72 + kk * 32 + fq * 8); o[vb] = __builtin_amdgcn_mfma_f32_16x16x32_bf16(vf, af, o[vb], 0, 0, 0); }
                    }
                }
#pragma unroll
                for (int ks = 0; ks < 4; ++ks) {
                    const bf16x8 qf = *(const bf16x8*)(sQb + (16 * i + fr) * 136 + ks * 32 + fq * 8);
#pragma unroll
                    for (int vb = 0; vb < 4; ++vb) { const bf16x8 sf = *(const bf16x8*)(sST + (64 * wh + 16 * vb + fr) * 136 + ks * 32 + fq * 8); o[vb] = __builtin_amdgcn_mfma_f32_16x16x32_bf16(sf, qf, o[vb], 0, 0, 0); }
                }
                float ss = 0.f;
#pragma unroll
                for (int vb = 0; vb < 4; ++vb)
#pragma unroll
                    for (int jj = 0; jj < 4; ++jj) ss += o[vb][jj] * o[vb][jj];
                ss += __shfl_xor(ss, 16); ss += __shfl_xor(ss, 32);
                if (fq == 0) sNrm[wh * 64 + 16 * i + fr] = ss;
            }
#pragma unroll
            for (int db = 0; db < 8; ++db) { const f32x4 e4 = *(const f32x4*)(sE + 16 * db + fq * 4); S[db] = S[db] * e4; }
#pragma unroll
            for (int ks = 0; ks < 2; ++ks) {
                const bf16x8 vf = *(const bf16x8*)(sVT + (16 * w + fr) * 72 + ks * 32 + fq * 8);
#pragma unroll
                for (int db = 0; db < 8; ++db) { const bf16x8 kf = *(const bf16x8*)(sKT + (16 * db + fr) * 72 + ks * 32 + fq * 8); S[db] = __builtin_amdgcn_mfma_f32_16x16x32_bf16(kf, vf, S[db], 0, 0, 0); }
            }
            __syncthreads();
            if (OUT) {
                const int i = wi;
                const float tot = sNrm[16 * i + fr] + sNrm[64 + 16 * i + fr];
                const float rstd = rsqrtf(tot * (1.0f / 128.0f) + 1e-6f);
                bf16_t* op = ((bf16_t*)((unsigned char*)p.h)) + (row0 + 16 * i + fr) * D + h * 128 + 64 * wh + fq * 4;
#pragma unroll
                for (int vb = 0; vb < 4; ++vb) {
                    const f32x4 gn = *(const f32x4*)(ogain + 64 * wh + 16 * vb + fq * 4);
                    const float g0 = bflo(graw[vb].x), g1 = bfhi(graw[vb].x), g2 = bflo(graw[vb].y), g3 = bfhi(graw[vb].y);
                    u32x2 ow; ow.x = cvt_pk_bf16(o[vb][0] * rstd * gn[0] * g0, o[vb][1] * rstd * gn[1] * g1); ow.y = cvt_pk_bf16(o[vb][2] * rstd * gn[2] * g2, o[vb][3] * rstd * gn[3] * g3);
                    *(u32x2*)(op + 16 * vb) = ow;
                }
            }
        }
        if (!OUT) {
            float* sl = ((float*)(p.ws + OFF_SLOC)) + (size_t)(bh * 4 + sc) * 16384;
#pragma unroll
            for (int db = 0; db < 8; ++db) *(f32x4*)(sl + ((w * 8 + db) * 64 + lane) * 4) = S[db];
            if (tid < 128) ((float*)(p.ws + OFF_DLOG))[(bh * 4 + sc) * 128 + tid] = dlacc;
        }
    }
    __syncthreads();
}

__device__ void rec_passA(const Params& p, unsigned char* shm) {
    bf16_t* sKT = (bf16_t*)shm;
    bf16_t* sVT = (bf16_t*)(shm + 34816);
    float* sE = (float*)(shm + 69632);
    float* sPart = (float*)(shm + 70144);
    const int tid = opaque_tid(), lane = tid & 63, w = tid >> 6, fr = lane & 15, fq = lane >> 4;
    const int d2 = (tid & 63) * 2, tq = tid >> 6;
    const int vs = tid & 127, vq = tid >> 7;
    const bf16_t* LFb = (const bf16_t*)(p.ws + OFF_LF); const bf16_t* Vp = (const bf16_t*)(p.ws + OFF_VH);
    for (int task = blockIdx.x; task < 192; task += gridDim.x) {
        const int sc = task % 3, bh = task / 3, b = bh >> 3, h = bh & 7;
        const size_t hoff = (size_t)b * SEQ * 896 + (size_t)h * SEQ * 128;
        f32x4 S[8];
#pragma unroll
        for (int db = 0; db < 8; ++db) S[db] = (f32x4){0.f, 0.f, 0.f, 0.f};
        float dla = 0.f, dlb = 0.f;
        const size_t rbase = (size_t)b * SEQ + (size_t)sc * 2048;
        unsigned lfn[16]; u32x4 vn[4];
        {
            const bf16_t* lp = LFb + (rbase + 16 * tq) * 128 + hoff + d2;
#pragma unroll
            for (int e = 0; e < 16; ++e) lfn[e] = *(const unsigned*)(lp + (size_t)e * 128);
#pragma unroll
            for (int i = 0; i < 4; ++i) vn[i] = *(const u32x4*)(Vp + (rbase + vs) * 128 + hoff + (vq + 4 * i) * 8);
        }
        __syncthreads();
        for (int cc = 0; cc < 16; ++cc) {
            const size_t row0 = rbase + (size_t)cc * 128;
            unsigned lf[16]; u32x4 vr[4];
            float ra = 0.f, rb = 0.f;
#pragma unroll
            for (int e = 0; e < 16; ++e) { lf[e] = lfn[e]; ra += bflo(lf[e]); rb += bfhi(lf[e]); }
#pragma unroll
            for (int i = 0; i < 4; ++i) vr[i] = vn[i];
            *(f32x2*)(sPart + tq * 128 + d2) = (f32x2){ra, rb};
            __syncthreads();
            if (cc + 1 < 16) {
                const bf16_t* lp = LFb + (row0 + 128 + 16 * tq) * 128 + hoff + d2;
#pragma unroll
                for (int e = 0; e < 16; ++e) lfn[e] = *(const unsigned*)(lp + (size_t)e * 128);
#pragma unroll
                for (int i = 0; i < 4; ++i) vn[i] = *(const u32x4*)(Vp + (row0 + 128 + vs) * 128 + hoff + (vq + 4 * i) * 8);
            }
            float ba = 0.f, bb = 0.f, tota = 0.f, totb = 0.f;
#pragma unroll
            for (int q = 0; q < 8; ++q) { const f32x2 pq = *(const f32x2*)(sPart + q * 128 + d2); tota += pq[0]; totb += pq[1]; if (q < tq) { ba += pq[0]; bb += pq[1]; } }
            if (tq == 0) { *(f32x2*)(sE + d2) = (f32x2){__expf(tota), __expf(totb)}; dla += tota; dlb += totb; }
#pragma unroll
            for (int g8 = 0; g8 < 2; ++g8) {
                u32x4 kwa, kwb;
#pragma unroll
                for (int e = 0; e < 8; e += 2) {
                    const float la0 = bflo(lf[8 * g8 + e]), lb0 = bfhi(lf[8 * g8 + e]), la1 = bflo(lf[8 * g8 + e + 1]), lb1 = bfhi(lf[8 * g8 + e + 1]);
                    const float a0 = ba + la0, a1 = a0 + la1; ba = a1;
                    const float b0 = bb + lb0, b1 = b0 + lb1; bb = b1;
                    kwa[e >> 1] = cvt_pk_bf16((1.0f - __expf(la0)) * __expf(tota - a0), (1.0f - __expf(la1)) * __expf(tota - a1));
                    kwb[e >> 1] = cvt_pk_bf16((1.0f - __expf(lb0)) * __expf(totb - b0), (1.0f - __expf(lb1)) * __expf(totb - b1));
                }
                *(u32x4*)(sKT + d2 * 136 + 16 * tq + 8 * g8) = kwa; *(u32x4*)(sKT + (d2 + 1) * 136 + 16 * tq + 8 * g8) = kwb;
            }
#pragma unroll
            for (int i = 0; i < 4; ++i)
#pragma unroll
                for (int e = 0; e < 8; ++e) sVT[((vq + 4 * i) * 8 + e) * 136 + vs] = (bf16_t)((e & 1) ? (vr[i][e >> 1] >> 16) : (vr[i][e >> 1] & 0xffffu));
            __syncthreads();
#pragma unroll
            for (int db = 0; db < 8; ++db) { const f32x4 e4 = *(const f32x4*)(sE + 16 * db + fq * 4); S[db] = S[db] * e4; }
#pragma unroll
            for (int ks = 0; ks < 4; ++ks) {
                const bf16x8 vf = *(const bf16x8*)(sVT + (16 * w + fr) * 136 + ks * 32 + fq * 8);
#pragma unroll
                for (int db = 0; db < 8; ++db) { const bf16x8 kf = *(const bf16x8*)(sKT + (16 * db + fr) * 136 + ks * 32 + fq * 8); S[db] = __builtin_amdgcn_mfma_f32_16x16x32_bf16(kf, vf, S[db], 0, 0, 0); }
            }
        }
        float* sl = (float*)(p.ws + OFF_SLOC) + (size_t)(bh * 4 + sc) * 16384;
#pragma unroll
        for (int db = 0; db < 8; ++db) *(f32x4*)(sl + ((w * 8 + db) * 64 + lane) * 4) = S[db];
        if (tq == 0) *(f32x2*)((float*)(p.ws + OFF_DLOG) + (bh * 4 + sc) * 128 + d2) = (f32x2){dla, dlb};
    }
    __syncthreads();
}

__device__ void attn_phase(const Params& p, int jl, unsigned char* shm) {
    bf16_t* sK = (bf16_t*)shm;
    bf16_t* sVT = sK + 5 * 4608;
    float* sB = (float*)(sVT + 5 * 4608);
    const int tid = opaque_tid(), lane = tid & 63, w = tid >> 6, fr = lane & 15, fq = lane >> 4;
    const int cq = w >> 1, half = w & 1;
    const float LOG2E = 1.4426950408889634f;
    const int skey = tid >> 3, spiece = tid & 7, vkey = tid & 63, vpiece = tid >> 6;
    const bf16_t* Kg = (const bf16_t*)(p.ws + OFF_KB); const bf16_t* Vg = (const bf16_t*)(p.ws + OFF_VB); const bf16_t* Qg = (const bf16_t*)((unsigned char*)p.h + ACTB);
    for (int task = blockIdx.x; task < 4096; task += gridDim.x) {
        const int g = task & 31, h = (task >> 5) & 15, b = task >> 9;
        const int c = 4 * g + cq;
        __syncthreads();
        for (int i = tid; i < 384; i += 512) { int r = i - 64; r = r < 0 ? 0 : (r > 319 ? 319 : r); sB[i] = p.in[18][((size_t)jl * 320 + r) * 16 + h] * LOG2E; }
        bf16x8 qf[2][2];
        {
            const bf16_t* qp = Qg + ((size_t)b * SEQ + c * 64 + half * 32) * D + h * 64;
#pragma unroll
            for (int qb = 0; qb < 2; ++qb)
#pragma unroll
                for (int ks = 0; ks < 2; ++ks) qf[qb][ks] = *(const bf16x8*)(qp + (size_t)(qb * 16 + fr) * D + ks * 32 + fq * 8);
        }
        f32x4 oacc[4][2];
#pragma unroll
        for (int db = 0; db < 4; ++db)
#pragma unroll
            for (int qb = 0; qb < 2; ++qb) oacc[db][qb] = (f32x4){0.f, 0.f, 0.f, 0.f};
        float mrun[2] = {0.f, 0.f}, lrun[2] = {0.f, 0.f};
        bool first = true;
        const size_t tokb = (size_t)b * SEQ;
        const size_t hoffk = (size_t)b * SEQ * 960 + (size_t)h * SEQ * 64;
        u32x4 kreg, vreg;
#define ATT_GLOAD(kc_) do { kreg = *(const u32x4*)(Kg + (tokb + (size_t)(kc_) * 64 + skey) * 64 + hoffk + spiece * 8); \
                            vreg = *(const u32x4*)(Vg + (tokb + (size_t)(kc_) * 64 + skey) * 64 + hoffk + spiece * 8); } while (0)
#define ATT_LSTORE(kc_) do { const int sl_ = ((kc_) + 10) % 5; *(u32x4*)(sK + sl_ * 4608 + skey * 72 + spiece * 8) = kreg; \
                             *(u32x4*)(sVT + sl_ * 4608 + skey * 72 + spiece * 8) = vreg; } while (0)
        {
            u32x4 k4[4], v4[4];
#pragma unroll
            for (int j = 0; j < 4; ++j) { const int kc = 4 * g - 8 + j; if (kc >= 0) { ATT_GLOAD(kc); k4[j] = kreg; v4[j] = vreg; } }
#pragma unroll
            for (int j = 0; j < 4; ++j) { const int kc = 4 * g - 8 + j; if (kc >= 0) { kreg = k4[j]; vreg = v4[j]; ATT_LSTORE(kc); } }
        }
        __syncthreads();
        for (int i = 0; i < 9; ++i) {
            const int knew = 4 * g - 4 + i;
            const bool ld = (i < 8) && (knew >= 0);
            if (ld) ATT_GLOAD(knew);
            const int kt = c - 8 + i;
            if (kt >= 0) {
                const int sl = (kt + 10) % 5, dk = i - 8;
                const bf16_t* kb_ = sK + sl * 4608; const bf16_t* vb_ = sVT + sl * 4608;
                f32x4 sacc[4][2];
                const float cb = (dk <= -5) ? sB[0] : 0.f;
                bf16x8 kfr[4][2];
#pragma unroll
                for (int kb = 0; kb < 4; ++kb)
#pragma unroll
                    for (int ks = 0; ks < 2; ++ks) kfr[kb][ks] = *(const bf16x8*)(kb_ + (kb * 16 + fr) * 72 + ks * 32 + fq * 8);
                __builtin_amdgcn_s_setprio(1);
#pragma unroll
                for (int qb = 0; qb < 2; ++qb) {
                    const float iv = cb - mrun[qb];
#pragma unroll
                    for (int kb = 0; kb < 4; ++kb) sacc[kb][qb] = (f32x4){iv, iv, iv, iv};
#pragma unroll
                    for (int ks = 0; ks < 2; ++ks)
#pragma unroll
                        for (int kb = 0; kb < 4; ++kb) sacc[kb][qb] = __builtin_amdgcn_mfma_f32_16x16x32_bf16(kfr[kb][ks], qf[qb][ks], sacc[kb][qb], 0, 0, 0);
                }
                __builtin_amdgcn_s_setprio(0);
                const unsigned va = (unsigned)((const unsigned char*)vb_ - shm) + (unsigned)(((fq * 4 + (fr >> 2)) * 72 + (fr & 3) * 4) * 2);
                u32x2 lo0[4], hi0[4], lo1[4], hi1[4];
#define ATT_TR8(o0, o1, b0, b1) asm volatile( \
                    "ds_read_b64_tr_b16 %0, %8 offset:" #b0 "\n\tds_read_b64_tr_b16 %1, %8 offset:" #b0 "+32\n\tds_read_b64_tr_b16 %2, %8 offset:" #b0 "+64\n\tds_read_b64_tr_b16 %3, %8 offset:" #b0 "+96\n\t" \
                    "ds_read_b64_tr_b16 %4, %8 offset:" #b1 "\n\tds_read_b64_tr_b16 %5, %8 offset:" #b1 "+32\n\tds_read_b64_tr_b16 %6, %8 offset:" #b1 "+64\n\tds_read_b64_tr_b16 %7, %8 offset:" #b1 "+96\n\t" \
                    "s_waitcnt lgkmcnt(0)" : "=&v"(o0[0]), "=&v"(o0[1]), "=&v"(o0[2]), "=&v"(o0[3]), "=&v"(o1[0]), "=&v"(o1[1]), "=&v"(o1[2]), "=&v"(o1[3]) : "v"(va) : "memory")
                ATT_TR8(lo0, hi0, 0, 2304);
                ATT_TR8(lo1, hi1, 4608, 6912);
#undef ATT_TR8
                const float* bp = sB + (dk * 64 + fq * 4 - half * 32 - fr + 256 + 64 - 16);
                bool didre = false;
#pragma unroll
                for (int qb = 0; qb < 2; ++qb) {
                    if (dk > -5) {
#pragma unroll
                        for (int kb = 0; kb < 4; ++kb)
#pragma unroll
                            for (int j = 0; j < 4; ++j) sacc[kb][qb][j] += bp[kb * 16 + j - qb * 16 + 16];
                    }
                    float mx = -3e38f;
#pragma unroll
                    for (int kb = 0; kb < 4; ++kb)
#pragma unroll
                        for (int j = 0; j < 4; ++j) mx = fmaxf(mx, sacc[kb][qb][j]);
                    if (first || __any(mx > 6.0f)) {
                        float m2 = fmaxf(mx, __shfl_xor(mx, 16)); m2 = fmaxf(m2, __shfl_xor(m2, 32));
                        const float delta = first ? m2 : fmaxf(m2, 0.f), corr = first ? 1.0f : __builtin_amdgcn_exp2f(-delta);
                        mrun[qb] += delta; lrun[qb] *= corr;
#pragma unroll
                        for (int db = 0; db < 4; ++db) oacc[db][qb] = oacc[db][qb] * corr;
#pragma unroll
                        for (int kb = 0; kb < 4; ++kb) sacc[kb][qb] = sacc[kb][qb] - delta;
                        didre = true;
                    }
                    float ps = 0.f;
#pragma unroll
                    for (int kb = 0; kb < 4; ++kb)
#pragma unroll
                        for (int j = 0; j < 4; ++j) { const float pv = __builtin_amdgcn_exp2f(sacc[kb][qb][j]); sacc[kb][qb][j] = pv; ps += pv; }
                    lrun[qb] += ps;
                    bf16x8 pf0, pf1;
                    {
                        u32x4 pw;
                        pw.x = cvt_pk_bf16(sacc[0][qb][0], sacc[0][qb][1]); pw.y = cvt_pk_bf16(sacc[0][qb][2], sacc[0][qb][3]);
                        pw.z = cvt_pk_bf16(sacc[1][qb][0], sacc[1][qb][1]); pw.w = cvt_pk_bf16(sacc[1][qb][2], sacc[1][qb][3]);
                        pf0 = __builtin_bit_cast(bf16x8, pw);
                        pw.x = cvt_pk_bf16(sacc[2][qb][0], sacc[2][qb][1]); pw.y = cvt_pk_bf16(sacc[2][qb][2], sacc[2][qb][3]);
                        pw.z = cvt_pk_bf16(sacc[3][qb][0], sacc[3][qb][1]); pw.w = cvt_pk_bf16(sacc[3][qb][2], sacc[3][qb][3]);
                        pf1 = __builtin_bit_cast(bf16x8, pw);
                    }
                    __builtin_amdgcn_s_setprio(1);
#pragma unroll
                    for (int db = 0; db < 4; ++db) {
                        u32x4 vw; vw.x = lo0[db].x; vw.y = lo0[db].y; vw.z = hi0[db].x; vw.w = hi0[db].y;
                        oacc[db][qb] = __builtin_amdgcn_mfma_f32_16x16x32_bf16(__builtin_bit_cast(bf16x8, vw), pf0, oacc[db][qb], 0, 0, 0);
                    }
#pragma unroll
                    for (int db = 0; db < 4; ++db) {
                        u32x4 vw; vw.x = lo1[db].x; vw.y = lo1[db].y; vw.z = hi1[db].x; vw.w = hi1[db].y;
                        oacc[db][qb] = __builtin_amdgcn_mfma_f32_16x16x32_bf16(__builtin_bit_cast(bf16x8, vw), pf1, oacc[db][qb], 0, 0, 0);
                    }
                    __builtin_amdgcn_s_setprio(0);
                }
                first = false;
                (void)didre;
            }
            if (ld) ATT_LSTORE(knew);
            __syncthreads();
        }
#undef ATT_GLOAD
#undef ATT_LSTORE
#pragma unroll
        for (int qb = 0; qb < 2; ++qb) {
            float lt = lrun[qb]; lt += __shfl_xor(lt, 16); lt += __shfl_xor(lt, 32);
            const float inv = 1.0f / lt;
            bf16_t* op = (bf16_t*)((unsigned char*)p.h) + (tokb + c * 64 + half * 32 + qb * 16 + fr) * D + h * 64 + fq * 4;
#pragma unroll
            for (int db = 0; db < 4; ++db) {
                u32x2 ow; ow.x = cvt_pk_bf16(oacc[db][qb][0] * inv, oacc[db][qb][1] * inv); ow.y = cvt_pk_bf16(oacc[db][qb][2] * inv, oacc[db][qb][3] * inv);
                *(u32x2*)(op + db * 16) = ow;
            }
        }
    }
    __syncthreads();
}

#ifndef REP_ATTN
#define REP_ATTN 1
#endif
#ifndef REP_REC
#define REP_REC 1
#endif
#ifndef REP_NORM
#define REP_NORM 1
#endif
#ifndef REP_SYNC
#define REP_SYNC 1
#endif
#ifndef REP_PREP
#define REP_PREP 1
#endif
#ifndef REP_G3
#define REP_G3 1
#endif
#define GSYNC() do { for (int r_ = 0; r_ < REP_SYNC; ++r_) xcd_barrier(xb); } while (0)
__global__ void __launch_bounds__(512, 2) yoco_fwd(Params p) {
    extern __shared__ __attribute__((aligned(16))) unsigned char shm[];
    cg::grid_group grid = cg::this_grid();
    {
        const int t0 = threadIdx.x;
        if ((t0 & 63) == 0) *(volatile LAS int*)(LAS unsigned char*)(shm + WAVE_TAB_OFF + 4 * hw_wave_slot()) = t0 >> 6;
        __syncthreads();
    }
    const int tid0 = opaque_tid();
    unsigned* barw = (unsigned*)(p.ws + OFF_BAR);
    for (int i = blockIdx.x * 512 + tid0; i < XCD_BAR_WORDS; i += gridDim.x * 512) barw[i] = 0u;
    {
        u32x4* z = (u32x4*)(p.ws + OFF_ROWSS); const int nz = (int)((8 * (size_t)MTOK * 8) / 16);
        for (int i = blockIdx.x * 512 + tid0; i < nz; i += gridDim.x * 512) z[i] = (u32x4){0u, 0u, 0u, 0u};
    }
    volatile LAS unsigned* xst = (volatile LAS unsigned*)(LAS unsigned char*)(shm + LDS_BYTES - 16);
    if (tid0 == 0) { xst[0] = 0u; xst[1] = 0u; }
    for (int r = 0; r < REP_PREP; ++r) prep_phase(p, shm);
    grid.sync();
    XcdBarrier xb = xcd_barrier_post(barw, xst);
    {
        const float* mv = (const float*)(p.ws + OFF_MODV);
        for (int r = 0; r < REP_NORM; ++r) norm_phase(p.in[0], (bf16_t*)((unsigned char*)p.h), p.in[4], mv, mv + D, 6144, nullptr, nullptr, nullptr, nullptr, 0);
    }
    GSYNC();
    for (int l = 0; l < 4; ++l) {
        const float* hsrc = (l == 0) ? p.in[0] : p.h;
        const float* mv = (const float*)(p.ws + OFF_MODV) + (size_t)l * 8 * 6144;
        bf16_t* UF = (l < 2) ? (bf16_t*)(p.ws + OFF_UF_A) : (bf16_t*)((unsigned char*)p.h + ACTB);
        if (l < 2) {
            pg8::EpiHgrnIn e; e.QVG = (bf16_t*)(p.ws + OFF_QH); e.LF = (bf16_t*)(p.ws + OFF_LF); e.lb = (const float*)(p.ws + OFF_LBV) + l * D;
            run_gemm(shm, (const bf16_t*)((unsigned char*)p.h), (const bf16_t*)(p.ws + OFF_WB_A_IN) + (size_t)l * AIN * D, AIN, D, e);
            GSYNC();
            for (int r = 0; r < REP_REC; ++r) rec_passA(p, shm);
            GSYNC();
            for (int r = 0; r < REP_REC; ++r) rec_pass<true>(p, l, shm);
        } else {
            if (l == 2) { pg8::EpiBf16Split e; e.d0 = (bf16_t*)(p.ws + OFF_KB); e.scale = 1.0f; e.hm = 1;
                run_gemm(shm, (const bf16_t*)(p.ws + OFF_QB), (const bf16_t*)(p.ws + OFF_WB_KV), 2048, D, e); }
            { pg8::EpiBf16Split e; e.d0 = (bf16_t*)((unsigned char*)p.h + ACTB); e.hm = 0; e.scale = 0.125f * 1.4426950408889634f;   run_gemm(shm, (const bf16_t*)((unsigned char*)p.h), (const bf16_t*)(p.ws + OFF_WB_Q) + (size_t)(l - 2) * D * D, D, D, e); }
            GSYNC();
            for (int r = 0; r < REP_ATTN; ++r) attn_phase(p, l - 2, shm);
        }
        GSYNC();
        {
            pg8::EpiResid e; e.in = p.in; e.ws = p.ws; e.hbuf = p.h; e.l = l; e.which = 0;
            e.fill_tables(shm, opaque_tid()); __syncthreads();
            run_gemm(shm, (const bf16_t*)((unsigned char*)p.h), (l < 2) ? (const bf16_t*)(p.ws + OFF_WB_A_OUT) + (size_t)l * D * D : (const bf16_t*)(p.ws + OFF_WB_O) + (size_t)(l - 2) * D * D, D, D, e);
        }
        GSYNC();
        for (int r = 0; r < REP_G3; ++r) { pg8::EpiSwiglu e; e.act = (bf16_t*)(p.ws + OFF_ACT); run_gemm(shm, UF, (const bf16_t*)(p.ws + OFF_WB_FFN_IN) + (size_t)l * 2 * FFN * D, 2 * FFN, D, e); }
        GSYNC();
        {
            pg8::EpiResid e; e.in = p.in; e.ws = p.ws; e.hbuf = p.h; e.l = l; e.which = 1;
            e.fill_tables(shm, opaque_tid()); __syncthreads();
            run_gemm(shm, (const bf16_t*)(p.ws + OFF_ACT), (const bf16_t*)(p.ws + OFF_WB_FFN_OUT) + (size_t)l * D * FFN, D, FFN, e);
        }
        if (l < 3) GSYNC();
    }
}

extern "C" void kernel_launch(void* const* d_in, const int* in_sizes, int n_in, void* d_out, int out_size, void* d_ws, size_t ws_size, hipStream_t stream) {
    static int grid_blocks = 0;
    if (!grid_blocks) {
        int dev = 0, cus = 0, per_cu = 0;
        hipGetDevice(&dev);
        hipDeviceGetAttribute(&cus, hipDeviceAttributeMultiprocessorCount, dev);
        hipFuncSetAttribute((const void*)yoco_fwd, hipFuncAttributeMaxDynamicSharedMemorySize, LDS_BYTES);
        hipOccupancyMaxActiveBlocksPerMultiprocessor(&per_cu, (const void*)yoco_fwd, 512, LDS_BYTES);
        if (per_cu < 1) per_cu = 1;
        grid_blocks = cus * per_cu;
        (void)hipGetLastError();
    }
    Params p{};
    for (int i = 0; i < 20; ++i) p.in[i] = (const float*)d_in[i];
    p.h = (float*)d_out; p.ws = (unsigned char*)d_ws;
    if (ws_size < WS_END || n_in != 20) { fprintf(stderr, "kernel_launch: workspace too small (%zu < %zu) or unexpected inputs\n", ws_size, (size_t)WS_END); return; }
    void* args[] = {&p};
    hipError_t e = hipLaunchCooperativeKernel((const void*)yoco_fwd, dim3(grid_blocks), dim3(512), args, LDS_BYTES, stream);
    if (e != hipSuccess) fprintf(stderr, "cooperative launch failed: %s (grid %d)\n", hipGetErrorString(e), grid_blocks);
}
```
